# Optimizing an MI355X kernel written in HIP

```python
import math
import jax, jax.numpy as jnp
from jax import lax
import numpy as np

D_MODEL = 1024
BATCH = 2
SEQ = 16384
DEPTH = 2

CHUNK = 64
D_MIX = D_MODEL
ATTN_WIDTH = D_MIX // 2
HEAD_DIM = 64
N_Q_HEADS = ATTN_WIDTH // HEAD_DIM
N_KV_HEADS = 2
GQA_GROUP = N_Q_HEADS // N_KV_HEADS
WINDOW = 128
WINDOW_CHUNKS = WINDOW // CHUNK
BAND = (WINDOW_CHUNKS + 1) * CHUNK
NEG_INF = -1e30
LRU_WIDTH = D_MIX - ATTN_WIDTH
LRU_BLOCKS = 8
LRU_BLOCK = LRU_WIDTH // LRU_BLOCKS
CONV_WIDTH = 4
LRU_C = 8.0
N_BUCKETS = 32
MAX_DISTANCE = 128
Q_COLS = N_Q_HEADS * HEAD_DIM
KV_COLS = N_KV_HEADS * HEAD_DIM
IN_COLS = Q_COLS + 2 * KV_COLS + 2 * LRU_WIDTH
D_FF = 2816
N_EXPERTS = 8
TOP_K = 2
D_FF_EXPERT = 3584
N_DENSE = (DEPTH + 1) // 2
N_MOE = DEPTH // 2
DEEPNORM_ALPHA = (2 * DEPTH) ** 0.25
DEEPNORM_BETA = (8 * DEPTH) ** -0.25
LN_EPS = 1e-5
RMS_EPS = 1e-6

kernel_name = "hybrid_swa_sink_rglru_moe_deepnorm"


def layer_norm(x, g, b):
    xf = x.astype(jnp.float32)
    mu = xf.mean(-1, keepdims=True)
    var = jnp.square(xf - mu).mean(-1, keepdims=True)
    return ((xf - mu) * lax.rsqrt(var + LN_EPS) * g.astype(jnp.float32) + b.astype(jnp.float32)).astype(x.dtype)


def rms_norm(x, g):
    xf = x.astype(jnp.float32)
    return (xf * lax.rsqrt(jnp.mean(xf * xf, -1, keepdims=True) + RMS_EPS) * g.astype(jnp.float32)).astype(x.dtype)


def t5_relative_bucket(rel):
    half = N_BUCKETS // 2
    max_exact = half // 2
    ret = jnp.where(rel > 0, half, 0)
    n = jnp.abs(rel)
    large = max_exact + (jnp.log(jnp.maximum(n, 1).astype(jnp.float32) / max_exact)
                         / math.log(MAX_DISTANCE / max_exact) * (half - max_exact)).astype(jnp.int32)
    large = jnp.minimum(large, half - 1)
    return ret + jnp.where(n < max_exact, n, large)


def banded_position_bias(rel_bias):
    qi = jnp.arange(CHUNK)[:, None]
    kj = jnp.arange(BAND)[None, :]
    rel = (kj - WINDOW_CHUNKS * CHUNK) - qi
    return jnp.transpose(rel_bias[t5_relative_bucket(rel)], (2, 0, 1))


def sliding_window_sink_attention(q, k, v, sinks, pos_bias):
    b, s = q.shape[:2]
    nc = s // CHUNK
    qc = q.reshape(b, nc, CHUNK, N_KV_HEADS, GQA_GROUP, HEAD_DIM)

    def band(t):
        tp = jnp.pad(t, ((0, 0), (WINDOW_CHUNKS * CHUNK, 0), (0, 0), (0, 0)))
        tp = tp.reshape(b, nc + WINDOW_CHUNKS, CHUNK, N_KV_HEADS, HEAD_DIM)
        return jnp.concatenate([tp[:, w:w + nc] for w in range(WINDOW_CHUNKS + 1)], axis=2)

    kb, vb = band(k), band(v)
    logits = jnp.einsum("bcqhgd,bckhd->bchgqk", qc, kb,
                        preferred_element_type=jnp.float32) * (HEAD_DIM ** -0.5)
    logits = logits + pos_bias.astype(jnp.float32).reshape(N_KV_HEADS, GQA_GROUP, CHUNK, BAND)
    key_pos = (jnp.arange(nc)[:, None] - WINDOW_CHUNKS) * CHUNK + jnp.arange(BAND)[None, :]
    logits = jnp.where((key_pos >= 0)[None, :, None, None, None, :], logits, NEG_INF)
    sink = jnp.broadcast_to(sinks.astype(jnp.float32).reshape(1, 1, N_KV_HEADS, GQA_GROUP, 1, 1),
                            logits.shape[:-1] + (1,))
    probs = jax.nn.softmax(jnp.concatenate([logits, sink], axis=-1), axis=-1)[..., :BAND]
    out = jnp.einsum("bchgqk,bckhd->bcqhgd", probs.astype(v.dtype), vb)
    return out.reshape(b, s, N_Q_HEADS * HEAD_DIM)


def rg_lru_branch(xb, gb, conv_w, conv_b, wr, br, wi, bi, lam):
    xc = lax.conv_general_dilated(xb, conv_w[:, None, :], window_strides=(1,),
                                  padding=[(CONV_WIDTH - 1, 0)],
                                  dimension_numbers=("NWC", "WIO", "NWC"),
                                  feature_group_count=LRU_WIDTH) + conv_b
    b, s = xc.shape[:2]
    xblk = xc.reshape(b, s, LRU_BLOCKS, LRU_BLOCK)
    r = jax.nn.sigmoid(jnp.einsum("bsnd,nde->bsne", xblk, wr).reshape(b, s, LRU_WIDTH).astype(jnp.float32)
                       + br.astype(jnp.float32))
    i = jax.nn.sigmoid(jnp.einsum("bsnd,nde->bsne", xblk, wi).reshape(b, s, LRU_WIDTH).astype(jnp.float32)
                       + bi.astype(jnp.float32))
    log_a = -LRU_C * r * jax.nn.softplus(-lam.astype(jnp.float32))
    a = jnp.exp(log_a)
    u = jnp.sqrt(-jnp.expm1(2.0 * log_a)) * (i * xc.astype(jnp.float32))

    def combine(left, right):
        a_l, h_l = left
        a_r, h_r = right
        return a_l * a_r, a_r * h_l + h_r

    _, h = lax.associative_scan(combine, (a, u), axis=1)
    return (jax.nn.gelu(gb.astype(jnp.float32)) * h).astype(xb.dtype)


def hybrid_mixer(x, pos_bias, w_in, sinks, conv_w, conv_b, wr, br, wi, bi, lam, g_attn, g_lru, w_out):
    b, s, _ = x.shape
    z = x @ w_in
    q, k, v, xb, gb = jnp.split(z, [Q_COLS, Q_COLS + KV_COLS, Q_COLS + 2 * KV_COLS,
                                    Q_COLS + 2 * KV_COLS + LRU_WIDTH], axis=-1)
    y_attn = sliding_window_sink_attention(q.reshape(b, s, N_Q_HEADS, HEAD_DIM),
                                           k.reshape(b, s, N_KV_HEADS, HEAD_DIM),
                                           v.reshape(b, s, N_KV_HEADS, HEAD_DIM), sinks, pos_bias)
    y_lru = rg_lru_branch(xb, gb, conv_w, conv_b, wr, br, wi, bi, lam)
    y = jnp.concatenate([rms_norm(y_attn, g_attn), rms_norm(y_lru, g_lru)], axis=-1)
    return y @ w_out


def swiglu(x, w_gate, w_up, w_down):
    return (jax.nn.silu(x @ w_gate) * (x @ w_up)) @ w_down


def moe_swiglu(x, router_w, w_gate, w_up, w_down):
    b, s, d = x.shape
    xf = x.reshape(b * s, d)
    logits = (xf @ router_w).astype(jnp.float32)
    top_vals, top_idx = lax.top_k(logits, TOP_K)
    top_w = jax.nn.softmax(top_vals, axis=-1)
    comb = jnp.sum(jax.nn.one_hot(top_idx, N_EXPERTS, dtype=jnp.float32) * top_w[..., None], axis=1)
    out = jnp.zeros((b * s, d), jnp.float32)
    for e in range(N_EXPERTS):
        ye = swiglu(xf, w_gate[e], w_up[e], w_down[e]).astype(jnp.float32)
        out = out + comb[:, e:e + 1] * ye
    return out.astype(x.dtype).reshape(b, s, d)


def setup_inputs(seed: int = 0) -> dict:
    key = jax.random.key(seed)
    ks = jax.random.split(key, 26)
    nrm = lambda k, shape, scale: jax.random.normal(k, shape, jnp.float32) * scale
    u = jax.random.uniform(ks[10], (DEPTH, LRU_WIDTH), jnp.float32, minval=0.9, maxval=0.999)
    a = u ** (1.0 / LRU_C)
    lru_lambda = jnp.log(a) - jnp.log1p(-a)
    return {
        "x": nrm(ks[0], (BATCH, SEQ, D_MODEL), 1.0),
        "rel_bias": nrm(ks[1], (N_BUCKETS, N_Q_HEADS), 0.5),
        "w_in": nrm(ks[2], (DEPTH, D_MODEL, IN_COLS), D_MODEL ** -0.5),
        "attn_sinks": nrm(ks[3], (DEPTH, N_Q_HEADS), 1.0),
        "conv_w": nrm(ks[4], (DEPTH, CONV_WIDTH, LRU_WIDTH), CONV_WIDTH ** -0.5),
        "conv_b": nrm(ks[5], (DEPTH, LRU_WIDTH), 0.01),
        "gate_r_w": nrm(ks[6], (DEPTH, LRU_BLOCKS, LRU_BLOCK, LRU_BLOCK), LRU_BLOCK ** -0.5),
        "gate_r_b": nrm(ks[7], (DEPTH, LRU_WIDTH), 0.01),
        "gate_i_w": nrm(ks[8], (DEPTH, LRU_BLOCKS, LRU_BLOCK, LRU_BLOCK), LRU_BLOCK ** -0.5),
        "gate_i_b": nrm(ks[9], (DEPTH, LRU_WIDTH), 0.01),
        "lru_lambda": lru_lambda,
        "norm_attn_g": 1.0 + nrm(ks[11], (DEPTH, ATTN_WIDTH), 0.01),
        "norm_lru_g": 1.0 + nrm(ks[12], (DEPTH, LRU_WIDTH), 0.01),
        "w_out": nrm(ks[13], (DEPTH, D_MIX, D_MODEL), D_MIX ** -0.5 * DEEPNORM_BETA),
        "ln1_g": 1.0 + nrm(ks[14], (DEPTH, D_MODEL), 0.01),
        "ln1_b": nrm(ks[15], (DEPTH, D_MODEL), 0.01),
        "ffn_w_gate": nrm(ks[16], (N_DENSE, D_MODEL, D_FF), D_MODEL ** -0.5),
        "ffn_w_up": nrm(ks[17], (N_DENSE, D_MODEL, D_FF), D_MODEL ** -0.5),
        "ffn_w_down": nrm(ks[18], (N_DENSE, D_FF, D_MODEL), D_FF ** -0.5 * DEEPNORM_BETA),
        "router_w": nrm(ks[19], (N_MOE, D_MODEL, N_EXPERTS), D_MODEL ** -0.5),
        "exp_w_gate": nrm(ks[20], (N_MOE, N_EXPERTS, D_MODEL, D_FF_EXPERT), D_MODEL ** -0.5),
        "exp_w_up": nrm(ks[21], (N_MOE, N_EXPERTS, D_MODEL, D_FF_EXPERT), D_MODEL ** -0.5),
        "exp_w_down": nrm(ks[22], (N_MOE, N_EXPERTS, D_FF_EXPERT, D_MODEL), D_FF_EXPERT ** -0.5 * DEEPNORM_BETA),
        "ln2_g": 1.0 + nrm(ks[23], (DEPTH, D_MODEL), 0.01),
        "ln2_b": nrm(ks[24], (DEPTH, D_MODEL), 0.01),
    }


def reference(x, rel_bias, w_in, attn_sinks, conv_w, conv_b, gate_r_w, gate_r_b, gate_i_w, gate_i_b,
              lru_lambda, norm_attn_g, norm_lru_g, w_out, ln1_g, ln1_b, ffn_w_gate, ffn_w_up, ffn_w_down,
              router_w, exp_w_gate, exp_w_up, exp_w_down, ln2_g, ln2_b):
    pos_bias = banded_position_bias(rel_bias)
    for l in range(DEPTH):
        y = hybrid_mixer(x, pos_bias, w_in[l], attn_sinks[l], conv_w[l], conv_b[l],
                         gate_r_w[l], gate_r_b[l], gate_i_w[l], gate_i_b[l], lru_lambda[l],
                         norm_attn_g[l], norm_lru_g[l], w_out[l])
        x = layer_norm(DEEPNORM_ALPHA * x + y, ln1_g[l], ln1_b[l])
        if l % 2 == 0:
            f = swiglu(x, ffn_w_gate[l // 2], ffn_w_up[l // 2], ffn_w_down[l // 2])
        else:
            f = moe_swiglu(x, router_w[l // 2], exp_w_gate[l // 2], exp_w_up[l // 2], exp_w_down[l // 2])
        x = layer_norm(DEEPNORM_ALPHA * x + f, ln2_g[l], ln2_b[l])
    return x
```

```cpp
#include <hip/hip_runtime.h>
#include <cstdio>
#include <cstdint>
namespace pg8 {
#define PG8_LAS __attribute__((address_space(3)))
typedef unsigned short bf16_t;
typedef short bf16x8 __attribute__((ext_vector_type(8)));
typedef float f32x4 __attribute__((ext_vector_type(4)));
typedef unsigned u32x4 __attribute__((ext_vector_type(4)));
constexpr int BM = 256, BK = 64, HALF = 128, HTB = HALF * BK * 2  , STAGE_BYTES = 8 * HTB, NXCD = 8, WGM = 8;

__host__ __device__ __forceinline__ int lds_byte(int r, int c) { const int st = (r >> 4) * 2 + (c >> 5), rr = r & 15, cc = c & 31, ob = rr * 64 + cc * 2; return st * 1024 + (ob ^ (((ob >> 9) & 1) << 5)); }
__host__ __device__ __forceinline__ void stage_rc(int b, int& R, int& C) { const int st = b / 1024, sb = b % 1024, swz = sb ^ (((sb >> 9) & 1) << 5); R = (st >> 1) * 16 + swz / 64; C = (st & 1) * 32 + (swz % 64) / 2; }
__host__ __device__ __forceinline__ int perm32(int rho) { const int n = rho >> 4, i = rho & 15; return 8 * (i >> 2) + 4 * n + (i & 3); }

struct Unit { int pm, pn, be; };
struct Gemm { const bf16_t* A; const bf16_t* Bt; int M, N, K; size_t bstride; };

struct StaticOrder {
    int nM, nN, nwg, G, c;
    __host__ __device__ void init(int M, int N, int G_, int c_) { nM = M / BM; nN = N / BM; nwg = nM * nN; G = G_; c = c_; }
    __host__ __device__ bool next(int i, Unit& u) const {
        const long L = (long)i * G + c; if (L >= nwg) return false;
        int wgid = (int)L; { const int q = nwg / NXCD, r = nwg % NXCD, xcd = wgid % NXCD, off = wgid / NXCD; wgid = (xcd < r ? xcd * (q + 1) : r * (q + 1) + (xcd - r) * q) + off; }
        const int nig = WGM * nN, gid = wgid / nig, fm = gid * WGM, gsz = (nM - fm) < WGM ? (nM - fm) : WGM;
        u.pm = fm + ((wgid % nig) % gsz); u.pn = (wgid % nig) / gsz; u.be = 0; return true;
    }
    __device__ __forceinline__ void a_ready(const Unit&) const {}
    __device__ __forceinline__ void done(const Unit&) const {}
};
struct MoeOrder {
    StaticOrder so; int tile0, s1, s2, s3, s4, s5, s6, s7;
    __device__ __forceinline__ bool next(int i, Unit& u) const {
        if (!so.next(i, u)) return false;
        const int t = tile0 + u.pm;
        u.be = (t >= s1) + (t >= s2) + (t >= s3) + (t >= s4) + (t >= s5) + (t >= s6) + (t >= s7); return true;
    }
    __device__ __forceinline__ void a_ready(const Unit&) const {}
    __device__ __forceinline__ void done(const Unit&) const {}
};

__device__ __forceinline__ unsigned cvt_pk_bf16(float lo, float hi) { unsigned r; asm volatile("v_cvt_pk_bf16_f32 %0, %1, %2" : "=v"(r) : "v"(lo), "v"(hi)); return r; }

struct EpiBf16 {
    static constexpr bool PERM = true, AFTER_DRAIN = false;
    bf16_t* O; int ldc;
    __device__ __forceinline__ void operator()(const f32x4 (&acc)[2][2][4][2], const Unit& u, int wr, int wc, int fr, int fq) const {
        const int row0 = u.pm * BM + wr * 64 + fr, col0 = u.pn * BM + wc * 32 + 8 * fq;
#pragma unroll
        for (int ai = 0; ai < 2; ++ai)
#pragma unroll
            for (int m = 0; m < 4; ++m) { bf16_t* rowp = O + (size_t)(row0 + ai * HALF + m * 16) * ldc + col0;
#pragma unroll
                for (int bj = 0; bj < 2; ++bj) { const f32x4 v0 = acc[ai][bj][m][0], v1 = acc[ai][bj][m][1];
                    u32x4 w; w.x = cvt_pk_bf16(v0[0], v0[1]); w.y = cvt_pk_bf16(v0[2], v0[3]); w.z = cvt_pk_bf16(v1[0], v1[1]); w.w = cvt_pk_bf16(v1[2], v1[3]);
                    *(u32x4*)(rowp + bj * HALF) = w; } }
    }
};
__device__ __forceinline__ float silu_mul(float g, float u) { return g * u * __builtin_amdgcn_rcpf(1.0f + __builtin_amdgcn_exp2f(g * -1.4426950408889634f)); }
struct EpiSwiGLU {
    static constexpr bool PERM = true, AFTER_DRAIN = false;
    bf16_t* H; int ldh;
    __device__ __forceinline__ void operator()(const f32x4 (&acc)[2][2][4][2], const Unit& u, int wr, int wc, int fr, int fq) const {
        const int row0 = u.pm * BM + wr * 64 + fr, col0 = u.pn * HALF + wc * 32 + 8 * fq;
#pragma unroll
        for (int ai = 0; ai < 2; ++ai)
#pragma unroll
            for (int m = 0; m < 4; ++m) { bf16_t* rowp = H + (size_t)(row0 + ai * HALF + m * 16) * ldh + col0;
                const f32x4 g0 = acc[ai][0][m][0], g1 = acc[ai][0][m][1], u0 = acc[ai][1][m][0], u1 = acc[ai][1][m][1];
                u32x4 w; w.x = cvt_pk_bf16(silu_mul(g0[0], u0[0]), silu_mul(g0[1], u0[1])); w.y = cvt_pk_bf16(silu_mul(g0[2], u0[2]), silu_mul(g0[3], u0[3]));
                w.z = cvt_pk_bf16(silu_mul(g1[0], u1[0]), silu_mul(g1[1], u1[1])); w.w = cvt_pk_bf16(silu_mul(g1[2], u1[2]), silu_mul(g1[3], u1[3]));
                *(u32x4*)rowp = w; }
    }
};
struct EpiResF32 {
    static constexpr bool PERM = false, AFTER_DRAIN = false;
    const float* res; float* out; int ldc; float alpha;
    __device__ __forceinline__ void operator()(const f32x4 (&acc)[2][2][4][2], const Unit& u, int wr, int wc, int fr, int fq) const {
        const int row0 = u.pm * BM + wr * 64 + fr, col0 = u.pn * BM + wc * 32 + 4 * fq;
#pragma unroll
        for (int ai = 0; ai < 2; ++ai)
#pragma unroll
            for (int m = 0; m < 4; ++m) { const size_t off = (size_t)(row0 + ai * HALF + m * 16) * ldc + col0;
                f32x4 rv[2][2];
#pragma unroll
                for (int bj = 0; bj < 2; ++bj)
#pragma unroll
                    for (int n = 0; n < 2; ++n) rv[bj][n] = *(const f32x4*)(res + off + bj * HALF + n * 16);
#pragma unroll
                for (int bj = 0; bj < 2; ++bj)
#pragma unroll
                    for (int n = 0; n < 2; ++n) *(f32x4*)(out + off + bj * HALF + n * 16) = rv[bj][n] * alpha + acc[ai][bj][m][n];
                asm volatile("" ::: "memory"); }
    }
};

template <class Epi, class Sched, bool ALIGN_EPI = false, bool SP2 = false>
__device__ __forceinline__ void gemm_phase(PG8_LAS unsigned char* lds, const Gemm g, const Sched& S, const Epi& E) {
    const int tid = threadIdx.x, wid = __builtin_amdgcn_readfirstlane(tid >> 6), lane = tid & 63, wr = wid >> 2, wc = wid & 3, fr = lane & 15, fq = lane >> 4;
    const int K = g.K, nt = K / BK;
    unsigned voffA[2], voffB[2];
#pragma unroll
    for (int i = 0; i < 2; ++i) { int R, C; stage_rc(tid * 16 + i * 8192, R, C); const int Rb = Epi::PERM ? ((R & ~31) + perm32(R & 31)) : R;
        voffA[i] = (unsigned)(R * K + C) * 2u; voffB[i] = (unsigned)(Rb * K + C) * 2u; }
    const size_t kstep = (size_t)(BK * 2);
    const size_t hstep = (size_t)HALF * K * 2;
    const size_t tstep = 2 * hstep;
    const unsigned ldsw = (unsigned)wid * 1024u;
    const int aoff = lds_byte(wr * 64 + fr, fq * 8), boff = lds_byte(wc * 32 + fr, fq * 8);
#define PG8_SA(b, h) (((b) * 2 + (h)) * HTB)
#define PG8_SB(b, h) ((4 + (b) * 2 + (h)) * HTB)
#define PG8_STAGE(bufoff, gbase, voff) do { _Pragma("unroll") for (int _i = 0; _i < 2; ++_i) \
        __builtin_amdgcn_global_load_lds((const unsigned*)((const char*)(gbase) + (voff)[_i]), (PG8_LAS unsigned*)(lds + (bufoff) + ldsw + _i * 8192), 16, 0, 0); } while (0)
#define PG8_LDA(dst, b, h) do { _Pragma("unroll") for (int m = 0; m < 4; ++m) _Pragma("unroll") for (int k = 0; k < 2; ++k) dst[m][k] = *(const PG8_LAS bf16x8*)(lds + PG8_SA(b, h) + aoff + m * 2048 + k * 1024); } while (0)
#define PG8_LDB(dst, b, h) do { _Pragma("unroll") for (int n = 0; n < 2; ++n) _Pragma("unroll") for (int k = 0; k < 2; ++k) dst[n][k] = *(const PG8_LAS bf16x8*)(lds + PG8_SB(b, h) + boff + n * 2048 + k * 1024); } while (0)
#define PG8_MMA(ai, bj, At, Bt) do { __builtin_amdgcn_s_setprio(1); _Pragma("unroll") for (int m = 0; m < 4; ++m) _Pragma("unroll") for (int n = 0; n < 2; ++n) _Pragma("unroll") for (int k = 0; k < 2; ++k) \
        acc[ai][bj][m][n] = __builtin_amdgcn_mfma_f32_16x16x32_bf16(Bt[n][k], At[m][k], acc[ai][bj][m][n], 0, 0, 0); __builtin_amdgcn_s_setprio(0); } while (0)
#define PG8_WAIT_V(n) asm volatile("s_waitcnt vmcnt(" #n ")" ::: "memory")
#define PG8_WAIT_L(n) asm volatile("s_waitcnt lgkmcnt(" #n ")" ::: "memory")
#define PG8_BAR __builtin_amdgcn_s_barrier()
#define PG8_SCHED __builtin_amdgcn_sched_barrier(0)
    Unit cur, nxt; int ui = 0;
    if (!S.next(0, cur)) return;
    f32x4 acc[2][2][4][2];
#pragma unroll
    for (int a = 0; a < 2; ++a)
#pragma unroll
        for (int b = 0; b < 2; ++b)
#pragma unroll
            for (int m = 0; m < 4; ++m)
#pragma unroll
                for (int n = 0; n < 2; ++n) acc[a][b][m][n] = (f32x4){0.f, 0.f, 0.f, 0.f};
    bf16x8 At[4][2], B0[2][2], B1[2][2];
    const char* cA = (const char*)g.A + (size_t)cur.pm * tstep; const char* cB = (const char*)g.Bt + (size_t)cur.be * g.bstride + (size_t)cur.pn * tstep;
    S.a_ready(cur);
    if constexpr (SP2) {
        PG8_STAGE(PG8_SB(0, 0), cB, voffB); PG8_STAGE(PG8_SB(0, 1), cB + hstep, voffB); PG8_STAGE(PG8_SA(0, 0), cA, voffA); PG8_STAGE(PG8_SA(0, 1), cA + hstep, voffA);
        if (wr == 1) PG8_BAR;
        PG8_WAIT_V(2); PG8_BAR;
        PG8_STAGE(PG8_SB(1, 0), cB + kstep, voffB); PG8_STAGE(PG8_SA(1, 0), cA + kstep, voffA); PG8_STAGE(PG8_SB(1, 1), cB + hstep + kstep, voffB);
        PG8_WAIT_V(6); PG8_BAR;
    } else {
        PG8_STAGE(PG8_SB(0, 0), cB, voffB); PG8_STAGE(PG8_SA(0, 0), cA, voffA); PG8_STAGE(PG8_SB(0, 1), cB + hstep, voffB); PG8_STAGE(PG8_SA(0, 1), cA + hstep, voffA);
        if (wr == 1) PG8_BAR;
        PG8_WAIT_V(4); PG8_BAR;
        PG8_STAGE(PG8_SB(1, 0), cB + kstep, voffB); PG8_STAGE(PG8_SA(1, 0), cA + kstep, voffA); PG8_STAGE(PG8_SB(1, 1), cB + hstep + kstep, voffB);
        PG8_WAIT_V(6); PG8_BAR;
    }
    for (;;) {
        const bool has_next = S.next(ui + 1, nxt);
        const char* nA = has_next ? (const char*)g.A + (size_t)nxt.pm * tstep : cA; const char* nB = has_next ? (const char*)g.Bt + (size_t)nxt.be * g.bstride + (size_t)nxt.pn * tstep : cB;
        for (int t = 0; t < nt; t += 2) {
            const bool last = (t == nt - 2);
            const char* a1 = cA + (size_t)(t + 1) * kstep;
            const char* a2 = last ? nA : cA + (size_t)(t + 2) * kstep; const char* b2 = last ? nB : cB + (size_t)(t + 2) * kstep;
            const char* a3 = a2 + kstep; const char* b3 = b2 + kstep;
            if (last && has_next) S.a_ready(nxt);
            if constexpr (SP2) {
            PG8_LDB(B0, 0, 0); PG8_LDB(B1, 0, 1); PG8_SCHED; PG8_LDA(At, 0, 0); PG8_STAGE(PG8_SA(1, 1), a1 + hstep, voffA);
            PG8_WAIT_V(8); PG8_WAIT_L(0); PG8_BAR; PG8_MMA(0, 0, At, B0); PG8_MMA(0, 1, At, B1); PG8_BAR; PG8_SCHED;
            PG8_LDA(At, 0, 1); PG8_STAGE(PG8_SB(0, 0), b2, voffB); PG8_STAGE(PG8_SB(0, 1), b2 + hstep, voffB); PG8_STAGE(PG8_SA(0, 0), a2, voffA);
            PG8_WAIT_V(8); PG8_WAIT_L(0); PG8_BAR; PG8_MMA(1, 0, At, B0); PG8_MMA(1, 1, At, B1); PG8_BAR; PG8_SCHED;
            PG8_LDB(B0, 1, 0); PG8_LDB(B1, 1, 1); PG8_SCHED; PG8_LDA(At, 1, 0); PG8_STAGE(PG8_SA(0, 1), a2 + hstep, voffA);
            PG8_WAIT_V(8); PG8_WAIT_L(0); PG8_BAR; PG8_MMA(0, 0, At, B0); PG8_MMA(0, 1, At, B1); PG8_BAR; PG8_SCHED;
            PG8_LDA(At, 1, 1); PG8_STAGE(PG8_SB(1, 0), b3, voffB); PG8_STAGE(PG8_SB(1, 1), b3 + hstep, voffB); PG8_STAGE(PG8_SA(1, 0), a3, voffA);
            PG8_WAIT_V(8); PG8_WAIT_L(0); PG8_BAR; PG8_MMA(1, 0, At, B0); PG8_MMA(1, 1, At, B1); PG8_BAR; PG8_SCHED;
            } else {
            PG8_LDB(B0, 0, 0); PG8_SCHED; PG8_LDA(At, 0, 0); PG8_STAGE(PG8_SA(1, 1), a1 + hstep, voffA);
            PG8_WAIT_L(8); PG8_BAR; PG8_WAIT_L(0); PG8_MMA(0, 0, At, B0); PG8_BAR; PG8_SCHED;
            PG8_LDB(B1, 0, 1); PG8_STAGE(PG8_SB(0, 0), b2, voffB);
            PG8_BAR; PG8_WAIT_L(0); PG8_MMA(0, 1, At, B1); PG8_BAR;
            PG8_LDA(At, 0, 1); PG8_STAGE(PG8_SA(0, 0), a2, voffA);
            PG8_BAR; PG8_WAIT_L(0); PG8_MMA(1, 0, At, B0); PG8_BAR; PG8_SCHED;
            PG8_STAGE(PG8_SB(0, 1), b2 + hstep, voffB);
            PG8_WAIT_V(6); PG8_BAR; PG8_MMA(1, 1, At, B1); PG8_BAR;
            PG8_LDB(B0, 1, 0); PG8_SCHED; PG8_LDA(At, 1, 0); PG8_STAGE(PG8_SA(0, 1), a2 + hstep, voffA);
            PG8_WAIT_L(8); PG8_BAR; PG8_WAIT_L(0); PG8_MMA(0, 0, At, B0); PG8_BAR; PG8_SCHED;
            PG8_LDB(B1, 1, 1); PG8_STAGE(PG8_SB(1, 0), b3, voffB);
            PG8_BAR; PG8_WAIT_L(0); PG8_MMA(0, 1, At, B1); PG8_BAR;
            PG8_LDA(At, 1, 1); PG8_STAGE(PG8_SA(1, 0), a3, voffA);
            PG8_BAR; PG8_WAIT_L(0); PG8_MMA(1, 0, At, B0); PG8_BAR; PG8_SCHED;
            PG8_STAGE(PG8_SB(1, 1), b3 + hstep, voffB);
            PG8_WAIT_V(6); PG8_BAR; PG8_MMA(1, 1, At, B1); PG8_BAR;
            }
        }
        if constexpr (ALIGN_EPI) { if (wr == 0) PG8_BAR; }
        if constexpr (!Epi::AFTER_DRAIN) { E(acc, cur, wr, wc, fr, fq); S.done(cur); }
        if (!has_next) break;
#pragma unroll
        for (int a = 0; a < 2; ++a)
#pragma unroll
            for (int b = 0; b < 2; ++b)
#pragma unroll
                for (int m = 0; m < 4; ++m)
#pragma unroll
                    for (int n = 0; n < 2; ++n) acc[a][b][m][n] = (f32x4){0.f, 0.f, 0.f, 0.f};
        cur = nxt; cA = nA; cB = nB; ++ui;
        if constexpr (ALIGN_EPI) { if (wr == 1) PG8_BAR; }
    }
    PG8_WAIT_V(0);
    if constexpr (!ALIGN_EPI) { if (wr == 0) PG8_BAR; }
    PG8_BAR;
    if constexpr (Epi::AFTER_DRAIN) { E.fused(acc, cur, wr, wc, fr, fq, lds, wid, lane); S.done(cur); }
#undef PG8_SA
#undef PG8_SB
#undef PG8_STAGE
#undef PG8_LDA
#undef PG8_LDB
#undef PG8_MMA
#undef PG8_WAIT_V
#undef PG8_WAIT_L
#undef PG8_BAR
#undef PG8_SCHED
}
}

constexpr int BATCH = 2, SEQ = 16384, DM = 1024, NTOK = BATCH * SEQ;
constexpr int CHK = 64, NCHUNK = SEQ / CHK;
constexpr int INC = 1792, KOFF = 512, VOFF = 640, XBOFF = 768, GBOFF = 1280;
constexpr int LRUW = 512, DFF = 2816, DFE = 3584, NEXP = 8;
constexpr int MAXTILES = 264, PASS_TILES = 64, NPASS = 5;
constexpr float ALPHA = 1.41421356237309515f, LN_EPS = 1e-5f, RMS_EPS = 1e-6f, LOG2E = 1.4426950408889634f, QSCALE = 0.125f * LOG2E;
constexpr int NWAVES = 8, NTHREADS = 512;

constexpr size_t MiB = 1u << 20;
constexpr size_t WS_CTL = 0, CTL_ZERO_BYTES = 64 * 1024;
constexpr size_t WS_LUT = 1 * MiB;
constexpr size_t WS_GATEW = 1 * MiB + 64 * 1024;
constexpr size_t WS_HIST = 1 * MiB + 512 * 1024;
constexpr size_t WS_META = 1 * MiB + 576 * 1024;
constexpr size_t WS_TOKE = 2 * MiB, WS_TOKW = 2 * MiB + 256 * 1024, WS_TOKPOS = 2 * MiB + 512 * 1024;
constexpr size_t WS_LRUP = 3 * MiB, WS_LRUE = 4 * MiB, WS_HIN = 5 * MiB;
constexpr size_t WS_WEGU = 8 * MiB, WS_WED = 120 * MiB;
constexpr size_t WS_WIN = 176 * MiB, WS_WOUT = 183 * MiB, WS_WGU = 187 * MiB, WS_WD = 198 * MiB;
constexpr size_t WS_A = 204 * MiB;
constexpr size_t WS_ZH = 268 * MiB;
constexpr size_t WS_XS = 204 * MiB;
constexpr size_t WS_HM = 336 * MiB;
constexpr size_t WS_END = 448 * MiB;
static_assert(WS_WED + (size_t)NEXP * DM * DFE * 2 <= WS_WIN && WS_WD + (size_t)DM * DFF * 2 <= WS_A && WS_A + (size_t)NTOK * DM * 2 <= WS_ZH && WS_ZH + (size_t)NTOK * DFF * 2 <= WS_END, "ws map");
static_assert(WS_XS + (size_t)MAXTILES * 256 * DM * 2 <= WS_HM && WS_HM + (size_t)PASS_TILES * 256 * DFE * 2 <= WS_END, "ws map (MoE)");
constexpr int CW_BAR = 0;

constexpr int RING_BYTES = 131072;
constexpr int LDS_LUT = RING_BYTES;
constexpr int LDS_SSQA = LDS_LUT + 8192, LDS_SSQL = LDS_SSQA + 2048;
constexpr int LDS_MISC = LDS_SSQL + 2048;
constexpr int LDS_POS = LDS_MISC + 256;
constexpr int LDS_BYTES = 147456;
static_assert(LDS_POS + 1024 <= LDS_BYTES, "LDS map");

#define GAS __attribute__((address_space(1)))
#define LAS __attribute__((address_space(3)))
typedef unsigned short bf16;
typedef unsigned v4u __attribute__((ext_vector_type(4)));
typedef unsigned v2u __attribute__((ext_vector_type(2)));
typedef float f32x4 __attribute__((ext_vector_type(4)));
typedef float f32x16 __attribute__((ext_vector_type(16)));
typedef short bf16x8 __attribute__((ext_vector_type(8)));
typedef short s16x4 __attribute__((ext_vector_type(4)));
#define LDS_WAIT() asm volatile("s_waitcnt lgkmcnt(0)" ::: "memory")
#define VM_WAIT() asm volatile("s_waitcnt vmcnt(0)" ::: "memory")
__device__ __forceinline__ unsigned pk2(float lo, float hi) { return pg8::cvt_pk_bf16(lo, hi); }
__device__ __forceinline__ float bf2f(unsigned short h) { return __uint_as_float((unsigned)h << 16); }
__device__ __forceinline__ float bflo(unsigned w) { return __uint_as_float(w << 16); }
__device__ __forceinline__ float bfhi(unsigned w) { return __uint_as_float(w & 0xffff0000u); }
__device__ __forceinline__ float wave_sum(float v) {
#pragma unroll
    for (int o = 1; o < 64; o <<= 1) v += __shfl_xor(v, o);
    return v;
}
__device__ __forceinline__ float fast_sigmoid(float x) { return __builtin_amdgcn_rcpf(1.0f + __builtin_amdgcn_exp2f(x * -LOG2E)); }
__device__ __forceinline__ float gelu_tanh(float x) {
    const float t = 1.5957691216057308f * (x + 0.044715f * x * x * x);
    return x * fast_sigmoid(t);
}

#define XB_TMO      128
#define XB_XCNT(j)  (256  + 64 * (j))
#define XB_XSUB(j)  (1280 + 64 * (j))
#define XB_XGEN(j)  (2304 + 64 * (j))
#define XB_TOP      3328
#define XB_TOPGEN   3392
#define XCD_BAR_WORDS 3456
#define XB_SPIN_CAP (1u << 18)

__device__ __forceinline__ unsigned xb_ld(unsigned* p)              { return __hip_atomic_load(p, __ATOMIC_RELAXED, __HIP_MEMORY_SCOPE_AGENT); }
__device__ __forceinline__ unsigned xb_add(unsigned* p, unsigned v) { return __hip_atomic_fetch_add(p, v, __ATOMIC_RELAXED, __HIP_MEMORY_SCOPE_AGENT); }
__device__ __forceinline__ unsigned xb_xcc_id() { return (unsigned)__builtin_amdgcn_s_getreg((3 << 11) | 20) & 0xFu; }
#define XB_SPIN(cond, bar) do { unsigned _sp = 0; while (cond) { __builtin_amdgcn_s_sleep(1); \
    if ((++_sp & 255u) == 0u) { if (xb_ld(&(bar)[XB_TMO])) break; if (_sp > XB_SPIN_CAP) { atomicAdd(&(bar)[XB_TMO], 1u); break; } } } } while (0)

struct XcdBarrier {
    unsigned* bar; unsigned x;
    volatile LAS unsigned* st;
};

__device__ __forceinline__ XcdBarrier xcd_barrier_post(unsigned* bar, volatile LAS unsigned* st) {
    XcdBarrier b; b.bar = bar; b.x = xb_xcc_id(); b.st = st;
    if (threadIdx.x == 0) (void)xb_add(&bar[XB_XCNT(b.x)], 1u);
    return b;
}
__device__ __forceinline__ void xcd_barrier_complete(unsigned* bar, unsigned x, unsigned& nloc, unsigned& nx) {
    const unsigned G = gridDim.x * gridDim.y * gridDim.z;
    unsigned sum, cnt, mine, sp = 0u;
    for (;;) {
        sum = 0u; cnt = 0u; mine = 0u;
#pragma unroll
        for (unsigned j = 0; j < 16; ++j) { const unsigned c = xb_ld(&bar[XB_XCNT(j)]); sum += c; cnt += (c > 0u) ? 1u : 0u; mine = (j == x) ? c : mine; }
        if (sum == G) break;
        __builtin_amdgcn_s_sleep(1);
        if ((++sp & 255u) == 0u) { if (xb_ld(&bar[XB_TMO])) break; if (sp > XB_SPIN_CAP) { atomicAdd(&bar[XB_TMO], 1u); break; } }
    }
    nloc = mine > 0u ? mine : 1u; nx = cnt > 0u ? cnt : 1u;
}

__device__ __forceinline__ void xcd_barrier(const XcdBarrier& b) {
    asm volatile("s_waitcnt vmcnt(0)" ::: "memory");
    __syncthreads();
    if (threadIdx.x == 0) {
        unsigned* bar = b.bar;
        __builtin_amdgcn_s_waitcnt(0);
        unsigned nloc = b.st[0], nx = b.st[1];
        if (nloc == 0u) { xcd_barrier_complete(bar, b.x, nloc, nx); b.st[0] = nloc; b.st[1] = nx; }
        const unsigned old = xb_add(&bar[XB_XSUB(b.x)], 1u);
        const unsigned gen = old / nloc;
        if (old + 1u == (gen + 1u) * nloc) {
            __builtin_amdgcn_fence(__ATOMIC_RELEASE, "agent");
            asm volatile("s_waitcnt vmcnt(0)" ::: "memory");
            const unsigned og = xb_add(&bar[XB_TOP], 1u);
            const unsigned tg = og / nx;
            if (og + 1u == (tg + 1u) * nx) xb_add(&bar[XB_TOPGEN], 1u);
            else XB_SPIN(xb_ld(&bar[XB_TOPGEN]) == tg, bar);
            __builtin_amdgcn_fence(__ATOMIC_ACQUIRE, "agent");
            xb_add(&bar[XB_XGEN(b.x)], 1u);
            asm volatile("s_waitcnt vmcnt(0)" ::: "memory");
        } else {
            XB_SPIN(xb_ld(&bar[XB_XGEN(b.x)]) == gen, bar);
            __builtin_amdgcn_fence(__ATOMIC_ACQUIRE, "agent");
            asm volatile("s_waitcnt vmcnt(0)" ::: "memory");
        }
    }
    __syncthreads();
}

struct Args { const float* in[25]; float* out; unsigned char* ws; int ph_lo, ph_hi; };
struct Frame {
    LAS unsigned char* lds;
    int tid, lane, wave, G, blk;
};

__device__ __forceinline__ void p0_transpose_item(const float* W, int K, int N, bf16* WT, int mode, const float* ksA, const float* ksB, float nscale, int nscale_cols, LAS float* scr, int item, int lane) {
    const int nblk = N / 32, kb = item / nblk, nb = item % nblk, k0 = 64 * kb, n0 = 32 * nb;
    const float* ks = ksA ? (k0 < 512 ? ksA + k0 : ksB + (k0 - 512)) : nullptr;
#pragma unroll 8
    for (int i = 0; i < 32; ++i) { const int kk = 2 * i + (lane >> 5); float v = W[(size_t)(k0 + kk) * N + n0 + (lane & 31)]; if (ks) v *= ks[kk]; scr[kk * 33 + (lane & 31)] = v; }
    LDS_WAIT(); asm volatile("" ::: "memory");
    const int drow0 = (mode == 0) ? n0 : ((n0 >> 7) * 256 + (n0 & 127) + (mode == 2 ? 128 : 0));
    const float sc = (n0 < nscale_cols) ? nscale : 1.0f;
    const int c = lane & 7;
#pragma unroll
    for (int j = 0; j < 4; ++j) { const int n = (lane >> 3) + 8 * j; const LAS float* s = scr + (8 * c) * 33 + n;
        v4u o; o.x = pk2(s[0 * 33] * sc, s[1 * 33] * sc); o.y = pk2(s[2 * 33] * sc, s[3 * 33] * sc); o.z = pk2(s[4 * 33] * sc, s[5 * 33] * sc); o.w = pk2(s[6 * 33] * sc, s[7 * 33] * sc);
        *(v4u*)(WT + (size_t)(drow0 + n) * K + k0 + 8 * c) = o; }
    LDS_WAIT(); asm volatile("" ::: "memory");
}
__device__ __forceinline__ int t5_bucket(int rel) {
    const int n = rel < 0 ? -rel : rel;
    int v;
    if (n < 8) v = n;
    else { v = 8 + (n >= 12) + (n >= 16) + (n >= 23) + (n >= 32) + (n >= 46) + (n >= 64) + (n >= 91); }
    return (rel > 0 ? 16 : 0) + v;
}
__device__ __forceinline__ void p0_prologue(const Frame& F, const Args& A) {
    unsigned char* ws = A.ws;
    LAS float* scr = (LAS float*)(F.lds + F.wave * 8448);
    const int gw = F.blk * NWAVES + F.wave, NGW = F.G * NWAVES;
    bf16* WIN = (bf16*)(ws + WS_WIN); bf16* WOUT = (bf16*)(ws + WS_WOUT); bf16* WGU = (bf16*)(ws + WS_WGU); bf16* WD = (bf16*)(ws + WS_WD);
    bf16* WEGU = (bf16*)(ws + WS_WEGU); bf16* WED = (bf16*)(ws + WS_WED);
    constexpr int I_IN = (DM / 64) * (INC / 32), I_OUT = (DM / 64) * (DM / 32), I_GU = (DM / 64) * (DFF / 32), I_D = (DFF / 64) * (DM / 32);
    constexpr int I_EGU = (DM / 64) * (DFE / 32), I_ED = (DFE / 64) * (DM / 32);
    constexpr int NITEMS = 2 * I_IN + 2 * I_OUT + 2 * I_GU + I_D + NEXP * (2 * I_EGU + I_ED);
    for (int it = gw; it < NITEMS; it += NGW) {
        int r = it;
        if (r < 2 * I_IN) { const int l = r / I_IN; r -= l * I_IN;
            p0_transpose_item(A.in[2] + (size_t)l * DM * INC, DM, INC, WIN + (size_t)l * INC * DM, 0, nullptr, nullptr, QSCALE, 512, scr, r, F.lane); continue; }
        r -= 2 * I_IN;
        if (r < 2 * I_OUT) { const int l = r / I_OUT; r -= l * I_OUT;
            p0_transpose_item(A.in[13] + (size_t)l * DM * DM, DM, DM, WOUT + (size_t)l * DM * DM, 0, A.in[11] + l * 512, A.in[12] + l * 512, 1.0f, 0, scr, r, F.lane); continue; }
        r -= 2 * I_OUT;
        if (r < I_GU) { p0_transpose_item(A.in[16], DM, DFF, WGU, 1, nullptr, nullptr, 1.0f, 0, scr, r, F.lane); continue; }
        r -= I_GU;
        if (r < I_GU) { p0_transpose_item(A.in[17], DM, DFF, WGU, 2, nullptr, nullptr, 1.0f, 0, scr, r, F.lane); continue; }
        r -= I_GU;
        if (r < I_D) { p0_transpose_item(A.in[18], DFF, DM, WD, 0, nullptr, nullptr, 1.0f, 0, scr, r, F.lane); continue; }
        r -= I_D;
        { constexpr int PER_E = 2 * I_EGU + I_ED; const int e = r / PER_E; r -= e * PER_E;
          if (r < I_EGU) { p0_transpose_item(A.in[20] + (size_t)e * DM * DFE, DM, DFE, WEGU + (size_t)e * 2 * DFE * DM, 1, nullptr, nullptr, 1.0f, 0, scr, r, F.lane); continue; }
          r -= I_EGU;
          if (r < I_EGU) { p0_transpose_item(A.in[21] + (size_t)e * DM * DFE, DM, DFE, WEGU + (size_t)e * 2 * DFE * DM, 2, nullptr, nullptr, 1.0f, 0, scr, r, F.lane); continue; }
          r -= I_EGU;
          p0_transpose_item(A.in[22] + (size_t)e * DFE * DM, DFE, DM, WED + (size_t)e * DM * DFE, 0, nullptr, nullptr, 1.0f, 0, scr, r, F.lane); }
    }
    { const f32x4* x4 = (const f32x4*)A.in[0]; v4u* o = (v4u*)(ws + WS_A);
      const size_t n8 = (size_t)NTOK * DM / 8, stride = (size_t)F.G * NTHREADS;
      for (size_t i = (size_t)F.blk * NTHREADS + F.tid; i < n8; i += stride) { const f32x4 a = x4[2 * i], b = x4[2 * i + 1];
          v4u w; w.x = pk2(a.x, a.y); w.y = pk2(a.z, a.w); w.z = pk2(b.x, b.y); w.w = pk2(b.z, b.w); o[i] = w; } }
    { bf16* GW = (bf16*)(ws + WS_GATEW);
      for (int i = F.blk * NTHREADS + F.tid; i < 2 * 2 * 8 * 64 * 64; i += F.G * NTHREADS) {
          const int d = i & 63, e = (i >> 6) & 63, n = (i >> 12) & 7, g = (i >> 15) & 1, l = i >> 16;
          const float v = (g ? A.in[8] : A.in[6])[(((size_t)l * 8 + n) * 64 + d) * 64 + e];
          GW[i] = (bf16)(pk2(v, v) & 0xffffu); } }
    if (F.blk == 0 && F.tid < 256) { float* LUT = (float*)(ws + WS_LUT); const int rel = F.tid - 191; const int bk = t5_bucket(rel);
#pragma unroll
        for (int h = 0; h < 8; ++h) LUT[h * 256 + F.tid] = A.in[1][bk * 8 + h] * LOG2E; }
}

template <bool FINAL>
__device__ __forceinline__ void lru_tile(const bf16* Z, int b, int c, int n, int lane, const bf16* gwr, const bf16* gwi, const float* convw, const float* convb,
                                         const float* br, const float* bi, const float* lam, float* outP, float* outE, const float* Hin, LAS float* yl) {
    const int fr = lane & 15, fq = lane >> 4;
    const size_t seq0 = (size_t)b * SEQ;
    bf16x8 xa[4][2];
#pragma unroll
    for (int ks = 0; ks < 2; ++ks) {
        const int ch = 64 * n + 32 * ks + 8 * fq;
        float cw[4][8], cb[8];
#pragma unroll
        for (int w = 0; w < 4; ++w) { const f32x4 a = *(const f32x4*)(convw + w * LRUW + ch), bq = *(const f32x4*)(convw + w * LRUW + ch + 4);
            cw[w][0] = a.x; cw[w][1] = a.y; cw[w][2] = a.z; cw[w][3] = a.w; cw[w][4] = bq.x; cw[w][5] = bq.y; cw[w][6] = bq.z; cw[w][7] = bq.w; }
        { const f32x4 a = *(const f32x4*)(convb + ch), bq = *(const f32x4*)(convb + ch + 4); cb[0] = a.x; cb[1] = a.y; cb[2] = a.z; cb[3] = a.w; cb[4] = bq.x; cb[5] = bq.y; cb[6] = bq.z; cb[7] = bq.w; }
#pragma unroll
        for (int m = 0; m < 4; ++m) {
            const int t = CHK * c + 16 * m + fr;
            float a8[8];
#pragma unroll
            for (int j = 0; j < 8; ++j) a8[j] = cb[j];
#pragma unroll
            for (int w = 0; w < 4; ++w) { const int tt = t + w - 3;
                if (tt >= 0) { const v4u v = *(const v4u*)(Z + (seq0 + tt) * INC + XBOFF + ch);
                    a8[0] += cw[w][0] * bflo(v.x); a8[1] += cw[w][1] * bfhi(v.x); a8[2] += cw[w][2] * bflo(v.y); a8[3] += cw[w][3] * bfhi(v.y);
                    a8[4] += cw[w][4] * bflo(v.z); a8[5] += cw[w][5] * bfhi(v.z); a8[6] += cw[w][6] * bflo(v.w); a8[7] += cw[w][7] * bfhi(v.w); } }
            v4u p; p.x = pk2(a8[0], a8[1]); p.y = pk2(a8[2], a8[3]); p.z = pk2(a8[4], a8[5]); p.w = pk2(a8[6], a8[7]);
            xa[m][ks] = __builtin_bit_cast(bf16x8, p);
        }
    }
#pragma unroll 1
    for (int nb = 0; nb < 4; ++nb) {
        bf16x8 wr[2], wi[2], idf[2];
#pragma unroll
        for (int ks = 0; ks < 2; ++ks) {
            wr[ks] = *(const bf16x8*)(gwr + (16 * nb + fr) * 64 + 32 * ks + 8 * fq);
            wi[ks] = *(const bf16x8*)(gwi + (16 * nb + fr) * 64 + 32 * ks + 8 * fq);
#pragma unroll
            for (int j = 0; j < 8; ++j) idf[ks][j] = (32 * ks + 8 * fq + j == 16 * nb + fr) ? (short)0x3F80 : (short)0;
        }
        f32x4 dr[4], di[4], dx[4];
#pragma unroll
        for (int m = 0; m < 4; ++m) { dr[m] = (f32x4){0.f, 0.f, 0.f, 0.f}; di[m] = dr[m]; dx[m] = dr[m];
#pragma unroll
            for (int ks = 0; ks < 2; ++ks) {
                dr[m] = __builtin_amdgcn_mfma_f32_16x16x32_bf16(xa[m][ks], wr[ks], dr[m], 0, 0, 0);
                di[m] = __builtin_amdgcn_mfma_f32_16x16x32_bf16(xa[m][ks], wi[ks], di[m], 0, 0, 0);
                dx[m] = __builtin_amdgcn_mfma_f32_16x16x32_bf16(xa[m][ks], idf[ks], dx[m], 0, 0, 0); } }
        const int chn = 64 * n + 16 * nb + fr;
        const float brv = br[chn], biv = bi[chn];
        const float sp = 8.0f * log1pf(__expf(-lam[chn]));
        float Hrun = 0.f, Prun = 1.f;
        if (FINAL) Hrun = Hin[((size_t)b * NCHUNK + c) * LRUW + chn];
#pragma unroll
        for (int m = 0; m < 4; ++m) {
            float pa[4], hl[4];
#pragma unroll
            for (int r = 0; r < 4; ++r) {
                const float rg = fast_sigmoid(dr[m][r] + brv), ig = fast_sigmoid(di[m][r] + biv);
                const float la = -rg * sp;
                const float a = __expf(la);
                const float x2 = 2.0f * la;
                const float om = (x2 > -0.02f) ? -x2 * (1.0f + x2 * (0.5f + x2 * (1.0f / 6.0f))) : (1.0f - a * a);
                const float u = sqrtf(fmaxf(om, 0.f)) * (ig * dx[m][r]);
                if (r == 0) { pa[0] = a; hl[0] = u; } else { hl[r] = a * hl[r - 1] + u; pa[r] = a * pa[r - 1]; }
            }
            float P = pa[3], H = hl[3];
            { const float P1 = __shfl_up(P, 16), H1 = __shfl_up(H, 16); if (fq >= 1) { H = P * H1 + H; P = P * P1; } }
            { const float P2 = __shfl_up(P, 32), H2 = __shfl_up(H, 32); if (fq >= 2) { H = P * H2 + H; P = P * P2; } }
            float Pex = __shfl_up(P, 16), Hex = __shfl_up(H, 16); if (fq == 0) { Pex = 1.f; Hex = 0.f; }
            const float Pblk = __shfl(P, 48 + fr), Hblk = __shfl(H, 48 + fr);
            if (FINAL) {
                const float hin = Hex + Pex * Hrun;
#pragma unroll
                for (int r = 0; r < 4; ++r) {
                    const float h = hl[r] + pa[r] * hin;
                    const float g = bf2f(Z[(seq0 + CHK * c + 16 * m + 4 * fq + r) * INC + GBOFF + chn]);
                    yl[(16 * m + 4 * fq + r) * LRUW + chn] = gelu_tanh(g) * h;
                }
            }
            Hrun = Hblk + Pblk * Hrun; Prun = Pblk * Prun;
        }
        if (!FINAL) { if (fq == 0) { const size_t o = ((size_t)b * NCHUNK + c) * LRUW + chn; outP[o] = Prun; outE[o] = Hrun; } }
    }
}

__device__ __forceinline__ void p_lru_summary(const Frame& F, const Args& A, int l) {
    unsigned char* ws = A.ws;
    const bf16* Z = (const bf16*)(ws + WS_ZH);
    const bf16* GW = (const bf16*)(ws + WS_GATEW) + (size_t)l * 2 * 8 * 4096;
    for (int it = F.blk; it < BATCH * NCHUNK; it += F.G) {
        const int b = it >> 8, c = it & 255, n = F.wave;
        lru_tile<false>(Z, b, c, n, F.lane, GW + n * 4096, GW + 8 * 4096 + n * 4096, A.in[4] + l * 4 * LRUW, A.in[5] + l * LRUW, A.in[7] + l * LRUW, A.in[9] + l * LRUW, A.in[10] + l * LRUW,
                        (float*)(ws + WS_LRUP), (float*)(ws + WS_LRUE), nullptr, nullptr);
    }
}
__device__ __forceinline__ void p_lru_carry(const Frame& F, const Args& A) {
    unsigned char* ws = A.ws;
    const float* Pg = (const float*)(ws + WS_LRUP); const float* Eg = (const float*)(ws + WS_LRUE); float* Hg = (float*)(ws + WS_HIN);
    const int gw = F.blk * NWAVES + F.wave, NGW = F.G * NWAVES;
    for (int p = gw; p < BATCH * LRUW; p += NGW) {
        const int b = p >> 9, ch = p & 511;
        float pk[4], ek[4];
#pragma unroll
        for (int k = 0; k < 4; ++k) { const size_t o = ((size_t)b * NCHUNK + 4 * F.lane + k) * LRUW + ch; pk[k] = Pg[o]; ek[k] = Eg[o]; }
        float P = pk[0], H = ek[0];
#pragma unroll
        for (int k = 1; k < 4; ++k) { H = pk[k] * H + ek[k]; P = pk[k] * P; }
#pragma unroll
        for (int d = 1; d < 64; d <<= 1) { const float P1 = __shfl_up(P, d), H1 = __shfl_up(H, d); if (F.lane >= d) { H = P * H1 + H; P = P * P1; } }
        float h = __shfl_up(H, 1); if (F.lane == 0) h = 0.f;
#pragma unroll
        for (int k = 0; k < 4; ++k) { Hg[((size_t)b * NCHUNK + 4 * F.lane + k) * LRUW + ch] = h; h = pk[k] * h + ek[k]; }
    }
}

__device__ __forceinline__ int crow(int r, int hi) { return (r & 3) + 8 * (r >> 2) + 4 * hi; }
__device__ __forceinline__ s16x4 vtr(const LAS unsigned char* p) { return __builtin_bit_cast(s16x4, __builtin_amdgcn_ds_read_tr16_b64_v4i16((LAS s16x4*)p)); }
__device__ __forceinline__ void p_mixer(const Frame& F, const Args& A, int l) {
    unsigned char* ws = A.ws;
    const bf16* Z = (const bf16*)(ws + WS_ZH);
    bf16* Y = (bf16*)(ws + WS_A);
    const bf16* GW = (const bf16*)(ws + WS_GATEW) + (size_t)l * 2 * 8 * 4096;
    LAS unsigned char* Kl = F.lds;
    LAS unsigned char* Vl = F.lds + 49152;
    LAS float* yl = (LAS float*)F.lds;
    LAS bf16* ya = (LAS bf16*)F.lds;
    LAS float* lut = (LAS float*)(F.lds + LDS_LUT);
    const int lane = F.lane, wave = F.wave, r32 = lane & 31, hi = lane >> 5;
    { const float* LUTg = (const float*)(ws + WS_LUT); for (int i = F.tid; i < 2048; i += NTHREADS) lut[i] = LUTg[i]; }
    const float sinkv = A.in[3][l * 8 + wave] * LOG2E;
    const int kvh = wave >> 2;
    for (int it = F.blk; it < BATCH * NCHUNK; it += F.G) {
        const int b = it >> 8, c = it & 255;
        const size_t row0 = (size_t)b * SEQ + (size_t)CHK * c;
        const int T0 = (c >= 2) ? 0 : 2 - c;
        __syncthreads();
        lru_tile<true>(Z, b, c, wave, lane, GW + wave * 4096, GW + 8 * 4096 + wave * 4096, A.in[4] + l * 4 * LRUW, A.in[5] + l * LRUW, A.in[7] + l * LRUW, A.in[9] + l * LRUW, A.in[10] + l * LRUW,
                       nullptr, nullptr, (const float*)(ws + WS_HIN), yl);
        __syncthreads();
#pragma unroll
        for (int i = 0; i < 8; ++i) { const int tok = 8 * wave + i;
            const f32x4 a = *(const LAS f32x4*)(yl + tok * LRUW + 8 * lane), q = *(const LAS f32x4*)(yl + tok * LRUW + 8 * lane + 4);
            const float ss = wave_sum((a.x * a.x + a.y * a.y) + (a.z * a.z + a.w * a.w) + (q.x * q.x + q.y * q.y) + (q.z * q.z + q.w * q.w));
            const float rstd = 1.0f / sqrtf(ss * (1.0f / 512.0f) + RMS_EPS);
            v4u w; w.x = pk2(a.x * rstd, a.y * rstd); w.y = pk2(a.z * rstd, a.w * rstd); w.z = pk2(q.x * rstd, q.y * rstd); w.w = pk2(q.z * rstd, q.w * rstd);
            *(v4u*)(Y + (row0 + tok) * DM + 512 + 8 * lane) = w; }
        __syncthreads();
#pragma unroll
        for (int h2 = 0; h2 < 2; ++h2)
#pragma unroll
            for (int T = 0; T < 3; ++T) {
                v4u kq = (v4u){0u, 0u, 0u, 0u}, vq = kq;
                if (T >= T0) { const size_t cr = row0 + (size_t)CHK * T - 2 * CHK;
                    kq = *(const v4u*)(Z + (cr + lane) * INC + KOFF + 64 * h2 + 8 * wave);
                    vq = *(const v4u*)(Z + (cr + 16 * (wave & 3) + (lane >> 2)) * INC + VOFF + 64 * h2 + 32 * (wave >> 2) + 8 * (lane & 3)); }
                *(LAS v4u*)(Kl + (h2 * 3 + T) * 8192 + wave * 1024 + lane * 16) = kq;
                *(LAS v4u*)(Vl + (h2 * 3 + T) * 8192 + wave * 1024 + lane * 16) = vq;
            }
        __syncthreads();
        unsigned opk[2][2][8];
#pragma unroll
        for (int qb = 0; qb < 2; ++qb) {
            const int qi = 32 * qb + r32;
            bf16x8 qr[4];
#pragma unroll
            for (int d0 = 0; d0 < 4; ++d0) qr[d0] = *(const bf16x8*)(Z + (row0 + qi) * INC + 64 * wave + 16 * d0 + 8 * hi);
            f32x16 s[3][2];
            const LAS float* lutq = lut + wave * 256 + 63 - qi;
#pragma unroll
            for (int T = 0; T < 3; ++T) {
#pragma unroll
                for (int hf = 0; hf < 2; ++hf)
#pragma unroll
                    for (int r = 0; r < 16; ++r) s[T][hf][r] = lutq[64 * T + 32 * hf + crow(r, hi)];
                const LAS unsigned char* kb = Kl + (kvh * 3 + T) * 8192 + hi * 1024 + r32 * 16;
#pragma unroll
                for (int d0 = 0; d0 < 4; ++d0) {
                    const bf16x8 b0 = *(const LAS bf16x8*)(kb + d0 * 2048), b1 = *(const LAS bf16x8*)(kb + d0 * 2048 + 512);
                    s[T][0] = __builtin_amdgcn_mfma_f32_32x32x16_bf16(b0, qr[d0], s[T][0], 0, 0, 0);
                    s[T][1] = __builtin_amdgcn_mfma_f32_32x32x16_bf16(b1, qr[d0], s[T][1], 0, 0, 0);
                }
                if (T < T0) {
#pragma unroll
                    for (int hf = 0; hf < 2; ++hf)
#pragma unroll
                        for (int r = 0; r < 16; ++r) s[T][hf][r] = -1e30f;
                }
            }
            float mx = sinkv;
#pragma unroll
            for (int T = 0; T < 3; ++T)
#pragma unroll
                for (int hf = 0; hf < 2; ++hf)
#pragma unroll
                    for (int r = 0; r < 16; ++r) mx = fmaxf(mx, s[T][hf][r]);
            mx = fmaxf(mx, __shfl_xor(mx, 32));
            float lsum = 0.f;
#pragma unroll
            for (int T = 0; T < 3; ++T)
#pragma unroll
                for (int hf = 0; hf < 2; ++hf)
#pragma unroll
                    for (int r = 0; r < 16; ++r) { const float p = __builtin_amdgcn_exp2f(s[T][hf][r] - mx); s[T][hf][r] = p; lsum += p; }
            lsum += __shfl_xor(lsum, 32);
            lsum += __builtin_amdgcn_exp2f(sinkv - mx);
            const float inv = 1.0f / lsum;
            f32x16 o[2]; o[0] = (f32x16){0.f, 0.f, 0.f, 0.f, 0.f, 0.f, 0.f, 0.f, 0.f, 0.f, 0.f, 0.f, 0.f, 0.f, 0.f, 0.f}; o[1] = o[0];
#pragma unroll
            for (int T = 0; T < 3; ++T) {
                v4u pw[4];
#pragma unroll
                for (int k = 0; k < 4; ++k) { const int hf = k >> 1, r0 = (k & 1) * 8;
                    pw[k].x = pk2(s[T][hf][r0 + 0], s[T][hf][r0 + 1]); pw[k].y = pk2(s[T][hf][r0 + 2], s[T][hf][r0 + 3]);
                    pw[k].z = pk2(s[T][hf][r0 + 4], s[T][hf][r0 + 5]); pw[k].w = pk2(s[T][hf][r0 + 6], s[T][hf][r0 + 7]); }
                const LAS unsigned char* vb = Vl + (kvh * 3 + T) * 8192 + ((lane >> 4) & 1) * 32 + (lane & 3) * 8 + (4 * hi + ((lane & 15) >> 2)) * 64;
#pragma unroll
                for (int d0 = 0; d0 < 2; ++d0)
#pragma unroll
                    for (int ks = 0; ks < 4; ++ks) {
                        const s16x4 lo = vtr(vb + d0 * 4096 + ks * 1024), hv = vtr(vb + d0 * 4096 + ks * 1024 + 512);
                        const bf16x8 vf = (bf16x8){lo[0], lo[1], lo[2], lo[3], hv[0], hv[1], hv[2], hv[3]};
                        o[d0] = __builtin_amdgcn_mfma_f32_32x32x16_bf16(vf, __builtin_bit_cast(bf16x8, pw[ks]), o[d0], 0, 0, 0);
                    }
            }
#pragma unroll
            for (int d0 = 0; d0 < 2; ++d0)
#pragma unroll
                for (int r = 0; r < 16; r += 2) opk[qb][d0][r >> 1] = pk2(o[d0][r] * inv, o[d0][r + 1] * inv);
        }
        __syncthreads();
#pragma unroll
        for (int qb = 0; qb < 2; ++qb)
#pragma unroll
            for (int d0 = 0; d0 < 2; ++d0)
#pragma unroll
                for (int g = 0; g < 4; ++g) { v2u w; w.x = opk[qb][d0][2 * g]; w.y = opk[qb][d0][2 * g + 1];
                    *(LAS v2u*)(ya + (32 * qb + r32) * 512 + 64 * wave + 32 * d0 + 8 * g + 4 * hi) = w; }
        __syncthreads();
#pragma unroll
        for (int i = 0; i < 8; ++i) { const int tok = 8 * wave + i;
            const v4u w0 = *(const LAS v4u*)(ya + tok * 512 + 8 * lane);
            const float x0 = bflo(w0.x), x1 = bfhi(w0.x), x2 = bflo(w0.y), x3 = bfhi(w0.y), x4 = bflo(w0.z), x5 = bfhi(w0.z), x6 = bflo(w0.w), x7 = bfhi(w0.w);
            const float ss = wave_sum((x0 * x0 + x1 * x1) + (x2 * x2 + x3 * x3) + (x4 * x4 + x5 * x5) + (x6 * x6 + x7 * x7));
            const float rstd = 1.0f / sqrtf(ss * (1.0f / 512.0f) + RMS_EPS);
            v4u w; w.x = pk2(x0 * rstd, x1 * rstd); w.y = pk2(x2 * rstd, x3 * rstd); w.z = pk2(x4 * rstd, x5 * rstd); w.w = pk2(x6 * rstd, x7 * rstd);
            *(v4u*)(Y + (row0 + tok) * DM + 8 * lane) = w; }
    }
}

template <int MODE>
__device__ __forceinline__ void p_layernorm(const Frame& F, const Args& A, const float* gam, const float* bet) {
    unsigned char* ws = A.ws;
    float* X = A.out;
    bf16* XB = (bf16*)(ws + WS_A);
    LAS unsigned* misc = (LAS unsigned*)(F.lds + LDS_MISC);
    const int lane = F.lane;
    if (MODE == 1) { if (F.tid < 8) misc[F.tid] = 0u; __syncthreads(); }
    f32x4 gv[4], bv[4];
#pragma unroll
    for (int j = 0; j < 4; ++j) { gv[j] = *(const f32x4*)(gam + 4 * lane + 256 * j); bv[j] = *(const f32x4*)(bet + 4 * lane + 256 * j); }
    const int rpw = NTOK / F.G;
    for (int i = F.wave; i < rpw; i += NWAVES) {
        const int m = F.blk * rpw + i;
        f32x4* xr = (f32x4*)(X + (size_t)m * DM) + lane;
        f32x4 v[4];
#pragma unroll
        for (int j = 0; j < 4; ++j) v[j] = xr[64 * j];
        if (MODE == 2) {
            const int* tp = (const int*)(ws + WS_TOKPOS) + 2 * m; const float* tw = (const float*)(ws + WS_TOKW) + 2 * m;
            const int p0 = tp[0], p1 = tp[1]; const float w0 = tw[0], w1 = tw[1];
            const v2u* y0 = (const v2u*)((const bf16*)(ws + WS_XS) + (size_t)p0 * DM) + lane; const v2u* y1 = (const v2u*)((const bf16*)(ws + WS_XS) + (size_t)p1 * DM) + lane;
#pragma unroll
            for (int j = 0; j < 4; ++j) { const v2u a = y0[64 * j], c = y1[64 * j];
                v[j].x = ALPHA * v[j].x + w0 * bflo(a.x) + w1 * bflo(c.x); v[j].y = ALPHA * v[j].y + w0 * bfhi(a.x) + w1 * bfhi(c.x);
                v[j].z = ALPHA * v[j].z + w0 * bflo(a.y) + w1 * bflo(c.y); v[j].w = ALPHA * v[j].w + w0 * bfhi(a.y) + w1 * bfhi(c.y); }
        }
        float s = 0.f;
#pragma unroll
        for (int j = 0; j < 4; ++j) s += (v[j].x + v[j].y) + (v[j].z + v[j].w);
        const float mean = wave_sum(s) * (1.f / DM); float s2 = 0.f;
#pragma unroll
        for (int j = 0; j < 4; ++j) { v[j] = v[j] - mean; s2 += (v[j].x * v[j].x + v[j].y * v[j].y) + (v[j].z * v[j].z + v[j].w * v[j].w); }
        const float rstd = 1.f / sqrtf(wave_sum(s2) * (1.f / DM) + LN_EPS);
#pragma unroll
        for (int j = 0; j < 4; ++j) { v[j] = v[j] * rstd * gv[j] + bv[j]; xr[64 * j] = v[j]; }
        if (MODE == 0) {
            v2u* o8 = (v2u*)(XB + (size_t)m * DM) + lane;
#pragma unroll
            for (int j = 0; j < 4; ++j) { v2u w; w.x = pk2(v[j].x, v[j].y); w.y = pk2(v[j].z, v[j].w); o8[64 * j] = w; }
        }
        if (MODE == 1) {
            const float* RW = A.in[19];
            float lg[8];
#pragma unroll
            for (int e = 0; e < 8; ++e) lg[e] = 0.f;
#pragma unroll
            for (int j = 0; j < 4; ++j)
#pragma unroll
                for (int q = 0; q < 4; ++q) { const int k = 4 * lane + 256 * j + q; const f32x4 a = *(const f32x4*)(RW + k * 8), c = *(const f32x4*)(RW + k * 8 + 4); const float xv = v[j][q];
                    lg[0] += xv * a.x; lg[1] += xv * a.y; lg[2] += xv * a.z; lg[3] += xv * a.w; lg[4] += xv * c.x; lg[5] += xv * c.y; lg[6] += xv * c.z; lg[7] += xv * c.w; }
#pragma unroll
            for (int e = 0; e < 8; ++e) lg[e] = wave_sum(lg[e]);
            int e0 = 0; float v0 = lg[0];
#pragma unroll
            for (int e = 1; e < 8; ++e) if (lg[e] > v0) { v0 = lg[e]; e0 = e; }
            int e1 = -1; float v1 = -3.0e38f;
#pragma unroll
            for (int e = 0; e < 8; ++e) if (e != e0 && lg[e] > v1) { v1 = lg[e]; e1 = e; }
            const float w0 = 1.0f / (1.0f + __expf(v1 - v0)), w1 = 1.0f - w0;
            if (lane == 0) { int* te = (int*)(ws + WS_TOKE) + 2 * m; float* tw = (float*)(ws + WS_TOKW) + 2 * m; te[0] = e0; te[1] = e1; tw[0] = w0; tw[1] = w1;
                atomicAdd((unsigned*)(misc + e0), 1u); atomicAdd((unsigned*)(misc + e1), 1u); }
        }
    }
    if (MODE == 1) { __syncthreads(); if (F.tid < 8) ((unsigned*)(ws + WS_HIST))[F.blk * 8 + F.tid] = misc[F.tid]; }
}

__device__ __forceinline__ void p_route(const Frame& F, const Args& A) {
    unsigned char* ws = A.ws;
    LAS unsigned* misc = (LAS unsigned*)(F.lds + LDS_MISC);
    LAS int* posl = (LAS int*)(F.lds + LDS_POS);
    const unsigned* hist = (const unsigned*)(ws + WS_HIST);
    const int lane = F.lane, rpw = NTOK / F.G;
    {
        const int e = F.wave; unsigned tot = 0u, bef = 0u;
        for (int v = lane; v < F.G; v += 64) { const unsigned h = hist[v * 8 + e]; tot += h; if (v < F.blk) bef += h; }
#pragma unroll
        for (int o = 1; o < 64; o <<= 1) { tot += __shfl_xor(tot, o); bef += __shfl_xor(bef, o); }
        if (lane == 0) { misc[16 + e] = tot; misc[24 + e] = bef; }
    }
    __syncthreads();
    int seg[9]; seg[0] = 0;
#pragma unroll
    for (int e = 0; e < 8; ++e) seg[e + 1] = seg[e] + (int)((misc[16 + e] + 255u) >> 8);
    if (F.blk == 0 && F.tid == 0) { int* meta = (int*)(ws + WS_META);
#pragma unroll
        for (int e = 0; e < 9; ++e) meta[e] = seg[e];
        meta[9] = seg[8]; }
    if (F.wave == 0) {
        const int* te = (const int*)(ws + WS_TOKE); int* tp = (int*)(ws + WS_TOKPOS); int* rt = nullptr; (void)rt;
        unsigned run[8];
#pragma unroll
        for (int e = 0; e < 8; ++e) run[e] = (unsigned)seg[e] * 256u + misc[24 + e];
        for (int h = 0; h < rpw; h += 64) {
            const int m = F.blk * rpw + h + lane;
#pragma unroll
            for (int k = 0; k < 2; ++k) {
                const int ek = te[2 * m + k]; int pos = 0;
#pragma unroll
                for (int e = 0; e < 8; ++e) { const unsigned long long mask = __ballot(ek == e);
                    if (ek == e) pos = (int)(run[e] + (unsigned)__popcll(mask & ((1ull << lane) - 1ull)));
                    run[e] += (unsigned)__popcll(mask); }
                tp[2 * m + k] = pos; posl[2 * (h + lane) + k] = pos;
            }
        }
    }
    __syncthreads();
    {
        const float* X = A.out; bf16* XS = (bf16*)(ws + WS_XS);
        for (int i = F.wave; i < rpw; i += NWAVES) {
            const int m = F.blk * rpw + i; const int p0 = posl[2 * i], p1 = posl[2 * i + 1];
            const f32x4* xr = (const f32x4*)(X + (size_t)m * DM) + lane;
            v2u* o0 = (v2u*)(XS + (size_t)p0 * DM) + lane; v2u* o1 = (v2u*)(XS + (size_t)p1 * DM) + lane;
#pragma unroll
            for (int j = 0; j < 4; ++j) { const f32x4 v = xr[64 * j]; v2u w; w.x = pk2(v.x, v.y); w.y = pk2(v.z, v.w); o0[64 * j] = w; o1[64 * j] = w; }
        }
    }
    if (F.blk < 8) {
        int r0 = 0, r1 = 0;
#pragma unroll
        for (int e = 0; e < 8; ++e) if (e == F.blk) { r0 = seg[e] * 256 + (int)misc[16 + e]; r1 = seg[e + 1] * 256; }
        v4u* XS4 = (v4u*)(ws + WS_XS);
        for (size_t i = (size_t)r0 * 128 + F.tid; i < (size_t)r1 * 128; i += NTHREADS) XS4[i] = (v4u){0u, 0u, 0u, 0u};
    }
}

#ifndef MK_ONE_LAUNCH
#define MK_ONE_LAUNCH 1
#endif
constexpr int NPHASES = 28;

#ifndef PH_MASK
#define PH_MASK 0xFFFFFFFu
#endif
#define IN(k) (((PH_MASK >> (k)) & 1u) && lo <= (k) && (k) < hi)
#define SEAM(k) do { if (MK_ONE_LAUNCH && lo <= (k) && (k) + 1 < hi) xcd_barrier(bar); } while (0)
template <int l>
__device__ __forceinline__ void layer_phases(const Frame& F, const Args& args, const XcdBarrier& bar, const int lo, const int hi) {
    unsigned char* ws = args.ws;
        const int pb = 1 + 9 * l;
        const float* xres = (l == 0) ? args.in[0] : args.out;
        if (IN(pb + 0)) {
            pg8::Gemm g{(const bf16*)(ws + WS_A), (const bf16*)(ws + WS_WIN) + (size_t)l * INC * DM, NTOK, INC, DM, 0};
            pg8::StaticOrder S; S.init(NTOK, INC, F.G, F.blk);
            pg8::EpiBf16 E{(bf16*)(ws + WS_ZH), INC};
            pg8::gemm_phase<pg8::EpiBf16, pg8::StaticOrder, true, true>(F.lds, g, S, E);
            SEAM(pb + 0);
        }
        if (IN(pb + 1)) { p_lru_summary(F, args, l); SEAM(pb + 1); }
        if (IN(pb + 2)) { p_lru_carry(F, args); SEAM(pb + 2); }
        if (IN(pb + 3)) { p_mixer(F, args, l); SEAM(pb + 3); }
        if (IN(pb + 4)) {
            pg8::Gemm g{(const bf16*)(ws + WS_A), (const bf16*)(ws + WS_WOUT) + (size_t)l * DM * DM, NTOK, DM, DM, 0};
            pg8::StaticOrder S; S.init(NTOK, DM, F.G, F.blk);
            pg8::EpiResF32 E{xres, args.out, DM, ALPHA};
            pg8::gemm_phase<pg8::EpiResF32, pg8::StaticOrder, true, true>(F.lds, g, S, E);
            SEAM(pb + 4);
        }
        if (l == 0) {
            if (IN(6)) { p_layernorm<0>(F, args, args.in[14], args.in[15]); SEAM(6); }
            if (IN(7)) {
                pg8::Gemm g{(const bf16*)(ws + WS_A), (const bf16*)(ws + WS_WGU), NTOK, 2 * DFF, DM, 0};
                pg8::StaticOrder S; S.init(NTOK, 2 * DFF, F.G, F.blk);
                pg8::EpiSwiGLU E{(bf16*)(ws + WS_ZH), DFF};
                pg8::gemm_phase<pg8::EpiSwiGLU, pg8::StaticOrder, true, true>(F.lds, g, S, E);
                SEAM(7);
            }
            if (IN(8)) {
                pg8::Gemm g{(const bf16*)(ws + WS_ZH), (const bf16*)(ws + WS_WD), NTOK, DM, DFF, 0};
                pg8::StaticOrder S; S.init(NTOK, DM, F.G, F.blk);
                pg8::EpiResF32 E{args.out, args.out, DM, ALPHA};
                pg8::gemm_phase<pg8::EpiResF32, pg8::StaticOrder, true, true>(F.lds, g, S, E);
                SEAM(8);
            }
            if (IN(9)) { p_layernorm<0>(F, args, args.in[23], args.in[24]); SEAM(9); }
        } else {
            if (IN(15)) { p_layernorm<1>(F, args, args.in[14] + DM, args.in[15] + DM); SEAM(15); }
            if (IN(16)) { p_route(F, args); SEAM(16); }
            for (int p = 0; p < NPASS; ++p) {
                int s1 = 0, s2 = 0, s3 = 0, s4 = 0, s5 = 0, s6 = 0, s7 = 0, nt = 0;
                if (IN(17 + 2 * p) || IN(18 + 2 * p)) { const int* meta = (const int*)(ws + WS_META);
                    s1 = __builtin_amdgcn_readfirstlane(meta[1]); s2 = __builtin_amdgcn_readfirstlane(meta[2]); s3 = __builtin_amdgcn_readfirstlane(meta[3]); s4 = __builtin_amdgcn_readfirstlane(meta[4]);
                    s5 = __builtin_amdgcn_readfirstlane(meta[5]); s6 = __builtin_amdgcn_readfirstlane(meta[6]); s7 = __builtin_amdgcn_readfirstlane(meta[7]); nt = __builtin_amdgcn_readfirstlane(meta[9]); }
                int nm = nt - PASS_TILES * p; nm = nm > PASS_TILES ? PASS_TILES : nm;
                if (IN(17 + 2 * p)) {
                    if (nm > 0) {
                        pg8::Gemm g{(const bf16*)(ws + WS_XS) + (size_t)p * PASS_TILES * 256 * DM, (const bf16*)(ws + WS_WEGU), nm * 256, 2 * DFE, DM, (size_t)2 * DFE * DM * 2};
                        pg8::MoeOrder S; S.so.init(nm * 256, 2 * DFE, F.G, F.blk); S.tile0 = p * PASS_TILES; S.s1 = s1; S.s2 = s2; S.s3 = s3; S.s4 = s4; S.s5 = s5; S.s6 = s6; S.s7 = s7;
                        pg8::EpiSwiGLU E{(bf16*)(ws + WS_HM), DFE};
                        pg8::gemm_phase<pg8::EpiSwiGLU, pg8::MoeOrder, true, true>(F.lds, g, S, E);
                    }
                    SEAM(17 + 2 * p);
                }
                if (IN(18 + 2 * p)) {
                    if (nm > 0) {
                        pg8::Gemm g{(const bf16*)(ws + WS_HM), (const bf16*)(ws + WS_WED), nm * 256, DM, DFE, (size_t)DM * DFE * 2};
                        pg8::MoeOrder S; S.so.init(nm * 256, DM, F.G, F.blk); S.tile0 = p * PASS_TILES; S.s1 = s1; S.s2 = s2; S.s3 = s3; S.s4 = s4; S.s5 = s5; S.s6 = s6; S.s7 = s7;
                        pg8::EpiBf16 E{(bf16*)(ws + WS_XS) + (size_t)p * PASS_TILES * 256 * DM, DM};
                        pg8::gemm_phase<pg8::EpiBf16, pg8::MoeOrder, true, true>(F.lds, g, S, E);
                    }
                    SEAM(18 + 2 * p);
                }
            }
            if (IN(27)) { p_layernorm<2>(F, args, args.in[23] + DM, args.in[24] + DM); }
        }
}
__global__ void __launch_bounds__(NTHREADS, 2) fwd_kernel(Args args) {
    extern __shared__ __attribute__((aligned(16))) unsigned char lds_raw[];
    Frame F;
    F.lds = (LAS unsigned char*)lds_raw;
    F.tid = threadIdx.x; F.lane = F.tid & 63; F.wave = __builtin_amdgcn_readfirstlane(F.tid >> 6);
    F.G = gridDim.x; F.blk = blockIdx.x;
    unsigned char* ws = args.ws;
    volatile LAS unsigned* MISC = (volatile LAS unsigned*)(F.lds + LDS_MISC);
    if (F.tid < 64) MISC[F.tid] = 0u;
    __syncthreads();
    XcdBarrier bar; bar.bar = (unsigned*)(ws + WS_CTL) + CW_BAR; bar.x = 0; bar.st = nullptr;
    if (MK_ONE_LAUNCH) bar = xcd_barrier_post((unsigned*)(ws + WS_CTL) + CW_BAR, MISC + 8);
    const int lo = args.ph_lo, hi = args.ph_hi;

    if (IN(0)) { p0_prologue(F, args); SEAM(0); }

    layer_phases<0>(F, args, bar, lo, hi);
    layer_phases<1>(F, args, bar, lo, hi);
}

extern "C" void kernel_launch(void* const* d_in, const int* in_sizes, int n_in, void* d_out, int out_size, void* d_ws, size_t ws_size, hipStream_t stream) {
    static int grid = 0;
    if (grid == 0) {
        if (n_in != 25 || in_sizes[0] != NTOK * DM || out_size != NTOK * DM || ws_size < WS_END) {
            fprintf(stderr, "kernel_launch: unexpected problem: n_in %d in0 %d out %d ws %zu (need %zu)\n", n_in, n_in > 0 ? in_sizes[0] : -1, out_size, ws_size, (size_t)WS_END); grid = -1; return; }
        int dev = 0, cus = 0, per_cu = 0;
        if (hipGetDevice(&dev) != hipSuccess || hipDeviceGetAttribute(&cus, hipDeviceAttributeMultiprocessorCount, dev) != hipSuccess) { fprintf(stderr, "kernel_launch: device query failed\n"); grid = -1; return; }
        if (hipFuncSetAttribute((const void*)fwd_kernel, hipFuncAttributeMaxDynamicSharedMemorySize, LDS_BYTES) != hipSuccess) { fprintf(stderr, "kernel_launch: hipFuncSetAttribute failed\n"); grid = -1; return; }
        if (hipOccupancyMaxActiveBlocksPerMultiprocessor(&per_cu, (const void*)fwd_kernel, NTHREADS, LDS_BYTES) != hipSuccess || per_cu < 1)
            fprintf(stderr, "kernel_launch: note: occupancy query reports %d workgroups per CU\n", per_cu);
        (void)hipGetLastError();
        grid = cus;
        if (grid != 256) fprintf(stderr, "kernel_launch: note: %d CUs (built for 256)\n", grid);
        if (NTOK % grid != 0 || grid > 256) grid = 256;
    }
    if (grid < 0) return;
    (void)hipMemsetAsync((char*)d_ws + WS_CTL, 0, CTL_ZERO_BYTES, stream);
    Args a{};
    for (int i = 0; i < 25; ++i) a.in[i] = (const float*)d_in[i];
    a.out = (float*)d_out; a.ws = (unsigned char*)d_ws;
#if MK_ONE_LAUNCH
    a.ph_lo = 0; a.ph_hi = NPHASES;
    hipLaunchKernelGGL(fwd_kernel, dim3(grid), dim3(NTHREADS), LDS_BYTES, stream, a);
#else
    for (int k = 0; k < NPHASES; ++k) { a.ph_lo = k; a.ph_hi = k + 1; hipLaunchKernelGGL(fwd_kernel, dim3(grid), dim3(NTHREADS), LDS_BYTES, stream, a); }
#endif
    const hipError_t le = hipPeekAtLastError();
    if (le != hipSuccess) fprintf(stderr, "kernel_launch: launch failed: %s\n", hipGetErrorName(le));
}
```

```cpp
#include <hip/hip_runtime.h>
#include <cstdio>
#include <cstdint>
namespace pg8 {
#define PG8_LAS __attribute__((address_space(3)))
typedef unsigned short bf16_t;
typedef short bf16x8 __attribute__((ext_vector_type(8)));
typedef float f32x4 __attribute__((ext_vector_type(4)));
typedef unsigned u32x4 __attribute__((ext_vector_type(4)));
typedef int v4i __attribute__((ext_vector_type(4)));
typedef int v8i __attribute__((ext_vector_type(8)));
constexpr int BM = 256, BK = 64, HALF = 128, HTB = HALF * BK * 2  , STAGE_BYTES = 8 * HTB, NXCD = 8, WGM = 8;

__host__ __device__ __forceinline__ int lds_byte(int r, int c) { const int st = (r >> 4) * 2 + (c >> 5), rr = r & 15, cc = c & 31, ob = rr * 64 + cc * 2; return st * 1024 + (ob ^ (((ob >> 9) & 1) << 5)); }
__host__ __device__ __forceinline__ void stage_rc(int b, int& R, int& C) { const int st = b / 1024, sb = b % 1024, swz = sb ^ (((sb >> 9) & 1) << 5); R = (st >> 1) * 16 + swz / 64; C = (st & 1) * 32 + (swz % 64) / 2; }
__host__ __device__ __forceinline__ int perm32(int rho) { const int n = rho >> 4, i = rho & 15; return 8 * (i >> 2) + 4 * n + (i & 3); }

struct Unit { int pm, pn, be; };
struct Gemm { const bf16_t* A; const bf16_t* Bt; int M, N, K; size_t bstride; };

struct StaticOrder {
    int nM, nN, nwg, G, c;
    __host__ __device__ void init(int M, int N, int G_, int c_) { nM = M / BM; nN = N / BM; nwg = nM * nN; G = G_; c = c_; }
    __host__ __device__ bool next(int i, Unit& u) const {
        const long L = (long)i * G + c; if (L >= nwg) return false;
        int wgid = (int)L; { const int q = nwg / NXCD, r = nwg % NXCD, xcd = wgid % NXCD, off = wgid / NXCD; wgid = (xcd < r ? xcd * (q + 1) : r * (q + 1) + (xcd - r) * q) + off; }
        const int nig = WGM * nN, gid = wgid / nig, fm = gid * WGM, gsz = (nM - fm) < WGM ? (nM - fm) : WGM;
        u.pm = fm + ((wgid % nig) % gsz); u.pn = (wgid % nig) / gsz; u.be = 0; return true;
    }
    __device__ __forceinline__ void a_ready(const Unit&) const {}
    __device__ __forceinline__ void done(const Unit&) const {}
};
struct MoeOrder {
    StaticOrder so; int tile0, s1, s2, s3, s4, s5, s6, s7;
    __device__ __forceinline__ bool next(int i, Unit& u) const {
        if (!so.next(i, u)) return false;
        const int t = tile0 + u.pm;
        u.be = (t >= s1) + (t >= s2) + (t >= s3) + (t >= s4) + (t >= s5) + (t >= s6) + (t >= s7); return true;
    }
    __device__ __forceinline__ void a_ready(const Unit&) const {}
    __device__ __forceinline__ void done(const Unit&) const {}
};

__device__ __forceinline__ unsigned cvt_pk_bf16(float lo, float hi) { unsigned r; asm volatile("v_cvt_pk_bf16_f32 %0, %1, %2" : "=v"(r) : "v"(lo), "v"(hi)); return r; }

struct EpiBf16 {
    static constexpr bool PERM = true, AFTER_DRAIN = false;
    bf16_t* O; int ldc; float scale;
    __device__ __forceinline__ void operator()(const f32x4 (&acc)[2][2][4][2], const Unit& u, int wr, int wc, int fr, int fq) const {
        const int row0 = u.pm * BM + wr * 64 + fr, col0 = u.pn * BM + wc * 32 + 8 * fq;
#pragma unroll
        for (int ai = 0; ai < 2; ++ai)
#pragma unroll
            for (int m = 0; m < 4; ++m) { bf16_t* rowp = O + (size_t)(row0 + ai * HALF + m * 16) * ldc + col0;
#pragma unroll
                for (int bj = 0; bj < 2; ++bj) { const f32x4 v0 = acc[ai][bj][m][0] * scale, v1 = acc[ai][bj][m][1] * scale;
                    u32x4 w; w.x = cvt_pk_bf16(v0[0], v0[1]); w.y = cvt_pk_bf16(v0[2], v0[3]); w.z = cvt_pk_bf16(v1[0], v1[1]); w.w = cvt_pk_bf16(v1[2], v1[3]);
                    *(u32x4*)(rowp + bj * HALF) = w; } }
    }
};
__device__ __forceinline__ float silu_mul(float g, float u) { return g * u * __builtin_amdgcn_rcpf(1.0f + __builtin_amdgcn_exp2f(g * -1.4426950408889634f)); }
struct EpiSwiGLU {
    static constexpr bool PERM = true, AFTER_DRAIN = false;
    bf16_t* H; int ldh;
    __device__ __forceinline__ void operator()(const f32x4 (&acc)[2][2][4][2], const Unit& u, int wr, int wc, int fr, int fq) const {
        const int row0 = u.pm * BM + wr * 64 + fr, col0 = u.pn * HALF + wc * 32 + 8 * fq;
#pragma unroll
        for (int ai = 0; ai < 2; ++ai)
#pragma unroll
            for (int m = 0; m < 4; ++m) { bf16_t* rowp = H + (size_t)(row0 + ai * HALF + m * 16) * ldh + col0;
                const f32x4 g0 = acc[ai][0][m][0], g1 = acc[ai][0][m][1], u0 = acc[ai][1][m][0], u1 = acc[ai][1][m][1];
                u32x4 w; w.x = cvt_pk_bf16(silu_mul(g0[0], u0[0]), silu_mul(g0[1], u0[1])); w.y = cvt_pk_bf16(silu_mul(g0[2], u0[2]), silu_mul(g0[3], u0[3]));
                w.z = cvt_pk_bf16(silu_mul(g1[0], u1[0]), silu_mul(g1[1], u1[1])); w.w = cvt_pk_bf16(silu_mul(g1[2], u1[2]), silu_mul(g1[3], u1[3]));
                *(u32x4*)rowp = w; }
    }
};
__device__ __forceinline__ unsigned pk4_fp8(float a, float b, float c, float d) { int w = __builtin_amdgcn_cvt_pk_fp8_f32(a, b, 0, false); w = __builtin_amdgcn_cvt_pk_fp8_f32(c, d, w, true); return (unsigned)w; }
struct EpiSwiGLU8 {
    static constexpr bool PERM = true, AFTER_DRAIN = false;
    unsigned char* H; int ldh; float sc;
    __device__ __forceinline__ void operator()(const f32x4 (&acc)[2][2][4][2], const Unit& u, int wr, int wc, int fr, int fq) const {
        const int row0 = u.pm * BM + wr * 64 + fr, col0 = u.pn * HALF + wc * 32 + 8 * fq;
        typedef unsigned u32x2 __attribute__((ext_vector_type(2)));
#pragma unroll
        for (int ai = 0; ai < 2; ++ai)
#pragma unroll
            for (int m = 0; m < 4; ++m) { unsigned char* rowp = H + (size_t)(row0 + ai * HALF + m * 16) * ldh + col0;
                const f32x4 g0 = acc[ai][0][m][0] * sc, g1 = acc[ai][0][m][1] * sc, u0 = acc[ai][1][m][0] * sc, u1 = acc[ai][1][m][1] * sc;
                u32x2 w; w.x = pk4_fp8(silu_mul(g0[0], u0[0]), silu_mul(g0[1], u0[1]), silu_mul(g0[2], u0[2]), silu_mul(g0[3], u0[3]));
                w.y = pk4_fp8(silu_mul(g1[0], u1[0]), silu_mul(g1[1], u1[1]), silu_mul(g1[2], u1[2]), silu_mul(g1[3], u1[3]));
                *(u32x2*)rowp = w; }
    }
};
struct EpiResF32 {
    static constexpr bool PERM = false, AFTER_DRAIN = false;
    const float* res; float* out; int ldc; float alpha;
    __device__ __forceinline__ void operator()(const f32x4 (&acc)[2][2][4][2], const Unit& u, int wr, int wc, int fr, int fq) const {
        const int row0 = u.pm * BM + wr * 64 + fr, col0 = u.pn * BM + wc * 32 + 4 * fq;
#pragma unroll
        for (int ai = 0; ai < 2; ++ai)
#pragma unroll
            for (int m = 0; m < 4; ++m) { const size_t off = (size_t)(row0 + ai * HALF + m * 16) * ldc + col0;
                f32x4 rv[2][2];
#pragma unroll
                for (int bj = 0; bj < 2; ++bj)
#pragma unroll
                    for (int n = 0; n < 2; ++n) rv[bj][n] = *(const f32x4*)(res + off + bj * HALF + n * 16);
#pragma unroll
                for (int bj = 0; bj < 2; ++bj)
#pragma unroll
                    for (int n = 0; n < 2; ++n) *(f32x4*)(out + off + bj * HALF + n * 16) = rv[bj][n] * alpha + acc[ai][bj][m][n];
                asm volatile("" ::: "memory"); }
    }
};

__device__ __forceinline__ void mfma8(f32x4& c, const v8i a, const v8i b, const int scl) { asm volatile("v_mfma_scale_f32_16x16x128_f8f6f4 %0, %1, %2, %0, %3, %3 op_sel_hi:[0,0,0]" : "+v"(c) : "v"(a), "v"(b), "v"(scl)); }
template <class Epi, class Sched, bool ALIGN_EPI = false, bool SP2 = false, bool FP8 = false>
__device__ __forceinline__ void gemm_phase(PG8_LAS unsigned char* lds, const Gemm g, const Sched& S, const Epi& E) {
    const int tid = threadIdx.x, wid = __builtin_amdgcn_readfirstlane(tid >> 6), lane = tid & 63, wr = wid >> 2, wc = wid & 3, fr = lane & 15, fq = lane >> 4;
    const int K = g.K, nt = K / BK;
    unsigned voffA[2], voffB[2];
#pragma unroll
    for (int i = 0; i < 2; ++i) { int R, C; stage_rc(tid * 16 + i * 8192, R, C); const int Rb = Epi::PERM ? ((R & ~31) + perm32(R & 31)) : R;
        voffA[i] = (unsigned)(R * K + C) * 2u; voffB[i] = (unsigned)(Rb * K + C) * 2u; }
    const size_t kstep = (size_t)(BK * 2);
    const size_t hstep = (size_t)HALF * K * 2;
    const size_t tstep = 2 * hstep;
    const unsigned ldsw = (unsigned)wid * 1024u;
    const int aoff = lds_byte(wr * 64 + fr, fq * 8), boff = lds_byte(wc * 32 + fr, fq * 8);
#define PG8_SA(b, h) (((b) * 2 + (h)) * HTB)
#define PG8_SB(b, h) ((4 + (b) * 2 + (h)) * HTB)
#define PG8_STAGE(bufoff, gbase, voff) do { _Pragma("unroll") for (int _i = 0; _i < 2; ++_i) \
        __builtin_amdgcn_global_load_lds((const unsigned*)((const char*)(gbase) + (voff)[_i]), (PG8_LAS unsigned*)(lds + (bufoff) + ldsw + _i * 8192), 16, 0, 0); } while (0)
#define PG8_LDA(dst, b, h) do { if constexpr (FP8) { _Pragma("unroll") for (int m = 0; m < 4; ++m) { dst##8[m][0] = *(const PG8_LAS v4i*)(lds + PG8_SA(b, h) + aoff + m * 2048); dst##8[m][1] = *(const PG8_LAS v4i*)(lds + PG8_SA(b, h) + aoff + m * 2048 + 1024); } } \
    else { _Pragma("unroll") for (int m = 0; m < 4; ++m) _Pragma("unroll") for (int k = 0; k < 2; ++k) dst[m][k] = *(const PG8_LAS bf16x8*)(lds + PG8_SA(b, h) + aoff + m * 2048 + k * 1024); } } while (0)
#define PG8_LDB(dst, b, h) do { if constexpr (FP8) { _Pragma("unroll") for (int n = 0; n < 2; ++n) { dst##8[n][0] = *(const PG8_LAS v4i*)(lds + PG8_SB(b, h) + boff + n * 2048); dst##8[n][1] = *(const PG8_LAS v4i*)(lds + PG8_SB(b, h) + boff + n * 2048 + 1024); } } \
    else { _Pragma("unroll") for (int n = 0; n < 2; ++n) _Pragma("unroll") for (int k = 0; k < 2; ++k) dst[n][k] = *(const PG8_LAS bf16x8*)(lds + PG8_SB(b, h) + boff + n * 2048 + k * 1024); } } while (0)
#define PG8_MMA(ai, bj, At, Bt) do { __builtin_amdgcn_s_setprio(1); if constexpr (FP8) { _Pragma("unroll") for (int m = 0; m < 4; ++m) _Pragma("unroll") for (int n = 0; n < 2; ++n) \
        mfma8(acc[ai][bj][m][n], __builtin_shufflevector(Bt##8[n][0], Bt##8[n][1], 0, 1, 2, 3, 4, 5, 6, 7), __builtin_shufflevector(At##8[m][0], At##8[m][1], 0, 1, 2, 3, 4, 5, 6, 7), scl8); } \
    else { _Pragma("unroll") for (int m = 0; m < 4; ++m) _Pragma("unroll") for (int n = 0; n < 2; ++n) _Pragma("unroll") for (int k = 0; k < 2; ++k) \
        acc[ai][bj][m][n] = __builtin_amdgcn_mfma_f32_16x16x32_bf16(Bt[n][k], At[m][k], acc[ai][bj][m][n], 0, 0, 0); } __builtin_amdgcn_s_setprio(0); } while (0)
#define PG8_WAIT_V(n) asm volatile("s_waitcnt vmcnt(" #n ")" ::: "memory")
#define PG8_WAIT_L(n) asm volatile("s_waitcnt lgkmcnt(" #n ")" ::: "memory")
#define PG8_BAR __builtin_amdgcn_s_barrier()
#define PG8_SCHED __builtin_amdgcn_sched_barrier(0)
    Unit cur, nxt; int ui = 0;
    if (!S.next(0, cur)) return;
    f32x4 acc[2][2][4][2];
#pragma unroll
    for (int a = 0; a < 2; ++a)
#pragma unroll
        for (int b = 0; b < 2; ++b)
#pragma unroll
            for (int m = 0; m < 4; ++m)
#pragma unroll
                for (int n = 0; n < 2; ++n) acc[a][b][m][n] = (f32x4){0.f, 0.f, 0.f, 0.f};
    bf16x8 At[4][2], B0[2][2], B1[2][2];
    v4i At8[4][2], B08[2][2], B18[2][2];
    int scl8 = 0x7F7F7F7F; asm volatile("" : "+v"(scl8));
    const char* cA = (const char*)g.A + (size_t)cur.pm * tstep; const char* cB = (const char*)g.Bt + (size_t)cur.be * g.bstride + (size_t)cur.pn * tstep;
    S.a_ready(cur);
    if constexpr (SP2) {
        PG8_STAGE(PG8_SB(0, 0), cB, voffB); PG8_STAGE(PG8_SB(0, 1), cB + hstep, voffB); PG8_STAGE(PG8_SA(0, 0), cA, voffA); PG8_STAGE(PG8_SA(0, 1), cA + hstep, voffA);
        if (wr == 1) PG8_BAR;
        PG8_WAIT_V(2); PG8_BAR;
        PG8_STAGE(PG8_SB(1, 0), cB + kstep, voffB); PG8_STAGE(PG8_SA(1, 0), cA + kstep, voffA); PG8_STAGE(PG8_SB(1, 1), cB + hstep + kstep, voffB);
        PG8_WAIT_V(6); PG8_BAR;
    } else {
        PG8_STAGE(PG8_SB(0, 0), cB, voffB); PG8_STAGE(PG8_SA(0, 0), cA, voffA); PG8_STAGE(PG8_SB(0, 1), cB + hstep, voffB); PG8_STAGE(PG8_SA(0, 1), cA + hstep, voffA);
        if (wr == 1) PG8_BAR;
        PG8_WAIT_V(4); PG8_BAR;
        PG8_STAGE(PG8_SB(1, 0), cB + kstep, voffB); PG8_STAGE(PG8_SA(1, 0), cA + kstep, voffA); PG8_STAGE(PG8_SB(1, 1), cB + hstep + kstep, voffB);
        PG8_WAIT_V(6); PG8_BAR;
    }
    for (;;) {
        const bool has_next = S.next(ui + 1, nxt);
        const char* nA = has_next ? (const char*)g.A + (size_t)nxt.pm * tstep : cA; const char* nB = has_next ? (const char*)g.Bt + (size_t)nxt.be * g.bstride + (size_t)nxt.pn * tstep : cB;
#pragma unroll 1
        for (int t = 0; t < nt; t += 2) {
            const bool last = (t == nt - 2);
            const char* a1 = cA + (size_t)(t + 1) * kstep;
            const char* a2 = last ? nA : cA + (size_t)(t + 2) * kstep; const char* b2 = last ? nB : cB + (size_t)(t + 2) * kstep;
            const char* a3 = a2 + kstep; const char* b3 = b2 + kstep;
            if (last && has_next) S.a_ready(nxt);
            if constexpr (SP2) {
            PG8_LDB(B0, 0, 0); PG8_LDB(B1, 0, 1); PG8_SCHED; PG8_LDA(At, 0, 0); PG8_STAGE(PG8_SA(1, 1), a1 + hstep, voffA);
            PG8_WAIT_V(8); PG8_WAIT_L(0); PG8_BAR; PG8_MMA(0, 0, At, B0); PG8_MMA(0, 1, At, B1); PG8_BAR; PG8_SCHED;
            PG8_LDA(At, 0, 1); PG8_STAGE(PG8_SB(0, 0), b2, voffB); PG8_STAGE(PG8_SB(0, 1), b2 + hstep, voffB); PG8_STAGE(PG8_SA(0, 0), a2, voffA);
            PG8_WAIT_V(8); PG8_WAIT_L(0); PG8_BAR; PG8_MMA(1, 0, At, B0); PG8_MMA(1, 1, At, B1); PG8_BAR; PG8_SCHED;
            PG8_LDB(B0, 1, 0); PG8_LDB(B1, 1, 1); PG8_SCHED; PG8_LDA(At, 1, 0); PG8_STAGE(PG8_SA(0, 1), a2 + hstep, voffA);
            PG8_WAIT_V(8); PG8_WAIT_L(0); PG8_BAR; PG8_MMA(0, 0, At, B0); PG8_MMA(0, 1, At, B1); PG8_BAR; PG8_SCHED;
            PG8_LDA(At, 1, 1); PG8_STAGE(PG8_SB(1, 0), b3, voffB); PG8_STAGE(PG8_SB(1, 1), b3 + hstep, voffB); PG8_STAGE(PG8_SA(1, 0), a3, voffA);
            PG8_WAIT_V(8); PG8_WAIT_L(0); PG8_BAR; PG8_MMA(1, 0, At, B0); PG8_MMA(1, 1, At, B1); PG8_BAR; PG8_SCHED;
            } else {
            PG8_LDB(B0, 0, 0); PG8_SCHED; PG8_LDA(At, 0, 0); PG8_STAGE(PG8_SA(1, 1), a1 + hstep, voffA);
            PG8_WAIT_L(8); PG8_BAR; PG8_WAIT_L(0); PG8_MMA(0, 0, At, B0); PG8_BAR; PG8_SCHED;
            PG8_LDB(B1, 0, 1); PG8_STAGE(PG8_SB(0, 0), b2, voffB);
            PG8_BAR; PG8_WAIT_L(0); PG8_MMA(0, 1, At, B1); PG8_BAR;
            PG8_LDA(At, 0, 1); PG8_STAGE(PG8_SA(0, 0), a2, voffA);
            PG8_BAR; PG8_WAIT_L(0); PG8_MMA(1, 0, At, B0); PG8_BAR; PG8_SCHED;
            PG8_STAGE(PG8_SB(0, 1), b2 + hstep, voffB);
            PG8_WAIT_V(6); PG8_BAR; PG8_MMA(1, 1, At, B1); PG8_BAR;
            PG8_LDB(B0, 1, 0); PG8_SCHED; PG8_LDA(At, 1, 0); PG8_STAGE(PG8_SA(0, 1), a2 + hstep, voffA);
            PG8_WAIT_L(8); PG8_BAR; PG8_WAIT_L(0); PG8_MMA(0, 0, At, B0); PG8_BAR; PG8_SCHED;
            PG8_LDB(B1, 1, 1); PG8_STAGE(PG8_SB(1, 0), b3, voffB);
            PG8_BAR; PG8_WAIT_L(0); PG8_MMA(0, 1, At, B1); PG8_BAR;
            PG8_LDA(At, 1, 1); PG8_STAGE(PG8_SA(1, 0), a3, voffA);
            PG8_BAR; PG8_WAIT_L(0); PG8_MMA(1, 0, At, B0); PG8_BAR; PG8_SCHED;
            PG8_STAGE(PG8_SB(1, 1), b3 + hstep, voffB);
            PG8_WAIT_V(6); PG8_BAR; PG8_MMA(1, 1, At, B1); PG8_BAR;
            }
        }
        if constexpr (FP8) asm volatile("s_nop 15\n\ts_nop 15" ::: "memory");
        if constexpr (ALIGN_EPI) { if (wr == 0) PG8_BAR; }
        if constexpr (!Epi::AFTER_DRAIN) { E(acc, cur, wr, wc, fr, fq); S.done(cur); }
        if (!has_next) break;
#pragma unroll
        for (int a = 0; a < 2; ++a)
#pragma unroll
            for (int b = 0; b < 2; ++b)
#pragma unroll
                for (int m = 0; m < 4; ++m)
#pragma unroll
                    for (int n = 0; n < 2; ++n) acc[a][b][m][n] = (f32x4){0.f, 0.f, 0.f, 0.f};
        cur = nxt; cA = nA; cB = nB; ++ui;
        if constexpr (ALIGN_EPI) { if (wr == 1) PG8_BAR; }
    }
    PG8_WAIT_V(0);
    if constexpr (!ALIGN_EPI) { if (wr == 0) PG8_BAR; }
    PG8_BAR;
    if constexpr (Epi::AFTER_DRAIN) { E.fused(acc, cur, wr, wc, fr, fq, lds, wid, lane); S.done(cur); }
#undef PG8_SA
#undef PG8_SB
#undef PG8_STAGE
#undef PG8_LDA
#undef PG8_LDB
#undef PG8_MMA
#undef PG8_WAIT_V
#undef PG8_WAIT_L
#undef PG8_BAR
#undef PG8_SCHED
}
}

constexpr int BATCH = 2, SEQ = 16384, DM = 1024, NTOK = BATCH * SEQ;
constexpr int CHK = 64, NCHUNK = SEQ / CHK;
constexpr int INC = 1792, KOFF = 512, VOFF = 640, XBOFF = 768, GBOFF = 1280;
constexpr int LRUW = 512, DFF = 2816, DFE = 3584, NEXP = 8;
constexpr int MAXTILES = 264, PASS_TILES = 128, NPASS = 3;
constexpr float ALPHA = 1.41421356237309515f, LN_EPS = 1e-5f, RMS_EPS = 1e-6f, LOG2E = 1.4426950408889634f, QSCALE = 0.125f * LOG2E;
constexpr int NWAVES = 8, NTHREADS = 512;

constexpr size_t MiB = 1u << 20;
constexpr size_t WS_CTL = 0, CTL_ZERO_BYTES = 64 * 1024;
constexpr size_t WS_LUT = 1 * MiB;
constexpr size_t WS_GATEW = 1 * MiB + 64 * 1024;
constexpr size_t WS_HIST = 1 * MiB + 512 * 1024;
constexpr size_t WS_META = 1 * MiB + 576 * 1024;
constexpr size_t WS_TOKE = 2 * MiB, WS_TOKW = 2 * MiB + 256 * 1024, WS_TOKPOS = 2 * MiB + 512 * 1024;
constexpr size_t WS_LRUP = 3 * MiB, WS_LRUE = 4 * MiB, WS_HIN = 5 * MiB;
constexpr size_t WS_WEGU = 8 * MiB, WS_WED = 64 * MiB;
constexpr size_t WS_WIN = 92 * MiB, WS_WOUT = 99 * MiB, WS_WGU = 103 * MiB, WS_WD = 114 * MiB;
constexpr size_t WS_A = 120 * MiB;
constexpr size_t WS_ZH = 184 * MiB;
constexpr size_t WS_XS = 120 * MiB;
constexpr size_t WS_Y2 = 186 * MiB;
constexpr size_t WS_HM = 318 * MiB;
constexpr size_t WS_END = 430 * MiB;
constexpr float WSC_GU = 64.0f, WSC_D = 256.0f;
static_assert(WS_WED + (size_t)NEXP * DM * DFE <= WS_WIN && WS_WD + (size_t)DM * DFF * 2 <= WS_A && WS_A + (size_t)NTOK * DM * 2 <= WS_ZH && WS_ZH + (size_t)NTOK * DFF * 2 <= WS_END, "ws map");
static_assert(WS_XS + (size_t)MAXTILES * 256 * DM <= WS_Y2 && WS_Y2 + (size_t)MAXTILES * 256 * DM * 2 <= WS_HM && WS_HM + (size_t)PASS_TILES * 256 * DFE <= WS_END, "ws map (MoE)");
constexpr int CW_BAR = 0;

constexpr int RING_BYTES = 131072;
constexpr int LDS_LUT = RING_BYTES;
constexpr int LDS_SSQA = LDS_LUT + 8192, LDS_SSQL = LDS_SSQA + 2048;
constexpr int LDS_MISC = LDS_SSQL + 2048;
constexpr int LDS_POS = LDS_MISC + 256;
constexpr int LDS_BYTES = 147456;
static_assert(LDS_POS + 1024 <= LDS_BYTES, "LDS map");

#define GAS __attribute__((address_space(1)))
#define LAS __attribute__((address_space(3)))
typedef unsigned short bf16;
typedef unsigned v4u __attribute__((ext_vector_type(4)));
typedef unsigned v2u __attribute__((ext_vector_type(2)));
typedef float f32x4 __attribute__((ext_vector_type(4)));
typedef float f32x16 __attribute__((ext_vector_type(16)));
typedef short bf16x8 __attribute__((ext_vector_type(8)));
typedef short s16x4 __attribute__((ext_vector_type(4)));
#define LDS_WAIT() asm volatile("s_waitcnt lgkmcnt(0)" ::: "memory")
#define VM_WAIT() asm volatile("s_waitcnt vmcnt(0)" ::: "memory")
__device__ __forceinline__ unsigned pk2(float lo, float hi) { return pg8::cvt_pk_bf16(lo, hi); }
__device__ __forceinline__ float bf2f(unsigned short h) { return __uint_as_float((unsigned)h << 16); }
__device__ __forceinline__ float bflo(unsigned w) { return __uint_as_float(w << 16); }
__device__ __forceinline__ float bfhi(unsigned w) { return __uint_as_float(w & 0xffff0000u); }
__device__ __forceinline__ float wave_sum(float v) {
#pragma unroll
    for (int o = 1; o < 64; o <<= 1) v += __shfl_xor(v, o);
    return v;
}
__device__ __forceinline__ float fast_sigmoid(float x) { return __builtin_amdgcn_rcpf(1.0f + __builtin_amdgcn_exp2f(x * -LOG2E)); }
__device__ __forceinline__ float gelu_tanh(float x) {
    const float t = 1.5957691216057308f * (x + 0.044715f * x * x * x);
    return x * fast_sigmoid(t);
}

#define XB_TMO      128
#define XB_XCNT(j)  (256  + 64 * (j))
#define XB_XSUB(j)  (1280 + 64 * (j))
#define XB_XGEN(j)  (2304 + 64 * (j))
#define XB_TOP      3328
#define XB_TOPGEN   3392
#define XCD_BAR_WORDS 3456
#define XB_SPIN_CAP (1u << 18)

__device__ __forceinline__ unsigned xb_ld(unsigned* p)              { return __hip_atomic_load(p, __ATOMIC_RELAXED, __HIP_MEMORY_SCOPE_AGENT); }
__device__ __forceinline__ unsigned xb_add(unsigned* p, unsigned v) { return __hip_atomic_fetch_add(p, v, __ATOMIC_RELAXED, __HIP_MEMORY_SCOPE_AGENT); }
__device__ __forceinline__ unsigned xb_xcc_id() { return (unsigned)__builtin_amdgcn_s_getreg((3 << 11) | 20) & 0xFu; }
#define XB_SPIN(cond, bar) do { unsigned _sp = 0; while (cond) { __builtin_amdgcn_s_sleep(1); \
    if ((++_sp & 255u) == 0u) { if (xb_ld(&(bar)[XB_TMO])) break; if (_sp > XB_SPIN_CAP) { atomicAdd(&(bar)[XB_TMO], 1u); break; } } } } while (0)

struct XcdBarrier {
    unsigned* bar; unsigned x;
    volatile LAS unsigned* st;
};

__device__ __forceinline__ XcdBarrier xcd_barrier_post(unsigned* bar, volatile LAS unsigned* st) {
    XcdBarrier b; b.bar = bar; b.x = xb_xcc_id(); b.st = st;
    if (threadIdx.x == 0) (void)xb_add(&bar[XB_XCNT(b.x)], 1u);
    return b;
}
__device__ __forceinline__ void xcd_barrier_complete(unsigned* bar, unsigned x, unsigned& nloc, unsigned& nx) {
    const unsigned G = gridDim.x * gridDim.y * gridDim.z;
    unsigned sum, cnt, mine, sp = 0u;
    for (;;) {
        sum = 0u; cnt = 0u; mine = 0u;
#pragma unroll
        for (unsigned j = 0; j < 16; ++j) { const unsigned c = xb_ld(&bar[XB_XCNT(j)]); sum += c; cnt += (c > 0u) ? 1u : 0u; mine = (j == x) ? c : mine; }
        if (sum == G) break;
        __builtin_amdgcn_s_sleep(1);
        if ((++sp & 255u) == 0u) { if (xb_ld(&bar[XB_TMO])) break; if (sp > XB_SPIN_CAP) { atomicAdd(&bar[XB_TMO], 1u); break; } }
    }
    nloc = mine > 0u ? mine : 1u; nx = cnt > 0u ? cnt : 1u;
}

__device__ __forceinline__ void xcd_barrier(const XcdBarrier& b) {
    asm volatile("s_waitcnt vmcnt(0)" ::: "memory");
    __syncthreads();
    if (threadIdx.x == 0) {
        unsigned* bar = b.bar;
        __builtin_amdgcn_s_waitcnt(0);
        unsigned nloc = b.st[0], nx = b.st[1];
        if (nloc == 0u) { xcd_barrier_complete(bar, b.x, nloc, nx); b.st[0] = nloc; b.st[1] = nx; }
        const unsigned old = xb_add(&bar[XB_XSUB(b.x)], 1u);
        const unsigned gen = old / nloc;
        if (old + 1u == (gen + 1u) * nloc) {
            __builtin_amdgcn_fence(__ATOMIC_RELEASE, "agent");
            asm volatile("s_waitcnt vmcnt(0)" ::: "memory");
            const unsigned og = xb_add(&bar[XB_TOP], 1u);
            const unsigned tg = og / nx;
            if (og + 1u == (tg + 1u) * nx) xb_add(&bar[XB_TOPGEN], 1u);
            else XB_SPIN(xb_ld(&bar[XB_TOPGEN]) == tg, bar);
            __builtin_amdgcn_fence(__ATOMIC_ACQUIRE, "agent");
            xb_add(&bar[XB_XGEN(b.x)], 1u);
            asm volatile("s_waitcnt vmcnt(0)" ::: "memory");
        } else {
            XB_SPIN(xb_ld(&bar[XB_XGEN(b.x)]) == gen, bar);
            __builtin_amdgcn_fence(__ATOMIC_ACQUIRE, "agent");
            asm volatile("s_waitcnt vmcnt(0)" ::: "memory");
        }
    }
    __syncthreads();
}

struct Args { const float* in[25]; float* out; unsigned char* ws; int ph_lo, ph_hi; };
struct Frame {
    LAS unsigned char* lds;
    int tid, lane, wave, G, blk;
};

__device__ __forceinline__ void p0_transpose_item(const float* W, int K, int N, bf16* WT, int mode, const float* ksA, const float* ksB, float nscale, int nscale_cols, LAS float* scr, int item, int lane) {
    const int nblk = N / 32, kb = item / nblk, nb = item % nblk, k0 = 64 * kb, n0 = 32 * nb;
    const float* ks = ksA ? (k0 < 512 ? ksA + k0 : ksB + (k0 - 512)) : nullptr;
#pragma unroll 8
    for (int i = 0; i < 32; ++i) { const int kk = 2 * i + (lane >> 5); float v = W[(size_t)(k0 + kk) * N + n0 + (lane & 31)]; if (ks) v *= ks[kk]; scr[kk * 33 + (lane & 31)] = v; }
    LDS_WAIT(); asm volatile("" ::: "memory");
    const int drow0 = (mode == 0) ? n0 : ((n0 >> 7) * 256 + (n0 & 127) + (mode == 2 ? 128 : 0));
    const float sc = (n0 < nscale_cols) ? nscale : 1.0f;
    const int c = lane & 7;
#pragma unroll
    for (int j = 0; j < 4; ++j) { const int n = (lane >> 3) + 8 * j; const LAS float* s = scr + (8 * c) * 33 + n;
        v4u o; o.x = pk2(s[0 * 33] * sc, s[1 * 33] * sc); o.y = pk2(s[2 * 33] * sc, s[3 * 33] * sc); o.z = pk2(s[4 * 33] * sc, s[5 * 33] * sc); o.w = pk2(s[6 * 33] * sc, s[7 * 33] * sc);
        *(v4u*)(WT + (size_t)(drow0 + n) * K + k0 + 8 * c) = o; }
    LDS_WAIT(); asm volatile("" ::: "memory");
}
__device__ __forceinline__ void p0_transpose_item_f8(const float* W, int K, int N, unsigned char* WT, int mode, float scale, LAS float* scr, int item, int lane) {
    const int nblk = N / 32, kb = item / nblk, nb = item % nblk, k0 = 64 * kb, n0 = 32 * nb;
#pragma unroll 8
    for (int i = 0; i < 32; ++i) { const int kk = 2 * i + (lane >> 5); scr[kk * 33 + (lane & 31)] = W[(size_t)(k0 + kk) * N + n0 + (lane & 31)] * scale; }
    LDS_WAIT(); asm volatile("" ::: "memory");
    const int drow0 = (mode == 0) ? n0 : ((n0 >> 7) * 256 + (n0 & 127) + (mode == 2 ? 128 : 0));
    const int c = lane & 3;
#pragma unroll
    for (int j = 0; j < 2; ++j) { const int n = (lane >> 2) + 16 * j; const LAS float* s = scr + (16 * c) * 33 + n;
        v4u o; o.x = pg8::pk4_fp8(s[0 * 33], s[1 * 33], s[2 * 33], s[3 * 33]); o.y = pg8::pk4_fp8(s[4 * 33], s[5 * 33], s[6 * 33], s[7 * 33]);
        o.z = pg8::pk4_fp8(s[8 * 33], s[9 * 33], s[10 * 33], s[11 * 33]); o.w = pg8::pk4_fp8(s[12 * 33], s[13 * 33], s[14 * 33], s[15 * 33]);
        *(v4u*)(WT + (size_t)(drow0 + n) * K + k0 + 16 * c) = o; }
    LDS_WAIT(); asm volatile("" ::: "memory");
}
__device__ __forceinline__ int t5_bucket(int rel) {
    const int n = rel < 0 ? -rel : rel;
    int v;
    if (n < 8) v = n;
    else { v = 8 + (n >= 12) + (n >= 16) + (n >= 23) + (n >= 32) + (n >= 46) + (n >= 64) + (n >= 91); }
    return (rel > 0 ? 16 : 0) + v;
}
__device__ __forceinline__ void p0_prologue(const Frame& F, const Args& A) {
    unsigned char* ws = A.ws;
    LAS float* scr = (LAS float*)(F.lds + F.wave * 8448);
    const int gw = F.blk * NWAVES + F.wave, NGW = F.G * NWAVES;
    bf16* WIN = (bf16*)(ws + WS_WIN); bf16* WOUT = (bf16*)(ws + WS_WOUT); bf16* WGU = (bf16*)(ws + WS_WGU); bf16* WD = (bf16*)(ws + WS_WD);
    unsigned char* WEGU = ws + WS_WEGU; unsigned char* WED = ws + WS_WED;
    constexpr int I_IN = (DM / 64) * (INC / 32), I_OUT = (DM / 64) * (DM / 32), I_GU = (DM / 64) * (DFF / 32), I_D = (DFF / 64) * (DM / 32);
    constexpr int I_EGU = (DM / 64) * (DFE / 32), I_ED = (DFE / 64) * (DM / 32);
    constexpr int NITEMS = 2 * I_IN + 2 * I_OUT + 2 * I_GU + I_D + NEXP * (2 * I_EGU + I_ED);
    for (int it = gw; it < NITEMS; it += NGW) {
        int r = it;
        if (r < 2 * I_IN) { const int l = r / I_IN; r -= l * I_IN;
            p0_transpose_item(A.in[2] + (size_t)l * DM * INC, DM, INC, WIN + (size_t)l * INC * DM, 0, nullptr, nullptr, QSCALE, 512, scr, r, F.lane); continue; }
        r -= 2 * I_IN;
        if (r < 2 * I_OUT) { const int l = r / I_OUT; r -= l * I_OUT;
            p0_transpose_item(A.in[13] + (size_t)l * DM * DM, DM, DM, WOUT + (size_t)l * DM * DM, 0, A.in[11] + l * 512, A.in[12] + l * 512, 1.0f, 0, scr, r, F.lane); continue; }
        r -= 2 * I_OUT;
        if (r < I_GU) { p0_transpose_item(A.in[16], DM, DFF, WGU, 1, nullptr, nullptr, 1.0f, 0, scr, r, F.lane); continue; }
        r -= I_GU;
        if (r < I_GU) { p0_transpose_item(A.in[17], DM, DFF, WGU, 2, nullptr, nullptr, 1.0f, 0, scr, r, F.lane); continue; }
        r -= I_GU;
        if (r < I_D) { p0_transpose_item(A.in[18], DFF, DM, WD, 0, nullptr, nullptr, 1.0f, 0, scr, r, F.lane); continue; }
        r -= I_D;
        { constexpr int PER_E = 2 * I_EGU + I_ED; const int e = r / PER_E; r -= e * PER_E;
          if (r < I_EGU) { p0_transpose_item_f8(A.in[20] + (size_t)e * DM * DFE, DM, DFE, WEGU + (size_t)e * 2 * DFE * DM, 1, WSC_GU, scr, r, F.lane); continue; }
          r -= I_EGU;
          if (r < I_EGU) { p0_transpose_item_f8(A.in[21] + (size_t)e * DM * DFE, DM, DFE, WEGU + (size_t)e * 2 * DFE * DM, 2, WSC_GU, scr, r, F.lane); continue; }
          r -= I_EGU;
          p0_transpose_item_f8(A.in[22] + (size_t)e * DFE * DM, DFE, DM, WED + (size_t)e * DM * DFE, 0, WSC_D, scr, r, F.lane); }
    }
    { const f32x4* x4 = (const f32x4*)A.in[0]; v4u* o = (v4u*)(ws + WS_A);
      const size_t n8 = (size_t)NTOK * DM / 8, stride = (size_t)F.G * NTHREADS;
      for (size_t i = (size_t)F.blk * NTHREADS + F.tid; i < n8; i += stride) { const f32x4 a = x4[2 * i], b = x4[2 * i + 1];
          v4u w; w.x = pk2(a.x, a.y); w.y = pk2(a.z, a.w); w.z = pk2(b.x, b.y); w.w = pk2(b.z, b.w); o[i] = w; } }
    { bf16* GW = (bf16*)(ws + WS_GATEW);
      for (int i = F.blk * NTHREADS + F.tid; i < 2 * 2 * 8 * 64 * 64; i += F.G * NTHREADS) {
          const int d = i & 63, e = (i >> 6) & 63, n = (i >> 12) & 7, g = (i >> 15) & 1, l = i >> 16;
          const float v = (g ? A.in[8] : A.in[6])[(((size_t)l * 8 + n) * 64 + d) * 64 + e];
          GW[i] = (bf16)(pk2(v, v) & 0xffffu); } }
    if (F.blk == 0 && F.tid < 256) { float* LUT = (float*)(ws + WS_LUT); const int rel = F.tid - 191; const int bk = t5_bucket(rel);
#pragma unroll
        for (int h = 0; h < 8; ++h) LUT[h * 256 + F.tid] = A.in[1][bk * 8 + h] * LOG2E; }
}

template <bool FINAL>
__device__ __forceinline__ void lru_tile(const bf16* Z, int b, int c, int n, int lane, const bf16* gwr, const bf16* gwi, const float* convw, const float* convb,
                                         const float* br, const float* bi, const float* lam, float* outP, float* outE, const float* Hin, LAS float* yl) {
    const int fr = lane & 15, fq = lane >> 4;
    const size_t seq0 = (size_t)b * SEQ;
    bf16x8 xa[4][2];
#pragma unroll
    for (int ks = 0; ks < 2; ++ks) {
        const int ch = 64 * n + 32 * ks + 8 * fq;
        float cw[4][8], cb[8];
#pragma unroll
        for (int w = 0; w < 4; ++w) { const f32x4 a = *(const f32x4*)(convw + w * LRUW + ch), bq = *(const f32x4*)(convw + w * LRUW + ch + 4);
            cw[w][0] = a.x; cw[w][1] = a.y; cw[w][2] = a.z; cw[w][3] = a.w; cw[w][4] = bq.x; cw[w][5] = bq.y; cw[w][6] = bq.z; cw[w][7] = bq.w; }
        { const f32x4 a = *(const f32x4*)(convb + ch), bq = *(const f32x4*)(convb + ch + 4); cb[0] = a.x; cb[1] = a.y; cb[2] = a.z; cb[3] = a.w; cb[4] = bq.x; cb[5] = bq.y; cb[6] = bq.z; cb[7] = bq.w; }
#pragma unroll
        for (int m = 0; m < 4; ++m) {
            const int t = CHK * c + 16 * m + fr;
            float a8[8];
#pragma unroll
            for (int j = 0; j < 8; ++j) a8[j] = cb[j];
#pragma unroll
            for (int w = 0; w < 4; ++w) { const int tt = t + w - 3;
                if (tt >= 0) { const v4u v = *(const v4u*)(Z + (seq0 + tt) * INC + XBOFF + ch);
                    a8[0] += cw[w][0] * bflo(v.x); a8[1] += cw[w][1] * bfhi(v.x); a8[2] += cw[w][2] * bflo(v.y); a8[3] += cw[w][3] * bfhi(v.y);
                    a8[4] += cw[w][4] * bflo(v.z); a8[5] += cw[w][5] * bfhi(v.z); a8[6] += cw[w][6] * bflo(v.w); a8[7] += cw[w][7] * bfhi(v.w); } }
            v4u p; p.x = pk2(a8[0], a8[1]); p.y = pk2(a8[2], a8[3]); p.z = pk2(a8[4], a8[5]); p.w = pk2(a8[6], a8[7]);
            xa[m][ks] = __builtin_bit_cast(bf16x8, p);
        }
    }
#pragma unroll 1
    for (int nb = 0; nb < 4; ++nb) {
        bf16x8 wr[2], wi[2], idf[2];
#pragma unroll
        for (int ks = 0; ks < 2; ++ks) {
            wr[ks] = *(const bf16x8*)(gwr + (16 * nb + fr) * 64 + 32 * ks + 8 * fq);
            wi[ks] = *(const bf16x8*)(gwi + (16 * nb + fr) * 64 + 32 * ks + 8 * fq);
#pragma unroll
            for (int j = 0; j < 8; ++j) idf[ks][j] = (32 * ks + 8 * fq + j == 16 * nb + fr) ? (short)0x3F80 : (short)0;
        }
        f32x4 dr[4], di[4], dx[4];
#pragma unroll
        for (int m = 0; m < 4; ++m) { dr[m] = (f32x4){0.f, 0.f, 0.f, 0.f}; di[m] = dr[m]; dx[m] = dr[m];
#pragma unroll
            for (int ks = 0; ks < 2; ++ks) {
                dr[m] = __builtin_amdgcn_mfma_f32_16x16x32_bf16(xa[m][ks], wr[ks], dr[m], 0, 0, 0);
                di[m] = __builtin_amdgcn_mfma_f32_16x16x32_bf16(xa[m][ks], wi[ks], di[m], 0, 0, 0);
                dx[m] = __builtin_amdgcn_mfma_f32_16x16x32_bf16(xa[m][ks], idf[ks], dx[m], 0, 0, 0); } }
        const int chn = 64 * n + 16 * nb + fr;
        const float brv = br[chn], biv = bi[chn];
        const float sp = 8.0f * log1pf(__expf(-lam[chn]));
        float Hrun = 0.f, Prun = 1.f;
        if (FINAL) Hrun = Hin[((size_t)b * NCHUNK + c) * LRUW + chn];
#pragma unroll
        for (int m = 0; m < 4; ++m) {
            float pa[4], hl[4];
#pragma unroll
            for (int r = 0; r < 4; ++r) {
                const float rg = fast_sigmoid(dr[m][r] + brv), ig = fast_sigmoid(di[m][r] + biv);
                const float la = -rg * sp;
                const float a = __expf(la);
                const float x2 = 2.0f * la;
                const float om = (x2 > -0.02f) ? -x2 * (1.0f + x2 * (0.5f + x2 * (1.0f / 6.0f))) : (1.0f - a * a);
                const float u = sqrtf(fmaxf(om, 0.f)) * (ig * dx[m][r]);
                if (r == 0) { pa[0] = a; hl[0] = u; } else { hl[r] = a * hl[r - 1] + u; pa[r] = a * pa[r - 1]; }
            }
            float P = pa[3], H = hl[3];
            { const float P1 = __shfl_up(P, 16), H1 = __shfl_up(H, 16); if (fq >= 1) { H = P * H1 + H; P = P * P1; } }
            { const float P2 = __shfl_up(P, 32), H2 = __shfl_up(H, 32); if (fq >= 2) { H = P * H2 + H; P = P * P2; } }
            float Pex = __shfl_up(P, 16), Hex = __shfl_up(H, 16); if (fq == 0) { Pex = 1.f; Hex = 0.f; }
            const float Pblk = __shfl(P, 48 + fr), Hblk = __shfl(H, 48 + fr);
            if (FINAL) {
                const float hin = Hex + Pex * Hrun;
#pragma unroll
                for (int r = 0; r < 4; ++r) {
                    const float h = hl[r] + pa[r] * hin;
                    const float g = bf2f(Z[(seq0 + CHK * c + 16 * m + 4 * fq + r) * INC + GBOFF + chn]);
                    yl[(16 * m + 4 * fq + r) * LRUW + chn] = gelu_tanh(g) * h;
                }
            }
            Hrun = Hblk + Pblk * Hrun; Prun = Pblk * Prun;
        }
        if (!FINAL) { if (fq == 0) { const size_t o = ((size_t)b * NCHUNK + c) * LRUW + chn; outP[o] = Prun; outE[o] = Hrun; } }
    }
}

__device__ __forceinline__ void p_lru_summary(const Frame& F, const Args& A, int l) {
    unsigned char* ws = A.ws;
    const bf16* Z = (const bf16*)(ws + WS_ZH);
    const bf16* GW = (const bf16*)(ws + WS_GATEW) + (size_t)l * 2 * 8 * 4096;
    for (int it = F.blk; it < BATCH * NCHUNK; it += F.G) {
        const int b = it >> 8, c = it & 255, n = F.wave;
        lru_tile<false>(Z, b, c, n, F.lane, GW + n * 4096, GW + 8 * 4096 + n * 4096, A.in[4] + l * 4 * LRUW, A.in[5] + l * LRUW, A.in[7] + l * LRUW, A.in[9] + l * LRUW, A.in[10] + l * LRUW,
                        (float*)(ws + WS_LRUP), (float*)(ws + WS_LRUE), nullptr, nullptr);
    }
}
__device__ __forceinline__ void p_lru_carry(const Frame& F, const Args& A) {
    unsigned char* ws = A.ws;
    const float* Pg = (const float*)(ws + WS_LRUP); const float* Eg = (const float*)(ws + WS_LRUE); float* Hg = (float*)(ws + WS_HIN);
    const int gw = F.blk * NWAVES + F.wave, NGW = F.G * NWAVES;
    for (int p = gw; p < BATCH * LRUW; p += NGW) {
        const int b = p >> 9, ch = p & 511;
        float pk[4], ek[4];
#pragma unroll
        for (int k = 0; k < 4; ++k) { const size_t o = ((size_t)b * NCHUNK + 4 * F.lane + k) * LRUW + ch; pk[k] = Pg[o]; ek[k] = Eg[o]; }
        float P = pk[0], H = ek[0];
#pragma unroll
        for (int k = 1; k < 4; ++k) { H = pk[k] * H + ek[k]; P = pk[k] * P; }
#pragma unroll
        for (int d = 1; d < 64; d <<= 1) { const float P1 = __shfl_up(P, d), H1 = __shfl_up(H, d); if (F.lane >= d) { H = P * H1 + H; P = P * P1; } }
        float h = __shfl_up(H, 1); if (F.lane == 0) h = 0.f;
#pragma unroll
        for (int k = 0; k < 4; ++k) { Hg[((size_t)b * NCHUNK + 4 * F.lane + k) * LRUW + ch] = h; h = pk[k] * h + ek[k]; }
    }
}

__device__ __forceinline__ int crow(int r, int hi) { return (r & 3) + 8 * (r >> 2) + 4 * hi; }
__device__ __forceinline__ s16x4 vtr(const LAS unsigned char* p) { return __builtin_bit_cast(s16x4, __builtin_amdgcn_ds_read_tr16_b64_v4i16((LAS s16x4*)p)); }
__device__ __forceinline__ void p_mixer(const Frame& F, const Args& A, int l) {
    unsigned char* ws = A.ws;
    const bf16* Z = (const bf16*)(ws + WS_ZH);
    bf16* Y = (bf16*)(ws + WS_A);
    const bf16* GW = (const bf16*)(ws + WS_GATEW) + (size_t)l * 2 * 8 * 4096;
    LAS unsigned char* Kl = F.lds;
    LAS unsigned char* Vl = F.lds + 49152;
    LAS float* yl = (LAS float*)F.lds;
    LAS bf16* ya = (LAS bf16*)F.lds;
    LAS float* lut = (LAS float*)(F.lds + LDS_LUT);
    const int lane = F.lane, wave = F.wave, r32 = lane & 31, hi = lane >> 5;
    { const float* LUTg = (const float*)(ws + WS_LUT); for (int i = F.tid; i < 2048; i += NTHREADS) lut[i] = LUTg[i]; }
    const float sinkv = A.in[3][l * 8 + wave] * LOG2E;
    const int kvh = wave >> 2;
    for (int it = F.blk; it < BATCH * NCHUNK; it += F.G) {
        const int b = it >> 8, c = it & 255;
        const size_t row0 = (size_t)b * SEQ + (size_t)CHK * c;
        const int T0 = (c >= 2) ? 0 : 2 - c;
        __syncthreads();
        lru_tile<true>(Z, b, c, wave, lane, GW + wave * 4096, GW + 8 * 4096 + wave * 4096, A.in[4] + l * 4 * LRUW, A.in[5] + l * LRUW, A.in[7] + l * LRUW, A.in[9] + l * LRUW, A.in[10] + l * LRUW,
                       nullptr, nullptr, (const float*)(ws + WS_HIN), yl);
        __syncthreads();
#pragma unroll
        for (int i = 0; i < 8; ++i) { const int tok = 8 * wave + i;
            const f32x4 a = *(const LAS f32x4*)(yl + tok * LRUW + 8 * lane), q = *(const LAS f32x4*)(yl + tok * LRUW + 8 * lane + 4);
            const float ss = wave_sum((a.x * a.x + a.y * a.y) + (a.z * a.z + a.w * a.w) + (q.x * q.x + q.y * q.y) + (q.z * q.z + q.w * q.w));
            const float rstd = 1.0f / sqrtf(ss * (1.0f / 512.0f) + RMS_EPS);
            v4u w; w.x = pk2(a.x * rstd, a.y * rstd); w.y = pk2(a.z * rstd, a.w * rstd); w.z = pk2(q.x * rstd, q.y * rstd); w.w = pk2(q.z * rstd, q.w * rstd);
            *(v4u*)(Y + (row0 + tok) * DM + 512 + 8 * lane) = w; }
        __syncthreads();
#pragma unroll
        for (int h2 = 0; h2 < 2; ++h2)
#pragma unroll
            for (int T = 0; T < 3; ++T) {
                v4u kq = (v4u){0u, 0u, 0u, 0u}, vq = kq;
                if (T >= T0) { const size_t cr = row0 + (size_t)CHK * T - 2 * CHK;
                    kq = *(const v4u*)(Z + (cr + lane) * INC + KOFF + 64 * h2 + 8 * wave);
                    vq = *(const v4u*)(Z + (cr + 16 * (wave & 3) + (lane >> 2)) * INC + VOFF + 64 * h2 + 32 * (wave >> 2) + 8 * (lane & 3)); }
                *(LAS v4u*)(Kl + (h2 * 3 + T) * 8192 + wave * 1024 + lane * 16) = kq;
                *(LAS v4u*)(Vl + (h2 * 3 + T) * 8192 + wave * 1024 + lane * 16) = vq;
            }
        __syncthreads();
        unsigned opk[2][2][8];
#pragma unroll
        for (int qb = 0; qb < 2; ++qb) {
            const int qi = 32 * qb + r32;
            bf16x8 qr[4];
#pragma unroll
            for (int d0 = 0; d0 < 4; ++d0) qr[d0] = *(const bf16x8*)(Z + (row0 + qi) * INC + 64 * wave + 16 * d0 + 8 * hi);
            f32x16 s[3][2];
            const LAS float* lutq = lut + wave * 256 + 63 - qi;
#pragma unroll
            for (int T = 0; T < 3; ++T) {
#pragma unroll
                for (int hf = 0; hf < 2; ++hf)
#pragma unroll
                    for (int r = 0; r < 16; ++r) s[T][hf][r] = lutq[64 * T + 32 * hf + crow(r, hi)];
                const LAS unsigned char* kb = Kl + (kvh * 3 + T) * 8192 + hi * 1024 + r32 * 16;
#pragma unroll
                for (int d0 = 0; d0 < 4; ++d0) {
                    const bf16x8 b0 = *(const LAS bf16x8*)(kb + d0 * 2048), b1 = *(const LAS bf16x8*)(kb + d0 * 2048 + 512);
                    s[T][0] = __builtin_amdgcn_mfma_f32_32x32x16_bf16(b0, qr[d0], s[T][0], 0, 0, 0);
                    s[T][1] = __builtin_amdgcn_mfma_f32_32x32x16_bf16(b1, qr[d0], s[T][1], 0, 0, 0);
                }
                if (T < T0) {
#pragma unroll
                    for (int hf = 0; hf < 2; ++hf)
#pragma unroll
                        for (int r = 0; r < 16; ++r) s[T][hf][r] = -1e30f;
                }
            }
            float mx = sinkv;
#pragma unroll
            for (int T = 0; T < 3; ++T)
#pragma unroll
                for (int hf = 0; hf < 2; ++hf)
#pragma unroll
                    for (int r = 0; r < 16; ++r) mx = fmaxf(mx, s[T][hf][r]);
            mx = fmaxf(mx, __shfl_xor(mx, 32));
            float lsum = 0.f;
#pragma unroll
            for (int T = 0; T < 3; ++T)
#pragma unroll
                for (int hf = 0; hf < 2; ++hf)
#pragma unroll
                    for (int r = 0; r < 16; ++r) { const float p = __builtin_amdgcn_exp2f(s[T][hf][r] - mx); s[T][hf][r] = p; lsum += p; }
            lsum += __shfl_xor(lsum, 32);
            lsum += __builtin_amdgcn_exp2f(sinkv - mx);
            const float inv = 1.0f / lsum;
            f32x16 o[2]; o[0] = (f32x16){0.f, 0.f, 0.f, 0.f, 0.f, 0.f, 0.f, 0.f, 0.f, 0.f, 0.f, 0.f, 0.f, 0.f, 0.f, 0.f}; o[1] = o[0];
#pragma unroll
            for (int T = 0; T < 3; ++T) {
                v4u pw[4];
#pragma unroll
                for (int k = 0; k < 4; ++k) { const int hf = k >> 1, r0 = (k & 1) * 8;
                    pw[k].x = pk2(s[T][hf][r0 + 0], s[T][hf][r0 + 1]); pw[k].y = pk2(s[T][hf][r0 + 2], s[T][hf][r0 + 3]);
                    pw[k].z = pk2(s[T][hf][r0 + 4], s[T][hf][r0 + 5]); pw[k].w = pk2(s[T][hf][r0 + 6], s[T][hf][r0 + 7]); }
                const LAS unsigned char* vb = Vl + (kvh * 3 + T) * 8192 + ((lane >> 4) & 1) * 32 + (lane & 3) * 8 + (4 * hi + ((lane & 15) >> 2)) * 64;
#pragma unroll
                for (int d0 = 0; d0 < 2; ++d0)
#pragma unroll
                    for (int ks = 0; ks < 4; ++ks) {
                        const s16x4 lo = vtr(vb + d0 * 4096 + ks * 1024), hv = vtr(vb + d0 * 4096 + ks * 1024 + 512);
                        const bf16x8 vf = (bf16x8){lo[0], lo[1], lo[2], lo[3], hv[0], hv[1], hv[2], hv[3]};
                        o[d0] = __builtin_amdgcn_mfma_f32_32x32x16_bf16(vf, __builtin_bit_cast(bf16x8, pw[ks]), o[d0], 0, 0, 0);
                    }
            }
#pragma unroll
            for (int d0 = 0; d0 < 2; ++d0)
#pragma unroll
                for (int r = 0; r < 16; r += 2) opk[qb][d0][r >> 1] = pk2(o[d0][r] * inv, o[d0][r + 1] * inv);
        }
        __syncthreads();
#pragma unroll
        for (int qb = 0; qb < 2; ++qb)
#pragma unroll
            for (int d0 = 0; d0 < 2; ++d0)
#pragma unroll
                for (int g = 0; g < 4; ++g) { v2u w; w.x = opk[qb][d0][2 * g]; w.y = opk[qb][d0][2 * g + 1];
                    *(LAS v2u*)(ya + (32 * qb + r32) * 512 + 64 * wave + 32 * d0 + 8 * g + 4 * hi) = w; }
        __syncthreads();
#pragma unroll
        for (int i = 0; i < 8; ++i) { const int tok = 8 * wave + i;
            const v4u w0 = *(const LAS v4u*)(ya + tok * 512 + 8 * lane);
            const float x0 = bflo(w0.x), x1 = bfhi(w0.x), x2 = bflo(w0.y), x3 = bfhi(w0.y), x4 = bflo(w0.z), x5 = bfhi(w0.z), x6 = bflo(w0.w), x7 = bfhi(w0.w);
            const float ss = wave_sum((x0 * x0 + x1 * x1) + (x2 * x2 + x3 * x3) + (x4 * x4 + x5 * x5) + (x6 * x6 + x7 * x7));
            const float rstd = 1.0f / sqrtf(ss * (1.0f / 512.0f) + RMS_EPS);
            v4u w; w.x = pk2(x0 * rstd, x1 * rstd); w.y = pk2(x2 * rstd, x3 * rstd); w.z = pk2(x4 * rstd, x5 * rstd); w.w = pk2(x6 * rstd, x7 * rstd);
            *(v4u*)(Y + (row0 + tok) * DM + 8 * lane) = w; }
    }
}

template <int MODE>
__device__ __forceinline__ void p_layernorm(const Frame& F, const Args& A, const float* gam, const float* bet) {
    unsigned char* ws = A.ws;
    float* X = A.out;
    bf16* XB = (bf16*)(ws + WS_A);
    LAS unsigned* misc = (LAS unsigned*)(F.lds + LDS_MISC);
    const int lane = F.lane;
    if (MODE == 1) { if (F.tid < 8) misc[F.tid] = 0u; __syncthreads(); }
    f32x4 gv[4], bv[4];
#pragma unroll
    for (int j = 0; j < 4; ++j) { gv[j] = *(const f32x4*)(gam + 4 * lane + 256 * j); bv[j] = *(const f32x4*)(bet + 4 * lane + 256 * j); }
    const int rpw = NTOK / F.G;
    for (int i = F.wave; i < rpw; i += NWAVES) {
        const int m = F.blk * rpw + i;
        f32x4* xr = (f32x4*)(X + (size_t)m * DM) + lane;
        f32x4 v[4];
#pragma unroll
        for (int j = 0; j < 4; ++j) v[j] = xr[64 * j];
        if (MODE == 2) {
            const int* tp = (const int*)(ws + WS_TOKPOS) + 2 * m; const float* tw = (const float*)(ws + WS_TOKW) + 2 * m;
            const int p0 = tp[0], p1 = tp[1]; const float w0 = tw[0], w1 = tw[1];
            const v2u* y0 = (const v2u*)((const bf16*)(ws + WS_Y2) + (size_t)p0 * DM) + lane; const v2u* y1 = (const v2u*)((const bf16*)(ws + WS_Y2) + (size_t)p1 * DM) + lane;
#pragma unroll
            for (int j = 0; j < 4; ++j) { const v2u a = y0[64 * j], c = y1[64 * j];
                v[j].x = ALPHA * v[j].x + w0 * bflo(a.x) + w1 * bflo(c.x); v[j].y = ALPHA * v[j].y + w0 * bfhi(a.x) + w1 * bfhi(c.x);
                v[j].z = ALPHA * v[j].z + w0 * bflo(a.y) + w1 * bflo(c.y); v[j].w = ALPHA * v[j].w + w0 * bfhi(a.y) + w1 * bfhi(c.y); }
        }
        float s = 0.f;
#pragma unroll
        for (int j = 0; j < 4; ++j) s += (v[j].x + v[j].y) + (v[j].z + v[j].w);
        const float mean = wave_sum(s) * (1.f / DM); float s2 = 0.f;
#pragma unroll
        for (int j = 0; j < 4; ++j) { v[j] = v[j] - mean; s2 += (v[j].x * v[j].x + v[j].y * v[j].y) + (v[j].z * v[j].z + v[j].w * v[j].w); }
        const float rstd = 1.f / sqrtf(wave_sum(s2) * (1.f / DM) + LN_EPS);
#pragma unroll
        for (int j = 0; j < 4; ++j) { v[j] = v[j] * rstd * gv[j] + bv[j]; xr[64 * j] = v[j]; }
        if (MODE == 0) {
            v2u* o8 = (v2u*)(XB + (size_t)m * DM) + lane;
#pragma unroll
            for (int j = 0; j < 4; ++j) { v2u w; w.x = pk2(v[j].x, v[j].y); w.y = pk2(v[j].z, v[j].w); o8[64 * j] = w; }
        }
        if (MODE == 1) {
            const float* RW = A.in[19];
            float lg[8];
#pragma unroll
            for (int e = 0; e < 8; ++e) lg[e] = 0.f;
#pragma unroll
            for (int j = 0; j < 4; ++j)
#pragma unroll
                for (int q = 0; q < 4; ++q) { const int k = 4 * lane + 256 * j + q; const f32x4 a = *(const f32x4*)(RW + k * 8), c = *(const f32x4*)(RW + k * 8 + 4); const float xv = v[j][q];
                    lg[0] += xv * a.x; lg[1] += xv * a.y; lg[2] += xv * a.z; lg[3] += xv * a.w; lg[4] += xv * c.x; lg[5] += xv * c.y; lg[6] += xv * c.z; lg[7] += xv * c.w; }
#pragma unroll
            for (int e = 0; e < 8; ++e) lg[e] = wave_sum(lg[e]);
            int e0 = 0; float v0 = lg[0];
#pragma unroll
            for (int e = 1; e < 8; ++e) if (lg[e] > v0) { v0 = lg[e]; e0 = e; }
            int e1 = -1; float v1 = -3.0e38f;
#pragma unroll
            for (int e = 0; e < 8; ++e) if (e != e0 && lg[e] > v1) { v1 = lg[e]; e1 = e; }
            const float w0 = 1.0f / (1.0f + __expf(v1 - v0)), w1 = 1.0f - w0;
            if (lane == 0) { int* te = (int*)(ws + WS_TOKE) + 2 * m; float* tw = (float*)(ws + WS_TOKW) + 2 * m; te[0] = e0; te[1] = e1; tw[0] = w0; tw[1] = w1;
                atomicAdd((unsigned*)(misc + e0), 1u); atomicAdd((unsigned*)(misc + e1), 1u); }
        }
    }
    if (MODE == 1) { __syncthreads(); if (F.tid < 8) ((unsigned*)(ws + WS_HIST))[F.blk * 8 + F.tid] = misc[F.tid]; }
}

__device__ __forceinline__ void p_route(const Frame& F, const Args& A) {
    unsigned char* ws = A.ws;
    LAS unsigned* misc = (LAS unsigned*)(F.lds + LDS_MISC);
    LAS int* posl = (LAS int*)(F.lds + LDS_POS);
    const unsigned* hist = (const unsigned*)(ws + WS_HIST);
    const int lane = F.lane, rpw = NTOK / F.G;
    {
        const int e = F.wave; unsigned tot = 0u, bef = 0u;
        for (int v = lane; v < F.G; v += 64) { const unsigned h = hist[v * 8 + e]; tot += h; if (v < F.blk) bef += h; }
#pragma unroll
        for (int o = 1; o < 64; o <<= 1) { tot += __shfl_xor(tot, o); bef += __shfl_xor(bef, o); }
        if (lane == 0) { misc[16 + e] = tot; misc[24 + e] = bef; }
    }
    __syncthreads();
    int seg[9]; seg[0] = 0;
#pragma unroll
    for (int e = 0; e < 8; ++e) seg[e + 1] = seg[e] + (int)((misc[16 + e] + 255u) >> 8);
    if (F.blk == 0 && F.tid == 0) { int* meta = (int*)(ws + WS_META);
#pragma unroll
        for (int e = 0; e < 9; ++e) meta[e] = seg[e];
        meta[9] = seg[8]; }
    if (F.wave == 0) {
        const int* te = (const int*)(ws + WS_TOKE); int* tp = (int*)(ws + WS_TOKPOS); int* rt = nullptr; (void)rt;
        unsigned run[8];
#pragma unroll
        for (int e = 0; e < 8; ++e) run[e] = (unsigned)seg[e] * 256u + misc[24 + e];
        for (int h = 0; h < rpw; h += 64) {
            const int m = F.blk * rpw + h + lane;
#pragma unroll
            for (int k = 0; k < 2; ++k) {
                const int ek = te[2 * m + k]; int pos = 0;
#pragma unroll
                for (int e = 0; e < 8; ++e) { const unsigned long long mask = __ballot(ek == e);
                    if (ek == e) pos = (int)(run[e] + (unsigned)__popcll(mask & ((1ull << lane) - 1ull)));
                    run[e] += (unsigned)__popcll(mask); }
                tp[2 * m + k] = pos; posl[2 * (h + lane) + k] = pos;
            }
        }
    }
    __syncthreads();
    {
        const float* X = A.out; unsigned char* XS = ws + WS_XS;
        for (int i = F.wave; i < rpw; i += NWAVES) {
            const int m = F.blk * rpw + i; const int p0 = posl[2 * i], p1 = posl[2 * i + 1];
            const f32x4* xr = (const f32x4*)(X + (size_t)m * DM) + 4 * lane;
            const f32x4 a = xr[0], b = xr[1], c = xr[2], d = xr[3];
            v4u w; w.x = pg8::pk4_fp8(a.x, a.y, a.z, a.w); w.y = pg8::pk4_fp8(b.x, b.y, b.z, b.w); w.z = pg8::pk4_fp8(c.x, c.y, c.z, c.w); w.w = pg8::pk4_fp8(d.x, d.y, d.z, d.w);
            *((v4u*)(XS + (size_t)p0 * DM) + lane) = w; *((v4u*)(XS + (size_t)p1 * DM) + lane) = w;
        }
    }
    if (F.blk < 8) {
        int r0 = 0, r1 = 0;
#pragma unroll
        for (int e = 0; e < 8; ++e) if (e == F.blk) { r0 = seg[e] * 256 + (int)misc[16 + e]; r1 = seg[e + 1] * 256; }
        v4u* XS4 = (v4u*)(ws + WS_XS);
        for (size_t i = (size_t)r0 * 64 + F.tid; i < (size_t)r1 * 64; i += NTHREADS) XS4[i] = (v4u){0u, 0u, 0u, 0u};
    }
}

#ifndef MK_ONE_LAUNCH
#define MK_ONE_LAUNCH 1
#endif
constexpr int PH_MOE = 17, PH_FINAL = PH_MOE + 2 * NPASS, NPHASES = PH_FINAL + 1;

#ifndef PH_MASK
#define PH_MASK 0xFFFFFFFFu
#endif
#define IN(k) (((PH_MASK >> (k)) & 1u) && lo <= (k) && (k) < hi)
#define SEAM(k) do { if (MK_ONE_LAUNCH && lo <= (k) && (k) + 1 < hi) xcd_barrier(bar); } while (0)
template <int l>
__device__ __forceinline__ void layer_phases(const Frame& F, const Args& args, const XcdBarrier& bar, const int lo, const int hi) {
    unsigned char* ws = args.ws;
        const int pb = 1 + 9 * l;
        const float* xres = (l == 0) ? args.in[0] : args.out;
        if (IN(pb + 0)) {
            pg8::Gemm g{(const bf16*)(ws + WS_A), (const bf16*)(ws + WS_WIN) + (size_t)l * INC * DM, NTOK, INC, DM, 0};
            pg8::StaticOrder S; S.init(NTOK, INC, F.G, F.blk);
            pg8::EpiBf16 E{(bf16*)(ws + WS_ZH), INC, 1.0f};
            pg8::gemm_phase<pg8::EpiBf16, pg8::StaticOrder, true, true>(F.lds, g, S, E);
            SEAM(pb + 0);
        }
        if (IN(pb + 1)) { p_lru_summary(F, args, l); SEAM(pb + 1); }
        if (IN(pb + 2)) { p_lru_carry(F, args); SEAM(pb + 2); }
        if (IN(pb + 3)) { p_mixer(F, args, l); SEAM(pb + 3); }
        if (IN(pb + 4)) {
            pg8::Gemm g{(const bf16*)(ws + WS_A), (const bf16*)(ws + WS_WOUT) + (size_t)l * DM * DM, NTOK, DM, DM, 0};
            pg8::StaticOrder S; S.init(NTOK, DM, F.G, F.blk);
            pg8::EpiResF32 E{xres, args.out, DM, ALPHA};
            pg8::gemm_phase<pg8::EpiResF32, pg8::StaticOrder, true, true>(F.lds, g, S, E);
            SEAM(pb + 4);
        }
        if (l == 0) {
            if (IN(6)) { p_layernorm<0>(F, args, args.in[14], args.in[15]); SEAM(6); }
            if (IN(7)) {
                pg8::Gemm g{(const bf16*)(ws + WS_A), (const bf16*)(ws + WS_WGU), NTOK, 2 * DFF, DM, 0};
                pg8::StaticOrder S; S.init(NTOK, 2 * DFF, F.G, F.blk);
                pg8::EpiSwiGLU E{(bf16*)(ws + WS_ZH), DFF};
                pg8::gemm_phase<pg8::EpiSwiGLU, pg8::StaticOrder, true, true>(F.lds, g, S, E);
                SEAM(7);
            }
            if (IN(8)) {
                pg8::Gemm g{(const bf16*)(ws + WS_ZH), (const bf16*)(ws + WS_WD), NTOK, DM, DFF, 0};
                pg8::StaticOrder S; S.init(NTOK, DM, F.G, F.blk);
                pg8::EpiResF32 E{args.out, args.out, DM, ALPHA};
                pg8::gemm_phase<pg8::EpiResF32, pg8::StaticOrder, true, true>(F.lds, g, S, E);
                SEAM(8);
            }
            if (IN(9)) { p_layernorm<0>(F, args, args.in[23], args.in[24]); SEAM(9); }
        } else {
            if (IN(15)) { p_layernorm<1>(F, args, args.in[14] + DM, args.in[15] + DM); SEAM(15); }
            if (IN(16)) { p_route(F, args); SEAM(16); }
            for (int p = 0; p < NPASS; ++p) {
                int s1 = 0, s2 = 0, s3 = 0, s4 = 0, s5 = 0, s6 = 0, s7 = 0, nt = 0;
                if (IN(PH_MOE + 2 * p) || IN(PH_MOE + 1 + 2 * p)) { const int* meta = (const int*)(ws + WS_META);
                    s1 = __builtin_amdgcn_readfirstlane(meta[1]); s2 = __builtin_amdgcn_readfirstlane(meta[2]); s3 = __builtin_amdgcn_readfirstlane(meta[3]); s4 = __builtin_amdgcn_readfirstlane(meta[4]);
                    s5 = __builtin_amdgcn_readfirstlane(meta[5]); s6 = __builtin_amdgcn_readfirstlane(meta[6]); s7 = __builtin_amdgcn_readfirstlane(meta[7]); nt = __builtin_amdgcn_readfirstlane(meta[9]); }
                int nm = nt - PASS_TILES * p; nm = nm > PASS_TILES ? PASS_TILES : nm;
                if (IN(PH_MOE + 2 * p)) {
                    if (nm > 0) {
                        pg8::Gemm g{(const bf16*)(ws + WS_XS + (size_t)p * PASS_TILES * 256 * DM), (const bf16*)(ws + WS_WEGU), nm * 256, 2 * DFE, DM / 2, (size_t)2 * DFE * DM};
                        pg8::MoeOrder S; S.so.init(nm * 256, 2 * DFE, F.G, F.blk); S.tile0 = p * PASS_TILES; S.s1 = s1; S.s2 = s2; S.s3 = s3; S.s4 = s4; S.s5 = s5; S.s6 = s6; S.s7 = s7;
                        pg8::EpiSwiGLU8 E{ws + WS_HM, DFE, 1.0f / WSC_GU};
                        pg8::gemm_phase<pg8::EpiSwiGLU8, pg8::MoeOrder, true, true, true>(F.lds, g, S, E);
                    }
                    SEAM(PH_MOE + 2 * p);
                }
                if (IN(PH_MOE + 1 + 2 * p)) {
                    if (nm > 0) {
                        pg8::Gemm g{(const bf16*)(ws + WS_HM), (const bf16*)(ws + WS_WED), nm * 256, DM, DFE / 2, (size_t)DM * DFE};
                        pg8::MoeOrder S; S.so.init(nm * 256, DM, F.G, F.blk); S.tile0 = p * PASS_TILES; S.s1 = s1; S.s2 = s2; S.s3 = s3; S.s4 = s4; S.s5 = s5; S.s6 = s6; S.s7 = s7;
                        pg8::EpiBf16 E{(bf16*)(ws + WS_Y2) + (size_t)p * PASS_TILES * 256 * DM, DM, 1.0f / WSC_D};
                        pg8::gemm_phase<pg8::EpiBf16, pg8::MoeOrder, true, true, true>(F.lds, g, S, E);
                    }
                    SEAM(PH_MOE + 1 + 2 * p);
                }
            }
            if (IN(PH_FINAL)) { p_layernorm<2>(F, args, args.in[23] + DM, args.in[24] + DM); }
        }
}
__global__ void __launch_bounds__(NTHREADS, 2) fwd_kernel(Args args) {
    extern __shared__ __attribute__((aligned(16))) unsigned char lds_raw[];
    Frame F;
    F.lds = (LAS unsigned char*)lds_raw;
    F.tid = threadIdx.x; F.lane = F.tid & 63; F.wave = __builtin_amdgcn_readfirstlane(F.tid >> 6);
    F.G = gridDim.x; F.blk = blockIdx.x;
    unsigned char* ws = args.ws;
    volatile LAS unsigned* MISC = (volatile LAS unsigned*)(F.lds + LDS_MISC);
    if (F.tid < 64) MISC[F.tid] = 0u;
    __syncthreads();
    XcdBarrier bar; bar.bar = (unsigned*)(ws + WS_CTL) + CW_BAR; bar.x = 0; bar.st = nullptr;
    if (MK_ONE_LAUNCH) bar = xcd_barrier_post((unsigned*)(ws + WS_CTL) + CW_BAR, MISC + 8);
    const int lo = args.ph_lo, hi = args.ph_hi;

    if (IN(0)) { p0_prologue(F, args); SEAM(0); }

    layer_phases<0>(F, args, bar, lo, hi);
    layer_phases<1>(F, args, bar, lo, hi);
}

extern "C" void kernel_launch(void* const* d_in, const int* in_sizes, int n_in, void* d_out, int out_size, void* d_ws, size_t ws_size, hipStream_t stream) {
    static int grid = 0;
    if (grid == 0) {
        if (n_in != 25 || in_sizes[0] != NTOK * DM || out_size != NTOK * DM || ws_size < WS_END) {
            fprintf(stderr, "kernel_launch: unexpected problem: n_in %d in0 %d out %d ws %zu (need %zu)\n", n_in, n_in > 0 ? in_sizes[0] : -1, out_size, ws_size, (size_t)WS_END); grid = -1; return; }
        int dev = 0, cus = 0, per_cu = 0;
        if (hipGetDevice(&dev) != hipSuccess || hipDeviceGetAttribute(&cus, hipDeviceAttributeMultiprocessorCount, dev) != hipSuccess) { fprintf(stderr, "kernel_launch: device query failed\n"); grid = -1; return; }
        if (hipFuncSetAttribute((const void*)fwd_kernel, hipFuncAttributeMaxDynamicSharedMemorySize, LDS_BYTES) != hipSuccess) { fprintf(stderr, "kernel_launch: hipFuncSetAttribute failed\n"); grid = -1; return; }
        if (hipOccupancyMaxActiveBlocksPerMultiprocessor(&per_cu, (const void*)fwd_kernel, NTHREADS, LDS_BYTES) != hipSuccess || per_cu < 1)
            fprintf(stderr, "kernel_launch: note: occupancy query reports %d workgroups per CU\n", per_cu);
        (void)hipGetLastError();
        grid = cus;
        if (grid != 256) fprintf(stderr, "kernel_launch: note: %d CUs (built for 256)\n", grid);
        if (NTOK % grid != 0 || grid > 256) grid = 256;
    }
    if (grid < 0) return;
    (void)hipMemsetAsync((char*)d_ws + WS_CTL, 0, CTL_ZERO_BYTES, stream);
    Args a{};
    for (int i = 0; i < 25; ++i) a.in[i] = (const float*)d_in[i];
    a.out = (float*)d_out; a.ws = (unsigned char*)d_ws;
#if MK_ONE_LAUNCH
    a.ph_lo = 0; a.ph_hi = NPHASES;
    hipLaunchKernelGGL(fwd_kernel, dim3(grid), dim3(NTHREADS), LDS_BYTES, stream, a);
#else
    for (int k = 0; k < NPHASES; ++k) { a.ph_lo = k; a.ph_hi = k + 1; hipLaunchKernelGGL(fwd_kernel, dim3(grid), dim3(NTHREADS), LDS_BYTES, stream, a); }
#endif
    const hipError_t le = hipPeekAtLastError();
    if (le != hipSuccess) fprintf(stderr, "kernel_launch: launch failed: %s\n", hipGetErrorName(le));
}
```

```cpp
#include <hip/hip_runtime.h>
#include <cstdio>
#include <cstdint>
namespace pg8 {
#define PG8_LAS __attribute__((address_space(3)))
typedef unsigned short bf16_t;
typedef short bf16x8 __attribute__((ext_vector_type(8)));
typedef float f32x4 __attribute__((ext_vector_type(4)));
typedef unsigned u32x4 __attribute__((ext_vector_type(4)));
typedef int v4i __attribute__((ext_vector_type(4)));
typedef int v8i __attribute__((ext_vector_type(8)));
constexpr int BM = 256, BK = 64, HALF = 128, HTB = HALF * BK * 2  , STAGE_BYTES = 8 * HTB, NXCD = 8, WGM = 8;

__host__ __device__ __forceinline__ int lds_byte(int r, int c) { const int st = (r >> 4) * 2 + (c >> 5), rr = r & 15, cc = c & 31, ob = rr * 64 + cc * 2; return st * 1024 + (ob ^ (((ob >> 9) & 1) << 5)); }
__host__ __device__ __forceinline__ void stage_rc(int b, int& R, int& C) { const int st = b / 1024, sb = b % 1024, swz = sb ^ (((sb >> 9) & 1) << 5); R = (st >> 1) * 16 + swz / 64; C = (st & 1) * 32 + (swz % 64) / 2; }
__host__ __device__ __forceinline__ int perm32(int rho) { const int n = rho >> 4, i = rho & 15; return 8 * (i >> 2) + 4 * n + (i & 3); }

struct Unit { int pm, pn, be; };
struct Gemm { const bf16_t* A; const bf16_t* Bt; int M, N, K; size_t bstride; };

struct StaticOrder {
    int nM, nN, nwg, G, c, rep;
    __host__ __device__ void init(int M, int N, int G_, int c_, int rep_ = 1) { nM = M / BM; nN = N / BM; nwg = nM * nN; G = G_; c = c_; rep = rep_; }
    __host__ __device__ bool next(int i, Unit& u) const {
        const long L = (long)i * G + c; if (L >= (long)nwg * rep) return false;
        int wgid = (int)(L % nwg); { const int q = nwg / NXCD, r = nwg % NXCD, xcd = wgid % NXCD, off = wgid / NXCD; wgid = (xcd < r ? xcd * (q + 1) : r * (q + 1) + (xcd - r) * q) + off; }
        const int nig = WGM * nN, gid = wgid / nig, fm = gid * WGM, gsz = (nM - fm) < WGM ? (nM - fm) : WGM;
        u.pm = fm + ((wgid % nig) % gsz); u.pn = (wgid % nig) / gsz; u.be = 0; return true;
    }
    __device__ __forceinline__ void a_ready(const Unit&) const {}
    __device__ __forceinline__ void done(const Unit&) const {}
};
struct MoeOrder {
    StaticOrder so; int tile0, s1, s2, s3, s4, s5, s6, s7;
    __device__ __forceinline__ bool next(int i, Unit& u) const {
        if (!so.next(i, u)) return false;
        const int t = tile0 + u.pm;
        u.be = (t >= s1) + (t >= s2) + (t >= s3) + (t >= s4) + (t >= s5) + (t >= s6) + (t >= s7); return true;
    }
    __device__ __forceinline__ void a_ready(const Unit&) const {}
    __device__ __forceinline__ void done(const Unit&) const {}
};

__device__ __forceinline__ unsigned cvt_pk_bf16(float lo, float hi) { unsigned r; asm volatile("v_cvt_pk_bf16_f32 %0, %1, %2" : "=v"(r) : "v"(lo), "v"(hi)); return r; }

struct EpiBf16 {
    static constexpr bool PERM = true, AFTER_DRAIN = false;
    bf16_t* O; int ldc; float scale;
    __device__ __forceinline__ void operator()(const f32x4 (&acc)[2][2][4][2], const Unit& u, int wr, int wc, int fr, int fq) const {
        const int row0 = u.pm * BM + wr * 64 + fr, col0 = u.pn * BM + wc * 32 + 8 * fq;
#pragma unroll
        for (int ai = 0; ai < 2; ++ai)
#pragma unroll
            for (int m = 0; m < 4; ++m) { bf16_t* rowp = O + (size_t)(row0 + ai * HALF + m * 16) * ldc + col0;
#pragma unroll
                for (int bj = 0; bj < 2; ++bj) { const f32x4 v0 = acc[ai][bj][m][0] * scale, v1 = acc[ai][bj][m][1] * scale;
                    u32x4 w; w.x = cvt_pk_bf16(v0[0], v0[1]); w.y = cvt_pk_bf16(v0[2], v0[3]); w.z = cvt_pk_bf16(v1[0], v1[1]); w.w = cvt_pk_bf16(v1[2], v1[3]);
                    *(u32x4*)(rowp + bj * HALF) = w; } }
    }
};
__device__ __forceinline__ float silu_mul(float g, float u) { return g * u * __builtin_amdgcn_rcpf(1.0f + __builtin_amdgcn_exp2f(g * -1.4426950408889634f)); }
struct EpiSwiGLU {
    static constexpr bool PERM = true, AFTER_DRAIN = false;
    bf16_t* H; int ldh;
    __device__ __forceinline__ void operator()(const f32x4 (&acc)[2][2][4][2], const Unit& u, int wr, int wc, int fr, int fq) const {
        const int row0 = u.pm * BM + wr * 64 + fr, col0 = u.pn * HALF + wc * 32 + 8 * fq;
#pragma unroll
        for (int ai = 0; ai < 2; ++ai)
#pragma unroll
            for (int m = 0; m < 4; ++m) { bf16_t* rowp = H + (size_t)(row0 + ai * HALF + m * 16) * ldh + col0;
                const f32x4 g0 = acc[ai][0][m][0], g1 = acc[ai][0][m][1], u0 = acc[ai][1][m][0], u1 = acc[ai][1][m][1];
                u32x4 w; w.x = cvt_pk_bf16(silu_mul(g0[0], u0[0]), silu_mul(g0[1], u0[1])); w.y = cvt_pk_bf16(silu_mul(g0[2], u0[2]), silu_mul(g0[3], u0[3]));
                w.z = cvt_pk_bf16(silu_mul(g1[0], u1[0]), silu_mul(g1[1], u1[1])); w.w = cvt_pk_bf16(silu_mul(g1[2], u1[2]), silu_mul(g1[3], u1[3]));
                *(u32x4*)rowp = w; }
    }
};
__device__ __forceinline__ unsigned pk4_fp8(float a, float b, float c, float d) { int w = __builtin_amdgcn_cvt_pk_fp8_f32(a, b, 0, false); w = __builtin_amdgcn_cvt_pk_fp8_f32(c, d, w, true); return (unsigned)w; }
struct EpiSwiGLU8 {
    static constexpr bool PERM = true, AFTER_DRAIN = false;
    unsigned char* H; int ldh; float sc;
    __device__ __forceinline__ void operator()(const f32x4 (&acc)[2][2][4][2], const Unit& u, int wr, int wc, int fr, int fq) const {
        const int row0 = u.pm * BM + wr * 64 + fr, col0 = u.pn * HALF + wc * 32 + 8 * fq;
        typedef unsigned u32x2 __attribute__((ext_vector_type(2)));
#pragma unroll
        for (int ai = 0; ai < 2; ++ai)
#pragma unroll
            for (int m = 0; m < 4; ++m) { unsigned char* rowp = H + (size_t)(row0 + ai * HALF + m * 16) * ldh + col0;
                const f32x4 g0 = acc[ai][0][m][0] * sc, g1 = acc[ai][0][m][1] * sc, u0 = acc[ai][1][m][0] * sc, u1 = acc[ai][1][m][1] * sc;
                u32x2 w; w.x = pk4_fp8(silu_mul(g0[0], u0[0]), silu_mul(g0[1], u0[1]), silu_mul(g0[2], u0[2]), silu_mul(g0[3], u0[3]));
                w.y = pk4_fp8(silu_mul(g1[0], u1[0]), silu_mul(g1[1], u1[1]), silu_mul(g1[2], u1[2]), silu_mul(g1[3], u1[3]));
                *(u32x2*)rowp = w; }
    }
};
struct EpiResF32 {
    static constexpr bool PERM = false, AFTER_DRAIN = false;
    const float* res; float* out; int ldc; float alpha, scale;
    __device__ __forceinline__ void operator()(const f32x4 (&acc)[2][2][4][2], const Unit& u, int wr, int wc, int fr, int fq) const {
        const int row0 = u.pm * BM + wr * 64 + fr, col0 = u.pn * BM + wc * 32 + 4 * fq;
#pragma unroll
        for (int ai = 0; ai < 2; ++ai)
#pragma unroll
            for (int m = 0; m < 4; ++m) { const size_t off = (size_t)(row0 + ai * HALF + m * 16) * ldc + col0;
                f32x4 rv[2][2];
#pragma unroll
                for (int bj = 0; bj < 2; ++bj)
#pragma unroll
                    for (int n = 0; n < 2; ++n) rv[bj][n] = *(const f32x4*)(res + off + bj * HALF + n * 16);
#pragma unroll
                for (int bj = 0; bj < 2; ++bj)
#pragma unroll
                    for (int n = 0; n < 2; ++n) *(f32x4*)(out + off + bj * HALF + n * 16) = rv[bj][n] * alpha + acc[ai][bj][m][n] * scale;
                asm volatile("" ::: "memory"); }
    }
};

__device__ __forceinline__ void mfma8(f32x4& c, const v8i a, const v8i b, const int scl) { asm volatile("v_mfma_scale_f32_16x16x128_f8f6f4 %0, %1, %2, %0, %3, %3 op_sel_hi:[0,0,0]" : "+v"(c) : "v"(a), "v"(b), "v"(scl)); }
template <class Epi, class Sched, bool ALIGN_EPI = false, bool SP2 = false, bool FP8 = false>
__device__ __forceinline__ void gemm_phase(PG8_LAS unsigned char* lds, const Gemm g, const Sched& S, const Epi& E) {
    const int tid = threadIdx.x, wid = __builtin_amdgcn_readfirstlane(tid >> 6), lane = tid & 63, wr = wid >> 2, wc = wid & 3, fr = lane & 15, fq = lane >> 4;
    const int K = g.K, nt = K / BK;
    unsigned voffA[2], voffB[2];
#pragma unroll
    for (int i = 0; i < 2; ++i) { int R, C; stage_rc(tid * 16 + i * 8192, R, C); const int Rb = Epi::PERM ? ((R & ~31) + perm32(R & 31)) : R;
        voffA[i] = (unsigned)(R * K + C) * 2u; voffB[i] = (unsigned)(Rb * K + C) * 2u; }
    const size_t kstep = (size_t)(BK * 2);
    const size_t hstep = (size_t)HALF * K * 2;
    const size_t tstep = 2 * hstep;
    const unsigned ldsw = (unsigned)wid * 1024u;
    const int aoff = lds_byte(wr * 64 + fr, fq * 8), boff = lds_byte(wc * 32 + fr, fq * 8);
#define PG8_SA(b, h) (((b) * 2 + (h)) * HTB)
#define PG8_SB(b, h) ((4 + (b) * 2 + (h)) * HTB)
#define PG8_STAGE(bufoff, gbase, voff) do { _Pragma("unroll") for (int _i = 0; _i < 2; ++_i) \
        __builtin_amdgcn_global_load_lds((const unsigned*)((const char*)(gbase) + (voff)[_i]), (PG8_LAS unsigned*)(lds + (bufoff) + ldsw + _i * 8192), 16, 0, 0); } while (0)
#define PG8_LDA(dst, b, h) do { if constexpr (FP8) { _Pragma("unroll") for (int m = 0; m < 4; ++m) { dst##8[m][0] = *(const PG8_LAS v4i*)(lds + PG8_SA(b, h) + aoff + m * 2048); dst##8[m][1] = *(const PG8_LAS v4i*)(lds + PG8_SA(b, h) + aoff + m * 2048 + 1024); } } \
    else { _Pragma("unroll") for (int m = 0; m < 4; ++m) _Pragma("unroll") for (int k = 0; k < 2; ++k) dst[m][k] = *(const PG8_LAS bf16x8*)(lds + PG8_SA(b, h) + aoff + m * 2048 + k * 1024); } } while (0)
#define PG8_LDB(dst, b, h) do { if constexpr (FP8) { _Pragma("unroll") for (int n = 0; n < 2; ++n) { dst##8[n][0] = *(const PG8_LAS v4i*)(lds + PG8_SB(b, h) + boff + n * 2048); dst##8[n][1] = *(const PG8_LAS v4i*)(lds + PG8_SB(b, h) + boff + n * 2048 + 1024); } } \
    else { _Pragma("unroll") for (int n = 0; n < 2; ++n) _Pragma("unroll") for (int k = 0; k < 2; ++k) dst[n][k] = *(const PG8_LAS bf16x8*)(lds + PG8_SB(b, h) + boff + n * 2048 + k * 1024); } } while (0)
#define PG8_MMA(ai, bj, At, Bt) do { __builtin_amdgcn_s_setprio(1); if constexpr (FP8) { _Pragma("unroll") for (int m = 0; m < 4; ++m) _Pragma("unroll") for (int n = 0; n < 2; ++n) \
        mfma8(acc[ai][bj][m][n], __builtin_shufflevector(Bt##8[n][0], Bt##8[n][1], 0, 1, 2, 3, 4, 5, 6, 7), __builtin_shufflevector(At##8[m][0], At##8[m][1], 0, 1, 2, 3, 4, 5, 6, 7), scl8); } \
    else { _Pragma("unroll") for (int m = 0; m < 4; ++m) _Pragma("unroll") for (int n = 0; n < 2; ++n) _Pragma("unroll") for (int k = 0; k < 2; ++k) \
        acc[ai][bj][m][n] = __builtin_amdgcn_mfma_f32_16x16x32_bf16(Bt[n][k], At[m][k], acc[ai][bj][m][n], 0, 0, 0); } __builtin_amdgcn_s_setprio(0); } while (0)
#define PG8_WAIT_V(n) asm volatile("s_waitcnt vmcnt(" #n ")" ::: "memory")
#define PG8_WAIT_L(n) asm volatile("s_waitcnt lgkmcnt(" #n ")" ::: "memory")
#define PG8_BAR __builtin_amdgcn_s_barrier()
#define PG8_SCHED __builtin_amdgcn_sched_barrier(0)
    Unit cur, nxt; int ui = 0;
    if (!S.next(0, cur)) return;
    f32x4 acc[2][2][4][2];
#pragma unroll
    for (int a = 0; a < 2; ++a)
#pragma unroll
        for (int b = 0; b < 2; ++b)
#pragma unroll
            for (int m = 0; m < 4; ++m)
#pragma unroll
                for (int n = 0; n < 2; ++n) acc[a][b][m][n] = (f32x4){0.f, 0.f, 0.f, 0.f};
    bf16x8 At[4][2], B0[2][2], B1[2][2];
    v4i At8[4][2], B08[2][2], B18[2][2];
    int scl8 = 0x7F7F7F7F; asm volatile("" : "+v"(scl8));
    const char* cA = (const char*)g.A + (size_t)cur.pm * tstep; const char* cB = (const char*)g.Bt + (size_t)cur.be * g.bstride + (size_t)cur.pn * tstep;
    S.a_ready(cur);
    if constexpr (SP2) {
        PG8_STAGE(PG8_SB(0, 0), cB, voffB); PG8_STAGE(PG8_SB(0, 1), cB + hstep, voffB); PG8_STAGE(PG8_SA(0, 0), cA, voffA); PG8_STAGE(PG8_SA(0, 1), cA + hstep, voffA);
        if (wr == 1) PG8_BAR;
        PG8_WAIT_V(2); PG8_BAR;
        PG8_STAGE(PG8_SB(1, 0), cB + kstep, voffB); PG8_STAGE(PG8_SA(1, 0), cA + kstep, voffA); PG8_STAGE(PG8_SB(1, 1), cB + hstep + kstep, voffB);
        PG8_WAIT_V(6); PG8_BAR;
    } else {
        PG8_STAGE(PG8_SB(0, 0), cB, voffB); PG8_STAGE(PG8_SA(0, 0), cA, voffA); PG8_STAGE(PG8_SB(0, 1), cB + hstep, voffB); PG8_STAGE(PG8_SA(0, 1), cA + hstep, voffA);
        if (wr == 1) PG8_BAR;
        PG8_WAIT_V(4); PG8_BAR;
        PG8_STAGE(PG8_SB(1, 0), cB + kstep, voffB); PG8_STAGE(PG8_SA(1, 0), cA + kstep, voffA); PG8_STAGE(PG8_SB(1, 1), cB + hstep + kstep, voffB);
        PG8_WAIT_V(6); PG8_BAR;
    }
    for (;;) {
        const bool has_next = S.next(ui + 1, nxt);
        const char* nA = has_next ? (const char*)g.A + (size_t)nxt.pm * tstep : cA; const char* nB = has_next ? (const char*)g.Bt + (size_t)nxt.be * g.bstride + (size_t)nxt.pn * tstep : cB;
#pragma unroll 1
        for (int t = 0; t < nt; t += 2) {
            const bool last = (t == nt - 2);
            const char* a1 = cA + (size_t)(t + 1) * kstep;
            const char* a2 = last ? nA : cA + (size_t)(t + 2) * kstep; const char* b2 = last ? nB : cB + (size_t)(t + 2) * kstep;
            const char* a3 = a2 + kstep; const char* b3 = b2 + kstep;
            if (last && has_next) S.a_ready(nxt);
            if constexpr (SP2) {
            PG8_LDB(B0, 0, 0); PG8_LDB(B1, 0, 1); PG8_SCHED; PG8_LDA(At, 0, 0); PG8_STAGE(PG8_SA(1, 1), a1 + hstep, voffA);
            PG8_WAIT_V(8); PG8_WAIT_L(0); PG8_BAR; PG8_MMA(0, 0, At, B0); PG8_MMA(0, 1, At, B1); PG8_BAR; PG8_SCHED;
            PG8_LDA(At, 0, 1); PG8_STAGE(PG8_SB(0, 0), b2, voffB); PG8_STAGE(PG8_SB(0, 1), b2 + hstep, voffB); PG8_STAGE(PG8_SA(0, 0), a2, voffA);
            PG8_WAIT_V(8); PG8_WAIT_L(0); PG8_BAR; PG8_MMA(1, 0, At, B0); PG8_MMA(1, 1, At, B1); PG8_BAR; PG8_SCHED;
            PG8_LDB(B0, 1, 0); PG8_LDB(B1, 1, 1); PG8_SCHED; PG8_LDA(At, 1, 0); PG8_STAGE(PG8_SA(0, 1), a2 + hstep, voffA);
            PG8_WAIT_V(8); PG8_WAIT_L(0); PG8_BAR; PG8_MMA(0, 0, At, B0); PG8_MMA(0, 1, At, B1); PG8_BAR; PG8_SCHED;
            PG8_LDA(At, 1, 1); PG8_STAGE(PG8_SB(1, 0), b3, voffB); PG8_STAGE(PG8_SB(1, 1), b3 + hstep, voffB); PG8_STAGE(PG8_SA(1, 0), a3, voffA);
            PG8_WAIT_V(8); PG8_WAIT_L(0); PG8_BAR; PG8_MMA(1, 0, At, B0); PG8_MMA(1, 1, At, B1); PG8_BAR; PG8_SCHED;
            } else {
            PG8_LDB(B0, 0, 0); PG8_SCHED; PG8_LDA(At, 0, 0); PG8_STAGE(PG8_SA(1, 1), a1 + hstep, voffA);
            PG8_WAIT_L(8); PG8_BAR; PG8_WAIT_L(0); PG8_MMA(0, 0, At, B0); PG8_BAR; PG8_SCHED;
            PG8_LDB(B1, 0, 1); PG8_STAGE(PG8_SB(0, 0), b2, voffB);
            PG8_BAR; PG8_WAIT_L(0); PG8_MMA(0, 1, At, B1); PG8_BAR;
            PG8_LDA(At, 0, 1); PG8_STAGE(PG8_SA(0, 0), a2, voffA);
            PG8_BAR; PG8_WAIT_L(0); PG8_MMA(1, 0, At, B0); PG8_BAR; PG8_SCHED;
            PG8_STAGE(PG8_SB(0, 1), b2 + hstep, voffB);
            PG8_WAIT_V(6); PG8_BAR; PG8_MMA(1, 1, At, B1); PG8_BAR;
            PG8_LDB(B0, 1, 0); PG8_SCHED; PG8_LDA(At, 1, 0); PG8_STAGE(PG8_SA(0, 1), a2 + hstep, voffA);
            PG8_WAIT_L(8); PG8_BAR; PG8_WAIT_L(0); PG8_MMA(0, 0, At, B0); PG8_BAR; PG8_SCHED;
            PG8_LDB(B1, 1, 1); PG8_STAGE(PG8_SB(1, 0), b3, voffB);
            PG8_BAR; PG8_WAIT_L(0); PG8_MMA(0, 1, At, B1); PG8_BAR;
            PG8_LDA(At, 1, 1); PG8_STAGE(PG8_SA(1, 0), a3, voffA);
            PG8_BAR; PG8_WAIT_L(0); PG8_MMA(1, 0, At, B0); PG8_BAR; PG8_SCHED;
            PG8_STAGE(PG8_SB(1, 1), b3 + hstep, voffB);
            PG8_WAIT_V(6); PG8_BAR; PG8_MMA(1, 1, At, B1); PG8_BAR;
            }
        }
        if constexpr (FP8) asm volatile("s_nop 15\n\ts_nop 15" ::: "memory");
        if constexpr (ALIGN_EPI) { if (wr == 0) PG8_BAR; }
        if constexpr (!Epi::AFTER_DRAIN) { E(acc, cur, wr, wc, fr, fq); S.done(cur); }
        if (!has_next) break;
#pragma unroll
        for (int a = 0; a < 2; ++a)
#pragma unroll
            for (int b = 0; b < 2; ++b)
#pragma unroll
                for (int m = 0; m < 4; ++m)
#pragma unroll
                    for (int n = 0; n < 2; ++n) acc[a][b][m][n] = (f32x4){0.f, 0.f, 0.f, 0.f};
        cur = nxt; cA = nA; cB = nB; ++ui;
        if constexpr (ALIGN_EPI) { if (wr == 1) PG8_BAR; }
    }
    PG8_WAIT_V(0);
    if constexpr (!ALIGN_EPI) { if (wr == 0) PG8_BAR; }
    PG8_BAR;
    if constexpr (Epi::AFTER_DRAIN) { E.fused(acc, cur, wr, wc, fr, fq, lds, wid, lane); S.done(cur); }
#undef PG8_SA
#undef PG8_SB
#undef PG8_STAGE
#undef PG8_LDA
#undef PG8_LDB
#undef PG8_MMA
#undef PG8_WAIT_V
#undef PG8_WAIT_L
#undef PG8_BAR
#undef PG8_SCHED
}
}

constexpr int BATCH = 2, SEQ = 16384, DM = 1024, NTOK = BATCH * SEQ;
constexpr int CHK = 64, NCHUNK = SEQ / CHK;
constexpr int INC = 1792, KOFF = 512, VOFF = 640, XBOFF = 768, GBOFF = 1280;
constexpr int LRUW = 512, DFF = 2816, DFE = 3584, NEXP = 8;
constexpr int MAXTILES = 264, PASS_TILES = 128, NPASS = 3;
constexpr float ALPHA = 1.41421356237309515f, LN_EPS = 1e-5f, RMS_EPS = 1e-6f, LOG2E = 1.4426950408889634f, QSCALE = 0.125f * LOG2E;
constexpr int NWAVES = 8, NTHREADS = 512;

constexpr size_t MiB = 1u << 20;
constexpr size_t WS_CTL = 0, CTL_ZERO_BYTES = 64 * 1024;
constexpr size_t WS_LUT = 1 * MiB;
constexpr size_t WS_GATEW = 1 * MiB + 64 * 1024;
constexpr size_t WS_HIST = 1 * MiB + 512 * 1024;
constexpr size_t WS_META = 1 * MiB + 576 * 1024;
constexpr size_t WS_TOKE = 2 * MiB, WS_TOKW = 2 * MiB + 256 * 1024, WS_TOKPOS = 2 * MiB + 512 * 1024;
constexpr size_t WS_LRUP = 3 * MiB, WS_LRUE = 4 * MiB, WS_HIN = 5 * MiB;
constexpr size_t WS_WEGU = 8 * MiB, WS_WED = 64 * MiB;
constexpr size_t WS_WIN = 92 * MiB, WS_WOUT = 99 * MiB, WS_WGU = 103 * MiB, WS_WD = 114 * MiB;
constexpr size_t WS_A = 120 * MiB;
constexpr size_t WS_ZH = 184 * MiB;
constexpr size_t WS_XS = 120 * MiB;
constexpr size_t WS_Y2 = 186 * MiB;
constexpr size_t WS_HM = 318 * MiB;
constexpr size_t WS_END = 430 * MiB;
constexpr float WSC_GU = 64.0f, WSC_D = 256.0f;
static_assert(WS_WED + (size_t)NEXP * DM * DFE <= WS_WIN && WS_WD + (size_t)DM * DFF * 2 <= WS_A && WS_A + (size_t)NTOK * DM * 2 <= WS_ZH && WS_ZH + (size_t)NTOK * DFF * 2 <= WS_END, "ws map");
static_assert(WS_XS + (size_t)MAXTILES * 256 * DM <= WS_Y2 && WS_Y2 + (size_t)MAXTILES * 256 * DM * 2 <= WS_HM && WS_HM + (size_t)PASS_TILES * 256 * DFE <= WS_END, "ws map (MoE)");
constexpr int CW_BAR = 0;

constexpr int RING_BYTES = 131072;
constexpr int LDS_LUT = RING_BYTES;
constexpr int LDS_SSQA = LDS_LUT + 8192, LDS_SSQL = LDS_SSQA + 2048;
constexpr int LDS_MISC = LDS_SSQL + 2048;
constexpr int LDS_POS = LDS_MISC + 256;
constexpr int LDS_BYTES = 147456;
static_assert(LDS_POS + 1024 <= LDS_BYTES, "LDS map");

#define GAS __attribute__((address_space(1)))
#define LAS __attribute__((address_space(3)))
typedef unsigned short bf16;
typedef unsigned v4u __attribute__((ext_vector_type(4)));
typedef unsigned v2u __attribute__((ext_vector_type(2)));
typedef float f32x4 __attribute__((ext_vector_type(4)));
typedef float f32x16 __attribute__((ext_vector_type(16)));
typedef short bf16x8 __attribute__((ext_vector_type(8)));
typedef short s16x4 __attribute__((ext_vector_type(4)));
#define LDS_WAIT() asm volatile("s_waitcnt lgkmcnt(0)" ::: "memory")
#define VM_WAIT() asm volatile("s_waitcnt vmcnt(0)" ::: "memory")
__device__ __forceinline__ unsigned pk2(float lo, float hi) { return pg8::cvt_pk_bf16(lo, hi); }
__device__ __forceinline__ float bf2f(unsigned short h) { return __uint_as_float((unsigned)h << 16); }
__device__ __forceinline__ float bflo(unsigned w) { return __uint_as_float(w << 16); }
__device__ __forceinline__ float bfhi(unsigned w) { return __uint_as_float(w & 0xffff0000u); }
__device__ __forceinline__ float wave_sum(float v) {
#pragma unroll
    for (int o = 1; o < 64; o <<= 1) v += __shfl_xor(v, o);
    return v;
}
__device__ __forceinline__ float fast_sigmoid(float x) { return __builtin_amdgcn_rcpf(1.0f + __builtin_amdgcn_exp2f(x * -LOG2E)); }
__device__ __forceinline__ float gelu_tanh(float x) {
    const float t = 1.5957691216057308f * (x + 0.044715f * x * x * x);
    return x * fast_sigmoid(t);
}

#define XB_TMO      128
#define XB_XCNT(j)  (256  + 64 * (j))
#define XB_XSUB(j)  (1280 + 64 * (j))
#define XB_XGEN(j)  (2304 + 64 * (j))
#define XB_TOP      3328
#define XB_TOPGEN   3392
#define XCD_BAR_WORDS 3456
#define XB_SPIN_CAP (1u << 18)

__device__ __forceinline__ unsigned xb_ld(unsigned* p)              { return __hip_atomic_load(p, __ATOMIC_RELAXED, __HIP_MEMORY_SCOPE_AGENT); }
__device__ __forceinline__ unsigned xb_add(unsigned* p, unsigned v) { return __hip_atomic_fetch_add(p, v, __ATOMIC_RELAXED, __HIP_MEMORY_SCOPE_AGENT); }
__device__ __forceinline__ unsigned xb_xcc_id() { return (unsigned)__builtin_amdgcn_s_getreg((3 << 11) | 20) & 0xFu; }
#define XB_SPIN(cond, bar) do { unsigned _sp = 0; while (cond) { __builtin_amdgcn_s_sleep(1); \
    if ((++_sp & 255u) == 0u) { if (xb_ld(&(bar)[XB_TMO])) break; if (_sp > XB_SPIN_CAP) { atomicAdd(&(bar)[XB_TMO], 1u); break; } } } } while (0)

struct XcdBarrier {
    unsigned* bar; unsigned x;
    volatile LAS unsigned* st;
};

__device__ __forceinline__ XcdBarrier xcd_barrier_post(unsigned* bar, volatile LAS unsigned* st) {
    XcdBarrier b; b.bar = bar; b.x = xb_xcc_id(); b.st = st;
    if (threadIdx.x == 0) (void)xb_add(&bar[XB_XCNT(b.x)], 1u);
    return b;
}
__device__ __forceinline__ void xcd_barrier_complete(unsigned* bar, unsigned x, unsigned& nloc, unsigned& nx) {
    const unsigned G = gridDim.x * gridDim.y * gridDim.z;
    unsigned sum, cnt, mine, sp = 0u;
    for (;;) {
        sum = 0u; cnt = 0u; mine = 0u;
#pragma unroll
        for (unsigned j = 0; j < 16; ++j) { const unsigned c = xb_ld(&bar[XB_XCNT(j)]); sum += c; cnt += (c > 0u) ? 1u : 0u; mine = (j == x) ? c : mine; }
        if (sum == G) break;
        __builtin_amdgcn_s_sleep(1);
        if ((++sp & 255u) == 0u) { if (xb_ld(&bar[XB_TMO])) break; if (sp > XB_SPIN_CAP) { atomicAdd(&bar[XB_TMO], 1u); break; } }
    }
    nloc = mine > 0u ? mine : 1u; nx = cnt > 0u ? cnt : 1u;
}

__device__ __forceinline__ void xcd_barrier(const XcdBarrier& b) {
    asm volatile("s_waitcnt vmcnt(0)" ::: "memory");
    __syncthreads();
    if (threadIdx.x == 0) {
        unsigned* bar = b.bar;
        __builtin_amdgcn_s_waitcnt(0);
        unsigned nloc = b.st[0], nx = b.st[1];
        if (nloc == 0u) { xcd_barrier_complete(bar, b.x, nloc, nx); b.st[0] = nloc; b.st[1] = nx; }
        const unsigned old = xb_add(&bar[XB_XSUB(b.x)], 1u);
        const unsigned gen = old / nloc;
        if (old + 1u == (gen + 1u) * nloc) {
            __builtin_amdgcn_fence(__ATOMIC_RELEASE, "agent");
            asm volatile("s_waitcnt vmcnt(0)" ::: "memory");
            const unsigned og = xb_add(&bar[XB_TOP], 1u);
            const unsigned tg = og / nx;
            if (og + 1u == (tg + 1u) * nx) xb_add(&bar[XB_TOPGEN], 1u);
            else XB_SPIN(xb_ld(&bar[XB_TOPGEN]) == tg, bar);
            __builtin_amdgcn_fence(__ATOMIC_ACQUIRE, "agent");
            xb_add(&bar[XB_XGEN(b.x)], 1u);
            asm volatile("s_waitcnt vmcnt(0)" ::: "memory");
        } else {
            XB_SPIN(xb_ld(&bar[XB_XGEN(b.x)]) == gen, bar);
            __builtin_amdgcn_fence(__ATOMIC_ACQUIRE, "agent");
            asm volatile("s_waitcnt vmcnt(0)" ::: "memory");
        }
    }
    __syncthreads();
}

struct Args { const float* in[25]; float* out; unsigned char* ws; int ph_lo, ph_hi; };
struct Frame {
    LAS unsigned char* lds;
    int tid, lane, wave, G, blk;
};

__device__ __forceinline__ void p0_transpose_item(const float* W, int K, int N, bf16* WT, int mode, const float* ksA, const float* ksB, float nscale, int nscale_cols, LAS float* scr, int item, int lane) {
    const int nblk = N / 32, kb = item / nblk, nb = item % nblk, k0 = 64 * kb, n0 = 32 * nb;
    const float* ks = ksA ? (k0 < 512 ? ksA + k0 : ksB + (k0 - 512)) : nullptr;
#pragma unroll 8
    for (int i = 0; i < 32; ++i) { const int kk = 2 * i + (lane >> 5); float v = W[(size_t)(k0 + kk) * N + n0 + (lane & 31)]; if (ks) v *= ks[kk]; scr[kk * 33 + (lane & 31)] = v; }
    LDS_WAIT(); asm volatile("" ::: "memory");
    const int drow0 = (mode == 0) ? n0 : ((n0 >> 7) * 256 + (n0 & 127) + (mode == 2 ? 128 : 0));
    const float sc = (n0 < nscale_cols) ? nscale : 1.0f;
    const int c = lane & 7;
#pragma unroll
    for (int j = 0; j < 4; ++j) { const int n = (lane >> 3) + 8 * j; const LAS float* s = scr + (8 * c) * 33 + n;
        v4u o; o.x = pk2(s[0 * 33] * sc, s[1 * 33] * sc); o.y = pk2(s[2 * 33] * sc, s[3 * 33] * sc); o.z = pk2(s[4 * 33] * sc, s[5 * 33] * sc); o.w = pk2(s[6 * 33] * sc, s[7 * 33] * sc);
        *(v4u*)(WT + (size_t)(drow0 + n) * K + k0 + 8 * c) = o; }
    LDS_WAIT(); asm volatile("" ::: "memory");
}
__device__ __forceinline__ void p0_transpose_item_f8(const float* W, int K, int N, unsigned char* WT, int mode, float scale, LAS float* scr, int item, int lane) {
    const int nblk = N / 32, kb = item / nblk, nb = item % nblk, k0 = 64 * kb, n0 = 32 * nb;
#pragma unroll 8
    for (int i = 0; i < 32; ++i) { const int kk = 2 * i + (lane >> 5); scr[kk * 33 + (lane & 31)] = W[(size_t)(k0 + kk) * N + n0 + (lane & 31)] * scale; }
    LDS_WAIT(); asm volatile("" ::: "memory");
    const int drow0 = (mode == 0) ? n0 : ((n0 >> 7) * 256 + (n0 & 127) + (mode == 2 ? 128 : 0));
    const int c = lane & 3;
#pragma unroll
    for (int j = 0; j < 2; ++j) { const int n = (lane >> 2) + 16 * j; const LAS float* s = scr + (16 * c) * 33 + n;
        v4u o; o.x = pg8::pk4_fp8(s[0 * 33], s[1 * 33], s[2 * 33], s[3 * 33]); o.y = pg8::pk4_fp8(s[4 * 33], s[5 * 33], s[6 * 33], s[7 * 33]);
        o.z = pg8::pk4_fp8(s[8 * 33], s[9 * 33], s[10 * 33], s[11 * 33]); o.w = pg8::pk4_fp8(s[12 * 33], s[13 * 33], s[14 * 33], s[15 * 33]);
        *(v4u*)(WT + (size_t)(drow0 + n) * K + k0 + 16 * c) = o; }
    LDS_WAIT(); asm volatile("" ::: "memory");
}
__device__ __forceinline__ int t5_bucket(int rel) {
    const int n = rel < 0 ? -rel : rel;
    int v;
    if (n < 8) v = n;
    else { v = 8 + (n >= 12) + (n >= 16) + (n >= 23) + (n >= 32) + (n >= 46) + (n >= 64) + (n >= 91); }
    return (rel > 0 ? 16 : 0) + v;
}
__device__ __forceinline__ void p0_prologue(const Frame& F, const Args& A) {
    unsigned char* ws = A.ws;
    LAS float* scr = (LAS float*)(F.lds + F.wave * 8448);
    const int gw = F.blk * NWAVES + F.wave, NGW = F.G * NWAVES;
    bf16* WIN = (bf16*)(ws + WS_WIN); bf16* WOUT = (bf16*)(ws + WS_WOUT); bf16* WGU = (bf16*)(ws + WS_WGU); bf16* WD = (bf16*)(ws + WS_WD);
    unsigned char* WEGU = ws + WS_WEGU; unsigned char* WED = ws + WS_WED;
    constexpr int I_IN = (DM / 64) * (INC / 32), I_OUT = (DM / 64) * (DM / 32), I_GU = (DM / 64) * (DFF / 32), I_D = (DFF / 64) * (DM / 32);
    constexpr int I_EGU = (DM / 64) * (DFE / 32), I_ED = (DFE / 64) * (DM / 32);
    constexpr int NITEMS = 2 * I_IN + 2 * I_OUT + 2 * I_GU + I_D + NEXP * (2 * I_EGU + I_ED);
    for (int it = gw; it < NITEMS; it += NGW) {
        int r = it;
        if (r < 2 * I_IN) { const int l = r / I_IN; r -= l * I_IN;
            p0_transpose_item(A.in[2] + (size_t)l * DM * INC, DM, INC, WIN + (size_t)l * INC * DM, 0, nullptr, nullptr, QSCALE, 512, scr, r, F.lane); continue; }
        r -= 2 * I_IN;
        if (r < 2 * I_OUT) { const int l = r / I_OUT; r -= l * I_OUT;
            p0_transpose_item(A.in[13] + (size_t)l * DM * DM, DM, DM, WOUT + (size_t)l * DM * DM, 0, A.in[11] + l * 512, A.in[12] + l * 512, 1.0f, 0, scr, r, F.lane); continue; }
        r -= 2 * I_OUT;
        if (r < I_GU) { p0_transpose_item_f8(A.in[16], DM, DFF, (unsigned char*)WGU, 1, WSC_GU, scr, r, F.lane); continue; }
        r -= I_GU;
        if (r < I_GU) { p0_transpose_item_f8(A.in[17], DM, DFF, (unsigned char*)WGU, 2, WSC_GU, scr, r, F.lane); continue; }
        r -= I_GU;
        if (r < I_D) { p0_transpose_item_f8(A.in[18], DFF, DM, (unsigned char*)WD, 0, WSC_D, scr, r, F.lane); continue; }
        r -= I_D;
        { constexpr int PER_E = 2 * I_EGU + I_ED; const int e = r / PER_E; r -= e * PER_E;
          if (r < I_EGU) { p0_transpose_item_f8(A.in[20] + (size_t)e * DM * DFE, DM, DFE, WEGU + (size_t)e * 2 * DFE * DM, 1, WSC_GU, scr, r, F.lane); continue; }
          r -= I_EGU;
          if (r < I_EGU) { p0_transpose_item_f8(A.in[21] + (size_t)e * DM * DFE, DM, DFE, WEGU + (size_t)e * 2 * DFE * DM, 2, WSC_GU, scr, r, F.lane); continue; }
          r -= I_EGU;
          p0_transpose_item_f8(A.in[22] + (size_t)e * DFE * DM, DFE, DM, WED + (size_t)e * DM * DFE, 0, WSC_D, scr, r, F.lane); }
    }
    { const f32x4* x4 = (const f32x4*)A.in[0]; v4u* o = (v4u*)(ws + WS_A);
      const size_t n8 = (size_t)NTOK * DM / 8, stride = (size_t)F.G * NTHREADS;
      for (size_t i = (size_t)F.blk * NTHREADS + F.tid; i < n8; i += stride) { const f32x4 a = x4[2 * i], b = x4[2 * i + 1];
          v4u w; w.x = pk2(a.x, a.y); w.y = pk2(a.z, a.w); w.z = pk2(b.x, b.y); w.w = pk2(b.z, b.w); o[i] = w; } }
    { bf16* GW = (bf16*)(ws + WS_GATEW);
      for (int i = F.blk * NTHREADS + F.tid; i < 2 * 2 * 8 * 64 * 64; i += F.G * NTHREADS) {
          const int d = i & 63, e = (i >> 6) & 63, n = (i >> 12) & 7, g = (i >> 15) & 1, l = i >> 16;
          const float v = (g ? A.in[8] : A.in[6])[(((size_t)l * 8 + n) * 64 + d) * 64 + e];
          GW[i] = (bf16)(pk2(v, v) & 0xffffu); } }
    if (F.blk == 0 && F.tid < 256) { float* LUT = (float*)(ws + WS_LUT); const int rel = F.tid - 191; const int bk = t5_bucket(rel);
#pragma unroll
        for (int h = 0; h < 8; ++h) LUT[h * 256 + F.tid] = A.in[1][bk * 8 + h] * LOG2E; }
}

template <bool FINAL>
__device__ __forceinline__ void lru_tile(const bf16* Z, int b, int c, int n, int lane, const bf16* gwr, const bf16* gwi, const float* convw, const float* convb,
                                         const float* br, const float* bi, const float* lam, float* outP, float* outE, const float* Hin, LAS float* yl) {
    const int fr = lane & 15, fq = lane >> 4;
    const size_t seq0 = (size_t)b * SEQ;
    bf16x8 xa[4][2];
#pragma unroll
    for (int ks = 0; ks < 2; ++ks) {
        const int ch = 64 * n + 32 * ks + 8 * fq;
        float cw[4][8], cb[8];
#pragma unroll
        for (int w = 0; w < 4; ++w) { const f32x4 a = *(const f32x4*)(convw + w * LRUW + ch), bq = *(const f32x4*)(convw + w * LRUW + ch + 4);
            cw[w][0] = a.x; cw[w][1] = a.y; cw[w][2] = a.z; cw[w][3] = a.w; cw[w][4] = bq.x; cw[w][5] = bq.y; cw[w][6] = bq.z; cw[w][7] = bq.w; }
        { const f32x4 a = *(const f32x4*)(convb + ch), bq = *(const f32x4*)(convb + ch + 4); cb[0] = a.x; cb[1] = a.y; cb[2] = a.z; cb[3] = a.w; cb[4] = bq.x; cb[5] = bq.y; cb[6] = bq.z; cb[7] = bq.w; }
#pragma unroll
        for (int m = 0; m < 4; ++m) {
            const int t = CHK * c + 16 * m + fr;
            float a8[8];
#pragma unroll
            for (int j = 0; j < 8; ++j) a8[j] = cb[j];
#pragma unroll
            for (int w = 0; w < 4; ++w) { const int tt = t + w - 3;
                if (tt >= 0) { const v4u v = *(const v4u*)(Z + (seq0 + tt) * INC + XBOFF + ch);
                    a8[0] += cw[w][0] * bflo(v.x); a8[1] += cw[w][1] * bfhi(v.x); a8[2] += cw[w][2] * bflo(v.y); a8[3] += cw[w][3] * bfhi(v.y);
                    a8[4] += cw[w][4] * bflo(v.z); a8[5] += cw[w][5] * bfhi(v.z); a8[6] += cw[w][6] * bflo(v.w); a8[7] += cw[w][7] * bfhi(v.w); } }
            v4u p; p.x = pk2(a8[0], a8[1]); p.y = pk2(a8[2], a8[3]); p.z = pk2(a8[4], a8[5]); p.w = pk2(a8[6], a8[7]);
            xa[m][ks] = __builtin_bit_cast(bf16x8, p);
        }
    }
#pragma unroll 1
    for (int nb = 0; nb < 4; ++nb) {
        bf16x8 wr[2], wi[2], idf[2];
#pragma unroll
        for (int ks = 0; ks < 2; ++ks) {
            wr[ks] = *(const bf16x8*)(gwr + (16 * nb + fr) * 64 + 32 * ks + 8 * fq);
            wi[ks] = *(const bf16x8*)(gwi + (16 * nb + fr) * 64 + 32 * ks + 8 * fq);
#pragma unroll
            for (int j = 0; j < 8; ++j) idf[ks][j] = (32 * ks + 8 * fq + j == 16 * nb + fr) ? (short)0x3F80 : (short)0;
        }
        f32x4 dr[4], di[4], dx[4];
#pragma unroll
        for (int m = 0; m < 4; ++m) { dr[m] = (f32x4){0.f, 0.f, 0.f, 0.f}; di[m] = dr[m]; dx[m] = dr[m];
#pragma unroll
            for (int ks = 0; ks < 2; ++ks) {
                dr[m] = __builtin_amdgcn_mfma_f32_16x16x32_bf16(xa[m][ks], wr[ks], dr[m], 0, 0, 0);
                di[m] = __builtin_amdgcn_mfma_f32_16x16x32_bf16(xa[m][ks], wi[ks], di[m], 0, 0, 0);
                dx[m] = __builtin_amdgcn_mfma_f32_16x16x32_bf16(xa[m][ks], idf[ks], dx[m], 0, 0, 0); } }
        const int chn = 64 * n + 16 * nb + fr;
        const float brv = br[chn], biv = bi[chn];
        const float sp = 8.0f * log1pf(__expf(-lam[chn]));
        float Hrun = 0.f, Prun = 1.f;
        if (FINAL) Hrun = Hin[((size_t)b * NCHUNK + c) * LRUW + chn];
#pragma unroll
        for (int m = 0; m < 4; ++m) {
            float pa[4], hl[4];
#pragma unroll
            for (int r = 0; r < 4; ++r) {
                const float rg = fast_sigmoid(dr[m][r] + brv), ig = fast_sigmoid(di[m][r] + biv);
                const float la = -rg * sp;
                const float a = __expf(la);
                const float x2 = 2.0f * la;
                const float om = (x2 > -0.02f) ? -x2 * (1.0f + x2 * (0.5f + x2 * (1.0f / 6.0f))) : (1.0f - a * a);
                const float u = sqrtf(fmaxf(om, 0.f)) * (ig * dx[m][r]);
                if (r == 0) { pa[0] = a; hl[0] = u; } else { hl[r] = a * hl[r - 1] + u; pa[r] = a * pa[r - 1]; }
            }
            float P = pa[3], H = hl[3];
            { const float P1 = __shfl_up(P, 16), H1 = __shfl_up(H, 16); if (fq >= 1) { H = P * H1 + H; P = P * P1; } }
            { const float P2 = __shfl_up(P, 32), H2 = __shfl_up(H, 32); if (fq >= 2) { H = P * H2 + H; P = P * P2; } }
            float Pex = __shfl_up(P, 16), Hex = __shfl_up(H, 16); if (fq == 0) { Pex = 1.f; Hex = 0.f; }
            const float Pblk = __shfl(P, 48 + fr), Hblk = __shfl(H, 48 + fr);
            if (FINAL) {
                const float hin = Hex + Pex * Hrun;
#pragma unroll
                for (int r = 0; r < 4; ++r) {
                    const float h = hl[r] + pa[r] * hin;
                    const float g = bf2f(Z[(seq0 + CHK * c + 16 * m + 4 * fq + r) * INC + GBOFF + chn]);
                    yl[(16 * m + 4 * fq + r) * LRUW + chn] = gelu_tanh(g) * h;
                }
            }
            Hrun = Hblk + Pblk * Hrun; Prun = Pblk * Prun;
        }
        if (!FINAL) { if (fq == 0) { const size_t o = ((size_t)b * NCHUNK + c) * LRUW + chn; outP[o] = Prun; outE[o] = Hrun; } }
    }
}

__device__ __forceinline__ void p_lru_summary(const Frame& F, const Args& A, int l) {
    unsigned char* ws = A.ws;
    const bf16* Z = (const bf16*)(ws + WS_ZH);
    const bf16* GW = (const bf16*)(ws + WS_GATEW) + (size_t)l * 2 * 8 * 4096;
    for (int it = F.blk; it < BATCH * NCHUNK; it += F.G) {
        const int b = it >> 8, c = it & 255, n = F.wave;
        lru_tile<false>(Z, b, c, n, F.lane, GW + n * 4096, GW + 8 * 4096 + n * 4096, A.in[4] + l * 4 * LRUW, A.in[5] + l * LRUW, A.in[7] + l * LRUW, A.in[9] + l * LRUW, A.in[10] + l * LRUW,
                        (float*)(ws + WS_LRUP), (float*)(ws + WS_LRUE), nullptr, nullptr);
    }
}
__device__ __forceinline__ void p_lru_carry(const Frame& F, const Args& A) {
    unsigned char* ws = A.ws;
    const float* Pg = (const float*)(ws + WS_LRUP); const float* Eg = (const float*)(ws + WS_LRUE); float* Hg = (float*)(ws + WS_HIN);
    const int gw = F.blk * NWAVES + F.wave, NGW = F.G * NWAVES;
    for (int p = gw; p < BATCH * LRUW; p += NGW) {
        const int b = p >> 9, ch = p & 511;
        float pk[4], ek[4];
#pragma unroll
        for (int k = 0; k < 4; ++k) { const size_t o = ((size_t)b * NCHUNK + 4 * F.lane + k) * LRUW + ch; pk[k] = Pg[o]; ek[k] = Eg[o]; }
        float P = pk[0], H = ek[0];
#pragma unroll
        for (int k = 1; k < 4; ++k) { H = pk[k] * H + ek[k]; P = pk[k] * P; }
#pragma unroll
        for (int d = 1; d < 64; d <<= 1) { const float P1 = __shfl_up(P, d), H1 = __shfl_up(H, d); if (F.lane >= d) { H = P * H1 + H; P = P * P1; } }
        float h = __shfl_up(H, 1); if (F.lane == 0) h = 0.f;
#pragma unroll
        for (int k = 0; k < 4; ++k) { Hg[((size_t)b * NCHUNK + 4 * F.lane + k) * LRUW + ch] = h; h = pk[k] * h + ek[k]; }
    }
}

__device__ __forceinline__ int crow(int r, int hi) { return (r & 3) + 8 * (r >> 2) + 4 * hi; }
__device__ __forceinline__ s16x4 vtr(const LAS unsigned char* p) { return __builtin_bit_cast(s16x4, __builtin_amdgcn_ds_read_tr16_b64_v4i16((LAS s16x4*)p)); }
__device__ __forceinline__ void p_mixer(const Frame& F, const Args& A, int l) {
    unsigned char* ws = A.ws;
    const bf16* Z = (const bf16*)(ws + WS_ZH);
    bf16* Y = (bf16*)(ws + WS_A);
    const bf16* GW = (const bf16*)(ws + WS_GATEW) + (size_t)l * 2 * 8 * 4096;
    LAS unsigned char* Kl = F.lds;
    LAS unsigned char* Vl = F.lds + 49152;
    LAS float* yl = (LAS float*)F.lds;
    LAS bf16* ya = (LAS bf16*)F.lds;
    LAS float* lut = (LAS float*)(F.lds + LDS_LUT);
    const int lane = F.lane, wave = F.wave, r32 = lane & 31, hi = lane >> 5;
    { const float* LUTg = (const float*)(ws + WS_LUT); for (int i = F.tid; i < 2048; i += NTHREADS) lut[i] = LUTg[i]; }
    const float sinkv = A.in[3][l * 8 + wave] * LOG2E;
    const int kvh = wave >> 2;
    for (int it = F.blk; it < BATCH * NCHUNK; it += F.G) {
        const int b = it >> 8, c = it & 255;
        const size_t row0 = (size_t)b * SEQ + (size_t)CHK * c;
        const int T0 = (c >= 2) ? 0 : 2 - c;
        __syncthreads();
        lru_tile<true>(Z, b, c, wave, lane, GW + wave * 4096, GW + 8 * 4096 + wave * 4096, A.in[4] + l * 4 * LRUW, A.in[5] + l * LRUW, A.in[7] + l * LRUW, A.in[9] + l * LRUW, A.in[10] + l * LRUW,
                       nullptr, nullptr, (const float*)(ws + WS_HIN), yl);
        __syncthreads();
#pragma unroll
        for (int i = 0; i < 8; ++i) { const int tok = 8 * wave + i;
            const f32x4 a = *(const LAS f32x4*)(yl + tok * LRUW + 8 * lane), q = *(const LAS f32x4*)(yl + tok * LRUW + 8 * lane + 4);
            const float ss = wave_sum((a.x * a.x + a.y * a.y) + (a.z * a.z + a.w * a.w) + (q.x * q.x + q.y * q.y) + (q.z * q.z + q.w * q.w));
            const float rstd = 1.0f / sqrtf(ss * (1.0f / 512.0f) + RMS_EPS);
            v4u w; w.x = pk2(a.x * rstd, a.y * rstd); w.y = pk2(a.z * rstd, a.w * rstd); w.z = pk2(q.x * rstd, q.y * rstd); w.w = pk2(q.z * rstd, q.w * rstd);
            *(v4u*)(Y + (row0 + tok) * DM + 512 + 8 * lane) = w; }
        __syncthreads();
#pragma unroll
        for (int h2 = 0; h2 < 2; ++h2)
#pragma unroll
            for (int T = 0; T < 3; ++T) {
                v4u kq = (v4u){0u, 0u, 0u, 0u}, vq = kq;
                if (T >= T0) { const size_t cr = row0 + (size_t)CHK * T - 2 * CHK;
                    kq = *(const v4u*)(Z + (cr + lane) * INC + KOFF + 64 * h2 + 8 * wave);
                    vq = *(const v4u*)(Z + (cr + 16 * (wave & 3) + (lane >> 2)) * INC + VOFF + 64 * h2 + 32 * (wave >> 2) + 8 * (lane & 3)); }
                *(LAS v4u*)(Kl + (h2 * 3 + T) * 8192 + wave * 1024 + lane * 16) = kq;
                *(LAS v4u*)(Vl + (h2 * 3 + T) * 8192 + wave * 1024 + lane * 16) = vq;
            }
        __syncthreads();
        unsigned opk[2][2][8];
#pragma unroll
        for (int qb = 0; qb < 2; ++qb) {
            const int qi = 32 * qb + r32;
            bf16x8 qr[4];
#pragma unroll
            for (int d0 = 0; d0 < 4; ++d0) qr[d0] = *(const bf16x8*)(Z + (row0 + qi) * INC + 64 * wave + 16 * d0 + 8 * hi);
            f32x16 s[3][2];
            const LAS float* lutq = lut + wave * 256 + 63 - qi;
#pragma unroll
            for (int T = 0; T < 3; ++T) {
#pragma unroll
                for (int hf = 0; hf < 2; ++hf)
#pragma unroll
                    for (int r = 0; r < 16; ++r) s[T][hf][r] = lutq[64 * T + 32 * hf + crow(r, hi)];
                const LAS unsigned char* kb = Kl + (kvh * 3 + T) * 8192 + hi * 1024 + r32 * 16;
#pragma unroll
                for (int d0 = 0; d0 < 4; ++d0) {
                    const bf16x8 b0 = *(const LAS bf16x8*)(kb + d0 * 2048), b1 = *(const LAS bf16x8*)(kb + d0 * 2048 + 512);
                    s[T][0] = __builtin_amdgcn_mfma_f32_32x32x16_bf16(b0, qr[d0], s[T][0], 0, 0, 0);
                    s[T][1] = __builtin_amdgcn_mfma_f32_32x32x16_bf16(b1, qr[d0], s[T][1], 0, 0, 0);
                }
                if (T < T0) {
#pragma unroll
                    for (int hf = 0; hf < 2; ++hf)
#pragma unroll
                        for (int r = 0; r < 16; ++r) s[T][hf][r] = -1e30f;
                }
            }
            float mx = sinkv;
#pragma unroll
            for (int T = 0; T < 3; ++T)
#pragma unroll
                for (int hf = 0; hf < 2; ++hf)
#pragma unroll
                    for (int r = 0; r < 16; ++r) mx = fmaxf(mx, s[T][hf][r]);
            mx = fmaxf(mx, __shfl_xor(mx, 32));
            float lsum = 0.f;
#pragma unroll
            for (int T = 0; T < 3; ++T)
#pragma unroll
                for (int hf = 0; hf < 2; ++hf)
#pragma unroll
                    for (int r = 0; r < 16; ++r) { const float p = __builtin_amdgcn_exp2f(s[T][hf][r] - mx); s[T][hf][r] = p; lsum += p; }
            lsum += __shfl_xor(lsum, 32);
            lsum += __builtin_amdgcn_exp2f(sinkv - mx);
            const float inv = 1.0f / lsum;
            f32x16 o[2]; o[0] = (f32x16){0.f, 0.f, 0.f, 0.f, 0.f, 0.f, 0.f, 0.f, 0.f, 0.f, 0.f, 0.f, 0.f, 0.f, 0.f, 0.f}; o[1] = o[0];
#pragma unroll
            for (int T = 0; T < 3; ++T) {
                v4u pw[4];
#pragma unroll
                for (int k = 0; k < 4; ++k) { const int hf = k >> 1, r0 = (k & 1) * 8;
                    pw[k].x = pk2(s[T][hf][r0 + 0], s[T][hf][r0 + 1]); pw[k].y = pk2(s[T][hf][r0 + 2], s[T][hf][r0 + 3]);
                    pw[k].z = pk2(s[T][hf][r0 + 4], s[T][hf][r0 + 5]); pw[k].w = pk2(s[T][hf][r0 + 6], s[T][hf][r0 + 7]); }
                const LAS unsigned char* vb = Vl + (kvh * 3 + T) * 8192 + ((lane >> 4) & 1) * 32 + (lane & 3) * 8 + (4 * hi + ((lane & 15) >> 2)) * 64;
#pragma unroll
                for (int d0 = 0; d0 < 2; ++d0)
#pragma unroll
                    for (int ks = 0; ks < 4; ++ks) {
                        const s16x4 lo = vtr(vb + d0 * 4096 + ks * 1024), hv = vtr(vb + d0 * 4096 + ks * 1024 + 512);
                        const bf16x8 vf = (bf16x8){lo[0], lo[1], lo[2], lo[3], hv[0], hv[1], hv[2], hv[3]};
                        o[d0] = __builtin_amdgcn_mfma_f32_32x32x16_bf16(vf, __builtin_bit_cast(bf16x8, pw[ks]), o[d0], 0, 0, 0);
                    }
            }
#pragma unroll
            for (int d0 = 0; d0 < 2; ++d0)
#pragma unroll
                for (int r = 0; r < 16; r += 2) opk[qb][d0][r >> 1] = pk2(o[d0][r] * inv, o[d0][r + 1] * inv);
        }
        __syncthreads();
#pragma unroll
        for (int qb = 0; qb < 2; ++qb)
#pragma unroll
            for (int d0 = 0; d0 < 2; ++d0)
#pragma unroll
                for (int g = 0; g < 4; ++g) { v2u w; w.x = opk[qb][d0][2 * g]; w.y = opk[qb][d0][2 * g + 1];
                    *(LAS v2u*)(ya + (32 * qb + r32) * 512 + 64 * wave + 32 * d0 + 8 * g + 4 * hi) = w; }
        __syncthreads();
#pragma unroll
        for (int i = 0; i < 8; ++i) { const int tok = 8 * wave + i;
            const v4u w0 = *(const LAS v4u*)(ya + tok * 512 + 8 * lane);
            const float x0 = bflo(w0.x), x1 = bfhi(w0.x), x2 = bflo(w0.y), x3 = bfhi(w0.y), x4 = bflo(w0.z), x5 = bfhi(w0.z), x6 = bflo(w0.w), x7 = bfhi(w0.w);
            const float ss = wave_sum((x0 * x0 + x1 * x1) + (x2 * x2 + x3 * x3) + (x4 * x4 + x5 * x5) + (x6 * x6 + x7 * x7));
            const float rstd = 1.0f / sqrtf(ss * (1.0f / 512.0f) + RMS_EPS);
            v4u w; w.x = pk2(x0 * rstd, x1 * rstd); w.y = pk2(x2 * rstd, x3 * rstd); w.z = pk2(x4 * rstd, x5 * rstd); w.w = pk2(x6 * rstd, x7 * rstd);
            *(v4u*)(Y + (row0 + tok) * DM + 8 * lane) = w; }
    }
}

template <int MODE>
__device__ __forceinline__ void p_layernorm(const Frame& F, const Args& A, const float* gam, const float* bet) {
    unsigned char* ws = A.ws;
    float* X = A.out;
    bf16* XB = (bf16*)(ws + WS_A);
    LAS unsigned* misc = (LAS unsigned*)(F.lds + LDS_MISC);
    const int lane = F.lane;
    if (MODE == 1) { if (F.tid < 8) misc[F.tid] = 0u; __syncthreads(); }
    f32x4 gv[4], bv[4];
#pragma unroll
    for (int j = 0; j < 4; ++j) { gv[j] = *(const f32x4*)(gam + 4 * lane + 256 * j); bv[j] = *(const f32x4*)(bet + 4 * lane + 256 * j); }
    const int rpw = NTOK / F.G;
    for (int i = F.wave; i < rpw; i += NWAVES) {
        const int m = F.blk * rpw + i;
        f32x4* xr = (f32x4*)(X + (size_t)m * DM) + lane;
        f32x4 v[4];
#pragma unroll
        for (int j = 0; j < 4; ++j) v[j] = xr[64 * j];
        if (MODE == 2) {
            const int* tp = (const int*)(ws + WS_TOKPOS) + 2 * m; const float* tw = (const float*)(ws + WS_TOKW) + 2 * m;
            const int p0 = tp[0], p1 = tp[1]; const float w0 = tw[0], w1 = tw[1];
            const v2u* y0 = (const v2u*)((const bf16*)(ws + WS_Y2) + (size_t)p0 * DM) + lane; const v2u* y1 = (const v2u*)((const bf16*)(ws + WS_Y2) + (size_t)p1 * DM) + lane;
#pragma unroll
            for (int j = 0; j < 4; ++j) { const v2u a = y0[64 * j], c = y1[64 * j];
                v[j].x = ALPHA * v[j].x + w0 * bflo(a.x) + w1 * bflo(c.x); v[j].y = ALPHA * v[j].y + w0 * bfhi(a.x) + w1 * bfhi(c.x);
                v[j].z = ALPHA * v[j].z + w0 * bflo(a.y) + w1 * bflo(c.y); v[j].w = ALPHA * v[j].w + w0 * bfhi(a.y) + w1 * bfhi(c.y); }
        }
        float s = 0.f;
#pragma unroll
        for (int j = 0; j < 4; ++j) s += (v[j].x + v[j].y) + (v[j].z + v[j].w);
        const float mean = wave_sum(s) * (1.f / DM); float s2 = 0.f;
#pragma unroll
        for (int j = 0; j < 4; ++j) { v[j] = v[j] - mean; s2 += (v[j].x * v[j].x + v[j].y * v[j].y) + (v[j].z * v[j].z + v[j].w * v[j].w); }
        const float rstd = 1.f / sqrtf(wave_sum(s2) * (1.f / DM) + LN_EPS);
#pragma unroll
        for (int j = 0; j < 4; ++j) { v[j] = v[j] * rstd * gv[j] + bv[j]; xr[64 * j] = v[j]; }
        if (MODE == 3) {
            unsigned* o4 = (unsigned*)((unsigned char*)XB + (size_t)m * DM) + lane;
#pragma unroll
            for (int j = 0; j < 4; ++j) o4[64 * j] = pg8::pk4_fp8(v[j].x, v[j].y, v[j].z, v[j].w);
        }
        if (MODE == 0) {
            v2u* o8 = (v2u*)(XB + (size_t)m * DM) + lane;
#pragma unroll
            for (int j = 0; j < 4; ++j) { v2u w; w.x = pk2(v[j].x, v[j].y); w.y = pk2(v[j].z, v[j].w); o8[64 * j] = w; }
        }
        if (MODE == 1) {
            const float* RW = A.in[19];
            float lg[8];
#pragma unroll
            for (int e = 0; e < 8; ++e) lg[e] = 0.f;
#pragma unroll
            for (int j = 0; j < 4; ++j)
#pragma unroll
                for (int q = 0; q < 4; ++q) { const int k = 4 * lane + 256 * j + q; const f32x4 a = *(const f32x4*)(RW + k * 8), c = *(const f32x4*)(RW + k * 8 + 4); const float xv = v[j][q];
                    lg[0] += xv * a.x; lg[1] += xv * a.y; lg[2] += xv * a.z; lg[3] += xv * a.w; lg[4] += xv * c.x; lg[5] += xv * c.y; lg[6] += xv * c.z; lg[7] += xv * c.w; }
#pragma unroll
            for (int e = 0; e < 8; ++e) lg[e] = wave_sum(lg[e]);
            int e0 = 0; float v0 = lg[0];
#pragma unroll
            for (int e = 1; e < 8; ++e) if (lg[e] > v0) { v0 = lg[e]; e0 = e; }
            int e1 = -1; float v1 = -3.0e38f;
#pragma unroll
            for (int e = 0; e < 8; ++e) if (e != e0 && lg[e] > v1) { v1 = lg[e]; e1 = e; }
            const float w0 = 1.0f / (1.0f + __expf(v1 - v0)), w1 = 1.0f - w0;
            if (lane == 0) { int* te = (int*)(ws + WS_TOKE) + 2 * m; float* tw = (float*)(ws + WS_TOKW) + 2 * m; te[0] = e0; te[1] = e1; tw[0] = w0; tw[1] = w1;
                atomicAdd((unsigned*)(misc + e0), 1u); atomicAdd((unsigned*)(misc + e1), 1u); }
        }
    }
    if (MODE == 1) { __syncthreads(); if (F.tid < 8) ((unsigned*)(ws + WS_HIST))[F.blk * 8 + F.tid] = misc[F.tid]; }
}

__device__ __forceinline__ void p_route(const Frame& F, const Args& A) {
    unsigned char* ws = A.ws;
    LAS unsigned* misc = (LAS unsigned*)(F.lds + LDS_MISC);
    LAS int* posl = (LAS int*)(F.lds + LDS_POS);
    const unsigned* hist = (const unsigned*)(ws + WS_HIST);
    const int lane = F.lane, rpw = NTOK / F.G;
    {
        const int e = F.wave; unsigned tot = 0u, bef = 0u;
        for (int v = lane; v < F.G; v += 64) { const unsigned h = hist[v * 8 + e]; tot += h; if (v < F.blk) bef += h; }
#pragma unroll
        for (int o = 1; o < 64; o <<= 1) { tot += __shfl_xor(tot, o); bef += __shfl_xor(bef, o); }
        if (lane == 0) { misc[16 + e] = tot; misc[24 + e] = bef; }
    }
    __syncthreads();
    int seg[9]; seg[0] = 0;
#pragma unroll
    for (int e = 0; e < 8; ++e) seg[e + 1] = seg[e] + (int)((misc[16 + e] + 255u) >> 8);
    if (F.blk == 0 && F.tid == 0) { int* meta = (int*)(ws + WS_META);
#pragma unroll
        for (int e = 0; e < 9; ++e) meta[e] = seg[e];
        meta[9] = seg[8]; }
    if (F.wave == 0) {
        const int* te = (const int*)(ws + WS_TOKE); int* tp = (int*)(ws + WS_TOKPOS); int* rt = nullptr; (void)rt;
        unsigned run[8];
#pragma unroll
        for (int e = 0; e < 8; ++e) run[e] = (unsigned)seg[e] * 256u + misc[24 + e];
        for (int h = 0; h < rpw; h += 64) {
            const int m = F.blk * rpw + h + lane;
#pragma unroll
            for (int k = 0; k < 2; ++k) {
                const int ek = te[2 * m + k]; int pos = 0;
#pragma unroll
                for (int e = 0; e < 8; ++e) { const unsigned long long mask = __ballot(ek == e);
                    if (ek == e) pos = (int)(run[e] + (unsigned)__popcll(mask & ((1ull << lane) - 1ull)));
                    run[e] += (unsigned)__popcll(mask); }
                tp[2 * m + k] = pos; posl[2 * (h + lane) + k] = pos;
            }
        }
    }
    __syncthreads();
    {
        const float* X = A.out; unsigned char* XS = ws + WS_XS;
        for (int i = F.wave; i < rpw; i += NWAVES) {
            const int m = F.blk * rpw + i; const int p0 = posl[2 * i], p1 = posl[2 * i + 1];
            const f32x4* xr = (const f32x4*)(X + (size_t)m * DM) + 4 * lane;
            const f32x4 a = xr[0], b = xr[1], c = xr[2], d = xr[3];
            v4u w; w.x = pg8::pk4_fp8(a.x, a.y, a.z, a.w); w.y = pg8::pk4_fp8(b.x, b.y, b.z, b.w); w.z = pg8::pk4_fp8(c.x, c.y, c.z, c.w); w.w = pg8::pk4_fp8(d.x, d.y, d.z, d.w);
            *((v4u*)(XS + (size_t)p0 * DM) + lane) = w; *((v4u*)(XS + (size_t)p1 * DM) + lane) = w;
        }
    }
    if (F.blk < 8) {
        int r0 = 0, r1 = 0;
#pragma unroll
        for (int e = 0; e < 8; ++e) if (e == F.blk) { r0 = seg[e] * 256 + (int)misc[16 + e]; r1 = seg[e + 1] * 256; }
        v4u* XS4 = (v4u*)(ws + WS_XS);
        for (size_t i = (size_t)r0 * 64 + F.tid; i < (size_t)r1 * 64; i += NTHREADS) XS4[i] = (v4u){0u, 0u, 0u, 0u};
    }
}

#ifndef MK_ONE_LAUNCH
#define MK_ONE_LAUNCH 1
#endif
constexpr int PH_MOE = 17, PH_FINAL = PH_MOE + 2 * NPASS, NPHASES = PH_FINAL + 1;

#ifndef PH_MASK
#define PH_MASK 0xFFFFFFFFu
#endif
#ifndef DUP_MASK
#define DUP_MASK 0u
#endif
#define NREP(k) ((((unsigned)DUP_MASK >> (k)) & 1u) ? 2 : 1)
#define IN(k) (((PH_MASK >> (k)) & 1u) && lo <= (k) && (k) < hi)
#define SEAM(k) do { if (MK_ONE_LAUNCH && lo <= (k) && (k) + 1 < hi) xcd_barrier(bar); } while (0)
template <int l>
__device__ __forceinline__ void layer_phases(const Frame& F, const Args& args, const XcdBarrier& bar, const int lo, const int hi) {
    unsigned char* ws = args.ws;
        const int pb = 1 + 9 * l;
        const float* xres = (l == 0) ? args.in[0] : args.out;
        if (IN(pb + 0)) {
            pg8::Gemm g{(const bf16*)(ws + WS_A), (const bf16*)(ws + WS_WIN) + (size_t)l * INC * DM, NTOK, INC, DM, 0};
            pg8::StaticOrder S; S.init(NTOK, INC, F.G, F.blk, NREP(pb + 0));
            pg8::EpiBf16 E{(bf16*)(ws + WS_ZH), INC, 1.0f};
            pg8::gemm_phase<pg8::EpiBf16, pg8::StaticOrder, true, true>(F.lds, g, S, E);
            SEAM(pb + 0);
        }
        if (IN(pb + 1)) for (int rep_ = 0; rep_ < NREP(pb + 1); ++rep_) { p_lru_summary(F, args, l); SEAM(pb + 1); }
        if (IN(pb + 2)) for (int rep_ = 0; rep_ < NREP(pb + 2); ++rep_) { p_lru_carry(F, args); SEAM(pb + 2); }
        if (IN(pb + 3)) for (int rep_ = 0; rep_ < NREP(pb + 3); ++rep_) { p_mixer(F, args, l); SEAM(pb + 3); }
        if (IN(pb + 4)) {
            pg8::Gemm g{(const bf16*)(ws + WS_A), (const bf16*)(ws + WS_WOUT) + (size_t)l * DM * DM, NTOK, DM, DM, 0};
            pg8::StaticOrder S; S.init(NTOK, DM, F.G, F.blk, NREP(pb + 4));
            pg8::EpiResF32 E{xres, args.out, DM, ALPHA, 1.0f};
            pg8::gemm_phase<pg8::EpiResF32, pg8::StaticOrder, true, true>(F.lds, g, S, E);
            SEAM(pb + 4);
        }
        if (l == 0) {
            if (IN(6)) for (int rep_ = 0; rep_ < NREP(6); ++rep_) { p_layernorm<3>(F, args, args.in[14], args.in[15]); SEAM(6); }
            if (IN(7)) {
                pg8::Gemm g{(const bf16*)(ws + WS_A), (const bf16*)(ws + WS_WGU), NTOK, 2 * DFF, DM / 2, 0};
                pg8::StaticOrder S; S.init(NTOK, 2 * DFF, F.G, F.blk, NREP(7));
                pg8::EpiSwiGLU8 E{ws + WS_ZH, DFF, 1.0f / WSC_GU};
                pg8::gemm_phase<pg8::EpiSwiGLU8, pg8::StaticOrder, true, true, true>(F.lds, g, S, E);
                SEAM(7);
            }
            if (IN(8)) {
                pg8::Gemm g{(const bf16*)(ws + WS_ZH), (const bf16*)(ws + WS_WD), NTOK, DM, DFF / 2, 0};
                pg8::StaticOrder S; S.init(NTOK, DM, F.G, F.blk, NREP(8));
                pg8::EpiResF32 E{args.out, args.out, DM, ALPHA, 1.0f / WSC_D};
                pg8::gemm_phase<pg8::EpiResF32, pg8::StaticOrder, true, true, true>(F.lds, g, S, E);
                SEAM(8);
            }
            if (IN(9)) for (int rep_ = 0; rep_ < NREP(9); ++rep_) { p_layernorm<0>(F, args, args.in[23], args.in[24]); SEAM(9); }
        } else {
            if (IN(15)) for (int rep_ = 0; rep_ < NREP(15); ++rep_) { p_layernorm<1>(F, args, args.in[14] + DM, args.in[15] + DM); SEAM(15); }
            if (IN(16)) for (int rep_ = 0; rep_ < NREP(16); ++rep_) { p_route(F, args); SEAM(16); }
            for (int p = 0; p < NPASS; ++p) {
                int s1 = 0, s2 = 0, s3 = 0, s4 = 0, s5 = 0, s6 = 0, s7 = 0, nt = 0;
                if (IN(PH_MOE + 2 * p) || IN(PH_MOE + 1 + 2 * p)) { const int* meta = (const int*)(ws + WS_META);
                    s1 = __builtin_amdgcn_readfirstlane(meta[1]); s2 = __builtin_amdgcn_readfirstlane(meta[2]); s3 = __builtin_amdgcn_readfirstlane(meta[3]); s4 = __builtin_amdgcn_readfirstlane(meta[4]);
                    s5 = __builtin_amdgcn_readfirstlane(meta[5]); s6 = __builtin_amdgcn_readfirstlane(meta[6]); s7 = __builtin_amdgcn_readfirstlane(meta[7]); nt = __builtin_amdgcn_readfirstlane(meta[9]); }
                int nm = nt - PASS_TILES * p; nm = nm > PASS_TILES ? PASS_TILES : nm;
                if (IN(PH_MOE + 2 * p)) {
                    if (nm > 0) {
                        pg8::Gemm g{(const bf16*)(ws + WS_XS + (size_t)p * PASS_TILES * 256 * DM), (const bf16*)(ws + WS_WEGU), nm * 256, 2 * DFE, DM / 2, (size_t)2 * DFE * DM};
                        pg8::MoeOrder S; S.so.init(nm * 256, 2 * DFE, F.G, F.blk, NREP(PH_MOE + 2 * p)); S.tile0 = p * PASS_TILES; S.s1 = s1; S.s2 = s2; S.s3 = s3; S.s4 = s4; S.s5 = s5; S.s6 = s6; S.s7 = s7;
                        pg8::EpiSwiGLU8 E{ws + WS_HM, DFE, 1.0f / WSC_GU};
                        pg8::gemm_phase<pg8::EpiSwiGLU8, pg8::MoeOrder, true, true, true>(F.lds, g, S, E);
                    }
                    SEAM(PH_MOE + 2 * p);
                }
                if (IN(PH_MOE + 1 + 2 * p)) {
                    if (nm > 0) {
                        pg8::Gemm g{(const bf16*)(ws + WS_HM), (const bf16*)(ws + WS_WED), nm * 256, DM, DFE / 2, (size_t)DM * DFE};
                        pg8::MoeOrder S; S.so.init(nm * 256, DM, F.G, F.blk, NREP(PH_MOE + 1 + 2 * p)); S.tile0 = p * PASS_TILES; S.s1 = s1; S.s2 = s2; S.s3 = s3; S.s4 = s4; S.s5 = s5; S.s6 = s6; S.s7 = s7;
                        pg8::EpiBf16 E{(bf16*)(ws + WS_Y2) + (size_t)p * PASS_TILES * 256 * DM, DM, 1.0f / WSC_D};
                        pg8::gemm_phase<pg8::EpiBf16, pg8::MoeOrder, true, true, true>(F.lds, g, S, E);
                    }
                    SEAM(PH_MOE + 1 + 2 * p);
                }
            }
            if (IN(PH_FINAL)) for (int rep_ = 0; rep_ < NREP(PH_FINAL); ++rep_) { p_layernorm<2>(F, args, args.in[23] + DM, args.in[24] + DM); }
        }
}
__global__ void __launch_bounds__(NTHREADS, 2) fwd_kernel(Args args) {
    extern __shared__ __attribute__((aligned(16))) unsigned char lds_raw[];
    Frame F;
    F.lds = (LAS unsigned char*)lds_raw;
    F.tid = threadIdx.x; F.lane = F.tid & 63; F.wave = __builtin_amdgcn_readfirstlane(F.tid >> 6);
    F.G = gridDim.x; F.blk = blockIdx.x;
    unsigned char* ws = args.ws;
    volatile LAS unsigned* MISC = (volatile LAS unsigned*)(F.lds + LDS_MISC);
    if (F.tid < 64) MISC[F.tid] = 0u;
    __syncthreads();
    XcdBarrier bar; bar.bar = (unsigned*)(ws + WS_CTL) + CW_BAR; bar.x = 0; bar.st = nullptr;
    if (MK_ONE_LAUNCH) bar = xcd_barrier_post((unsigned*)(ws + WS_CTL) + CW_BAR, MISC + 8);
    const int lo = args.ph_lo, hi = args.ph_hi;

    if (IN(0)) for (int rep_ = 0; rep_ < NREP(0); ++rep_) { p0_prologue(F, args); SEAM(0); }

    layer_phases<0>(F, args, bar, lo, hi);
    layer_phases<1>(F, args, bar, lo, hi);
}

extern "C" void kernel_launch(void* const* d_in, const int* in_sizes, int n_in, void* d_out, int out_size, void* d_ws, size_t ws_size, hipStream_t stream) {
    static int grid = 0;
    if (grid == 0) {
        if (n_in != 25 || in_sizes[0] != NTOK * DM || out_size != NTOK * DM || ws_size < WS_END) {
            fprintf(stderr, "kernel_launch: unexpected problem: n_in %d in0 %d out %d ws %zu (need %zu)\n", n_in, n_in > 0 ? in_sizes[0] : -1, out_size, ws_size, (size_t)WS_END); grid = -1; return; }
        int dev = 0, cus = 0, per_cu = 0;
        if (hipGetDevice(&dev) != hipSuccess || hipDeviceGetAttribute(&cus, hipDeviceAttributeMultiprocessorCount, dev) != hipSuccess) { fprintf(stderr, "kernel_launch: device query failed\n"); grid = -1; return; }
        if (hipFuncSetAttribute((const void*)fwd_kernel, hipFuncAttributeMaxDynamicSharedMemorySize, LDS_BYTES) != hipSuccess) { fprintf(stderr, "kernel_launch: hipFuncSetAttribute failed\n"); grid = -1; return; }
        if (hipOccupancyMaxActiveBlocksPerMultiprocessor(&per_cu, (const void*)fwd_kernel, NTHREADS, LDS_BYTES) != hipSuccess || per_cu < 1)
            fprintf(stderr, "kernel_launch: note: occupancy query reports %d workgroups per CU\n", per_cu);
        (void)hipGetLastError();
        grid = cus;
        if (grid != 256) fprintf(stderr, "kernel_launch: note: %d CUs (built for 256)\n", grid);
        if (NTOK % grid != 0 || grid > 256) grid = 256;
    }
    if (grid < 0) return;
    (void)hipMemsetAsync((char*)d_ws + WS_CTL, 0, CTL_ZERO_BYTES, stream);
    Args a{};
    for (int i = 0; i < 25; ++i) a.in[i] = (const float*)d_in[i];
    a.out = (float*)d_out; a.ws = (unsigned char*)d_ws;
#if MK_ONE_LAUNCH
    a.ph_lo = 0; a.ph_hi = NPHASES;
    hipLaunchKernelGGL(fwd_kernel, dim3(grid), dim3(NTHREADS), LDS_BYTES, stream, a);
#else
    for (int k = 0; k < NPHASES; ++k) { a.ph_lo = k; a.ph_hi = k + 1; hipLaunchKernelGGL(fwd_kernel, dim3(grid), dim3(NTHREADS), LDS_BYTES, stream, a); }
#endif
    const hipError_t le = hipPeekAtLastError();
    if (le != hipSuccess) fprintf(stderr, "kernel_launch: launch failed: %s\n", hipGetErrorName(le));
}
```

```cpp
#include <hip/hip_runtime.h>
#include <cstdio>
#include <cstdint>
namespace pg8 {
#define PG8_LAS __attribute__((address_space(3)))
typedef unsigned short bf16_t;
typedef short bf16x8 __attribute__((ext_vector_type(8)));
typedef float f32x4 __attribute__((ext_vector_type(4)));
typedef unsigned u32x4 __attribute__((ext_vector_type(4)));
typedef int v4i __attribute__((ext_vector_type(4)));
typedef int v8i __attribute__((ext_vector_type(8)));
constexpr int BM = 256, BK = 64, HALF = 128, HTB = HALF * BK * 2  , STAGE_BYTES = 8 * HTB, NXCD = 8, WGM = 8;

__host__ __device__ __forceinline__ int lds_byte(int r, int c) { const int st = (r >> 4) * 2 + (c >> 5), rr = r & 15, cc = c & 31, ob = rr * 64 + cc * 2; return st * 1024 + (ob ^ (((ob >> 9) & 1) << 5)); }
__host__ __device__ __forceinline__ void stage_rc(int b, int& R, int& C) { const int st = b / 1024, sb = b % 1024, swz = sb ^ (((sb >> 9) & 1) << 5); R = (st >> 1) * 16 + swz / 64; C = (st & 1) * 32 + (swz % 64) / 2; }
__host__ __device__ __forceinline__ int perm32(int rho) { const int n = rho >> 4, i = rho & 15; return 8 * (i >> 2) + 4 * n + (i & 3); }

struct Unit { int pm, pn, be; };
struct Gemm { const bf16_t* A; const bf16_t* Bt; int M, N, K; size_t bstride; };

struct StaticOrder {
    int nM, nN, nwg, G, c, rep;
    __host__ __device__ void init(int M, int N, int G_, int c_, int rep_ = 1) { nM = M / BM; nN = N / BM; nwg = nM * nN; G = G_; c = c_; rep = rep_; }
    __host__ __device__ bool next(int i, Unit& u) const {
        const long L = (long)i * G + c; if (L >= (long)nwg * rep) return false;
        int wgid = (int)(L % nwg); { const int q = nwg / NXCD, r = nwg % NXCD, xcd = wgid % NXCD, off = wgid / NXCD; wgid = (xcd < r ? xcd * (q + 1) : r * (q + 1) + (xcd - r) * q) + off; }
        const int nig = WGM * nN, gid = wgid / nig, fm = gid * WGM, gsz = (nM - fm) < WGM ? (nM - fm) : WGM;
        u.pm = fm + ((wgid % nig) % gsz); u.pn = (wgid % nig) / gsz; u.be = 0; return true;
    }
    __device__ __forceinline__ void a_ready(const Unit&) const {}
    __device__ __forceinline__ void done(const Unit&) const {}
};
struct MoeOrder {
    StaticOrder so; int tile0, s1, s2, s3, s4, s5, s6, s7;
    __device__ __forceinline__ bool next(int i, Unit& u) const {
        if (!so.next(i, u)) return false;
        const int t = tile0 + u.pm;
        u.be = (t >= s1) + (t >= s2) + (t >= s3) + (t >= s4) + (t >= s5) + (t >= s6) + (t >= s7); return true;
    }
    __device__ __forceinline__ void a_ready(const Unit&) const {}
    __device__ __forceinline__ void done(const Unit&) const {}
};

__device__ __forceinline__ unsigned cvt_pk_bf16(float lo, float hi) { unsigned r; asm volatile("v_cvt_pk_bf16_f32 %0, %1, %2" : "=v"(r) : "v"(lo), "v"(hi)); return r; }

struct EpiBf16 {
    static constexpr bool PERM = true, AFTER_DRAIN = false;
    bf16_t* O; int ldc; float scale;
    __device__ __forceinline__ void operator()(const f32x4 (&acc)[2][2][4][2], const Unit& u, int wr, int wc, int fr, int fq) const {
        const int row0 = u.pm * BM + wr * 64 + fr, col0 = u.pn * BM + wc * 32 + 8 * fq;
#pragma unroll
        for (int ai = 0; ai < 2; ++ai)
#pragma unroll
            for (int m = 0; m < 4; ++m) { bf16_t* rowp = O + (size_t)(row0 + ai * HALF + m * 16) * ldc + col0;
#pragma unroll
                for (int bj = 0; bj < 2; ++bj) { const f32x4 v0 = acc[ai][bj][m][0] * scale, v1 = acc[ai][bj][m][1] * scale;
                    u32x4 w; w.x = cvt_pk_bf16(v0[0], v0[1]); w.y = cvt_pk_bf16(v0[2], v0[3]); w.z = cvt_pk_bf16(v1[0], v1[1]); w.w = cvt_pk_bf16(v1[2], v1[3]);
                    *(u32x4*)(rowp + bj * HALF) = w; } }
    }
};
__device__ __forceinline__ float silu_mul(float g, float u) { return g * u * __builtin_amdgcn_rcpf(1.0f + __builtin_amdgcn_exp2f(g * -1.4426950408889634f)); }
struct EpiSwiGLU {
    static constexpr bool PERM = true, AFTER_DRAIN = false;
    bf16_t* H; int ldh;
    __device__ __forceinline__ void operator()(const f32x4 (&acc)[2][2][4][2], const Unit& u, int wr, int wc, int fr, int fq) const {
        const int row0 = u.pm * BM + wr * 64 + fr, col0 = u.pn * HALF + wc * 32 + 8 * fq;
#pragma unroll
        for (int ai = 0; ai < 2; ++ai)
#pragma unroll
            for (int m = 0; m < 4; ++m) { bf16_t* rowp = H + (size_t)(row0 + ai * HALF + m * 16) * ldh + col0;
                const f32x4 g0 = acc[ai][0][m][0], g1 = acc[ai][0][m][1], u0 = acc[ai][1][m][0], u1 = acc[ai][1][m][1];
                u32x4 w; w.x = cvt_pk_bf16(silu_mul(g0[0], u0[0]), silu_mul(g0[1], u0[1])); w.y = cvt_pk_bf16(silu_mul(g0[2], u0[2]), silu_mul(g0[3], u0[3]));
                w.z = cvt_pk_bf16(silu_mul(g1[0], u1[0]), silu_mul(g1[1], u1[1])); w.w = cvt_pk_bf16(silu_mul(g1[2], u1[2]), silu_mul(g1[3], u1[3]));
                *(u32x4*)rowp = w; }
    }
};
__device__ __forceinline__ unsigned pk4_fp8(float a, float b, float c, float d) { int w = __builtin_amdgcn_cvt_pk_fp8_f32(a, b, 0, false); w = __builtin_amdgcn_cvt_pk_fp8_f32(c, d, w, true); return (unsigned)w; }
struct EpiSwiGLU8 {
    static constexpr bool PERM = true, AFTER_DRAIN = false;
    unsigned char* H; int ldh; float sc;
    __device__ __forceinline__ void operator()(const f32x4 (&acc)[2][2][4][2], const Unit& u, int wr, int wc, int fr, int fq) const {
        const int row0 = u.pm * BM + wr * 64 + fr, col0 = u.pn * HALF + wc * 32 + 8 * fq;
        typedef unsigned u32x2 __attribute__((ext_vector_type(2)));
#pragma unroll
        for (int ai = 0; ai < 2; ++ai)
#pragma unroll
            for (int m = 0; m < 4; ++m) { unsigned char* rowp = H + (size_t)(row0 + ai * HALF + m * 16) * ldh + col0;
                const f32x4 g0 = acc[ai][0][m][0] * sc, g1 = acc[ai][0][m][1] * sc, u0 = acc[ai][1][m][0] * sc, u1 = acc[ai][1][m][1] * sc;
                u32x2 w; w.x = pk4_fp8(silu_mul(g0[0], u0[0]), silu_mul(g0[1], u0[1]), silu_mul(g0[2], u0[2]), silu_mul(g0[3], u0[3]));
                w.y = pk4_fp8(silu_mul(g1[0], u1[0]), silu_mul(g1[1], u1[1]), silu_mul(g1[2], u1[2]), silu_mul(g1[3], u1[3]));
                *(u32x2*)rowp = w; }
    }
};
struct EpiResF32 {
    static constexpr bool PERM = false, AFTER_DRAIN = false;
    const float* res; float* out; int ldc; float alpha, scale;
    __device__ __forceinline__ void operator()(const f32x4 (&acc)[2][2][4][2], const Unit& u, int wr, int wc, int fr, int fq) const {
        const int row0 = u.pm * BM + wr * 64 + fr, col0 = u.pn * BM + wc * 32 + 4 * fq;
#pragma unroll
        for (int ai = 0; ai < 2; ++ai)
#pragma unroll
            for (int m = 0; m < 4; ++m) { const size_t off = (size_t)(row0 + ai * HALF + m * 16) * ldc + col0;
                f32x4 rv[2][2];
#pragma unroll
                for (int bj = 0; bj < 2; ++bj)
#pragma unroll
                    for (int n = 0; n < 2; ++n) rv[bj][n] = *(const f32x4*)(res + off + bj * HALF + n * 16);
#pragma unroll
                for (int bj = 0; bj < 2; ++bj)
#pragma unroll
                    for (int n = 0; n < 2; ++n) *(f32x4*)(out + off + bj * HALF + n * 16) = rv[bj][n] * alpha + acc[ai][bj][m][n] * scale;
                asm volatile("" ::: "memory"); }
    }
};

__device__ __forceinline__ void mfma8(f32x4& c, const v8i a, const v8i b, const int scl) { asm volatile("v_mfma_scale_f32_16x16x128_f8f6f4 %0, %1, %2, %0, %3, %3 op_sel_hi:[0,0,0]" : "+v"(c) : "v"(a), "v"(b), "v"(scl)); }
template <class Epi, class Sched, bool ALIGN_EPI = false, bool SP2 = false, bool FP8 = false>
__device__ __forceinline__ void gemm_phase(PG8_LAS unsigned char* lds, const Gemm g, const Sched& S, const Epi& E) {
    const int tid = threadIdx.x, wid = __builtin_amdgcn_readfirstlane(tid >> 6), lane = tid & 63, wr = wid >> 2, wc = wid & 3, fr = lane & 15, fq = lane >> 4;
    const int K = g.K, nt = K / BK;
    unsigned voffA[2], voffB[2];
#pragma unroll
    for (int i = 0; i < 2; ++i) { int R, C; stage_rc(tid * 16 + i * 8192, R, C); const int Rb = Epi::PERM ? ((R & ~31) + perm32(R & 31)) : R;
        voffA[i] = (unsigned)(R * K + C) * 2u; voffB[i] = (unsigned)(Rb * K + C) * 2u; }
    const size_t kstep = (size_t)(BK * 2);
    const size_t hstep = (size_t)HALF * K * 2;
    const size_t tstep = 2 * hstep;
    const unsigned ldsw = (unsigned)wid * 1024u;
    const int aoff = lds_byte(wr * 64 + fr, fq * 8), boff = lds_byte(wc * 32 + fr, fq * 8);
#define PG8_SA(b, h) (((b) * 2 + (h)) * HTB)
#define PG8_SB(b, h) ((4 + (b) * 2 + (h)) * HTB)
#define PG8_STAGE(bufoff, gbase, voff) do { _Pragma("unroll") for (int _i = 0; _i < 2; ++_i) \
        __builtin_amdgcn_global_load_lds((const unsigned*)((const char*)(gbase) + (voff)[_i]), (PG8_LAS unsigned*)(lds + (bufoff) + ldsw + _i * 8192), 16, 0, 0); } while (0)
#define PG8_LDA(dst, b, h) do { if constexpr (FP8) { _Pragma("unroll") for (int m = 0; m < 4; ++m) { dst##8[m][0] = *(const PG8_LAS v4i*)(lds + PG8_SA(b, h) + aoff + m * 2048); dst##8[m][1] = *(const PG8_LAS v4i*)(lds + PG8_SA(b, h) + aoff + m * 2048 + 1024); } } \
    else { _Pragma("unroll") for (int m = 0; m < 4; ++m) _Pragma("unroll") for (int k = 0; k < 2; ++k) dst[m][k] = *(const PG8_LAS bf16x8*)(lds + PG8_SA(b, h) + aoff + m * 2048 + k * 1024); } } while (0)
#define PG8_LDB(dst, b, h) do { if constexpr (FP8) { _Pragma("unroll") for (int n = 0; n < 2; ++n) { dst##8[n][0] = *(const PG8_LAS v4i*)(lds + PG8_SB(b, h) + boff + n * 2048); dst##8[n][1] = *(const PG8_LAS v4i*)(lds + PG8_SB(b, h) + boff + n * 2048 + 1024); } } \
    else { _Pragma("unroll") for (int n = 0; n < 2; ++n) _Pragma("unroll") for (int k = 0; k < 2; ++k) dst[n][k] = *(const PG8_LAS bf16x8*)(lds + PG8_SB(b, h) + boff + n * 2048 + k * 1024); } } while (0)
#define PG8_MMA(ai, bj, At, Bt) do { __builtin_amdgcn_s_setprio(1); if constexpr (FP8) { _Pragma("unroll") for (int m = 0; m < 4; ++m) _Pragma("unroll") for (int n = 0; n < 2; ++n) \
        mfma8(acc[ai][bj][m][n], __builtin_shufflevector(Bt##8[n][0], Bt##8[n][1], 0, 1, 2, 3, 4, 5, 6, 7), __builtin_shufflevector(At##8[m][0], At##8[m][1], 0, 1, 2, 3, 4, 5, 6, 7), scl8); } \
    else { _Pragma("unroll") for (int m = 0; m < 4; ++m) _Pragma("unroll") for (int n = 0; n < 2; ++n) _Pragma("unroll") for (int k = 0; k < 2; ++k) \
        acc[ai][bj][m][n] = __builtin_amdgcn_mfma_f32_16x16x32_bf16(Bt[n][k], At[m][k], acc[ai][bj][m][n], 0, 0, 0); } __builtin_amdgcn_s_setprio(0); } while (0)
#define PG8_WAIT_V(n) asm volatile("s_waitcnt vmcnt(" #n ")" ::: "memory")
#define PG8_WAIT_L(n) asm volatile("s_waitcnt lgkmcnt(" #n ")" ::: "memory")
#define PG8_BAR __builtin_amdgcn_s_barrier()
#define PG8_SCHED __builtin_amdgcn_sched_barrier(0)
    Unit cur, nxt; int ui = 0;
    if (!S.next(0, cur)) return;
    f32x4 acc[2][2][4][2];
#pragma unroll
    for (int a = 0; a < 2; ++a)
#pragma unroll
        for (int b = 0; b < 2; ++b)
#pragma unroll
            for (int m = 0; m < 4; ++m)
#pragma unroll
                for (int n = 0; n < 2; ++n) acc[a][b][m][n] = (f32x4){0.f, 0.f, 0.f, 0.f};
    bf16x8 At[4][2], B0[2][2], B1[2][2];
    v4i At8[4][2], B08[2][2], B18[2][2];
    int scl8 = 0x7F7F7F7F; asm volatile("" : "+v"(scl8));
    const char* cA = (const char*)g.A + (size_t)cur.pm * tstep; const char* cB = (const char*)g.Bt + (size_t)cur.be * g.bstride + (size_t)cur.pn * tstep;
    S.a_ready(cur);
    if constexpr (SP2) {
        PG8_STAGE(PG8_SB(0, 0), cB, voffB); PG8_STAGE(PG8_SB(0, 1), cB + hstep, voffB); PG8_STAGE(PG8_SA(0, 0), cA, voffA); PG8_STAGE(PG8_SA(0, 1), cA + hstep, voffA);
        if (wr == 1) PG8_BAR;
        PG8_WAIT_V(2); PG8_BAR;
        PG8_STAGE(PG8_SB(1, 0), cB + kstep, voffB); PG8_STAGE(PG8_SA(1, 0), cA + kstep, voffA); PG8_STAGE(PG8_SB(1, 1), cB + hstep + kstep, voffB);
        PG8_WAIT_V(6); PG8_BAR;
    } else {
        PG8_STAGE(PG8_SB(0, 0), cB, voffB); PG8_STAGE(PG8_SA(0, 0), cA, voffA); PG8_STAGE(PG8_SB(0, 1), cB + hstep, voffB); PG8_STAGE(PG8_SA(0, 1), cA + hstep, voffA);
        if (wr == 1) PG8_BAR;
        PG8_WAIT_V(4); PG8_BAR;
        PG8_STAGE(PG8_SB(1, 0), cB + kstep, voffB); PG8_STAGE(PG8_SA(1, 0), cA + kstep, voffA); PG8_STAGE(PG8_SB(1, 1), cB + hstep + kstep, voffB);
        PG8_WAIT_V(6); PG8_BAR;
    }
    for (;;) {
        const bool has_next = S.next(ui + 1, nxt);
        const char* nA = has_next ? (const char*)g.A + (size_t)nxt.pm * tstep : cA; const char* nB = has_next ? (const char*)g.Bt + (size_t)nxt.be * g.bstride + (size_t)nxt.pn * tstep : cB;
#pragma unroll 1
        for (int t = 0; t < nt; t += 2) {
            const bool last = (t == nt - 2);
            const char* a1 = cA + (size_t)(t + 1) * kstep;
            const char* a2 = last ? nA : cA + (size_t)(t + 2) * kstep; const char* b2 = last ? nB : cB + (size_t)(t + 2) * kstep;
            const char* a3 = a2 + kstep; const char* b3 = b2 + kstep;
            if (last && has_next) S.a_ready(nxt);
            if constexpr (SP2) {
            PG8_LDB(B0, 0, 0); PG8_LDB(B1, 0, 1); PG8_SCHED; PG8_LDA(At, 0, 0); PG8_STAGE(PG8_SA(1, 1), a1 + hstep, voffA);
            PG8_WAIT_V(8); PG8_WAIT_L(0); PG8_BAR; PG8_MMA(0, 0, At, B0); PG8_MMA(0, 1, At, B1); PG8_BAR; PG8_SCHED;
            PG8_LDA(At, 0, 1); PG8_STAGE(PG8_SB(0, 0), b2, voffB); PG8_STAGE(PG8_SB(0, 1), b2 + hstep, voffB); PG8_STAGE(PG8_SA(0, 0), a2, voffA);
            PG8_WAIT_V(8); PG8_WAIT_L(0); PG8_BAR; PG8_MMA(1, 0, At, B0); PG8_MMA(1, 1, At, B1); PG8_BAR; PG8_SCHED;
            PG8_LDB(B0, 1, 0); PG8_LDB(B1, 1, 1); PG8_SCHED; PG8_LDA(At, 1, 0); PG8_STAGE(PG8_SA(0, 1), a2 + hstep, voffA);
            PG8_WAIT_V(8); PG8_WAIT_L(0); PG8_BAR; PG8_MMA(0, 0, At, B0); PG8_MMA(0, 1, At, B1); PG8_BAR; PG8_SCHED;
            PG8_LDA(At, 1, 1); PG8_STAGE(PG8_SB(1, 0), b3, voffB); PG8_STAGE(PG8_SB(1, 1), b3 + hstep, voffB); PG8_STAGE(PG8_SA(1, 0), a3, voffA);
            PG8_WAIT_V(8); PG8_WAIT_L(0); PG8_BAR; PG8_MMA(1, 0, At, B0); PG8_MMA(1, 1, At, B1); PG8_BAR; PG8_SCHED;
            } else {
            PG8_LDB(B0, 0, 0); PG8_SCHED; PG8_LDA(At, 0, 0); PG8_STAGE(PG8_SA(1, 1), a1 + hstep, voffA);
            PG8_WAIT_L(8); PG8_BAR; PG8_WAIT_L(0); PG8_MMA(0, 0, At, B0); PG8_BAR; PG8_SCHED;
            PG8_LDB(B1, 0, 1); PG8_STAGE(PG8_SB(0, 0), b2, voffB);
            PG8_BAR; PG8_WAIT_L(0); PG8_MMA(0, 1, At, B1); PG8_BAR;
            PG8_LDA(At, 0, 1); PG8_STAGE(PG8_SA(0, 0), a2, voffA);
            PG8_BAR; PG8_WAIT_L(0); PG8_MMA(1, 0, At, B0); PG8_BAR; PG8_SCHED;
            PG8_STAGE(PG8_SB(0, 1), b2 + hstep, voffB);
            PG8_WAIT_V(6); PG8_BAR; PG8_MMA(1, 1, At, B1); PG8_BAR;
            PG8_LDB(B0, 1, 0); PG8_SCHED; PG8_LDA(At, 1, 0); PG8_STAGE(PG8_SA(0, 1), a2 + hstep, voffA);
            PG8_WAIT_L(8); PG8_BAR; PG8_WAIT_L(0); PG8_MMA(0, 0, At, B0); PG8_BAR; PG8_SCHED;
            PG8_LDB(B1, 1, 1); PG8_STAGE(PG8_SB(1, 0), b3, voffB);
            PG8_BAR; PG8_WAIT_L(0); PG8_MMA(0, 1, At, B1); PG8_BAR;
            PG8_LDA(At, 1, 1); PG8_STAGE(PG8_SA(1, 0), a3, voffA);
            PG8_BAR; PG8_WAIT_L(0); PG8_MMA(1, 0, At, B0); PG8_BAR; PG8_SCHED;
            PG8_STAGE(PG8_SB(1, 1), b3 + hstep, voffB);
            PG8_WAIT_V(6); PG8_BAR; PG8_MMA(1, 1, At, B1); PG8_BAR;
            }
        }
        if constexpr (FP8) asm volatile("s_nop 15\n\ts_nop 15" ::: "memory");
        if constexpr (ALIGN_EPI) { if (wr == 0) PG8_BAR; }
        if constexpr (!Epi::AFTER_DRAIN) { E(acc, cur, wr, wc, fr, fq); S.done(cur); }
        if (!has_next) break;
#pragma unroll
        for (int a = 0; a < 2; ++a)
#pragma unroll
            for (int b = 0; b < 2; ++b)
#pragma unroll
                for (int m = 0; m < 4; ++m)
#pragma unroll
                    for (int n = 0; n < 2; ++n) acc[a][b][m][n] = (f32x4){0.f, 0.f, 0.f, 0.f};
        cur = nxt; cA = nA; cB = nB; ++ui;
        if constexpr (ALIGN_EPI) { if (wr == 1) PG8_BAR; }
    }
    PG8_WAIT_V(0);
    if constexpr (!ALIGN_EPI) { if (wr == 0) PG8_BAR; }
    PG8_BAR;
    if constexpr (Epi::AFTER_DRAIN) { E.fused(acc, cur, wr, wc, fr, fq, lds, wid, lane); S.done(cur); }
#undef PG8_SA
#undef PG8_SB
#undef PG8_STAGE
#undef PG8_LDA
#undef PG8_LDB
#undef PG8_MMA
#undef PG8_WAIT_V
#undef PG8_WAIT_L
#undef PG8_BAR
#undef PG8_SCHED
}
}

constexpr int BATCH = 2, SEQ = 16384, DM = 1024, NTOK = BATCH * SEQ;
constexpr int CHK = 64, NCHUNK = SEQ / CHK;
constexpr int INC = 1792, KOFF = 512, VOFF = 640, XBOFF = 768, GBOFF = 1280;
constexpr int LRUW = 512, DFF = 2816, DFE = 3584, NEXP = 8;
constexpr int MAXTILES = 264, PASS_TILES = 128, NPASS = 3;
constexpr float ALPHA = 1.41421356237309515f, LN_EPS = 1e-5f, RMS_EPS = 1e-6f, LOG2E = 1.4426950408889634f, QSCALE = 0.125f * LOG2E;
constexpr int NWAVES = 8, NTHREADS = 512;

constexpr size_t MiB = 1u << 20;
constexpr size_t WS_CTL = 0, CTL_ZERO_BYTES = 64 * 1024;
constexpr size_t WS_LUT = 1 * MiB;
constexpr size_t WS_GATEW = 1 * MiB + 64 * 1024;
constexpr size_t WS_HIST = 1 * MiB + 512 * 1024;
constexpr size_t WS_META = 1 * MiB + 576 * 1024;
constexpr size_t WS_TOKE = 2 * MiB, WS_TOKW = 2 * MiB + 256 * 1024, WS_TOKPOS = 2 * MiB + 512 * 1024;
constexpr size_t WS_LRUP = 3 * MiB, WS_LRUE = 4 * MiB, WS_HIN = 5 * MiB;
constexpr size_t WS_WEGU = 8 * MiB, WS_WED = 64 * MiB;
constexpr size_t WS_WIN = 92 * MiB, WS_WOUT = 99 * MiB, WS_WGU = 103 * MiB, WS_WD = 114 * MiB;
constexpr size_t WS_A = 120 * MiB;
constexpr size_t WS_ZH = 184 * MiB;
constexpr size_t WS_XS = 120 * MiB;
constexpr size_t WS_Y2 = 186 * MiB;
constexpr size_t WS_HM = 318 * MiB;
constexpr size_t WS_END = 430 * MiB;
constexpr float WSC_GU = 64.0f, WSC_D = 256.0f;
static_assert(WS_WED + (size_t)NEXP * DM * DFE <= WS_WIN && WS_WD + (size_t)DM * DFF * 2 <= WS_A && WS_A + (size_t)NTOK * DM * 2 <= WS_ZH && WS_ZH + (size_t)NTOK * DFF * 2 <= WS_END, "ws map");
static_assert(WS_XS + (size_t)MAXTILES * 256 * DM <= WS_Y2 && WS_Y2 + (size_t)MAXTILES * 256 * DM * 2 <= WS_HM && WS_HM + (size_t)PASS_TILES * 256 * DFE <= WS_END, "ws map (MoE)");
constexpr int CW_BAR = 0;

constexpr int RING_BYTES = 131072;
constexpr int LDS_LUT = RING_BYTES;
constexpr int LDS_CTAB = LDS_LUT + 8192;
constexpr int CT_CB = 4 * 512, CT_BR = 5 * 512, CT_BI = 6 * 512, CT_SP = 7 * 512;
constexpr int LDS_MISC = LDS_CTAB + 16384;
constexpr int LDS_POS = LDS_MISC + 256;
constexpr int LDS_BYTES = 159744;
static_assert(LDS_POS + 1024 <= LDS_BYTES, "LDS map");

#define GAS __attribute__((address_space(1)))
#define LAS __attribute__((address_space(3)))
typedef unsigned short bf16;
typedef unsigned v4u __attribute__((ext_vector_type(4)));
typedef unsigned v2u __attribute__((ext_vector_type(2)));
typedef float f32x4 __attribute__((ext_vector_type(4)));
typedef float f32x16 __attribute__((ext_vector_type(16)));
typedef short bf16x8 __attribute__((ext_vector_type(8)));
typedef short s16x4 __attribute__((ext_vector_type(4)));
#define LDS_WAIT() asm volatile("s_waitcnt lgkmcnt(0)" ::: "memory")
#define VM_WAIT() asm volatile("s_waitcnt vmcnt(0)" ::: "memory")
__device__ __forceinline__ unsigned pk2(float lo, float hi) { return pg8::cvt_pk_bf16(lo, hi); }
__device__ __forceinline__ float bf2f(unsigned short h) { return __uint_as_float((unsigned)h << 16); }
__device__ __forceinline__ float bflo(unsigned w) { return __uint_as_float(w << 16); }
__device__ __forceinline__ float bfhi(unsigned w) { return __uint_as_float(w & 0xffff0000u); }
__device__ __forceinline__ float wave_sum(float v) {
#pragma unroll
    for (int o = 1; o < 64; o <<= 1) v += __shfl_xor(v, o);
    return v;
}
__device__ __forceinline__ float fast_sigmoid(float x) { return __builtin_amdgcn_rcpf(1.0f + __builtin_amdgcn_exp2f(x * -LOG2E)); }
__device__ __forceinline__ float gelu_tanh(float x) {
    const float t = 1.5957691216057308f * (x + 0.044715f * x * x * x);
    return x * fast_sigmoid(t);
}

#define XB_TMO      128
#define XB_XCNT(j)  (256  + 64 * (j))
#define XB_XSUB(j)  (1280 + 64 * (j))
#define XB_XGEN(j)  (2304 + 64 * (j))
#define XB_TOP      3328
#define XB_TOPGEN   3392
#define XCD_BAR_WORDS 3456
#define XB_SPIN_CAP (1u << 18)

__device__ __forceinline__ unsigned xb_ld(unsigned* p)              { return __hip_atomic_load(p, __ATOMIC_RELAXED, __HIP_MEMORY_SCOPE_AGENT); }
__device__ __forceinline__ unsigned xb_add(unsigned* p, unsigned v) { return __hip_atomic_fetch_add(p, v, __ATOMIC_RELAXED, __HIP_MEMORY_SCOPE_AGENT); }
__device__ __forceinline__ unsigned xb_xcc_id() { return (unsigned)__builtin_amdgcn_s_getreg((3 << 11) | 20) & 0xFu; }
#define XB_SPIN(cond, bar) do { unsigned _sp = 0; while (cond) { __builtin_amdgcn_s_sleep(1); \
    if ((++_sp & 255u) == 0u) { if (xb_ld(&(bar)[XB_TMO])) break; if (_sp > XB_SPIN_CAP) { atomicAdd(&(bar)[XB_TMO], 1u); break; } } } } while (0)

struct XcdBarrier {
    unsigned* bar; unsigned x;
    volatile LAS unsigned* st;
};

__device__ __forceinline__ XcdBarrier xcd_barrier_post(unsigned* bar, volatile LAS unsigned* st) {
    XcdBarrier b; b.bar = bar; b.x = xb_xcc_id(); b.st = st;
    if (threadIdx.x == 0) (void)xb_add(&bar[XB_XCNT(b.x)], 1u);
    return b;
}
__device__ __forceinline__ void xcd_barrier_complete(unsigned* bar, unsigned x, unsigned& nloc, unsigned& nx) {
    const unsigned G = gridDim.x * gridDim.y * gridDim.z;
    unsigned sum, cnt, mine, sp = 0u;
    for (;;) {
        sum = 0u; cnt = 0u; mine = 0u;
#pragma unroll
        for (unsigned j = 0; j < 16; ++j) { const unsigned c = xb_ld(&bar[XB_XCNT(j)]); sum += c; cnt += (c > 0u) ? 1u : 0u; mine = (j == x) ? c : mine; }
        if (sum == G) break;
        __builtin_amdgcn_s_sleep(1);
        if ((++sp & 255u) == 0u) { if (xb_ld(&bar[XB_TMO])) break; if (sp > XB_SPIN_CAP) { atomicAdd(&bar[XB_TMO], 1u); break; } }
    }
    nloc = mine > 0u ? mine : 1u; nx = cnt > 0u ? cnt : 1u;
}

__device__ __forceinline__ void xcd_barrier(const XcdBarrier& b) {
    asm volatile("s_waitcnt vmcnt(0)" ::: "memory");
    __syncthreads();
    if (threadIdx.x == 0) {
        unsigned* bar = b.bar;
        __builtin_amdgcn_s_waitcnt(0);
        unsigned nloc = b.st[0], nx = b.st[1];
        if (nloc == 0u) { xcd_barrier_complete(bar, b.x, nloc, nx); b.st[0] = nloc; b.st[1] = nx; }
        const unsigned old = xb_add(&bar[XB_XSUB(b.x)], 1u);
        const unsigned gen = old / nloc;
        if (old + 1u == (gen + 1u) * nloc) {
            __builtin_amdgcn_fence(__ATOMIC_RELEASE, "agent");
            asm volatile("s_waitcnt vmcnt(0)" ::: "memory");
            const unsigned og = xb_add(&bar[XB_TOP], 1u);
            const unsigned tg = og / nx;
            if (og + 1u == (tg + 1u) * nx) xb_add(&bar[XB_TOPGEN], 1u);
            else XB_SPIN(xb_ld(&bar[XB_TOPGEN]) == tg, bar);
            __builtin_amdgcn_fence(__ATOMIC_ACQUIRE, "agent");
            xb_add(&bar[XB_XGEN(b.x)], 1u);
            asm volatile("s_waitcnt vmcnt(0)" ::: "memory");
        } else {
            XB_SPIN(xb_ld(&bar[XB_XGEN(b.x)]) == gen, bar);
            __builtin_amdgcn_fence(__ATOMIC_ACQUIRE, "agent");
            asm volatile("s_waitcnt vmcnt(0)" ::: "memory");
        }
    }
    __syncthreads();
}

struct Args { const float* in[25]; float* out; unsigned char* ws; int ph_lo, ph_hi; };
struct Frame {
    LAS unsigned char* lds;
    int tid, lane, wave, G, blk;
};

__device__ __forceinline__ void p0_transpose_item(const float* W, int K, int N, bf16* WT, int mode, const float* ksA, const float* ksB, float nscale, int nscale_cols, LAS float* scr, int item, int lane) {
    const int nblk = N / 32, kb = item / nblk, nb = item % nblk, k0 = 64 * kb, n0 = 32 * nb;
    const float* ks = ksA ? (k0 < 512 ? ksA + k0 : ksB + (k0 - 512)) : nullptr;
#pragma unroll
    for (int i = 0; i < 32; ++i) { const int kk = 2 * i + (lane >> 5); float v = W[(size_t)(k0 + kk) * N + n0 + (lane & 31)]; if (ks) v *= ks[kk]; scr[kk * 33 + (lane & 31)] = v; }
    LDS_WAIT(); asm volatile("" ::: "memory");
    const int drow0 = (mode == 0) ? n0 : ((n0 >> 7) * 256 + (n0 & 127) + (mode == 2 ? 128 : 0));
    const float sc = (n0 < nscale_cols) ? nscale : 1.0f;
    const int c = lane & 7;
#pragma unroll
    for (int j = 0; j < 4; ++j) { const int n = (lane >> 3) + 8 * j; const LAS float* s = scr + (8 * c) * 33 + n;
        v4u o; o.x = pk2(s[0 * 33] * sc, s[1 * 33] * sc); o.y = pk2(s[2 * 33] * sc, s[3 * 33] * sc); o.z = pk2(s[4 * 33] * sc, s[5 * 33] * sc); o.w = pk2(s[6 * 33] * sc, s[7 * 33] * sc);
        *(v4u*)(WT + (size_t)(drow0 + n) * K + k0 + 8 * c) = o; }
    LDS_WAIT(); asm volatile("" ::: "memory");
}
__device__ __forceinline__ void p0_transpose_item_f8(const float* W, int K, int N, unsigned char* WT, int mode, float scale, LAS float* scr, int item, int lane) {
    const int nblk = N / 32, kb = item / nblk, nb = item % nblk, k0 = 64 * kb, n0 = 32 * nb;
#pragma unroll
    for (int i = 0; i < 32; ++i) { const int kk = 2 * i + (lane >> 5); scr[kk * 33 + (lane & 31)] = W[(size_t)(k0 + kk) * N + n0 + (lane & 31)] * scale; }
    LDS_WAIT(); asm volatile("" ::: "memory");
    const int drow0 = (mode == 0) ? n0 : ((n0 >> 7) * 256 + (n0 & 127) + (mode == 2 ? 128 : 0));
    const int c = lane & 3;
#pragma unroll
    for (int j = 0; j < 2; ++j) { const int n = (lane >> 2) + 16 * j; const LAS float* s = scr + (16 * c) * 33 + n;
        v4u o; o.x = pg8::pk4_fp8(s[0 * 33], s[1 * 33], s[2 * 33], s[3 * 33]); o.y = pg8::pk4_fp8(s[4 * 33], s[5 * 33], s[6 * 33], s[7 * 33]);
        o.z = pg8::pk4_fp8(s[8 * 33], s[9 * 33], s[10 * 33], s[11 * 33]); o.w = pg8::pk4_fp8(s[12 * 33], s[13 * 33], s[14 * 33], s[15 * 33]);
        *(v4u*)(WT + (size_t)(drow0 + n) * K + k0 + 16 * c) = o; }
    LDS_WAIT(); asm volatile("" ::: "memory");
}
__device__ __forceinline__ int t5_bucket(int rel) {
    const int n = rel < 0 ? -rel : rel;
    int v;
    if (n < 8) v = n;
    else { v = 8 + (n >= 12) + (n >= 16) + (n >= 23) + (n >= 32) + (n >= 46) + (n >= 64) + (n >= 91); }
    return (rel > 0 ? 16 : 0) + v;
}
__device__ __forceinline__ void p0_prologue(const Frame& F, const Args& A) {
    unsigned char* ws = A.ws;
    LAS float* scr = (LAS float*)(F.lds + F.wave * 8448);
    const int gw = F.blk * NWAVES + F.wave, NGW = F.G * NWAVES;
    bf16* WIN = (bf16*)(ws + WS_WIN); bf16* WOUT = (bf16*)(ws + WS_WOUT); bf16* WGU = (bf16*)(ws + WS_WGU); bf16* WD = (bf16*)(ws + WS_WD);
    unsigned char* WEGU = ws + WS_WEGU; unsigned char* WED = ws + WS_WED;
    constexpr int I_IN = (DM / 64) * (INC / 32), I_OUT = (DM / 64) * (DM / 32), I_GU = (DM / 64) * (DFF / 32), I_D = (DFF / 64) * (DM / 32);
    constexpr int I_EGU = (DM / 64) * (DFE / 32), I_ED = (DFE / 64) * (DM / 32);
    constexpr int NITEMS = 2 * I_IN + 2 * I_OUT + 2 * I_GU + I_D + NEXP * (2 * I_EGU + I_ED);
    for (int it = gw; it < NITEMS; it += NGW) {
        int r = it;
        if (r < 2 * I_IN) { const int l = r / I_IN; r -= l * I_IN;
            p0_transpose_item(A.in[2] + (size_t)l * DM * INC, DM, INC, WIN + (size_t)l * INC * DM, 0, nullptr, nullptr, QSCALE, 512, scr, r, F.lane); continue; }
        r -= 2 * I_IN;
        if (r < 2 * I_OUT) { const int l = r / I_OUT; r -= l * I_OUT;
            p0_transpose_item(A.in[13] + (size_t)l * DM * DM, DM, DM, WOUT + (size_t)l * DM * DM, 0, A.in[11] + l * 512, A.in[12] + l * 512, 1.0f, 0, scr, r, F.lane); continue; }
        r -= 2 * I_OUT;
        if (r < I_GU) { p0_transpose_item_f8(A.in[16], DM, DFF, (unsigned char*)WGU, 1, WSC_GU, scr, r, F.lane); continue; }
        r -= I_GU;
        if (r < I_GU) { p0_transpose_item_f8(A.in[17], DM, DFF, (unsigned char*)WGU, 2, WSC_GU, scr, r, F.lane); continue; }
        r -= I_GU;
        if (r < I_D) { p0_transpose_item_f8(A.in[18], DFF, DM, (unsigned char*)WD, 0, WSC_D, scr, r, F.lane); continue; }
        r -= I_D;
        { constexpr int PER_E = 2 * I_EGU + I_ED; const int e = r / PER_E; r -= e * PER_E;
          if (r < I_EGU) { p0_transpose_item_f8(A.in[20] + (size_t)e * DM * DFE, DM, DFE, WEGU + (size_t)e * 2 * DFE * DM, 1, WSC_GU, scr, r, F.lane); continue; }
          r -= I_EGU;
          if (r < I_EGU) { p0_transpose_item_f8(A.in[21] + (size_t)e * DM * DFE, DM, DFE, WEGU + (size_t)e * 2 * DFE * DM, 2, WSC_GU, scr, r, F.lane); continue; }
          r -= I_EGU;
          p0_transpose_item_f8(A.in[22] + (size_t)e * DFE * DM, DFE, DM, WED + (size_t)e * DM * DFE, 0, WSC_D, scr, r, F.lane); }
    }
    { const f32x4* x4 = (const f32x4*)A.in[0]; v4u* o = (v4u*)(ws + WS_A);
      const size_t n8 = (size_t)NTOK * DM / 8, stride = (size_t)F.G * NTHREADS;
      for (size_t i0 = (size_t)F.blk * NTHREADS + F.tid; i0 < n8; i0 += 4 * stride) {
          f32x4 a[4], b[4];
#pragma unroll
          for (int u = 0; u < 4; ++u) { const size_t i = i0 + u * stride; if (i < n8) { a[u] = x4[2 * i]; b[u] = x4[2 * i + 1]; } }
#pragma unroll
          for (int u = 0; u < 4; ++u) { const size_t i = i0 + u * stride; if (i < n8) { v4u w; w.x = pk2(a[u].x, a[u].y); w.y = pk2(a[u].z, a[u].w); w.z = pk2(b[u].x, b[u].y); w.w = pk2(b[u].z, b[u].w); o[i] = w; } } } }

    { bf16* GW = (bf16*)(ws + WS_GATEW);
      for (int i = F.blk * NTHREADS + F.tid; i < 2 * 2 * 8 * 64 * 64; i += F.G * NTHREADS) {
          const int d = i & 63, e = (i >> 6) & 63, n = (i >> 12) & 7, g = (i >> 15) & 1, l = i >> 16;
          const float v = (g ? A.in[8] : A.in[6])[(((size_t)l * 8 + n) * 64 + d) * 64 + e];
          GW[i] = (bf16)(pk2(v, v) & 0xffffu); } }
    if (F.blk == 0 && F.tid < 256) { float* LUT = (float*)(ws + WS_LUT); const int rel = F.tid - 191; const int bk = t5_bucket(rel);
#pragma unroll
        for (int h = 0; h < 8; ++h) LUT[h * 256 + F.tid] = A.in[1][bk * 8 + h] * LOG2E; }
}

template <int D> __device__ __forceinline__ float dpp_shr(float v, float idv) { return __builtin_bit_cast(float, __builtin_amdgcn_update_dpp(__builtin_bit_cast(int, idv), __builtin_bit_cast(int, v), 0x110 + D, 0xF, 0xF, false)); }
__device__ __forceinline__ float dpp_ror1(float v) { return __builtin_bit_cast(float, __builtin_amdgcn_update_dpp(0, __builtin_bit_cast(int, v), 0x121, 0xF, 0xF, false)); }
template <int D> __device__ __forceinline__ void scan_step(float& P, float& H) { const float P1 = dpp_shr<D>(P, 1.0f), H1 = dpp_shr<D>(H, 0.0f); H = P * H1 + H; P = P * P1; }
__device__ __forceinline__ void lru_tables(const Frame& F, const Args& A, int l) {
    LAS float* ct = (LAS float*)(F.lds + LDS_CTAB);
    const int ch = F.tid;
#pragma unroll
    for (int w = 0; w < 4; ++w) ct[w * 512 + ch] = A.in[4][(l * 4 + w) * LRUW + ch];
    ct[CT_CB + ch] = A.in[5][l * LRUW + ch]; ct[CT_BR + ch] = A.in[7][l * LRUW + ch]; ct[CT_BI + ch] = A.in[9][l * LRUW + ch];
    ct[CT_SP + ch] = 8.0f * log1pf(__expf(-A.in[10][l * LRUW + ch]));
}
struct LruNb { bf16x8 wr[2], wi[2]; v2u gb[4]; f32x4 hin; };
template <bool FINAL, int PART  >
__device__ __forceinline__ void lru_load_nb(LruNb& L, int nb, const bf16* Z, size_t row0, int n, int fr, int fq, const bf16* gwr, const bf16* gwi, const float* HinRow) {
    const int ch0 = 64 * n + 16 * nb + 4 * fq;
    if (PART & 1) {
#pragma unroll
        for (int ks = 0; ks < 2; ++ks) { L.wr[ks] = *(const bf16x8*)(gwr + (16 * nb + fr) * 64 + 32 * ks + 8 * fq); L.wi[ks] = *(const bf16x8*)(gwi + (16 * nb + fr) * 64 + 32 * ks + 8 * fq); }
    }
    if (FINAL && (PART & 2)) {
#pragma unroll
        for (int m = 0; m < 4; ++m) L.gb[m] = *(const v2u*)(Z + (row0 + 16 * m + fr) * INC + GBOFF + ch0);
        L.hin = *(const f32x4*)(HinRow + ch0);
    }
}
template <bool FINAL>
__device__ __forceinline__ void lru_tile(const bf16* Z, int b, int c, int n, int lane, const bf16* gwr, const bf16* gwi, const LAS float* ct,
                                         float* outP, float* outE, const float* Hin, LAS float* yl) {
    const int fr = lane & 15, fq = lane >> 4;
    const size_t seq0 = (size_t)b * SEQ, row0 = seq0 + (size_t)CHK * c;
    const float* HinRow = Hin + ((size_t)b * NCHUNK + c) * LRUW;
    LruNb cur, nxt;
    lru_load_nb<FINAL, 1>(cur, 0, Z, row0, n, fr, fq, gwr, gwi, HinRow);
    v4u xv[2][4][4];
    bf16x8 xa[4][2];
#define LRU_LOADXV(ks) do { _Pragma("unroll") for (int m = 0; m < 4; ++m) _Pragma("unroll") for (int w = 0; w < 4; ++w) { const int tt = CHK * c + 16 * m + fr + w - 3; \
        xv[ks][m][w] = *(const v4u*)(Z + (seq0 + (tt < 0 ? 0 : tt)) * INC + XBOFF + 64 * n + 32 * (ks) + 8 * fq); } } while (0)
#define LRU_CONV(ks) do { const int ch = 64 * n + 32 * (ks) + 8 * fq; float cw[4][8], cb[8]; \
        _Pragma("unroll") for (int w = 0; w < 4; ++w) { const f32x4 a = *(const LAS f32x4*)(ct + w * 512 + ch), bq = *(const LAS f32x4*)(ct + w * 512 + ch + 4); \
            cw[w][0] = a.x; cw[w][1] = a.y; cw[w][2] = a.z; cw[w][3] = a.w; cw[w][4] = bq.x; cw[w][5] = bq.y; cw[w][6] = bq.z; cw[w][7] = bq.w; } \
        { const f32x4 a = *(const LAS f32x4*)(ct + CT_CB + ch), bq = *(const LAS f32x4*)(ct + CT_CB + ch + 4); cb[0] = a.x; cb[1] = a.y; cb[2] = a.z; cb[3] = a.w; cb[4] = bq.x; cb[5] = bq.y; cb[6] = bq.z; cb[7] = bq.w; } \
        _Pragma("unroll") for (int m = 0; m < 4; ++m) { float a8[8]; \
            _Pragma("unroll") for (int j = 0; j < 8; ++j) a8[j] = cb[j]; \
            _Pragma("unroll") for (int w = 0; w < 4; ++w) { const int tt = CHK * c + 16 * m + fr + w - 3; const float mk = (tt >= 0) ? 1.0f : 0.0f; const v4u v = xv[ks][m][w]; \
                a8[0] += mk * cw[w][0] * bflo(v.x); a8[1] += mk * cw[w][1] * bfhi(v.x); a8[2] += mk * cw[w][2] * bflo(v.y); a8[3] += mk * cw[w][3] * bfhi(v.y); \
                a8[4] += mk * cw[w][4] * bflo(v.z); a8[5] += mk * cw[w][5] * bfhi(v.z); a8[6] += mk * cw[w][6] * bflo(v.w); a8[7] += mk * cw[w][7] * bfhi(v.w); } \
            v4u p; p.x = pk2(a8[0], a8[1]); p.y = pk2(a8[2], a8[3]); p.z = pk2(a8[4], a8[5]); p.w = pk2(a8[6], a8[7]); \
            xa[m][ks] = __builtin_bit_cast(bf16x8, p); } } while (0)
    if (FINAL) {
        LRU_LOADXV(0); asm volatile("" ::: "memory"); LRU_CONV(0); asm volatile("" ::: "memory");
        LRU_LOADXV(1); asm volatile("" ::: "memory"); LRU_CONV(1);
    } else {
        LRU_LOADXV(0); LRU_LOADXV(1); asm volatile("" ::: "memory"); LRU_CONV(0); LRU_CONV(1);
    }
#undef LRU_LOADXV
#undef LRU_CONV
    lru_load_nb<FINAL, 2>(cur, 0, Z, row0, n, fr, fq, gwr, gwi, HinRow);
#pragma unroll 1
    for (int nb = 0; nb < 4; ++nb) {
        const int ch0 = 64 * n + 16 * nb + 4 * fq;
        if (nb < 3) lru_load_nb<FINAL, 1>(nxt, nb + 1, Z, row0, n, fr, fq, gwr, gwi, HinRow);
        if (nb > 0) lru_load_nb<FINAL, 2>(cur, nb, Z, row0, n, fr, fq, gwr, gwi, HinRow);
        asm volatile("" ::: "memory");
        bf16x8 idf[2];
#pragma unroll
        for (int ks = 0; ks < 2; ++ks)
#pragma unroll
            for (int j = 0; j < 8; ++j) idf[ks][j] = (32 * ks + 8 * fq + j == 16 * nb + fr) ? (short)0x3F80 : (short)0;
        const f32x4 brv = *(const LAS f32x4*)(ct + CT_BR + ch0), biv = *(const LAS f32x4*)(ct + CT_BI + ch0), spv = *(const LAS f32x4*)(ct + CT_SP + ch0);
        f32x4 dr[4], di[4], dx[4];
#pragma unroll
        for (int m = 0; m < 4; ++m) { dr[m] = (f32x4){0.f, 0.f, 0.f, 0.f}; di[m] = dr[m]; dx[m] = dr[m];
#pragma unroll
            for (int ks = 0; ks < 2; ++ks) {
                dr[m] = __builtin_amdgcn_mfma_f32_16x16x32_bf16(cur.wr[ks], xa[m][ks], dr[m], 0, 0, 0);
                di[m] = __builtin_amdgcn_mfma_f32_16x16x32_bf16(cur.wi[ks], xa[m][ks], di[m], 0, 0, 0);
                dx[m] = __builtin_amdgcn_mfma_f32_16x16x32_bf16(idf[ks], xa[m][ks], dx[m], 0, 0, 0); } }
        float cP[4], cH[4];
#pragma unroll
        for (int r = 0; r < 4; ++r) { cP[r] = 1.0f; cH[r] = FINAL ? cur.hin[r] : 0.0f; }
#pragma unroll
        for (int m = 0; m < 4; ++m) {
            float P[4], H[4];
#pragma unroll
            for (int r = 0; r < 4; ++r) {
                const float rg = fast_sigmoid(dr[m][r] + brv[r]), ig = fast_sigmoid(di[m][r] + biv[r]);
                const float la = -rg * spv[r];
                const float a = __builtin_amdgcn_exp2f(la * LOG2E);
                const float x2 = 2.0f * la;
                const float om = (x2 > -0.02f) ? -x2 * (1.0f + x2 * (0.5f + x2 * (1.0f / 6.0f))) : (1.0f - a * a);
                const float u = __builtin_amdgcn_sqrtf(fmaxf(om, 0.f)) * (ig * dx[m][r]);
                P[r] = (fr == 0) ? a * cP[r] : a; H[r] = (fr == 0) ? a * cH[r] + u : u;
            }
#pragma unroll
            for (int r = 0; r < 4; ++r) { scan_step<1>(P[r], H[r]); scan_step<2>(P[r], H[r]); scan_step<4>(P[r], H[r]); scan_step<8>(P[r], H[r]); }
            if (FINAL) {
                const v2u g = cur.gb[m];
                f32x4 y; y[0] = gelu_tanh(bflo(g.x)) * H[0]; y[1] = gelu_tanh(bfhi(g.x)) * H[1]; y[2] = gelu_tanh(bflo(g.y)) * H[2]; y[3] = gelu_tanh(bfhi(g.y)) * H[3];
                *(LAS f32x4*)(yl + (16 * m + fr) * LRUW + ch0) = y;
            }
#pragma unroll
            for (int r = 0; r < 4; ++r) { cP[r] = dpp_ror1(P[r]); cH[r] = dpp_ror1(H[r]); }
        }
        if (!FINAL) { if (fr == 0) { const size_t o = ((size_t)b * NCHUNK + c) * LRUW + ch0;
            *(f32x4*)(outP + o) = (f32x4){cP[0], cP[1], cP[2], cP[3]}; *(f32x4*)(outE + o) = (f32x4){cH[0], cH[1], cH[2], cH[3]}; } }
        cur.wr[0] = nxt.wr[0]; cur.wr[1] = nxt.wr[1]; cur.wi[0] = nxt.wi[0]; cur.wi[1] = nxt.wi[1];
    }
}

__device__ __forceinline__ void p_lru_summary(const Frame& F, const Args& A, int l) {
    unsigned char* ws = A.ws;
    const bf16* Z = (const bf16*)(ws + WS_ZH);
    const bf16* GW = (const bf16*)(ws + WS_GATEW) + (size_t)l * 2 * 8 * 4096;
    lru_tables(F, A, l); __syncthreads();
    for (int it = F.blk; it < BATCH * NCHUNK; it += F.G) {
        const int b = it >> 8, c = it & 255, n = F.wave;
        lru_tile<false>(Z, b, c, n, F.lane, GW + n * 4096, GW + 8 * 4096 + n * 4096, (const LAS float*)(F.lds + LDS_CTAB), (float*)(ws + WS_LRUP), (float*)(ws + WS_LRUE), (const float*)(ws + WS_HIN), nullptr);
    }
}
__device__ __forceinline__ void p_lru_carry(const Frame& F, const Args& A) {
    unsigned char* ws = A.ws;
    const float* Pg = (const float*)(ws + WS_LRUP); const float* Eg = (const float*)(ws + WS_LRUE); float* Hg = (float*)(ws + WS_HIN);
    const int gw = F.blk * NWAVES + F.wave, NGW = F.G * NWAVES;
    for (int p = gw; p < BATCH * LRUW; p += NGW) {
        const int b = p >> 9, ch = p & 511;
        float pk[4], ek[4];
#pragma unroll
        for (int k = 0; k < 4; ++k) { const size_t o = ((size_t)b * NCHUNK + 4 * F.lane + k) * LRUW + ch; pk[k] = Pg[o]; ek[k] = Eg[o]; }
        float P = pk[0], H = ek[0];
#pragma unroll
        for (int k = 1; k < 4; ++k) { H = pk[k] * H + ek[k]; P = pk[k] * P; }
#pragma unroll
        for (int d = 1; d < 64; d <<= 1) { const float P1 = __shfl_up(P, d), H1 = __shfl_up(H, d); if (F.lane >= d) { H = P * H1 + H; P = P * P1; } }
        float h = __shfl_up(H, 1); if (F.lane == 0) h = 0.f;
#pragma unroll
        for (int k = 0; k < 4; ++k) { Hg[((size_t)b * NCHUNK + 4 * F.lane + k) * LRUW + ch] = h; h = pk[k] * h + ek[k]; }
    }
}

__device__ __forceinline__ int crow(int r, int hi) { return (r & 3) + 8 * (r >> 2) + 4 * hi; }
__device__ __forceinline__ s16x4 vtr(const LAS unsigned char* p) { return __builtin_bit_cast(s16x4, __builtin_amdgcn_ds_read_tr16_b64_v4i16((LAS s16x4*)p)); }
__device__ __forceinline__ void p_mixer(const Frame& F, const Args& A, int l) {
    unsigned char* ws = A.ws;
    const bf16* Z = (const bf16*)(ws + WS_ZH);
    bf16* Y = (bf16*)(ws + WS_A);
    const bf16* GW = (const bf16*)(ws + WS_GATEW) + (size_t)l * 2 * 8 * 4096;
    LAS unsigned char* Kl = F.lds;
    LAS unsigned char* Vl = F.lds + 49152;
    LAS float* yl = (LAS float*)F.lds;
    LAS bf16* ya = (LAS bf16*)F.lds;
    LAS float* lut = (LAS float*)(F.lds + LDS_LUT);
    const int lane = F.lane, wave = F.wave, r32 = lane & 31, hi = lane >> 5;
    { const float* LUTg = (const float*)(ws + WS_LUT); for (int i = F.tid; i < 2048; i += NTHREADS) lut[i] = LUTg[i]; }
    lru_tables(F, A, l);
    const float sinkv = A.in[3][l * 8 + wave] * LOG2E;
    const int kvh = wave >> 2;
    for (int it = F.blk; it < BATCH * NCHUNK; it += F.G) {
        const int b = it >> 8, c = it & 255;
        const size_t row0 = (size_t)b * SEQ + (size_t)CHK * c;
        const int T0 = (c >= 2) ? 0 : 2 - c;
        __syncthreads();
#ifndef NO_LRU_FINAL
        lru_tile<true>(Z, b, c, wave, lane, GW + wave * 4096, GW + 8 * 4096 + wave * 4096, (const LAS float*)(F.lds + LDS_CTAB), nullptr, nullptr, (const float*)(ws + WS_HIN), yl);
#endif
        __syncthreads();
#pragma unroll
        for (int i = 0; i < 8; ++i) { const int tok = 8 * wave + i;
            const f32x4 a = *(const LAS f32x4*)(yl + tok * LRUW + 8 * lane), q = *(const LAS f32x4*)(yl + tok * LRUW + 8 * lane + 4);
            const float ss = wave_sum((a.x * a.x + a.y * a.y) + (a.z * a.z + a.w * a.w) + (q.x * q.x + q.y * q.y) + (q.z * q.z + q.w * q.w));
            const float rstd = 1.0f / sqrtf(ss * (1.0f / 512.0f) + RMS_EPS);
            v4u w; w.x = pk2(a.x * rstd, a.y * rstd); w.y = pk2(a.z * rstd, a.w * rstd); w.z = pk2(q.x * rstd, q.y * rstd); w.w = pk2(q.z * rstd, q.w * rstd);
            *(v4u*)(Y + (row0 + tok) * DM + 512 + 8 * lane) = w; }
        __syncthreads();
#pragma unroll
        for (int h2 = 0; h2 < 2; ++h2)
#pragma unroll
            for (int T = 0; T < 3; ++T) {
                v4u kq = (v4u){0u, 0u, 0u, 0u}, vq = kq;
                if (T >= T0) { const size_t cr = row0 + (size_t)CHK * T - 2 * CHK;
                    kq = *(const v4u*)(Z + (cr + lane) * INC + KOFF + 64 * h2 + 8 * wave);
                    vq = *(const v4u*)(Z + (cr + 16 * (wave & 3) + (lane >> 2)) * INC + VOFF + 64 * h2 + 32 * (wave >> 2) + 8 * (lane & 3)); }
                *(LAS v4u*)(Kl + (h2 * 3 + T) * 8192 + wave * 1024 + lane * 16) = kq;
                *(LAS v4u*)(Vl + (h2 * 3 + T) * 8192 + wave * 1024 + lane * 16) = vq;
            }
        __syncthreads();
        unsigned opk[2][2][8];
#pragma unroll
        for (int qb = 0; qb < 2; ++qb) {
            const int qi = 32 * qb + r32;
            bf16x8 qr[4];
#pragma unroll
            for (int d0 = 0; d0 < 4; ++d0) qr[d0] = *(const bf16x8*)(Z + (row0 + qi) * INC + 64 * wave + 16 * d0 + 8 * hi);
            f32x16 s[3][2];
            const LAS float* lutq = lut + wave * 256 + 63 - qi;
#pragma unroll
            for (int T = 0; T < 3; ++T) {
#pragma unroll
                for (int hf = 0; hf < 2; ++hf)
#pragma unroll
                    for (int r = 0; r < 16; ++r) s[T][hf][r] = lutq[64 * T + 32 * hf + crow(r, hi)];
                const LAS unsigned char* kb = Kl + (kvh * 3 + T) * 8192 + hi * 1024 + r32 * 16;
#pragma unroll
                for (int d0 = 0; d0 < 4; ++d0) {
                    const bf16x8 b0 = *(const LAS bf16x8*)(kb + d0 * 2048), b1 = *(const LAS bf16x8*)(kb + d0 * 2048 + 512);
                    s[T][0] = __builtin_amdgcn_mfma_f32_32x32x16_bf16(b0, qr[d0], s[T][0], 0, 0, 0);
                    s[T][1] = __builtin_amdgcn_mfma_f32_32x32x16_bf16(b1, qr[d0], s[T][1], 0, 0, 0);
                }
                if (T < T0) {
#pragma unroll
                    for (int hf = 0; hf < 2; ++hf)
#pragma unroll
                        for (int r = 0; r < 16; ++r) s[T][hf][r] = -1e30f;
                }
            }
            float mx = sinkv;
#pragma unroll
            for (int T = 0; T < 3; ++T)
#pragma unroll
                for (int hf = 0; hf < 2; ++hf)
#pragma unroll
                    for (int r = 0; r < 16; ++r) mx = fmaxf(mx, s[T][hf][r]);
            mx = fmaxf(mx, __shfl_xor(mx, 32));
            float lsum = 0.f;
#pragma unroll
            for (int T = 0; T < 3; ++T)
#pragma unroll
                for (int hf = 0; hf < 2; ++hf)
#pragma unroll
                    for (int r = 0; r < 16; ++r) { const float p = __builtin_amdgcn_exp2f(s[T][hf][r] - mx); s[T][hf][r] = p; lsum += p; }
            lsum += __shfl_xor(lsum, 32);
            lsum += __builtin_amdgcn_exp2f(sinkv - mx);
            const float inv = 1.0f / lsum;
            f32x16 o[2]; o[0] = (f32x16){0.f, 0.f, 0.f, 0.f, 0.f, 0.f, 0.f, 0.f, 0.f, 0.f, 0.f, 0.f, 0.f, 0.f, 0.f, 0.f}; o[1] = o[0];
#pragma unroll
            for (int T = 0; T < 3; ++T) {
                v4u pw[4];
#pragma unroll
                for (int k = 0; k < 4; ++k) { const int hf = k >> 1, r0 = (k & 1) * 8;
                    pw[k].x = pk2(s[T][hf][r0 + 0], s[T][hf][r0 + 1]); pw[k].y = pk2(s[T][hf][r0 + 2], s[T][hf][r0 + 3]);
                    pw[k].z = pk2(s[T][hf][r0 + 4], s[T][hf][r0 + 5]); pw[k].w = pk2(s[T][hf][r0 + 6], s[T][hf][r0 + 7]); }
                const LAS unsigned char* vb = Vl + (kvh * 3 + T) * 8192 + ((lane >> 4) & 1) * 32 + (lane & 3) * 8 + (4 * hi + ((lane & 15) >> 2)) * 64;
#pragma unroll
                for (int d0 = 0; d0 < 2; ++d0)
#pragma unroll
                    for (int ks = 0; ks < 4; ++ks) {
                        const s16x4 lo = vtr(vb + d0 * 4096 + ks * 1024), hv = vtr(vb + d0 * 4096 + ks * 1024 + 512);
                        const bf16x8 vf = (bf16x8){lo[0], lo[1], lo[2], lo[3], hv[0], hv[1], hv[2], hv[3]};
                        o[d0] = __builtin_amdgcn_mfma_f32_32x32x16_bf16(vf, __builtin_bit_cast(bf16x8, pw[ks]), o[d0], 0, 0, 0);
                    }
            }
#pragma unroll
            for (int d0 = 0; d0 < 2; ++d0)
#pragma unroll
                for (int r = 0; r < 16; r += 2) opk[qb][d0][r >> 1] = pk2(o[d0][r] * inv, o[d0][r + 1] * inv);
        }
        __syncthreads();
#pragma unroll
        for (int qb = 0; qb < 2; ++qb)
#pragma unroll
            for (int d0 = 0; d0 < 2; ++d0)
#pragma unroll
                for (int g = 0; g < 4; ++g) { v2u w; w.x = opk[qb][d0][2 * g]; w.y = opk[qb][d0][2 * g + 1];
                    *(LAS v2u*)(ya + (32 * qb + r32) * 512 + 64 * wave + 32 * d0 + 8 * g + 4 * hi) = w; }
        __syncthreads();
#pragma unroll
        for (int i = 0; i < 8; ++i) { const int tok = 8 * wave + i;
            const v4u w0 = *(const LAS v4u*)(ya + tok * 512 + 8 * lane);
            const float x0 = bflo(w0.x), x1 = bfhi(w0.x), x2 = bflo(w0.y), x3 = bfhi(w0.y), x4 = bflo(w0.z), x5 = bfhi(w0.z), x6 = bflo(w0.w), x7 = bfhi(w0.w);
            const float ss = wave_sum((x0 * x0 + x1 * x1) + (x2 * x2 + x3 * x3) + (x4 * x4 + x5 * x5) + (x6 * x6 + x7 * x7));
            const float rstd = 1.0f / sqrtf(ss * (1.0f / 512.0f) + RMS_EPS);
            v4u w; w.x = pk2(x0 * rstd, x1 * rstd); w.y = pk2(x2 * rstd, x3 * rstd); w.z = pk2(x4 * rstd, x5 * rstd); w.w = pk2(x6 * rstd, x7 * rstd);
            *(v4u*)(Y + (row0 + tok) * DM + 8 * lane) = w; }
    }
}

template <int MODE>
__device__ __forceinline__ void p_layernorm(const Frame& F, const Args& A, const float* gam, const float* bet) {
    unsigned char* ws = A.ws;
    float* X = A.out;
    bf16* XB = (bf16*)(ws + WS_A);
    const bf16* Y2 = (const bf16*)(ws + WS_Y2);
    const int* TP = (const int*)(ws + WS_TOKPOS); const float* TW = (const float*)(ws + WS_TOKW);
    LAS unsigned* misc = (LAS unsigned*)(F.lds + LDS_MISC);
    const int lane = F.lane;
    if (MODE == 1) { if (F.tid < 8) misc[F.tid] = 0u; __syncthreads(); }
    f32x4 gv[4], bv[4];
#pragma unroll
    for (int j = 0; j < 4; ++j) { gv[j] = *(const f32x4*)(gam + 4 * lane + 256 * j); bv[j] = *(const f32x4*)(bet + 4 * lane + 256 * j); }
    const int rpw = NTOK / F.G;
    const int m0 = F.blk * rpw;
    f32x4 v[4], nv[4]; v2u ya[4], yb[4], nya[4], nyb[4]; float w0 = 0.f, w1 = 0.f, nw0 = 0.f, nw1 = 0.f; int np0 = 0, np1 = 0;
    {   const int m = m0 + F.wave;
        const f32x4* xr = (const f32x4*)(X + (size_t)m * DM) + lane;
#pragma unroll
        for (int j = 0; j < 4; ++j) v[j] = xr[64 * j];
        if (MODE == 2) { const int p0 = TP[2 * m], p1 = TP[2 * m + 1]; w0 = TW[2 * m]; w1 = TW[2 * m + 1];
            const v2u* y0 = (const v2u*)(Y2 + (size_t)p0 * DM) + lane; const v2u* y1 = (const v2u*)(Y2 + (size_t)p1 * DM) + lane;
#pragma unroll
            for (int j = 0; j < 4; ++j) { ya[j] = y0[64 * j]; yb[j] = y1[64 * j]; }
            if (F.wave + NWAVES < rpw) { np0 = TP[2 * (m + NWAVES)]; np1 = TP[2 * (m + NWAVES) + 1]; nw0 = TW[2 * (m + NWAVES)]; nw1 = TW[2 * (m + NWAVES) + 1]; } }
    }
    for (int i = F.wave; i < rpw; i += NWAVES) {
        const int m = m0 + i;
        f32x4* xr = (f32x4*)(X + (size_t)m * DM) + lane;
        const bool more = (i + NWAVES < rpw);
        float nnw0 = 0.f, nnw1 = 0.f; int nnp0 = 0, nnp1 = 0;
        if (more) {
            const f32x4* xn = (const f32x4*)(X + (size_t)(m + NWAVES) * DM) + lane;
#pragma unroll
            for (int j = 0; j < 4; ++j) nv[j] = xn[64 * j];
            if (MODE == 2) {
                const v2u* y0 = (const v2u*)(Y2 + (size_t)np0 * DM) + lane; const v2u* y1 = (const v2u*)(Y2 + (size_t)np1 * DM) + lane;
#pragma unroll
                for (int j = 0; j < 4; ++j) { nya[j] = y0[64 * j]; nyb[j] = y1[64 * j]; }
                if (i + 2 * NWAVES < rpw) { nnp0 = TP[2 * (m + 2 * NWAVES)]; nnp1 = TP[2 * (m + 2 * NWAVES) + 1]; nnw0 = TW[2 * (m + 2 * NWAVES)]; nnw1 = TW[2 * (m + 2 * NWAVES) + 1]; }
            }
        }
        asm volatile("" ::: "memory");
        if (MODE == 2) {
#pragma unroll
            for (int j = 0; j < 4; ++j) { const v2u a = ya[j], c = yb[j];
                v[j].x = ALPHA * v[j].x + w0 * bflo(a.x) + w1 * bflo(c.x); v[j].y = ALPHA * v[j].y + w0 * bfhi(a.x) + w1 * bfhi(c.x);
                v[j].z = ALPHA * v[j].z + w0 * bflo(a.y) + w1 * bflo(c.y); v[j].w = ALPHA * v[j].w + w0 * bfhi(a.y) + w1 * bfhi(c.y); }
        }
        float s = 0.f;
#pragma unroll
        for (int j = 0; j < 4; ++j) s += (v[j].x + v[j].y) + (v[j].z + v[j].w);
        const float mean = wave_sum(s) * (1.f / DM); float s2 = 0.f;
#pragma unroll
        for (int j = 0; j < 4; ++j) { v[j] = v[j] - mean; s2 += (v[j].x * v[j].x + v[j].y * v[j].y) + (v[j].z * v[j].z + v[j].w * v[j].w); }
        const float rstd = 1.f / sqrtf(wave_sum(s2) * (1.f / DM) + LN_EPS);
#pragma unroll
        for (int j = 0; j < 4; ++j) { v[j] = v[j] * rstd * gv[j] + bv[j]; xr[64 * j] = v[j]; }
        if (MODE == 3) {
            unsigned* o4 = (unsigned*)((unsigned char*)XB + (size_t)m * DM) + lane;
#pragma unroll
            for (int j = 0; j < 4; ++j) o4[64 * j] = pg8::pk4_fp8(v[j].x, v[j].y, v[j].z, v[j].w);
        }
        if (MODE == 0) {
            v2u* o8 = (v2u*)(XB + (size_t)m * DM) + lane;
#pragma unroll
            for (int j = 0; j < 4; ++j) { v2u w; w.x = pk2(v[j].x, v[j].y); w.y = pk2(v[j].z, v[j].w); o8[64 * j] = w; }
        }
        if (MODE == 1) {
            const float* RW = A.in[19];
            float lg[8];
#pragma unroll
            for (int e = 0; e < 8; ++e) lg[e] = 0.f;
#pragma unroll
            for (int j = 0; j < 4; ++j)
#pragma unroll
                for (int q = 0; q < 4; ++q) { const int k = 4 * lane + 256 * j + q; const f32x4 a = *(const f32x4*)(RW + k * 8), c = *(const f32x4*)(RW + k * 8 + 4); const float xv = v[j][q];
                    lg[0] += xv * a.x; lg[1] += xv * a.y; lg[2] += xv * a.z; lg[3] += xv * a.w; lg[4] += xv * c.x; lg[5] += xv * c.y; lg[6] += xv * c.z; lg[7] += xv * c.w; }
#pragma unroll
            for (int e = 0; e < 8; ++e) lg[e] = wave_sum(lg[e]);
            int e0 = 0; float v0 = lg[0];
#pragma unroll
            for (int e = 1; e < 8; ++e) if (lg[e] > v0) { v0 = lg[e]; e0 = e; }
            int e1 = -1; float v1 = -3.0e38f;
#pragma unroll
            for (int e = 0; e < 8; ++e) if (e != e0 && lg[e] > v1) { v1 = lg[e]; e1 = e; }
            const float g0 = 1.0f / (1.0f + __expf(v1 - v0)), g1 = 1.0f - g0;
            if (lane == 0) { int* te = (int*)(ws + WS_TOKE) + 2 * m; float* tw = (float*)(ws + WS_TOKW) + 2 * m; te[0] = e0; te[1] = e1; tw[0] = g0; tw[1] = g1;
                atomicAdd((unsigned*)(misc + e0), 1u); atomicAdd((unsigned*)(misc + e1), 1u); }
        }
        if (more) {
#pragma unroll
            for (int j = 0; j < 4; ++j) v[j] = nv[j];
            if (MODE == 2) {
#pragma unroll
                for (int j = 0; j < 4; ++j) { ya[j] = nya[j]; yb[j] = nyb[j]; }
                w0 = nw0; w1 = nw1; np0 = nnp0; np1 = nnp1; nw0 = nnw0; nw1 = nnw1; }
        }
    }
    if (MODE == 1) { __syncthreads(); if (F.tid < 8) ((unsigned*)(ws + WS_HIST))[F.blk * 8 + F.tid] = misc[F.tid]; }
}

__device__ __forceinline__ void p_route(const Frame& F, const Args& A) {
    unsigned char* ws = A.ws;
    LAS unsigned* misc = (LAS unsigned*)(F.lds + LDS_MISC);
    LAS int* posl = (LAS int*)(F.lds + LDS_POS);
    const unsigned* hist = (const unsigned*)(ws + WS_HIST);
    const int lane = F.lane, rpw = NTOK / F.G;
    {
        const int e = F.wave; unsigned tot = 0u, bef = 0u;
        for (int v = lane; v < F.G; v += 64) { const unsigned h = hist[v * 8 + e]; tot += h; if (v < F.blk) bef += h; }
#pragma unroll
        for (int o = 1; o < 64; o <<= 1) { tot += __shfl_xor(tot, o); bef += __shfl_xor(bef, o); }
        if (lane == 0) { misc[16 + e] = tot; misc[24 + e] = bef; }
    }
    __syncthreads();
    int seg[9]; seg[0] = 0;
#pragma unroll
    for (int e = 0; e < 8; ++e) seg[e + 1] = seg[e] + (int)((misc[16 + e] + 255u) >> 8);
    if (F.blk == 0 && F.tid == 0) { int* meta = (int*)(ws + WS_META);
#pragma unroll
        for (int e = 0; e < 9; ++e) meta[e] = seg[e];
        meta[9] = seg[8]; }
    if (F.wave == 0) {
        const int* te = (const int*)(ws + WS_TOKE); int* tp = (int*)(ws + WS_TOKPOS); int* rt = nullptr; (void)rt;
        unsigned run[8];
#pragma unroll
        for (int e = 0; e < 8; ++e) run[e] = (unsigned)seg[e] * 256u + misc[24 + e];
        for (int h = 0; h < rpw; h += 64) {
            const int m = F.blk * rpw + h + lane;
#pragma unroll
            for (int k = 0; k < 2; ++k) {
                const int ek = te[2 * m + k]; int pos = 0;
#pragma unroll
                for (int e = 0; e < 8; ++e) { const unsigned long long mask = __ballot(ek == e);
                    if (ek == e) pos = (int)(run[e] + (unsigned)__popcll(mask & ((1ull << lane) - 1ull)));
                    run[e] += (unsigned)__popcll(mask); }
                tp[2 * m + k] = pos; posl[2 * (h + lane) + k] = pos;
            }
        }
    }
    __syncthreads();
    {
        const float* X = A.out; unsigned char* XS = ws + WS_XS;
        f32x4 a, b, c, d, na, nb, nc, nd;
        { const f32x4* xr = (const f32x4*)(X + (size_t)(F.blk * rpw + F.wave) * DM) + 4 * lane; a = xr[0]; b = xr[1]; c = xr[2]; d = xr[3]; }
        for (int i = F.wave; i < rpw; i += NWAVES) {
            const int m = F.blk * rpw + i; const int p0 = posl[2 * i], p1 = posl[2 * i + 1];
            const bool more = (i + NWAVES < rpw);
            if (more) { const f32x4* xr = (const f32x4*)(X + (size_t)(m + NWAVES) * DM) + 4 * lane; na = xr[0]; nb = xr[1]; nc = xr[2]; nd = xr[3]; }
            asm volatile("" ::: "memory");
            v4u w; w.x = pg8::pk4_fp8(a.x, a.y, a.z, a.w); w.y = pg8::pk4_fp8(b.x, b.y, b.z, b.w); w.z = pg8::pk4_fp8(c.x, c.y, c.z, c.w); w.w = pg8::pk4_fp8(d.x, d.y, d.z, d.w);
            *((v4u*)(XS + (size_t)p0 * DM) + lane) = w; *((v4u*)(XS + (size_t)p1 * DM) + lane) = w;
            if (more) { a = na; b = nb; c = nc; d = nd; }
        }
    }
    if (F.blk < 8) {
        int r0 = 0, r1 = 0;
#pragma unroll
        for (int e = 0; e < 8; ++e) if (e == F.blk) { r0 = seg[e] * 256 + (int)misc[16 + e]; r1 = seg[e + 1] * 256; }
        v4u* XS4 = (v4u*)(ws + WS_XS);
        for (size_t i = (size_t)r0 * 64 + F.tid; i < (size_t)r1 * 64; i += NTHREADS) XS4[i] = (v4u){0u, 0u, 0u, 0u};
    }
}

#ifndef MK_ONE_LAUNCH
#define MK_ONE_LAUNCH 1
#endif
constexpr int PH_MOE = 17, PH_FINAL = PH_MOE + 2 * NPASS, NPHASES = PH_FINAL + 1;

#ifndef PH_MASK
#define PH_MASK 0xFFFFFFFFu
#endif
#ifndef DUP_MASK
#define DUP_MASK 0u
#endif
#define NREP(k) ((((unsigned)DUP_MASK >> (k)) & 1u) ? 2 : 1)
#define IN(k) (((PH_MASK >> (k)) & 1u) && lo <= (k) && (k) < hi)
#define SEAM(k) do { if (MK_ONE_LAUNCH && lo <= (k) && (k) + 1 < hi) xcd_barrier(bar); } while (0)
template <int l>
__device__ __forceinline__ void layer_phases(const Frame& F, const Args& args, const XcdBarrier& bar, const int lo, const int hi) {
    unsigned char* ws = args.ws;
        const int pb = 1 + 9 * l;
        const float* xres = (l == 0) ? args.in[0] : args.out;
        if (IN(pb + 0)) {
            pg8::Gemm g{(const bf16*)(ws + WS_A), (const bf16*)(ws + WS_WIN) + (size_t)l * INC * DM, NTOK, INC, DM, 0};
            pg8::StaticOrder S; S.init(NTOK, INC, F.G, F.blk, NREP(pb + 0));
            pg8::EpiBf16 E{(bf16*)(ws + WS_ZH), INC, 1.0f};
            pg8::gemm_phase<pg8::EpiBf16, pg8::StaticOrder, true, true>(F.lds, g, S, E);
            SEAM(pb + 0);
        }
        if (IN(pb + 1)) for (int rep_ = 0; rep_ < NREP(pb + 1); ++rep_) { p_lru_summary(F, args, l); SEAM(pb + 1); }
        if (IN(pb + 2)) for (int rep_ = 0; rep_ < NREP(pb + 2); ++rep_) { p_lru_carry(F, args); SEAM(pb + 2); }
        if (IN(pb + 3)) for (int rep_ = 0; rep_ < NREP(pb + 3); ++rep_) { p_mixer(F, args, l); SEAM(pb + 3); }
        if (IN(pb + 4)) {
            pg8::Gemm g{(const bf16*)(ws + WS_A), (const bf16*)(ws + WS_WOUT) + (size_t)l * DM * DM, NTOK, DM, DM, 0};
            pg8::StaticOrder S; S.init(NTOK, DM, F.G, F.blk, NREP(pb + 4));
            pg8::EpiResF32 E{xres, args.out, DM, ALPHA, 1.0f};
            pg8::gemm_phase<pg8::EpiResF32, pg8::StaticOrder, true, true>(F.lds, g, S, E);
            SEAM(pb + 4);
        }
        if (l == 0) {
            if (IN(6)) for (int rep_ = 0; rep_ < NREP(6); ++rep_) { p_layernorm<3>(F, args, args.in[14], args.in[15]); SEAM(6); }
            if (IN(7)) {
                pg8::Gemm g{(const bf16*)(ws + WS_A), (const bf16*)(ws + WS_WGU), NTOK, 2 * DFF, DM / 2, 0};
                pg8::StaticOrder S; S.init(NTOK, 2 * DFF, F.G, F.blk, NREP(7));
                pg8::EpiSwiGLU8 E{ws + WS_ZH, DFF, 1.0f / WSC_GU};
                pg8::gemm_phase<pg8::EpiSwiGLU8, pg8::StaticOrder, true, true, true>(F.lds, g, S, E);
                SEAM(7);
            }
            if (IN(8)) {
                pg8::Gemm g{(const bf16*)(ws + WS_ZH), (const bf16*)(ws + WS_WD), NTOK, DM, DFF / 2, 0};
                pg8::StaticOrder S; S.init(NTOK, DM, F.G, F.blk, NREP(8));
                pg8::EpiResF32 E{args.out, args.out, DM, ALPHA, 1.0f / WSC_D};
                pg8::gemm_phase<pg8::EpiResF32, pg8::StaticOrder, true, true, true>(F.lds, g, S, E);
                SEAM(8);
            }
            if (IN(9)) for (int rep_ = 0; rep_ < NREP(9); ++rep_) { p_layernorm<0>(F, args, args.in[23], args.in[24]); SEAM(9); }
        } else {
            if (IN(15)) for (int rep_ = 0; rep_ < NREP(15); ++rep_) { p_layernorm<1>(F, args, args.in[14] + DM, args.in[15] + DM); SEAM(15); }
            if (IN(16)) for (int rep_ = 0; rep_ < NREP(16); ++rep_) { p_route(F, args); SEAM(16); }
            for (int p = 0; p < NPASS; ++p) {
                int s1 = 0, s2 = 0, s3 = 0, s4 = 0, s5 = 0, s6 = 0, s7 = 0, nt = 0;
                if (IN(PH_MOE + 2 * p) || IN(PH_MOE + 1 + 2 * p)) { const int* meta = (const int*)(ws + WS_META);
                    s1 = __builtin_amdgcn_readfirstlane(meta[1]); s2 = __builtin_amdgcn_readfirstlane(meta[2]); s3 = __builtin_amdgcn_readfirstlane(meta[3]); s4 = __builtin_amdgcn_readfirstlane(meta[4]);
                    s5 = __builtin_amdgcn_readfirstlane(meta[5]); s6 = __builtin_amdgcn_readfirstlane(meta[6]); s7 = __builtin_amdgcn_readfirstlane(meta[7]); nt = __builtin_amdgcn_readfirstlane(meta[9]); }
                int nm = nt - PASS_TILES * p; nm = nm > PASS_TILES ? PASS_TILES : nm;
                if (IN(PH_MOE + 2 * p)) {
                    if (nm > 0) {
                        pg8::Gemm g{(const bf16*)(ws + WS_XS + (size_t)p * PASS_TILES * 256 * DM), (const bf16*)(ws + WS_WEGU), nm * 256, 2 * DFE, DM / 2, (size_t)2 * DFE * DM};
                        pg8::MoeOrder S; S.so.init(nm * 256, 2 * DFE, F.G, F.blk, NREP(PH_MOE + 2 * p)); S.tile0 = p * PASS_TILES; S.s1 = s1; S.s2 = s2; S.s3 = s3; S.s4 = s4; S.s5 = s5; S.s6 = s6; S.s7 = s7;
                        pg8::EpiSwiGLU8 E{ws + WS_HM, DFE, 1.0f / WSC_GU};
                        pg8::gemm_phase<pg8::EpiSwiGLU8, pg8::MoeOrder, true, true, true>(F.lds, g, S, E);
                    }
                    SEAM(PH_MOE + 2 * p);
                }
                if (IN(PH_MOE + 1 + 2 * p)) {
                    if (nm > 0) {
                        pg8::Gemm g{(const bf16*)(ws + WS_HM), (const bf16*)(ws + WS_WED), nm * 256, DM, DFE / 2, (size_t)DM * DFE};
                        pg8::MoeOrder S; S.so.init(nm * 256, DM, F.G, F.blk, NREP(PH_MOE + 1 + 2 * p)); S.tile0 = p * PASS_TILES; S.s1 = s1; S.s2 = s2; S.s3 = s3; S.s4 = s4; S.s5 = s5; S.s6 = s6; S.s7 = s7;
                        pg8::EpiBf16 E{(bf16*)(ws + WS_Y2) + (size_t)p * PASS_TILES * 256 * DM, DM, 1.0f / WSC_D};
                        pg8::gemm_phase<pg8::EpiBf16, pg8::MoeOrder, true, true, true>(F.lds, g, S, E);
                    }
                    SEAM(PH_MOE + 1 + 2 * p);
                }
            }
            if (IN(PH_FINAL)) for (int rep_ = 0; rep_ < NREP(PH_FINAL); ++rep_) { p_layernorm<2>(F, args, args.in[23] + DM, args.in[24] + DM); }
        }
}
__global__ void __launch_bounds__(NTHREADS, 2) fwd_kernel(Args args) {
    extern __shared__ __attribute__((aligned(16))) unsigned char lds_raw[];
    Frame F;
    F.lds = (LAS unsigned char*)lds_raw;
    F.tid = threadIdx.x; F.lane = F.tid & 63; F.wave = __builtin_amdgcn_readfirstlane(F.tid >> 6);
    F.G = gridDim.x; F.blk = blockIdx.x;
    unsigned char* ws = args.ws;
    volatile LAS unsigned* MISC = (volatile LAS unsigned*)(F.lds + LDS_MISC);
    if (F.tid < 64) MISC[F.tid] = 0u;
    __syncthreads();
    XcdBarrier bar; bar.bar = (unsigned*)(ws + WS_CTL) + CW_BAR; bar.x = 0; bar.st = nullptr;
    if (MK_ONE_LAUNCH) bar = xcd_barrier_post((unsigned*)(ws + WS_CTL) + CW_BAR, MISC + 8);
    const int lo = args.ph_lo, hi = args.ph_hi;

    if (IN(0)) for (int rep_ = 0; rep_ < NREP(0); ++rep_) { p0_prologue(F, args); SEAM(0); }

    layer_phases<0>(F, args, bar, lo, hi);
    layer_phases<1>(F, args, bar, lo, hi);
}

extern "C" void kernel_launch(void* const* d_in, const int* in_sizes, int n_in, void* d_out, int out_size, void* d_ws, size_t ws_size, hipStream_t stream) {
    static int grid = 0;
    if (grid == 0) {
        if (n_in != 25 || in_sizes[0] != NTOK * DM || out_size != NTOK * DM || ws_size < WS_END) {
            fprintf(stderr, "kernel_launch: unexpected problem: n_in %d in0 %d out %d ws %zu (need %zu)\n", n_in, n_in > 0 ? in_sizes[0] : -1, out_size, ws_size, (size_t)WS_END); grid = -1; return; }
        int dev = 0, cus = 0, per_cu = 0;
        if (hipGetDevice(&dev) != hipSuccess || hipDeviceGetAttribute(&cus, hipDeviceAttributeMultiprocessorCount, dev) != hipSuccess) { fprintf(stderr, "kernel_launch: device query failed\n"); grid = -1; return; }
        if (hipFuncSetAttribute((const void*)fwd_kernel, hipFuncAttributeMaxDynamicSharedMemorySize, LDS_BYTES) != hipSuccess) { fprintf(stderr, "kernel_launch: hipFuncSetAttribute failed\n"); grid = -1; return; }
        if (hipOccupancyMaxActiveBlocksPerMultiprocessor(&per_cu, (const void*)fwd_kernel, NTHREADS, LDS_BYTES) != hipSuccess || per_cu < 1)
            fprintf(stderr, "kernel_launch: note: occupancy query reports %d workgroups per CU\n", per_cu);
        (void)hipGetLastError();
        grid = cus;
        if (grid != 256) fprintf(stderr, "kernel_launch: note: %d CUs (built for 256)\n", grid);
        if (NTOK % grid != 0 || grid > 256) grid = 256;
    }
    if (grid < 0) return;
    (void)hipMemsetAsync((char*)d_ws + WS_CTL, 0, CTL_ZERO_BYTES, stream);
    Args a{};
    for (int i = 0; i < 25; ++i) a.in[i] = (const float*)d_in[i];
    a.out = (float*)d_out; a.ws = (unsigned char*)d_ws;
#if MK_ONE_LAUNCH
    a.ph_lo = 0; a.ph_hi = NPHASES;
    hipLaunchKernelGGL(fwd_kernel, dim3(grid), dim3(NTHREADS), LDS_BYTES, stream, a);
#else
    for (int k = 0; k < NPHASES; ++k) { a.ph_lo = k; a.ph_hi = k + 1; hipLaunchKernelGGL(fwd_kernel, dim3(grid), dim3(NTHREADS), LDS_BYTES, stream, a); }
#endif
    const hipError_t le = hipPeekAtLastError();
    if (le != hipSuccess) fprintf(stderr, "kernel_launch: launch failed: %s\n", hipGetErrorName(le));
}
```

```cpp
#include <hip/hip_runtime.h>
#include <cstdio>
#include <cstdint>
namespace pg8 {
#define PG8_LAS __attribute__((address_space(3)))
typedef unsigned short bf16_t;
typedef short bf16x8 __attribute__((ext_vector_type(8)));
typedef float f32x4 __attribute__((ext_vector_type(4)));
typedef unsigned u32x4 __attribute__((ext_vector_type(4)));
typedef int v4i __attribute__((ext_vector_type(4)));
typedef int v8i __attribute__((ext_vector_type(8)));
constexpr int BM = 256, BK = 64, HALF = 128, HTB = HALF * BK * 2  , STAGE_BYTES = 8 * HTB, NXCD = 8, WGM = 8;

__host__ __device__ __forceinline__ int lds_byte(int r, int c) { const int st = (r >> 4) * 2 + (c >> 5), rr = r & 15, cc = c & 31, ob = rr * 64 + cc * 2; return st * 1024 + (ob ^ (((ob >> 9) & 1) << 5)); }
__host__ __device__ __forceinline__ void stage_rc(int b, int& R, int& C) { const int st = b / 1024, sb = b % 1024, swz = sb ^ (((sb >> 9) & 1) << 5); R = (st >> 1) * 16 + swz / 64; C = (st & 1) * 32 + (swz % 64) / 2; }
__host__ __device__ __forceinline__ int perm32(int rho) { const int n = rho >> 4, i = rho & 15; return 8 * (i >> 2) + 4 * n + (i & 3); }

struct Unit { int pm, pn, be; };
struct Gemm { const bf16_t* A; const bf16_t* Bt; int M, N, K; size_t bstride; };

struct StaticOrder {
    int nM, nN, nwg, G, c, rep;
    __host__ __device__ void init(int M, int N, int G_, int c_, int rep_ = 1) { nM = M / BM; nN = N / BM; nwg = nM * nN; G = G_; c = c_; rep = rep_; }
    __host__ __device__ bool next(int i, Unit& u) const {
        const long L = (long)i * G + c; if (L >= (long)nwg * rep) return false;
        int wgid = (int)(L % nwg); { const int q = nwg / NXCD, r = nwg % NXCD, xcd = wgid % NXCD, off = wgid / NXCD; wgid = (xcd < r ? xcd * (q + 1) : r * (q + 1) + (xcd - r) * q) + off; }
        const int nig = WGM * nN, gid = wgid / nig, fm = gid * WGM, gsz = (nM - fm) < WGM ? (nM - fm) : WGM;
        u.pm = fm + ((wgid % nig) % gsz); u.pn = (wgid % nig) / gsz; u.be = 0; return true;
    }
    __device__ __forceinline__ void a_ready(const Unit&) const {}
    __device__ __forceinline__ void done(const Unit&) const {}
};
struct MoeOrder {
    StaticOrder so; int tile0, s1, s2, s3, s4, s5, s6, s7;
    __device__ __forceinline__ bool next(int i, Unit& u) const {
        if (!so.next(i, u)) return false;
        const int t = tile0 + u.pm;
        u.be = (t >= s1) + (t >= s2) + (t >= s3) + (t >= s4) + (t >= s5) + (t >= s6) + (t >= s7); return true;
    }
    __device__ __forceinline__ void a_ready(const Unit&) const {}
    __device__ __forceinline__ void done(const Unit&) const {}
};

__device__ __forceinline__ unsigned cvt_pk_bf16(float lo, float hi) { unsigned r; asm volatile("v_cvt_pk_bf16_f32 %0, %1, %2" : "=v"(r) : "v"(lo), "v"(hi)); return r; }

struct EpiBf16 {
    static constexpr bool PERM = true, AFTER_DRAIN = false;
    bf16_t* O; int ldc; float scale;
    __device__ __forceinline__ void operator()(const f32x4 (&acc)[2][2][4][2], const Unit& u, int wr, int wc, int fr, int fq) const {
        const int row0 = u.pm * BM + wr * 64 + fr, col0 = u.pn * BM + wc * 32 + 8 * fq;
#pragma unroll
        for (int ai = 0; ai < 2; ++ai)
#pragma unroll
            for (int m = 0; m < 4; ++m) { bf16_t* rowp = O + (size_t)(row0 + ai * HALF + m * 16) * ldc + col0;
#pragma unroll
                for (int bj = 0; bj < 2; ++bj) { const f32x4 v0 = acc[ai][bj][m][0] * scale, v1 = acc[ai][bj][m][1] * scale;
                    u32x4 w; w.x = cvt_pk_bf16(v0[0], v0[1]); w.y = cvt_pk_bf16(v0[2], v0[3]); w.z = cvt_pk_bf16(v1[0], v1[1]); w.w = cvt_pk_bf16(v1[2], v1[3]);
                    *(u32x4*)(rowp + bj * HALF) = w; } }
    }
};
__device__ __forceinline__ float silu_mul(float g, float u) { return g * u * __builtin_amdgcn_rcpf(1.0f + __builtin_amdgcn_exp2f(g * -1.4426950408889634f)); }
struct EpiSwiGLU {
    static constexpr bool PERM = true, AFTER_DRAIN = false;
    bf16_t* H; int ldh;
    __device__ __forceinline__ void operator()(const f32x4 (&acc)[2][2][4][2], const Unit& u, int wr, int wc, int fr, int fq) const {
        const int row0 = u.pm * BM + wr * 64 + fr, col0 = u.pn * HALF + wc * 32 + 8 * fq;
#pragma unroll
        for (int ai = 0; ai < 2; ++ai)
#pragma unroll
            for (int m = 0; m < 4; ++m) { bf16_t* rowp = H + (size_t)(row0 + ai * HALF + m * 16) * ldh + col0;
                const f32x4 g0 = acc[ai][0][m][0], g1 = acc[ai][0][m][1], u0 = acc[ai][1][m][0], u1 = acc[ai][1][m][1];
                u32x4 w; w.x = cvt_pk_bf16(silu_mul(g0[0], u0[0]), silu_mul(g0[1], u0[1])); w.y = cvt_pk_bf16(silu_mul(g0[2], u0[2]), silu_mul(g0[3], u0[3]));
                w.z = cvt_pk_bf16(silu_mul(g1[0], u1[0]), silu_mul(g1[1], u1[1])); w.w = cvt_pk_bf16(silu_mul(g1[2], u1[2]), silu_mul(g1[3], u1[3]));
                *(u32x4*)rowp = w; }
    }
};
__device__ __forceinline__ unsigned pk4_fp8(float a, float b, float c, float d) { int w = __builtin_amdgcn_cvt_pk_fp8_f32(a, b, 0, false); w = __builtin_amdgcn_cvt_pk_fp8_f32(c, d, w, true); return (unsigned)w; }
struct EpiSwiGLU8 {
    static constexpr bool PERM = true, AFTER_DRAIN = false;
    unsigned char* H; int ldh; float sc;
    __device__ __forceinline__ void operator()(const f32x4 (&acc)[2][2][4][2], const Unit& u, int wr, int wc, int fr, int fq) const {
        const int row0 = u.pm * BM + wr * 64 + fr, col0 = u.pn * HALF + wc * 32 + 8 * fq;
        typedef unsigned u32x2 __attribute__((ext_vector_type(2)));
#pragma unroll
        for (int ai = 0; ai < 2; ++ai)
#pragma unroll
            for (int m = 0; m < 4; ++m) { unsigned char* rowp = H + (size_t)(row0 + ai * HALF + m * 16) * ldh + col0;
                const f32x4 g0 = acc[ai][0][m][0] * sc, g1 = acc[ai][0][m][1] * sc, u0 = acc[ai][1][m][0] * sc, u1 = acc[ai][1][m][1] * sc;
                u32x2 w; w.x = pk4_fp8(silu_mul(g0[0], u0[0]), silu_mul(g0[1], u0[1]), silu_mul(g0[2], u0[2]), silu_mul(g0[3], u0[3]));
                w.y = pk4_fp8(silu_mul(g1[0], u1[0]), silu_mul(g1[1], u1[1]), silu_mul(g1[2], u1[2]), silu_mul(g1[3], u1[3]));
                *(u32x2*)rowp = w; }
    }
};
struct EpiResF32 {
    static constexpr bool PERM = false, AFTER_DRAIN = false;
    const float* res; float* out; int ldc; float alpha, scale;
    __device__ __forceinline__ void operator()(const f32x4 (&acc)[2][2][4][2], const Unit& u, int wr, int wc, int fr, int fq) const {
        const int row0 = u.pm * BM + wr * 64 + fr, col0 = u.pn * BM + wc * 32 + 4 * fq;
#pragma unroll
        for (int ai = 0; ai < 2; ++ai)
#pragma unroll
            for (int m = 0; m < 4; ++m) { const size_t off = (size_t)(row0 + ai * HALF + m * 16) * ldc + col0;
                f32x4 rv[2][2];
#pragma unroll
                for (int bj = 0; bj < 2; ++bj)
#pragma unroll
                    for (int n = 0; n < 2; ++n) rv[bj][n] = *(const f32x4*)(res + off + bj * HALF + n * 16);
#pragma unroll
                for (int bj = 0; bj < 2; ++bj)
#pragma unroll
                    for (int n = 0; n < 2; ++n) *(f32x4*)(out + off + bj * HALF + n * 16) = rv[bj][n] * alpha + acc[ai][bj][m][n] * scale;
                asm volatile("" ::: "memory"); }
    }
};

__device__ __forceinline__ void mfma8(f32x4& c, const v8i a, const v8i b, const int scl) { asm volatile("v_mfma_scale_f32_16x16x128_f8f6f4 %0, %1, %2, %0, %3, %3 op_sel_hi:[0,0,0]" : "+v"(c) : "v"(a), "v"(b), "v"(scl)); }
template <class Epi, class Sched, bool ALIGN_EPI = false, bool SP2 = false, bool FP8 = false>
__device__ __forceinline__ void gemm_phase(PG8_LAS unsigned char* lds, const Gemm g, const Sched& S, const Epi& E) {
    const int tid = threadIdx.x, wid = __builtin_amdgcn_readfirstlane(tid >> 6), lane = tid & 63, wr = wid >> 2, wc = wid & 3, fr = lane & 15, fq = lane >> 4;
    const int K = g.K, nt = K / BK;
    unsigned voffA[2], voffB[2];
#pragma unroll
    for (int i = 0; i < 2; ++i) { int R, C; stage_rc(tid * 16 + i * 8192, R, C); const int Rb = Epi::PERM ? ((R & ~31) + perm32(R & 31)) : R;
        voffA[i] = (unsigned)(R * K + C) * 2u; voffB[i] = (unsigned)(Rb * K + C) * 2u; }
    const size_t kstep = (size_t)(BK * 2);
    const size_t hstep = (size_t)HALF * K * 2;
    const size_t tstep = 2 * hstep;
    const unsigned ldsw = (unsigned)wid * 1024u;
    const int aoff = lds_byte(wr * 64 + fr, fq * 8), boff = lds_byte(wc * 32 + fr, fq * 8);
#define PG8_SA(b, h) (((b) * 2 + (h)) * HTB)
#define PG8_SB(b, h) ((4 + (b) * 2 + (h)) * HTB)
#define PG8_STAGE(bufoff, gbase, voff) do { _Pragma("unroll") for (int _i = 0; _i < 2; ++_i) \
        __builtin_amdgcn_global_load_lds((const unsigned*)((const char*)(gbase) + (voff)[_i]), (PG8_LAS unsigned*)(lds + (bufoff) + ldsw + _i * 8192), 16, 0, 0); } while (0)
#define PG8_LDA(dst, b, h) do { if constexpr (FP8) { _Pragma("unroll") for (int m = 0; m < 4; ++m) { dst##8[m][0] = *(const PG8_LAS v4i*)(lds + PG8_SA(b, h) + aoff + m * 2048); dst##8[m][1] = *(const PG8_LAS v4i*)(lds + PG8_SA(b, h) + aoff + m * 2048 + 1024); } } \
    else { _Pragma("unroll") for (int m = 0; m < 4; ++m) _Pragma("unroll") for (int k = 0; k < 2; ++k) dst[m][k] = *(const PG8_LAS bf16x8*)(lds + PG8_SA(b, h) + aoff + m * 2048 + k * 1024); } } while (0)
#define PG8_LDB(dst, b, h) do { if constexpr (FP8) { _Pragma("unroll") for (int n = 0; n < 2; ++n) { dst##8[n][0] = *(const PG8_LAS v4i*)(lds + PG8_SB(b, h) + boff + n * 2048); dst##8[n][1] = *(const PG8_LAS v4i*)(lds + PG8_SB(b, h) + boff + n * 2048 + 1024); } } \
    else { _Pragma("unroll") for (int n = 0; n < 2; ++n) _Pragma("unroll") for (int k = 0; k < 2; ++k) dst[n][k] = *(const PG8_LAS bf16x8*)(lds + PG8_SB(b, h) + boff + n * 2048 + k * 1024); } } while (0)
#define PG8_MMA(ai, bj, At, Bt) do { __builtin_amdgcn_s_setprio(1); if constexpr (FP8) { _Pragma("unroll") for (int m = 0; m < 4; ++m) _Pragma("unroll") for (int n = 0; n < 2; ++n) \
        mfma8(acc[ai][bj][m][n], __builtin_shufflevector(Bt##8[n][0], Bt##8[n][1], 0, 1, 2, 3, 4, 5, 6, 7), __builtin_shufflevector(At##8[m][0], At##8[m][1], 0, 1, 2, 3, 4, 5, 6, 7), scl8); } \
    else { _Pragma("unroll") for (int m = 0; m < 4; ++m) _Pragma("unroll") for (int n = 0; n < 2; ++n) _Pragma("unroll") for (int k = 0; k < 2; ++k) \
        acc[ai][bj][m][n] = __builtin_amdgcn_mfma_f32_16x16x32_bf16(Bt[n][k], At[m][k], acc[ai][bj][m][n], 0, 0, 0); } __builtin_amdgcn_s_setprio(0); } while (0)
#define PG8_WAIT_V(n) asm volatile("s_waitcnt vmcnt(" #n ")" ::: "memory")
#define PG8_WAIT_L(n) asm volatile("s_waitcnt lgkmcnt(" #n ")" ::: "memory")
#define PG8_BAR __builtin_amdgcn_s_barrier()
#define PG8_SCHED __builtin_amdgcn_sched_barrier(0)
    Unit cur, nxt; int ui = 0;
    if (!S.next(0, cur)) return;
    f32x4 acc[2][2][4][2];
#pragma unroll
    for (int a = 0; a < 2; ++a)
#pragma unroll
        for (int b = 0; b < 2; ++b)
#pragma unroll
            for (int m = 0; m < 4; ++m)
#pragma unroll
                for (int n = 0; n < 2; ++n) acc[a][b][m][n] = (f32x4){0.f, 0.f, 0.f, 0.f};
    bf16x8 At[4][2], B0[2][2], B1[2][2];
    v4i At8[4][2], B08[2][2], B18[2][2];
    int scl8 = 0x7F7F7F7F; asm volatile("" : "+v"(scl8));
    const char* cA = (const char*)g.A + (size_t)cur.pm * tstep; const char* cB = (const char*)g.Bt + (size_t)cur.be * g.bstride + (size_t)cur.pn * tstep;
    S.a_ready(cur);
    if constexpr (SP2) {
        PG8_STAGE(PG8_SB(0, 0), cB, voffB); PG8_STAGE(PG8_SB(0, 1), cB + hstep, voffB); PG8_STAGE(PG8_SA(0, 0), cA, voffA); PG8_STAGE(PG8_SA(0, 1), cA + hstep, voffA);
        if (wr == 1) PG8_BAR;
        PG8_WAIT_V(2); PG8_BAR;
        PG8_STAGE(PG8_SB(1, 0), cB + kstep, voffB); PG8_STAGE(PG8_SA(1, 0), cA + kstep, voffA); PG8_STAGE(PG8_SB(1, 1), cB + hstep + kstep, voffB);
        PG8_WAIT_V(6); PG8_BAR;
    } else {
        PG8_STAGE(PG8_SB(0, 0), cB, voffB); PG8_STAGE(PG8_SA(0, 0), cA, voffA); PG8_STAGE(PG8_SB(0, 1), cB + hstep, voffB); PG8_STAGE(PG8_SA(0, 1), cA + hstep, voffA);
        if (wr == 1) PG8_BAR;
        PG8_WAIT_V(4); PG8_BAR;
        PG8_STAGE(PG8_SB(1, 0), cB + kstep, voffB); PG8_STAGE(PG8_SA(1, 0), cA + kstep, voffA); PG8_STAGE(PG8_SB(1, 1), cB + hstep + kstep, voffB);
        PG8_WAIT_V(6); PG8_BAR;
    }
    for (;;) {
        const bool has_next = S.next(ui + 1, nxt);
        const char* nA = has_next ? (const char*)g.A + (size_t)nxt.pm * tstep : cA; const char* nB = has_next ? (const char*)g.Bt + (size_t)nxt.be * g.bstride + (size_t)nxt.pn * tstep : cB;
#pragma unroll 1
        for (int t = 0; t < nt; t += 2) {
            const bool last = (t == nt - 2);
            const char* a1 = cA + (size_t)(t + 1) * kstep;
            const char* a2 = last ? nA : cA + (size_t)(t + 2) * kstep; const char* b2 = last ? nB : cB + (size_t)(t + 2) * kstep;
            const char* a3 = a2 + kstep; const char* b3 = b2 + kstep;
            if (last && has_next) S.a_ready(nxt);
            if constexpr (SP2) {
            PG8_LDB(B0, 0, 0); PG8_LDB(B1, 0, 1); PG8_SCHED; PG8_LDA(At, 0, 0); PG8_STAGE(PG8_SA(1, 1), a1 + hstep, voffA);
            PG8_WAIT_V(8); PG8_WAIT_L(0); PG8_BAR; PG8_MMA(0, 0, At, B0); PG8_MMA(0, 1, At, B1); PG8_BAR; PG8_SCHED;
            PG8_LDA(At, 0, 1); PG8_STAGE(PG8_SB(0, 0), b2, voffB); PG8_STAGE(PG8_SB(0, 1), b2 + hstep, voffB); PG8_STAGE(PG8_SA(0, 0), a2, voffA);
            PG8_WAIT_V(8); PG8_WAIT_L(0); PG8_BAR; PG8_MMA(1, 0, At, B0); PG8_MMA(1, 1, At, B1); PG8_BAR; PG8_SCHED;
            PG8_LDB(B0, 1, 0); PG8_LDB(B1, 1, 1); PG8_SCHED; PG8_LDA(At, 1, 0); PG8_STAGE(PG8_SA(0, 1), a2 + hstep, voffA);
            PG8_WAIT_V(8); PG8_WAIT_L(0); PG8_BAR; PG8_MMA(0, 0, At, B0); PG8_MMA(0, 1, At, B1); PG8_BAR; PG8_SCHED;
            PG8_LDA(At, 1, 1); PG8_STAGE(PG8_SB(1, 0), b3, voffB); PG8_STAGE(PG8_SB(1, 1), b3 + hstep, voffB); PG8_STAGE(PG8_SA(1, 0), a3, voffA);
            PG8_WAIT_V(8); PG8_WAIT_L(0); PG8_BAR; PG8_MMA(1, 0, At, B0); PG8_MMA(1, 1, At, B1); PG8_BAR; PG8_SCHED;
            } else {
            PG8_LDB(B0, 0, 0); PG8_SCHED; PG8_LDA(At, 0, 0); PG8_STAGE(PG8_SA(1, 1), a1 + hstep, voffA);
            PG8_WAIT_L(8); PG8_BAR; PG8_WAIT_L(0); PG8_MMA(0, 0, At, B0); PG8_BAR; PG8_SCHED;
            PG8_LDB(B1, 0, 1); PG8_STAGE(PG8_SB(0, 0), b2, voffB);
            PG8_BAR; PG8_WAIT_L(0); PG8_MMA(0, 1, At, B1); PG8_BAR;
            PG8_LDA(At, 0, 1); PG8_STAGE(PG8_SA(0, 0), a2, voffA);
            PG8_BAR; PG8_WAIT_L(0); PG8_MMA(1, 0, At, B0); PG8_BAR; PG8_SCHED;
            PG8_STAGE(PG8_SB(0, 1), b2 + hstep, voffB);
            PG8_WAIT_V(6); PG8_BAR; PG8_MMA(1, 1, At, B1); PG8_BAR;
            PG8_LDB(B0, 1, 0); PG8_SCHED; PG8_LDA(At, 1, 0); PG8_STAGE(PG8_SA(0, 1), a2 + hstep, voffA);
            PG8_WAIT_L(8); PG8_BAR; PG8_WAIT_L(0); PG8_MMA(0, 0, At, B0); PG8_BAR; PG8_SCHED;
            PG8_LDB(B1, 1, 1); PG8_STAGE(PG8_SB(1, 0), b3, voffB);
            PG8_BAR; PG8_WAIT_L(0); PG8_MMA(0, 1, At, B1); PG8_BAR;
            PG8_LDA(At, 1, 1); PG8_STAGE(PG8_SA(1, 0), a3, voffA);
            PG8_BAR; PG8_WAIT_L(0); PG8_MMA(1, 0, At, B0); PG8_BAR; PG8_SCHED;
            PG8_STAGE(PG8_SB(1, 1), b3 + hstep, voffB);
            PG8_WAIT_V(6); PG8_BAR; PG8_MMA(1, 1, At, B1); PG8_BAR;
            }
        }
        if constexpr (FP8) asm volatile("s_nop 15\n\ts_nop 15" ::: "memory");
        if constexpr (ALIGN_EPI) { if (wr == 0) PG8_BAR; }
        if constexpr (!Epi::AFTER_DRAIN) { E(acc, cur, wr, wc, fr, fq); S.done(cur); }
        if (!has_next) break;
#pragma unroll
        for (int a = 0; a < 2; ++a)
#pragma unroll
            for (int b = 0; b < 2; ++b)
#pragma unroll
                for (int m = 0; m < 4; ++m)
#pragma unroll
                    for (int n = 0; n < 2; ++n) acc[a][b][m][n] = (f32x4){0.f, 0.f, 0.f, 0.f};
        cur = nxt; cA = nA; cB = nB; ++ui;
        if constexpr (ALIGN_EPI) { if (wr == 1) PG8_BAR; }
    }
    PG8_WAIT_V(0);
    if constexpr (!ALIGN_EPI) { if (wr == 0) PG8_BAR; }
    PG8_BAR;
    if constexpr (Epi::AFTER_DRAIN) { E.fused(acc, cur, wr, wc, fr, fq, lds, wid, lane); S.done(cur); }
#undef PG8_SA
#undef PG8_SB
#undef PG8_STAGE
#undef PG8_LDA
#undef PG8_LDB
#undef PG8_MMA
#undef PG8_WAIT_V
#undef PG8_WAIT_L
#undef PG8_BAR
#undef PG8_SCHED
}
}

constexpr int BATCH = 2, SEQ = 16384, DM = 1024, NTOK = BATCH * SEQ;
constexpr int CHK = 64, NCHUNK = SEQ / CHK;
constexpr int INC = 1792, KOFF = 512, VOFF = 640, XBOFF = 768, GBOFF = 1280;
constexpr int LRUW = 512, DFF = 2816, DFE = 3584, NEXP = 8;
constexpr int MAXTILES = 264, PASS_TILES = 128, NPASS = 3;
constexpr float ALPHA = 1.41421356237309515f, LN_EPS = 1e-5f, RMS_EPS = 1e-6f, LOG2E = 1.4426950408889634f, QSCALE = 0.125f * LOG2E;
constexpr int NWAVES = 8, NTHREADS = 512;

constexpr size_t MiB = 1u << 20;
constexpr size_t WS_CTL = 0, CTL_ZERO_BYTES = 64 * 1024;
constexpr size_t WS_LUT = 1 * MiB;
constexpr size_t WS_GATEW = 1 * MiB + 64 * 1024;
constexpr size_t WS_HIST = 1 * MiB + 512 * 1024;
constexpr size_t WS_META = 1 * MiB + 576 * 1024;
constexpr size_t WS_TOKE = 2 * MiB, WS_TOKW = 2 * MiB + 256 * 1024, WS_TOKPOS = 2 * MiB + 512 * 1024;
constexpr size_t WS_LRUP = 3 * MiB, WS_LRUE = 4 * MiB, WS_HIN = 5 * MiB;
constexpr size_t WS_WEGU = 8 * MiB, WS_WED = 64 * MiB;
constexpr size_t WS_WIN = 92 * MiB, WS_WOUT = 99 * MiB, WS_WGU = 103 * MiB, WS_WD = 114 * MiB;
constexpr size_t WS_A = 120 * MiB;
constexpr size_t WS_ZH = 184 * MiB;
constexpr size_t WS_HL = 296 * MiB, WS_PA = 328 * MiB;
constexpr size_t WS_XS = 120 * MiB;
constexpr size_t WS_Y2 = 186 * MiB;
constexpr size_t WS_HM = 318 * MiB;
constexpr size_t WS_END = 430 * MiB;
constexpr float WSC_GU = 64.0f, WSC_D = 256.0f;
static_assert(WS_WED + (size_t)NEXP * DM * DFE <= WS_WIN && WS_WD + (size_t)DM * DFF * 2 <= WS_A && WS_A + (size_t)NTOK * DM * 2 <= WS_ZH && WS_ZH + (size_t)NTOK * DFF * 2 <= WS_END, "ws map");
static_assert(WS_ZH + (size_t)NTOK * INC * 2 <= WS_HL && WS_HL + (size_t)NTOK * LRUW * 2 <= WS_PA && WS_PA + (size_t)NTOK * LRUW * 2 <= WS_ZH + (size_t)NTOK * DFF * 2, "ws map (LRU)");
static_assert(WS_XS + (size_t)MAXTILES * 256 * DM <= WS_Y2 && WS_Y2 + (size_t)MAXTILES * 256 * DM * 2 <= WS_HM && WS_HM + (size_t)PASS_TILES * 256 * DFE <= WS_END, "ws map (MoE)");
constexpr int CW_BAR = 0;

constexpr int RING_BYTES = 131072;
constexpr int LDS_LUT = RING_BYTES;
constexpr int LDS_CTAB = LDS_LUT + 8192;
constexpr int CT_CB = 4 * 512, CT_BR = 5 * 512, CT_BI = 6 * 512, CT_SP = 7 * 512;
constexpr int LDS_MISC = LDS_CTAB + 16384;
constexpr int LDS_POS = LDS_MISC + 256;
constexpr int LDS_BYTES = 159744;
static_assert(LDS_POS + 1024 <= LDS_BYTES, "LDS map");

#define GAS __attribute__((address_space(1)))
#define LAS __attribute__((address_space(3)))
typedef unsigned short bf16;
typedef unsigned v4u __attribute__((ext_vector_type(4)));
typedef unsigned v2u __attribute__((ext_vector_type(2)));
typedef float f32x4 __attribute__((ext_vector_type(4)));
typedef float f32x16 __attribute__((ext_vector_type(16)));
typedef short bf16x8 __attribute__((ext_vector_type(8)));
typedef short s16x4 __attribute__((ext_vector_type(4)));
#define LDS_WAIT() asm volatile("s_waitcnt lgkmcnt(0)" ::: "memory")
#define VM_WAIT() asm volatile("s_waitcnt vmcnt(0)" ::: "memory")
__device__ __forceinline__ unsigned pk2(float lo, float hi) { return pg8::cvt_pk_bf16(lo, hi); }
__device__ __forceinline__ float bf2f(unsigned short h) { return __uint_as_float((unsigned)h << 16); }
__device__ __forceinline__ float bflo(unsigned w) { return __uint_as_float(w << 16); }
__device__ __forceinline__ float bfhi(unsigned w) { return __uint_as_float(w & 0xffff0000u); }
__device__ __forceinline__ float wave_sum(float v) {
#pragma unroll
    for (int o = 1; o < 64; o <<= 1) v += __shfl_xor(v, o);
    return v;
}
__device__ __forceinline__ float fast_sigmoid(float x) { return __builtin_amdgcn_rcpf(1.0f + __builtin_amdgcn_exp2f(x * -LOG2E)); }
__device__ __forceinline__ float gelu_tanh(float x) {
    const float t = 1.5957691216057308f * (x + 0.044715f * x * x * x);
    return x * fast_sigmoid(t);
}

#define XB_TMO      128
#define XB_XCNT(j)  (256  + 64 * (j))
#define XB_XSUB(j)  (1280 + 64 * (j))
#define XB_XGEN(j)  (2304 + 64 * (j))
#define XB_TOP      3328
#define XB_TOPGEN   3392
#define XCD_BAR_WORDS 3456
#define XB_SPIN_CAP (1u << 18)

__device__ __forceinline__ unsigned xb_ld(unsigned* p)              { return __hip_atomic_load(p, __ATOMIC_RELAXED, __HIP_MEMORY_SCOPE_AGENT); }
__device__ __forceinline__ unsigned xb_add(unsigned* p, unsigned v) { return __hip_atomic_fetch_add(p, v, __ATOMIC_RELAXED, __HIP_MEMORY_SCOPE_AGENT); }
__device__ __forceinline__ unsigned xb_xcc_id() { return (unsigned)__builtin_amdgcn_s_getreg((3 << 11) | 20) & 0xFu; }
#define XB_SPIN(cond, bar) do { unsigned _sp = 0; while (cond) { __builtin_amdgcn_s_sleep(1); \
    if ((++_sp & 255u) == 0u) { if (xb_ld(&(bar)[XB_TMO])) break; if (_sp > XB_SPIN_CAP) { atomicAdd(&(bar)[XB_TMO], 1u); break; } } } } while (0)

struct XcdBarrier {
    unsigned* bar; unsigned x;
    volatile LAS unsigned* st;
};

__device__ __forceinline__ XcdBarrier xcd_barrier_post(unsigned* bar, volatile LAS unsigned* st) {
    XcdBarrier b; b.bar = bar; b.x = xb_xcc_id(); b.st = st;
    if (threadIdx.x == 0) (void)xb_add(&bar[XB_XCNT(b.x)], 1u);
    return b;
}
__device__ __forceinline__ void xcd_barrier_complete(unsigned* bar, unsigned x, unsigned& nloc, unsigned& nx) {
    const unsigned G = gridDim.x * gridDim.y * gridDim.z;
    unsigned sum, cnt, mine, sp = 0u;
    for (;;) {
        sum = 0u; cnt = 0u; mine = 0u;
#pragma unroll
        for (unsigned j = 0; j < 16; ++j) { const unsigned c = xb_ld(&bar[XB_XCNT(j)]); sum += c; cnt += (c > 0u) ? 1u : 0u; mine = (j == x) ? c : mine; }
        if (sum == G) break;
        __builtin_amdgcn_s_sleep(1);
        if ((++sp & 255u) == 0u) { if (xb_ld(&bar[XB_TMO])) break; if (sp > XB_SPIN_CAP) { atomicAdd(&bar[XB_TMO], 1u); break; } }
    }
    nloc = mine > 0u ? mine : 1u; nx = cnt > 0u ? cnt : 1u;
}

__device__ __forceinline__ void xcd_barrier(const XcdBarrier& b) {
    asm volatile("s_waitcnt vmcnt(0)" ::: "memory");
    __syncthreads();
    if (threadIdx.x == 0) {
        unsigned* bar = b.bar;
        __builtin_amdgcn_s_waitcnt(0);
        unsigned nloc = b.st[0], nx = b.st[1];
        if (nloc == 0u) { xcd_barrier_complete(bar, b.x, nloc, nx); b.st[0] = nloc; b.st[1] = nx; }
        const unsigned old = xb_add(&bar[XB_XSUB(b.x)], 1u);
        const unsigned gen = old / nloc;
        if (old + 1u == (gen + 1u) * nloc) {
            __builtin_amdgcn_fence(__ATOMIC_RELEASE, "agent");
            asm volatile("s_waitcnt vmcnt(0)" ::: "memory");
            const unsigned og = xb_add(&bar[XB_TOP], 1u);
            const unsigned tg = og / nx;
            if (og + 1u == (tg + 1u) * nx) xb_add(&bar[XB_TOPGEN], 1u);
            else XB_SPIN(xb_ld(&bar[XB_TOPGEN]) == tg, bar);
            __builtin_amdgcn_fence(__ATOMIC_ACQUIRE, "agent");
            xb_add(&bar[XB_XGEN(b.x)], 1u);
            asm volatile("s_waitcnt vmcnt(0)" ::: "memory");
        } else {
            XB_SPIN(xb_ld(&bar[XB_XGEN(b.x)]) == gen, bar);
            __builtin_amdgcn_fence(__ATOMIC_ACQUIRE, "agent");
            asm volatile("s_waitcnt vmcnt(0)" ::: "memory");
        }
    }
    __syncthreads();
}

struct Args { const float* in[25]; float* out; unsigned char* ws; int ph_lo, ph_hi; };
struct Frame {
    LAS unsigned char* lds;
    int tid, lane, wave, G, blk;
};

__device__ __forceinline__ void p0_transpose_item(const float* W, int K, int N, bf16* WT, int mode, const float* ksA, const float* ksB, float nscale, int nscale_cols, LAS float* scr, int item, int lane) {
    const int nblk = N / 32, kb = item / nblk, nb = item % nblk, k0 = 64 * kb, n0 = 32 * nb;
    const float* ks = ksA ? (k0 < 512 ? ksA + k0 : ksB + (k0 - 512)) : nullptr;
#pragma unroll
    for (int i = 0; i < 32; ++i) { const int kk = 2 * i + (lane >> 5); float v = W[(size_t)(k0 + kk) * N + n0 + (lane & 31)]; if (ks) v *= ks[kk]; scr[kk * 33 + (lane & 31)] = v; }
    LDS_WAIT(); asm volatile("" ::: "memory");
    const int drow0 = (mode == 0) ? n0 : ((n0 >> 7) * 256 + (n0 & 127) + (mode == 2 ? 128 : 0));
    const float sc = (n0 < nscale_cols) ? nscale : 1.0f;
    const int c = lane & 7;
#pragma unroll
    for (int j = 0; j < 4; ++j) { const int n = (lane >> 3) + 8 * j; const LAS float* s = scr + (8 * c) * 33 + n;
        v4u o; o.x = pk2(s[0 * 33] * sc, s[1 * 33] * sc); o.y = pk2(s[2 * 33] * sc, s[3 * 33] * sc); o.z = pk2(s[4 * 33] * sc, s[5 * 33] * sc); o.w = pk2(s[6 * 33] * sc, s[7 * 33] * sc);
        *(v4u*)(WT + (size_t)(drow0 + n) * K + k0 + 8 * c) = o; }
    LDS_WAIT(); asm volatile("" ::: "memory");
}
__device__ __forceinline__ void p0_transpose_item_f8(const float* W, int K, int N, unsigned char* WT, int mode, float scale, LAS float* scr, int item, int lane) {
    const int nblk = N / 32, kb = item / nblk, nb = item % nblk, k0 = 64 * kb, n0 = 32 * nb;
#pragma unroll
    for (int i = 0; i < 32; ++i) { const int kk = 2 * i + (lane >> 5); scr[kk * 33 + (lane & 31)] = W[(size_t)(k0 + kk) * N + n0 + (lane & 31)] * scale; }
    LDS_WAIT(); asm volatile("" ::: "memory");
    const int drow0 = (mode == 0) ? n0 : ((n0 >> 7) * 256 + (n0 & 127) + (mode == 2 ? 128 : 0));
    const int c = lane & 3;
#pragma unroll
    for (int j = 0; j < 2; ++j) { const int n = (lane >> 2) + 16 * j; const LAS float* s = scr + (16 * c) * 33 + n;
        v4u o; o.x = pg8::pk4_fp8(s[0 * 33], s[1 * 33], s[2 * 33], s[3 * 33]); o.y = pg8::pk4_fp8(s[4 * 33], s[5 * 33], s[6 * 33], s[7 * 33]);
        o.z = pg8::pk4_fp8(s[8 * 33], s[9 * 33], s[10 * 33], s[11 * 33]); o.w = pg8::pk4_fp8(s[12 * 33], s[13 * 33], s[14 * 33], s[15 * 33]);
        *(v4u*)(WT + (size_t)(drow0 + n) * K + k0 + 16 * c) = o; }
    LDS_WAIT(); asm volatile("" ::: "memory");
}
__device__ __forceinline__ int t5_bucket(int rel) {
    const int n = rel < 0 ? -rel : rel;
    int v;
    if (n < 8) v = n;
    else { v = 8 + (n >= 12) + (n >= 16) + (n >= 23) + (n >= 32) + (n >= 46) + (n >= 64) + (n >= 91); }
    return (rel > 0 ? 16 : 0) + v;
}
__device__ __forceinline__ void p0_prologue(const Frame& F, const Args& A) {
    unsigned char* ws = A.ws;
    LAS float* scr = (LAS float*)(F.lds + F.wave * 8448);
    const int gw = F.blk * NWAVES + F.wave, NGW = F.G * NWAVES;
    bf16* WIN = (bf16*)(ws + WS_WIN); bf16* WOUT = (bf16*)(ws + WS_WOUT); bf16* WGU = (bf16*)(ws + WS_WGU); bf16* WD = (bf16*)(ws + WS_WD);
    unsigned char* WEGU = ws + WS_WEGU; unsigned char* WED = ws + WS_WED;
    constexpr int I_IN = (DM / 64) * (INC / 32), I_OUT = (DM / 64) * (DM / 32), I_GU = (DM / 64) * (DFF / 32), I_D = (DFF / 64) * (DM / 32);
    constexpr int I_EGU = (DM / 64) * (DFE / 32), I_ED = (DFE / 64) * (DM / 32);
    constexpr int NITEMS = 2 * I_IN + 2 * I_OUT + 2 * I_GU + I_D + NEXP * (2 * I_EGU + I_ED);
    for (int it = gw; it < NITEMS; it += NGW) {
        int r = it;
        if (r < 2 * I_IN) { const int l = r / I_IN; r -= l * I_IN;
            p0_transpose_item(A.in[2] + (size_t)l * DM * INC, DM, INC, WIN + (size_t)l * INC * DM, 0, nullptr, nullptr, QSCALE, 512, scr, r, F.lane); continue; }
        r -= 2 * I_IN;
        if (r < 2 * I_OUT) { const int l = r / I_OUT; r -= l * I_OUT;
            p0_transpose_item(A.in[13] + (size_t)l * DM * DM, DM, DM, WOUT + (size_t)l * DM * DM, 0, A.in[11] + l * 512, A.in[12] + l * 512, 1.0f, 0, scr, r, F.lane); continue; }
        r -= 2 * I_OUT;
        if (r < I_GU) { p0_transpose_item_f8(A.in[16], DM, DFF, (unsigned char*)WGU, 1, WSC_GU, scr, r, F.lane); continue; }
        r -= I_GU;
        if (r < I_GU) { p0_transpose_item_f8(A.in[17], DM, DFF, (unsigned char*)WGU, 2, WSC_GU, scr, r, F.lane); continue; }
        r -= I_GU;
        if (r < I_D) { p0_transpose_item_f8(A.in[18], DFF, DM, (unsigned char*)WD, 0, WSC_D, scr, r, F.lane); continue; }
        r -= I_D;
        { constexpr int PER_E = 2 * I_EGU + I_ED; const int e = r / PER_E; r -= e * PER_E;
          if (r < I_EGU) { p0_transpose_item_f8(A.in[20] + (size_t)e * DM * DFE, DM, DFE, WEGU + (size_t)e * 2 * DFE * DM, 1, WSC_GU, scr, r, F.lane); continue; }
          r -= I_EGU;
          if (r < I_EGU) { p0_transpose_item_f8(A.in[21] + (size_t)e * DM * DFE, DM, DFE, WEGU + (size_t)e * 2 * DFE * DM, 2, WSC_GU, scr, r, F.lane); continue; }
          r -= I_EGU;
          p0_transpose_item_f8(A.in[22] + (size_t)e * DFE * DM, DFE, DM, WED + (size_t)e * DM * DFE, 0, WSC_D, scr, r, F.lane); }
    }
    { const f32x4* x4 = (const f32x4*)A.in[0]; v4u* o = (v4u*)(ws + WS_A);
      const size_t n8 = (size_t)NTOK * DM / 8, stride = (size_t)F.G * NTHREADS;
      for (size_t i0 = (size_t)F.blk * NTHREADS + F.tid; i0 < n8; i0 += 4 * stride) {
          f32x4 a[4], b[4];
#pragma unroll
          for (int u = 0; u < 4; ++u) { const size_t i = i0 + u * stride; if (i < n8) { a[u] = x4[2 * i]; b[u] = x4[2 * i + 1]; } }
#pragma unroll
          for (int u = 0; u < 4; ++u) { const size_t i = i0 + u * stride; if (i < n8) { v4u w; w.x = pk2(a[u].x, a[u].y); w.y = pk2(a[u].z, a[u].w); w.z = pk2(b[u].x, b[u].y); w.w = pk2(b[u].z, b[u].w); o[i] = w; } } } }

    { bf16* GW = (bf16*)(ws + WS_GATEW);
      for (int i = F.blk * NTHREADS + F.tid; i < 2 * 2 * 8 * 64 * 64; i += F.G * NTHREADS) {
          const int d = i & 63, e = (i >> 6) & 63, n = (i >> 12) & 7, g = (i >> 15) & 1, l = i >> 16;
          const float v = (g ? A.in[8] : A.in[6])[(((size_t)l * 8 + n) * 64 + d) * 64 + e];
          GW[i] = (bf16)(pk2(v, v) & 0xffffu); } }
    if (F.blk == 0 && F.tid < 256) { float* LUT = (float*)(ws + WS_LUT); const int rel = F.tid - 191; const int bk = t5_bucket(rel);
#pragma unroll
        for (int h = 0; h < 8; ++h) LUT[h * 256 + F.tid] = A.in[1][bk * 8 + h] * LOG2E; }
}

template <int D> __device__ __forceinline__ float dpp_shr(float v, float idv) { return __builtin_bit_cast(float, __builtin_amdgcn_update_dpp(__builtin_bit_cast(int, idv), __builtin_bit_cast(int, v), 0x110 + D, 0xF, 0xF, false)); }
__device__ __forceinline__ float dpp_ror1(float v) { return __builtin_bit_cast(float, __builtin_amdgcn_update_dpp(0, __builtin_bit_cast(int, v), 0x121, 0xF, 0xF, false)); }
template <int D> __device__ __forceinline__ void scan_step(float& P, float& H) { const float P1 = dpp_shr<D>(P, 1.0f), H1 = dpp_shr<D>(H, 0.0f); H = P * H1 + H; P = P * P1; }
__device__ __forceinline__ void lru_tables(const Frame& F, const Args& A, int l) {
    LAS float* ct = (LAS float*)(F.lds + LDS_CTAB);
    const int ch = F.tid;
#pragma unroll
    for (int w = 0; w < 4; ++w) ct[w * 512 + ch] = A.in[4][(l * 4 + w) * LRUW + ch];
    ct[CT_CB + ch] = A.in[5][l * LRUW + ch]; ct[CT_BR + ch] = A.in[7][l * LRUW + ch]; ct[CT_BI + ch] = A.in[9][l * LRUW + ch];
    ct[CT_SP + ch] = 8.0f * log1pf(__expf(-A.in[10][l * LRUW + ch]));
}
struct LruNb { bf16x8 wr[2], wi[2]; v2u gb[4]; f32x4 hin; };
template <bool FINAL, int PART  >
__device__ __forceinline__ void lru_load_nb(LruNb& L, int nb, const bf16* Z, size_t row0, int n, int fr, int fq, const bf16* gwr, const bf16* gwi, const float* HinRow) {
    const int ch0 = 64 * n + 16 * nb + 4 * fq;
    if (PART & 1) {
#pragma unroll
        for (int ks = 0; ks < 2; ++ks) { L.wr[ks] = *(const bf16x8*)(gwr + (16 * nb + fr) * 64 + 32 * ks + 8 * fq); L.wi[ks] = *(const bf16x8*)(gwi + (16 * nb + fr) * 64 + 32 * ks + 8 * fq); }
    }
    if (FINAL && (PART & 2)) {
#pragma unroll
        for (int m = 0; m < 4; ++m) L.gb[m] = *(const v2u*)(Z + (row0 + 16 * m + fr) * INC + GBOFF + ch0);
        L.hin = *(const f32x4*)(HinRow + ch0);
    }
}
template <bool FINAL>
__device__ __forceinline__ void lru_tile(const bf16* Z, int b, int c, int n, int lane, const bf16* gwr, const bf16* gwi, const LAS float* ct,
                                         float* outP, float* outE, const float* Hin, LAS float* yl, bf16* HLg, bf16* PAg) {
    const int fr = lane & 15, fq = lane >> 4;
    const size_t seq0 = (size_t)b * SEQ, row0 = seq0 + (size_t)CHK * c;
    const float* HinRow = Hin + ((size_t)b * NCHUNK + c) * LRUW;
    LruNb cur, nxt;
    lru_load_nb<FINAL, 1>(cur, 0, Z, row0, n, fr, fq, gwr, gwi, HinRow);
    v4u xv[2][4][4];
    bf16x8 xa[4][2];
#define LRU_LOADXV(ks) do { _Pragma("unroll") for (int m = 0; m < 4; ++m) _Pragma("unroll") for (int w = 0; w < 4; ++w) { const int tt = CHK * c + 16 * m + fr + w - 3; \
        xv[ks][m][w] = *(const v4u*)(Z + (seq0 + (tt < 0 ? 0 : tt)) * INC + XBOFF + 64 * n + 32 * (ks) + 8 * fq); } } while (0)
#define LRU_CONV(ks) do { const int ch = 64 * n + 32 * (ks) + 8 * fq; float cw[4][8], cb[8]; \
        _Pragma("unroll") for (int w = 0; w < 4; ++w) { const f32x4 a = *(const LAS f32x4*)(ct + w * 512 + ch), bq = *(const LAS f32x4*)(ct + w * 512 + ch + 4); \
            cw[w][0] = a.x; cw[w][1] = a.y; cw[w][2] = a.z; cw[w][3] = a.w; cw[w][4] = bq.x; cw[w][5] = bq.y; cw[w][6] = bq.z; cw[w][7] = bq.w; } \
        { const f32x4 a = *(const LAS f32x4*)(ct + CT_CB + ch), bq = *(const LAS f32x4*)(ct + CT_CB + ch + 4); cb[0] = a.x; cb[1] = a.y; cb[2] = a.z; cb[3] = a.w; cb[4] = bq.x; cb[5] = bq.y; cb[6] = bq.z; cb[7] = bq.w; } \
        _Pragma("unroll") for (int m = 0; m < 4; ++m) { float a8[8]; \
            _Pragma("unroll") for (int j = 0; j < 8; ++j) a8[j] = cb[j]; \
            _Pragma("unroll") for (int w = 0; w < 4; ++w) { const int tt = CHK * c + 16 * m + fr + w - 3; const float mk = (tt >= 0) ? 1.0f : 0.0f; const v4u v = xv[ks][m][w]; \
                a8[0] += mk * cw[w][0] * bflo(v.x); a8[1] += mk * cw[w][1] * bfhi(v.x); a8[2] += mk * cw[w][2] * bflo(v.y); a8[3] += mk * cw[w][3] * bfhi(v.y); \
                a8[4] += mk * cw[w][4] * bflo(v.z); a8[5] += mk * cw[w][5] * bfhi(v.z); a8[6] += mk * cw[w][6] * bflo(v.w); a8[7] += mk * cw[w][7] * bfhi(v.w); } \
            v4u p; p.x = pk2(a8[0], a8[1]); p.y = pk2(a8[2], a8[3]); p.z = pk2(a8[4], a8[5]); p.w = pk2(a8[6], a8[7]); \
            xa[m][ks] = __builtin_bit_cast(bf16x8, p); } } while (0)
    if (FINAL) {
        LRU_LOADXV(0); asm volatile("" ::: "memory"); LRU_CONV(0); asm volatile("" ::: "memory");
        LRU_LOADXV(1); asm volatile("" ::: "memory"); LRU_CONV(1);
    } else {
        LRU_LOADXV(0); LRU_LOADXV(1); asm volatile("" ::: "memory"); LRU_CONV(0); LRU_CONV(1);
    }
#undef LRU_LOADXV
#undef LRU_CONV
    lru_load_nb<FINAL, 2>(cur, 0, Z, row0, n, fr, fq, gwr, gwi, HinRow);
#pragma unroll 1
    for (int nb = 0; nb < 4; ++nb) {
        const int ch0 = 64 * n + 16 * nb + 4 * fq;
        if (nb < 3) lru_load_nb<FINAL, 1>(nxt, nb + 1, Z, row0, n, fr, fq, gwr, gwi, HinRow);
        if (nb > 0) lru_load_nb<FINAL, 2>(cur, nb, Z, row0, n, fr, fq, gwr, gwi, HinRow);
        asm volatile("" ::: "memory");
        bf16x8 idf[2];
#pragma unroll
        for (int ks = 0; ks < 2; ++ks)
#pragma unroll
            for (int j = 0; j < 8; ++j) idf[ks][j] = (32 * ks + 8 * fq + j == 16 * nb + fr) ? (short)0x3F80 : (short)0;
        const f32x4 brv = *(const LAS f32x4*)(ct + CT_BR + ch0), biv = *(const LAS f32x4*)(ct + CT_BI + ch0), spv = *(const LAS f32x4*)(ct + CT_SP + ch0);
        f32x4 dr[4], di[4], dx[4];
#pragma unroll
        for (int m = 0; m < 4; ++m) { dr[m] = (f32x4){0.f, 0.f, 0.f, 0.f}; di[m] = dr[m]; dx[m] = dr[m];
#pragma unroll
            for (int ks = 0; ks < 2; ++ks) {
                dr[m] = __builtin_amdgcn_mfma_f32_16x16x32_bf16(cur.wr[ks], xa[m][ks], dr[m], 0, 0, 0);
                di[m] = __builtin_amdgcn_mfma_f32_16x16x32_bf16(cur.wi[ks], xa[m][ks], di[m], 0, 0, 0);
                dx[m] = __builtin_amdgcn_mfma_f32_16x16x32_bf16(idf[ks], xa[m][ks], dx[m], 0, 0, 0); } }
        float cP[4], cH[4];
#pragma unroll
        for (int r = 0; r < 4; ++r) { cP[r] = 1.0f; cH[r] = FINAL ? cur.hin[r] : 0.0f; }
#pragma unroll
        for (int m = 0; m < 4; ++m) {
            float P[4], H[4];
#pragma unroll
            for (int r = 0; r < 4; ++r) {
                const float rg = fast_sigmoid(dr[m][r] + brv[r]), ig = fast_sigmoid(di[m][r] + biv[r]);
                const float la = -rg * spv[r];
                const float a = __builtin_amdgcn_exp2f(la * LOG2E);
                const float x2 = 2.0f * la;
                const float om = (x2 > -0.02f) ? -x2 * (1.0f + x2 * (0.5f + x2 * (1.0f / 6.0f))) : (1.0f - a * a);
                const float u = __builtin_amdgcn_sqrtf(fmaxf(om, 0.f)) * (ig * dx[m][r]);
                P[r] = (fr == 0) ? a * cP[r] : a; H[r] = (fr == 0) ? a * cH[r] + u : u;
            }
#pragma unroll
            for (int r = 0; r < 4; ++r) { scan_step<1>(P[r], H[r]); scan_step<2>(P[r], H[r]); scan_step<4>(P[r], H[r]); scan_step<8>(P[r], H[r]); }
            if (!FINAL) {
                const size_t o = (row0 + 16 * m + fr) * LRUW + ch0;
                v2u wh, wp; wh.x = pk2(H[0], H[1]); wh.y = pk2(H[2], H[3]); wp.x = pk2(P[0], P[1]); wp.y = pk2(P[2], P[3]);
                *(v2u*)(HLg + o) = wh; *(v2u*)(PAg + o) = wp;
            }
            if (FINAL) {
                const v2u g = cur.gb[m];
                f32x4 y; y[0] = gelu_tanh(bflo(g.x)) * H[0]; y[1] = gelu_tanh(bfhi(g.x)) * H[1]; y[2] = gelu_tanh(bflo(g.y)) * H[2]; y[3] = gelu_tanh(bfhi(g.y)) * H[3];
                *(LAS f32x4*)(yl + (16 * m + fr) * LRUW + ch0) = y;
            }
#pragma unroll
            for (int r = 0; r < 4; ++r) { cP[r] = dpp_ror1(P[r]); cH[r] = dpp_ror1(H[r]); }
        }
        if (!FINAL) { if (fr == 0) { const size_t o = ((size_t)b * NCHUNK + c) * LRUW + ch0;
            *(f32x4*)(outP + o) = (f32x4){cP[0], cP[1], cP[2], cP[3]}; *(f32x4*)(outE + o) = (f32x4){cH[0], cH[1], cH[2], cH[3]}; } }
        cur.wr[0] = nxt.wr[0]; cur.wr[1] = nxt.wr[1]; cur.wi[0] = nxt.wi[0]; cur.wi[1] = nxt.wi[1];
    }
}

__device__ __forceinline__ void p_lru_summary(const Frame& F, const Args& A, int l, int nrep) {
    unsigned char* ws = A.ws;
    const bf16* Z = (const bf16*)(ws + WS_ZH);
    const bf16* GW = (const bf16*)(ws + WS_GATEW) + (size_t)l * 2 * 8 * 4096;
    lru_tables(F, A, l); __syncthreads();
    for (int it = F.blk; it < BATCH * NCHUNK * nrep; it += F.G) {
        const int b = (it >> 8) & 1, c = it & 255, n = F.wave;
        lru_tile<false>(Z, b, c, n, F.lane, GW + n * 4096, GW + 8 * 4096 + n * 4096, (const LAS float*)(F.lds + LDS_CTAB), (float*)(ws + WS_LRUP), (float*)(ws + WS_LRUE), (const float*)(ws + WS_HIN), nullptr, (bf16*)(ws + WS_HL), (bf16*)(ws + WS_PA));
    }
}
__device__ __forceinline__ void p_lru_carry(const Frame& F, const Args& A) {
    unsigned char* ws = A.ws;
    const float* Pg = (const float*)(ws + WS_LRUP); const float* Eg = (const float*)(ws + WS_LRUE); float* Hg = (float*)(ws + WS_HIN);
    const int gw = F.blk * NWAVES + F.wave, NGW = F.G * NWAVES;
    for (int p = gw; p < BATCH * LRUW; p += NGW) {
        const int b = p >> 9, ch = p & 511;
        float pk[4], ek[4];
#pragma unroll
        for (int k = 0; k < 4; ++k) { const size_t o = ((size_t)b * NCHUNK + 4 * F.lane + k) * LRUW + ch; pk[k] = Pg[o]; ek[k] = Eg[o]; }
        float P = pk[0], H = ek[0];
#pragma unroll
        for (int k = 1; k < 4; ++k) { H = pk[k] * H + ek[k]; P = pk[k] * P; }
#pragma unroll
        for (int d = 1; d < 64; d <<= 1) { const float P1 = __shfl_up(P, d), H1 = __shfl_up(H, d); if (F.lane >= d) { H = P * H1 + H; P = P * P1; } }
        float h = __shfl_up(H, 1); if (F.lane == 0) h = 0.f;
#pragma unroll
        for (int k = 0; k < 4; ++k) { Hg[((size_t)b * NCHUNK + 4 * F.lane + k) * LRUW + ch] = h; h = pk[k] * h + ek[k]; }
    }
}

__device__ __forceinline__ int crow(int r, int hi) { return (r & 3) + 8 * (r >> 2) + 4 * hi; }
__device__ __forceinline__ s16x4 vtr(const LAS unsigned char* p) { return __builtin_bit_cast(s16x4, __builtin_amdgcn_ds_read_tr16_b64_v4i16((LAS s16x4*)p)); }
__device__ __forceinline__ void p_mixer(const Frame& F, const Args& A, int l, int nrep) {
    unsigned char* ws = A.ws;
    const bf16* Z = (const bf16*)(ws + WS_ZH);
    bf16* Y = (bf16*)(ws + WS_A);
    const bf16* GW = (const bf16*)(ws + WS_GATEW) + (size_t)l * 2 * 8 * 4096;
    LAS unsigned char* Kl = F.lds;
    LAS unsigned char* Vl = F.lds + 49152;
    LAS bf16* ya = (LAS bf16*)F.lds;
    LAS float* lut = (LAS float*)(F.lds + LDS_LUT);
    const int lane = F.lane, wave = F.wave, r32 = lane & 31, hi = lane >> 5;
    { const float* LUTg = (const float*)(ws + WS_LUT); for (int i = F.tid; i < 2048; i += NTHREADS) lut[i] = LUTg[i]; }
    const float sinkv = A.in[3][l * 8 + wave] * LOG2E;
    const int kvh = wave >> 2;
    for (int it = F.blk; it < BATCH * NCHUNK * nrep; it += F.G) {
        const int b = (it >> 8) & 1, c = it & 255;
        const size_t row0 = (size_t)b * SEQ + (size_t)CHK * c;
        const int T0 = (c >= 2) ? 0 : 2 - c;
        __syncthreads();
        {   const float* hinr = (const float*)(ws + WS_HIN) + ((size_t)b * NCHUNK + c) * LRUW + 8 * lane;
            const f32x4 hi0 = *(const f32x4*)hinr, hi1 = *(const f32x4*)(hinr + 4);
            const bf16* HLg = (const bf16*)(ws + WS_HL); const bf16* PAg = (const bf16*)(ws + WS_PA);
            v4u vh[8], vp[8], vg[8];
#pragma unroll
            for (int i = 0; i < 8; ++i) { const size_t r = row0 + 8 * wave + i;
                vh[i] = *(const v4u*)(HLg + r * LRUW + 8 * lane); vp[i] = *(const v4u*)(PAg + r * LRUW + 8 * lane); vg[i] = *(const v4u*)(Z + r * INC + GBOFF + 8 * lane); }
            asm volatile("" ::: "memory");
#pragma unroll
            for (int i = 0; i < 8; ++i) { const size_t r = row0 + 8 * wave + i;
                float y[8];
                y[0] = gelu_tanh(bflo(vg[i].x)) * (bflo(vh[i].x) + bflo(vp[i].x) * hi0.x); y[1] = gelu_tanh(bfhi(vg[i].x)) * (bfhi(vh[i].x) + bfhi(vp[i].x) * hi0.y);
                y[2] = gelu_tanh(bflo(vg[i].y)) * (bflo(vh[i].y) + bflo(vp[i].y) * hi0.z); y[3] = gelu_tanh(bfhi(vg[i].y)) * (bfhi(vh[i].y) + bfhi(vp[i].y) * hi0.w);
                y[4] = gelu_tanh(bflo(vg[i].z)) * (bflo(vh[i].z) + bflo(vp[i].z) * hi1.x); y[5] = gelu_tanh(bfhi(vg[i].z)) * (bfhi(vh[i].z) + bfhi(vp[i].z) * hi1.y);
                y[6] = gelu_tanh(bflo(vg[i].w)) * (bflo(vh[i].w) + bflo(vp[i].w) * hi1.z); y[7] = gelu_tanh(bfhi(vg[i].w)) * (bfhi(vh[i].w) + bfhi(vp[i].w) * hi1.w);
                const float ss = wave_sum((y[0] * y[0] + y[1] * y[1]) + (y[2] * y[2] + y[3] * y[3]) + (y[4] * y[4] + y[5] * y[5]) + (y[6] * y[6] + y[7] * y[7]));
                const float rstd = 1.0f / sqrtf(ss * (1.0f / 512.0f) + RMS_EPS);
                v4u w; w.x = pk2(y[0] * rstd, y[1] * rstd); w.y = pk2(y[2] * rstd, y[3] * rstd); w.z = pk2(y[4] * rstd, y[5] * rstd); w.w = pk2(y[6] * rstd, y[7] * rstd);
                *(v4u*)(Y + r * DM + 512 + 8 * lane) = w; }
        }
#pragma unroll
        for (int h2 = 0; h2 < 2; ++h2)
#pragma unroll
            for (int T = 0; T < 3; ++T) {
                v4u kq = (v4u){0u, 0u, 0u, 0u}, vq = kq;
                if (T >= T0) { const size_t cr = row0 + (size_t)CHK * T - 2 * CHK;
                    kq = *(const v4u*)(Z + (cr + lane) * INC + KOFF + 64 * h2 + 8 * wave);
                    vq = *(const v4u*)(Z + (cr + 16 * (wave & 3) + (lane >> 2)) * INC + VOFF + 64 * h2 + 32 * (wave >> 2) + 8 * (lane & 3)); }
                *(LAS v4u*)(Kl + (h2 * 3 + T) * 8192 + wave * 1024 + lane * 16) = kq;
                *(LAS v4u*)(Vl + (h2 * 3 + T) * 8192 + wave * 1024 + lane * 16) = vq;
            }
        __syncthreads();
        unsigned opk[2][2][8];
#pragma unroll
        for (int qb = 0; qb < 2; ++qb) {
            const int qi = 32 * qb + r32;
            bf16x8 qr[4];
#pragma unroll
            for (int d0 = 0; d0 < 4; ++d0) qr[d0] = *(const bf16x8*)(Z + (row0 + qi) * INC + 64 * wave + 16 * d0 + 8 * hi);
            f32x16 s[3][2];
            const LAS float* lutq = lut + wave * 256 + 63 - qi;
#pragma unroll
            for (int T = 0; T < 3; ++T) {
#pragma unroll
                for (int hf = 0; hf < 2; ++hf)
#pragma unroll
                    for (int r = 0; r < 16; ++r) s[T][hf][r] = lutq[64 * T + 32 * hf + crow(r, hi)];
                const LAS unsigned char* kb = Kl + (kvh * 3 + T) * 8192 + hi * 1024 + r32 * 16;
#pragma unroll
                for (int d0 = 0; d0 < 4; ++d0) {
                    const bf16x8 b0 = *(const LAS bf16x8*)(kb + d0 * 2048), b1 = *(const LAS bf16x8*)(kb + d0 * 2048 + 512);
                    s[T][0] = __builtin_amdgcn_mfma_f32_32x32x16_bf16(b0, qr[d0], s[T][0], 0, 0, 0);
                    s[T][1] = __builtin_amdgcn_mfma_f32_32x32x16_bf16(b1, qr[d0], s[T][1], 0, 0, 0);
                }
                if (T < T0) {
#pragma unroll
                    for (int hf = 0; hf < 2; ++hf)
#pragma unroll
                        for (int r = 0; r < 16; ++r) s[T][hf][r] = -1e30f;
                }
            }
            float mx = sinkv;
#pragma unroll
            for (int T = 0; T < 3; ++T)
#pragma unroll
                for (int hf = 0; hf < 2; ++hf)
#pragma unroll
                    for (int r = 0; r < 16; ++r) mx = fmaxf(mx, s[T][hf][r]);
            mx = fmaxf(mx, __shfl_xor(mx, 32));
            float lsum = 0.f;
#pragma unroll
            for (int T = 0; T < 3; ++T)
#pragma unroll
                for (int hf = 0; hf < 2; ++hf)
#pragma unroll
                    for (int r = 0; r < 16; ++r) { const float p = __builtin_amdgcn_exp2f(s[T][hf][r] - mx); s[T][hf][r] = p; lsum += p; }
            lsum += __shfl_xor(lsum, 32);
            lsum += __builtin_amdgcn_exp2f(sinkv - mx);
            const float inv = 1.0f / lsum;
            f32x16 o[2]; o[0] = (f32x16){0.f, 0.f, 0.f, 0.f, 0.f, 0.f, 0.f, 0.f, 0.f, 0.f, 0.f, 0.f, 0.f, 0.f, 0.f, 0.f}; o[1] = o[0];
#pragma unroll
            for (int T = 0; T < 3; ++T) {
                v4u pw[4];
#pragma unroll
                for (int k = 0; k < 4; ++k) { const int hf = k >> 1, r0 = (k & 1) * 8;
                    pw[k].x = pk2(s[T][hf][r0 + 0], s[T][hf][r0 + 1]); pw[k].y = pk2(s[T][hf][r0 + 2], s[T][hf][r0 + 3]);
                    pw[k].z = pk2(s[T][hf][r0 + 4], s[T][hf][r0 + 5]); pw[k].w = pk2(s[T][hf][r0 + 6], s[T][hf][r0 + 7]); }
                const LAS unsigned char* vb = Vl + (kvh * 3 + T) * 8192 + ((lane >> 4) & 1) * 32 + (lane & 3) * 8 + (4 * hi + ((lane & 15) >> 2)) * 64;
#pragma unroll
                for (int d0 = 0; d0 < 2; ++d0)
#pragma unroll
                    for (int ks = 0; ks < 4; ++ks) {
                        const s16x4 lo = vtr(vb + d0 * 4096 + ks * 1024), hv = vtr(vb + d0 * 4096 + ks * 1024 + 512);
                        const bf16x8 vf = (bf16x8){lo[0], lo[1], lo[2], lo[3], hv[0], hv[1], hv[2], hv[3]};
                        o[d0] = __builtin_amdgcn_mfma_f32_32x32x16_bf16(vf, __builtin_bit_cast(bf16x8, pw[ks]), o[d0], 0, 0, 0);
                    }
            }
#pragma unroll
            for (int d0 = 0; d0 < 2; ++d0)
#pragma unroll
                for (int r = 0; r < 16; r += 2) opk[qb][d0][r >> 1] = pk2(o[d0][r] * inv, o[d0][r + 1] * inv);
        }
        __syncthreads();
#pragma unroll
        for (int qb = 0; qb < 2; ++qb)
#pragma unroll
            for (int d0 = 0; d0 < 2; ++d0)
#pragma unroll
                for (int g = 0; g < 4; ++g) { v2u w; w.x = opk[qb][d0][2 * g]; w.y = opk[qb][d0][2 * g + 1];
                    *(LAS v2u*)(ya + (32 * qb + r32) * 512 + 64 * wave + 32 * d0 + 8 * g + 4 * hi) = w; }
        __syncthreads();
#pragma unroll
        for (int i = 0; i < 8; ++i) { const int tok = 8 * wave + i;
            const v4u w0 = *(const LAS v4u*)(ya + tok * 512 + 8 * lane);
            const float x0 = bflo(w0.x), x1 = bfhi(w0.x), x2 = bflo(w0.y), x3 = bfhi(w0.y), x4 = bflo(w0.z), x5 = bfhi(w0.z), x6 = bflo(w0.w), x7 = bfhi(w0.w);
            const float ss = wave_sum((x0 * x0 + x1 * x1) + (x2 * x2 + x3 * x3) + (x4 * x4 + x5 * x5) + (x6 * x6 + x7 * x7));
            const float rstd = 1.0f / sqrtf(ss * (1.0f / 512.0f) + RMS_EPS);
            v4u w; w.x = pk2(x0 * rstd, x1 * rstd); w.y = pk2(x2 * rstd, x3 * rstd); w.z = pk2(x4 * rstd, x5 * rstd); w.w = pk2(x6 * rstd, x7 * rstd);
            *(v4u*)(Y + (row0 + tok) * DM + 8 * lane) = w; }
    }
}

template <int MODE>
__device__ __forceinline__ void p_layernorm(const Frame& F, const Args& A, const float* gam, const float* bet) {
    unsigned char* ws = A.ws;
    float* X = A.out;
    bf16* XB = (bf16*)(ws + WS_A);
    const bf16* Y2 = (const bf16*)(ws + WS_Y2);
    const int* TP = (const int*)(ws + WS_TOKPOS); const float* TW = (const float*)(ws + WS_TOKW);
    LAS unsigned* misc = (LAS unsigned*)(F.lds + LDS_MISC);
    const int lane = F.lane;
    if (MODE == 1) { if (F.tid < 8) misc[F.tid] = 0u; __syncthreads(); }
    f32x4 gv[4], bv[4];
#pragma unroll
    for (int j = 0; j < 4; ++j) { gv[j] = *(const f32x4*)(gam + 4 * lane + 256 * j); bv[j] = *(const f32x4*)(bet + 4 * lane + 256 * j); }
    const int rpw = NTOK / F.G;
    const int m0 = F.blk * rpw;
    f32x4 v[4], nv[4]; v2u ya[4], yb[4], nya[4], nyb[4]; float w0 = 0.f, w1 = 0.f, nw0 = 0.f, nw1 = 0.f; int np0 = 0, np1 = 0;
    {   const int m = m0 + F.wave;
        const f32x4* xr = (const f32x4*)(X + (size_t)m * DM) + lane;
#pragma unroll
        for (int j = 0; j < 4; ++j) v[j] = xr[64 * j];
        if (MODE == 2) { const int p0 = TP[2 * m], p1 = TP[2 * m + 1]; w0 = TW[2 * m]; w1 = TW[2 * m + 1];
            const v2u* y0 = (const v2u*)(Y2 + (size_t)p0 * DM) + lane; const v2u* y1 = (const v2u*)(Y2 + (size_t)p1 * DM) + lane;
#pragma unroll
            for (int j = 0; j < 4; ++j) { ya[j] = y0[64 * j]; yb[j] = y1[64 * j]; }
            if (F.wave + NWAVES < rpw) { np0 = TP[2 * (m + NWAVES)]; np1 = TP[2 * (m + NWAVES) + 1]; nw0 = TW[2 * (m + NWAVES)]; nw1 = TW[2 * (m + NWAVES) + 1]; } }
    }
    for (int i = F.wave; i < rpw; i += NWAVES) {
        const int m = m0 + i;
        f32x4* xr = (f32x4*)(X + (size_t)m * DM) + lane;
        const bool more = (i + NWAVES < rpw);
        float nnw0 = 0.f, nnw1 = 0.f; int nnp0 = 0, nnp1 = 0;
        if (more) {
            const f32x4* xn = (const f32x4*)(X + (size_t)(m + NWAVES) * DM) + lane;
#pragma unroll
            for (int j = 0; j < 4; ++j) nv[j] = xn[64 * j];
            if (MODE == 2) {
                const v2u* y0 = (const v2u*)(Y2 + (size_t)np0 * DM) + lane; const v2u* y1 = (const v2u*)(Y2 + (size_t)np1 * DM) + lane;
#pragma unroll
                for (int j = 0; j < 4; ++j) { nya[j] = y0[64 * j]; nyb[j] = y1[64 * j]; }
                if (i + 2 * NWAVES < rpw) { nnp0 = TP[2 * (m + 2 * NWAVES)]; nnp1 = TP[2 * (m + 2 * NWAVES) + 1]; nnw0 = TW[2 * (m + 2 * NWAVES)]; nnw1 = TW[2 * (m + 2 * NWAVES) + 1]; }
            }
        }
        asm volatile("" ::: "memory");
        if (MODE == 2) {
#pragma unroll
            for (int j = 0; j < 4; ++j) { const v2u a = ya[j], c = yb[j];
                v[j].x = ALPHA * v[j].x + w0 * bflo(a.x) + w1 * bflo(c.x); v[j].y = ALPHA * v[j].y + w0 * bfhi(a.x) + w1 * bfhi(c.x);
                v[j].z = ALPHA * v[j].z + w0 * bflo(a.y) + w1 * bflo(c.y); v[j].w = ALPHA * v[j].w + w0 * bfhi(a.y) + w1 * bfhi(c.y); }
        }
        float s = 0.f;
#pragma unroll
        for (int j = 0; j < 4; ++j) s += (v[j].x + v[j].y) + (v[j].z + v[j].w);
        const float mean = wave_sum(s) * (1.f / DM); float s2 = 0.f;
#pragma unroll
        for (int j = 0; j < 4; ++j) { v[j] = v[j] - mean; s2 += (v[j].x * v[j].x + v[j].y * v[j].y) + (v[j].z * v[j].z + v[j].w * v[j].w); }
        const float rstd = 1.f / sqrtf(wave_sum(s2) * (1.f / DM) + LN_EPS);
#pragma unroll
        for (int j = 0; j < 4; ++j) { v[j] = v[j] * rstd * gv[j] + bv[j]; xr[64 * j] = v[j]; }
        if (MODE == 3) {
            unsigned* o4 = (unsigned*)((unsigned char*)XB + (size_t)m * DM) + lane;
#pragma unroll
            for (int j = 0; j < 4; ++j) o4[64 * j] = pg8::pk4_fp8(v[j].x, v[j].y, v[j].z, v[j].w);
        }
        if (MODE == 0) {
            v2u* o8 = (v2u*)(XB + (size_t)m * DM) + lane;
#pragma unroll
            for (int j = 0; j < 4; ++j) { v2u w; w.x = pk2(v[j].x, v[j].y); w.y = pk2(v[j].z, v[j].w); o8[64 * j] = w; }
        }
        if (MODE == 1) {
            const float* RW = A.in[19];
            float lg[8];
#pragma unroll
            for (int e = 0; e < 8; ++e) lg[e] = 0.f;
#pragma unroll
            for (int j = 0; j < 4; ++j)
#pragma unroll
                for (int q = 0; q < 4; ++q) { const int k = 4 * lane + 256 * j + q; const f32x4 a = *(const f32x4*)(RW + k * 8), c = *(const f32x4*)(RW + k * 8 + 4); const float xv = v[j][q];
                    lg[0] += xv * a.x; lg[1] += xv * a.y; lg[2] += xv * a.z; lg[3] += xv * a.w; lg[4] += xv * c.x; lg[5] += xv * c.y; lg[6] += xv * c.z; lg[7] += xv * c.w; }
#pragma unroll
            for (int e = 0; e < 8; ++e) lg[e] = wave_sum(lg[e]);
            int e0 = 0; float v0 = lg[0];
#pragma unroll
            for (int e = 1; e < 8; ++e) if (lg[e] > v0) { v0 = lg[e]; e0 = e; }
            int e1 = -1; float v1 = -3.0e38f;
#pragma unroll
            for (int e = 0; e < 8; ++e) if (e != e0 && lg[e] > v1) { v1 = lg[e]; e1 = e; }
            const float g0 = 1.0f / (1.0f + __expf(v1 - v0)), g1 = 1.0f - g0;
            if (lane == 0) { int* te = (int*)(ws + WS_TOKE) + 2 * m; float* tw = (float*)(ws + WS_TOKW) + 2 * m; te[0] = e0; te[1] = e1; tw[0] = g0; tw[1] = g1;
                atomicAdd((unsigned*)(misc + e0), 1u); atomicAdd((unsigned*)(misc + e1), 1u); }
        }
        if (more) {
#pragma unroll
            for (int j = 0; j < 4; ++j) v[j] = nv[j];
            if (MODE == 2) {
#pragma unroll
                for (int j = 0; j < 4; ++j) { ya[j] = nya[j]; yb[j] = nyb[j]; }
                w0 = nw0; w1 = nw1; np0 = nnp0; np1 = nnp1; nw0 = nnw0; nw1 = nnw1; }
        }
    }
    if (MODE == 1) { __syncthreads(); if (F.tid < 8) ((unsigned*)(ws + WS_HIST))[F.blk * 8 + F.tid] = misc[F.tid]; }
}

__device__ __forceinline__ void p_route(const Frame& F, const Args& A) {
    unsigned char* ws = A.ws;
    LAS unsigned* misc = (LAS unsigned*)(F.lds + LDS_MISC);
    LAS int* posl = (LAS int*)(F.lds + LDS_POS);
    const unsigned* hist = (const unsigned*)(ws + WS_HIST);
    const int lane = F.lane, rpw = NTOK / F.G;
    {
        const int e = F.wave; unsigned tot = 0u, bef = 0u;
        for (int v = lane; v < F.G; v += 64) { const unsigned h = hist[v * 8 + e]; tot += h; if (v < F.blk) bef += h; }
#pragma unroll
        for (int o = 1; o < 64; o <<= 1) { tot += __shfl_xor(tot, o); bef += __shfl_xor(bef, o); }
        if (lane == 0) { misc[16 + e] = tot; misc[24 + e] = bef; }
    }
    __syncthreads();
    int seg[9]; seg[0] = 0;
#pragma unroll
    for (int e = 0; e < 8; ++e) seg[e + 1] = seg[e] + (int)((misc[16 + e] + 255u) >> 8);
    if (F.blk == 0 && F.tid == 0) { int* meta = (int*)(ws + WS_META);
#pragma unroll
        for (int e = 0; e < 9; ++e) meta[e] = seg[e];
        meta[9] = seg[8]; }
    if (F.wave == 0) {
        const int* te = (const int*)(ws + WS_TOKE); int* tp = (int*)(ws + WS_TOKPOS); int* rt = nullptr; (void)rt;
        unsigned run[8];
#pragma unroll
        for (int e = 0; e < 8; ++e) run[e] = (unsigned)seg[e] * 256u + misc[24 + e];
        for (int h = 0; h < rpw; h += 64) {
            const int m = F.blk * rpw + h + lane;
#pragma unroll
            for (int k = 0; k < 2; ++k) {
                const int ek = te[2 * m + k]; int pos = 0;
#pragma unroll
                for (int e = 0; e < 8; ++e) { const unsigned long long mask = __ballot(ek == e);
                    if (ek == e) pos = (int)(run[e] + (unsigned)__popcll(mask & ((1ull << lane) - 1ull)));
                    run[e] += (unsigned)__popcll(mask); }
                tp[2 * m + k] = pos; posl[2 * (h + lane) + k] = pos;
            }
        }
    }
    __syncthreads();
    {
        const float* X = A.out; unsigned char* XS = ws + WS_XS;
        f32x4 a, b, c, d, na, nb, nc, nd;
        { const f32x4* xr = (const f32x4*)(X + (size_t)(F.blk * rpw + F.wave) * DM) + 4 * lane; a = xr[0]; b = xr[1]; c = xr[2]; d = xr[3]; }
        for (int i = F.wave; i < rpw; i += NWAVES) {
            const int m = F.blk * rpw + i; const int p0 = posl[2 * i], p1 = posl[2 * i + 1];
            const bool more = (i + NWAVES < rpw);
            if (more) { const f32x4* xr = (const f32x4*)(X + (size_t)(m + NWAVES) * DM) + 4 * lane; na = xr[0]; nb = xr[1]; nc = xr[2]; nd = xr[3]; }
            asm volatile("" ::: "memory");
            v4u w; w.x = pg8::pk4_fp8(a.x, a.y, a.z, a.w); w.y = pg8::pk4_fp8(b.x, b.y, b.z, b.w); w.z = pg8::pk4_fp8(c.x, c.y, c.z, c.w); w.w = pg8::pk4_fp8(d.x, d.y, d.z, d.w);
            *((v4u*)(XS + (size_t)p0 * DM) + lane) = w; *((v4u*)(XS + (size_t)p1 * DM) + lane) = w;
            if (more) { a = na; b = nb; c = nc; d = nd; }
        }
    }
    if (F.blk < 8) {
        int r0 = 0, r1 = 0;
#pragma unroll
        for (int e = 0; e < 8; ++e) if (e == F.blk) { r0 = seg[e] * 256 + (int)misc[16 + e]; r1 = seg[e + 1] * 256; }
        v4u* XS4 = (v4u*)(ws + WS_XS);
        for (size_t i = (size_t)r0 * 64 + F.tid; i < (size_t)r1 * 64; i += NTHREADS) XS4[i] = (v4u){0u, 0u, 0u, 0u};
    }
}

#ifndef MK_ONE_LAUNCH
#define MK_ONE_LAUNCH 1
#endif
constexpr int PH_MOE = 17, PH_FINAL = PH_MOE + 2 * NPASS, NPHASES = PH_FINAL + 1;

#ifndef PH_MASK
#define PH_MASK 0xFFFFFFFFu
#endif
#ifndef DUP_MASK
#define DUP_MASK 0u
#endif
#define NREP(k) ((((unsigned)DUP_MASK >> (k)) & 1u) ? 2 : 1)
#define IN(k) (((PH_MASK >> (k)) & 1u) && lo <= (k) && (k) < hi)
#define SEAM(k) do { if (MK_ONE_LAUNCH && lo <= (k) && (k) + 1 < hi) xcd_barrier(bar); } while (0)
template <int l>
__device__ __forceinline__ void layer_phases(const Frame& F, const Args& args, const XcdBarrier& bar, const int lo, const int hi) {
    unsigned char* ws = args.ws;
        const int pb = 1 + 9 * l;
        const float* xres = (l == 0) ? args.in[0] : args.out;
        if (IN(pb + 0)) {
            pg8::Gemm g{(const bf16*)(ws + WS_A), (const bf16*)(ws + WS_WIN) + (size_t)l * INC * DM, NTOK, INC, DM, 0};
            pg8::StaticOrder S; S.init(NTOK, INC, F.G, F.blk, NREP(pb + 0));
            pg8::EpiBf16 E{(bf16*)(ws + WS_ZH), INC, 1.0f};
            pg8::gemm_phase<pg8::EpiBf16, pg8::StaticOrder, true, true>(F.lds, g, S, E);
            SEAM(pb + 0);
        }
        if (IN(pb + 1)) { p_lru_summary(F, args, l, NREP(pb + 1)); SEAM(pb + 1); }
        if (IN(pb + 2)) for (int rep_ = 0; rep_ < NREP(pb + 2); ++rep_) { p_lru_carry(F, args); SEAM(pb + 2); }
        if (IN(pb + 3)) { p_mixer(F, args, l, NREP(pb + 3)); SEAM(pb + 3); }
        if (IN(pb + 4)) {
            pg8::Gemm g{(const bf16*)(ws + WS_A), (const bf16*)(ws + WS_WOUT) + (size_t)l * DM * DM, NTOK, DM, DM, 0};
            pg8::StaticOrder S; S.init(NTOK, DM, F.G, F.blk, NREP(pb + 4));
            pg8::EpiResF32 E{xres, args.out, DM, ALPHA, 1.0f};
            pg8::gemm_phase<pg8::EpiResF32, pg8::StaticOrder, true, true>(F.lds, g, S, E);
            SEAM(pb + 4);
        }
        if (l == 0) {
            if (IN(6)) for (int rep_ = 0; rep_ < NREP(6); ++rep_) { p_layernorm<3>(F, args, args.in[14], args.in[15]); SEAM(6); }
            if (IN(7)) {
                pg8::Gemm g{(const bf16*)(ws + WS_A), (const bf16*)(ws + WS_WGU), NTOK, 2 * DFF, DM / 2, 0};
                pg8::StaticOrder S; S.init(NTOK, 2 * DFF, F.G, F.blk, NREP(7));
                pg8::EpiSwiGLU8 E{ws + WS_ZH, DFF, 1.0f / WSC_GU};
                pg8::gemm_phase<pg8::EpiSwiGLU8, pg8::StaticOrder, true, true, true>(F.lds, g, S, E);
                SEAM(7);
            }
            if (IN(8)) {
                pg8::Gemm g{(const bf16*)(ws + WS_ZH), (const bf16*)(ws + WS_WD), NTOK, DM, DFF / 2, 0};
                pg8::StaticOrder S; S.init(NTOK, DM, F.G, F.blk, NREP(8));
                pg8::EpiResF32 E{args.out, args.out, DM, ALPHA, 1.0f / WSC_D};
                pg8::gemm_phase<pg8::EpiResF32, pg8::StaticOrder, true, true, true>(F.lds, g, S, E);
                SEAM(8);
            }
            if (IN(9)) for (int rep_ = 0; rep_ < NREP(9); ++rep_) { p_layernorm<0>(F, args, args.in[23], args.in[24]); SEAM(9); }
        } else {
            if (IN(15)) for (int rep_ = 0; rep_ < NREP(15); ++rep_) { p_layernorm<1>(F, args, args.in[14] + DM, args.in[15] + DM); SEAM(15); }
            if (IN(16)) for (int rep_ = 0; rep_ < NREP(16); ++rep_) { p_route(F, args); SEAM(16); }
            for (int p = 0; p < NPASS; ++p) {
                int s1 = 0, s2 = 0, s3 = 0, s4 = 0, s5 = 0, s6 = 0, s7 = 0, nt = 0;
                if (IN(PH_MOE + 2 * p) || IN(PH_MOE + 1 + 2 * p)) { const int* meta = (const int*)(ws + WS_META);
                    s1 = __builtin_amdgcn_readfirstlane(meta[1]); s2 = __builtin_amdgcn_readfirstlane(meta[2]); s3 = __builtin_amdgcn_readfirstlane(meta[3]); s4 = __builtin_amdgcn_readfirstlane(meta[4]);
                    s5 = __builtin_amdgcn_readfirstlane(meta[5]); s6 = __builtin_amdgcn_readfirstlane(meta[6]); s7 = __builtin_amdgcn_readfirstlane(meta[7]); nt = __builtin_amdgcn_readfirstlane(meta[9]); }
                int nm = nt - PASS_TILES * p; nm = nm > PASS_TILES ? PASS_TILES : nm;
                if (IN(PH_MOE + 2 * p)) {
                    if (nm > 0) {
                        pg8::Gemm g{(const bf16*)(ws + WS_XS + (size_t)p * PASS_TILES * 256 * DM), (const bf16*)(ws + WS_WEGU), nm * 256, 2 * DFE, DM / 2, (size_t)2 * DFE * DM};
                        pg8::MoeOrder S; S.so.init(nm * 256, 2 * DFE, F.G, F.blk, NREP(PH_MOE + 2 * p)); S.tile0 = p * PASS_TILES; S.s1 = s1; S.s2 = s2; S.s3 = s3; S.s4 = s4; S.s5 = s5; S.s6 = s6; S.s7 = s7;
                        pg8::EpiSwiGLU8 E{ws + WS_HM, DFE, 1.0f / WSC_GU};
                        pg8::gemm_phase<pg8::EpiSwiGLU8, pg8::MoeOrder, true, true, true>(F.lds, g, S, E);
                    }
                    SEAM(PH_MOE + 2 * p);
                }
                if (IN(PH_MOE + 1 + 2 * p)) {
                    if (nm > 0) {
                        pg8::Gemm g{(const bf16*)(ws + WS_HM), (const bf16*)(ws + WS_WED), nm * 256, DM, DFE / 2, (size_t)DM * DFE};
                        pg8::MoeOrder S; S.so.init(nm * 256, DM, F.G, F.blk, NREP(PH_MOE + 1 + 2 * p)); S.tile0 = p * PASS_TILES; S.s1 = s1; S.s2 = s2; S.s3 = s3; S.s4 = s4; S.s5 = s5; S.s6 = s6; S.s7 = s7;
                        pg8::EpiBf16 E{(bf16*)(ws + WS_Y2) + (size_t)p * PASS_TILES * 256 * DM, DM, 1.0f / WSC_D};
                        pg8::gemm_phase<pg8::EpiBf16, pg8::MoeOrder, true, true, true>(F.lds, g, S, E);
                    }
                    SEAM(PH_MOE + 1 + 2 * p);
                }
            }
            if (IN(PH_FINAL)) for (int rep_ = 0; rep_ < NREP(PH_FINAL); ++rep_) { p_layernorm<2>(F, args, args.in[23] + DM, args.in[24] + DM); }
        }
}
__global__ void __launch_bounds__(NTHREADS, 2) fwd_kernel(Args args) {
    extern __shared__ __attribute__((aligned(16))) unsigned char lds_raw[];
    Frame F;
    F.lds = (LAS unsigned char*)lds_raw;
    F.tid = threadIdx.x; F.lane = F.tid & 63; F.wave = __builtin_amdgcn_readfirstlane(F.tid >> 6);
    F.G = gridDim.x; F.blk = blockIdx.x;
    unsigned char* ws = args.ws;
    volatile LAS unsigned* MISC = (volatile LAS unsigned*)(F.lds + LDS_MISC);
    if (F.tid < 64) MISC[F.tid] = 0u;
    __syncthreads();
    XcdBarrier bar; bar.bar = (unsigned*)(ws + WS_CTL) + CW_BAR; bar.x = 0; bar.st = nullptr;
    if (MK_ONE_LAUNCH) bar = xcd_barrier_post((unsigned*)(ws + WS_CTL) + CW_BAR, MISC + 8);
    const int lo = args.ph_lo, hi = args.ph_hi;

    if (IN(0)) for (int rep_ = 0; rep_ < NREP(0); ++rep_) { p0_prologue(F, args); SEAM(0); }

    layer_phases<0>(F, args, bar, lo, hi);
    layer_phases<1>(F, args, bar, lo, hi);
}

extern "C" void kernel_launch(void* const* d_in, const int* in_sizes, int n_in, void* d_out, int out_size, void* d_ws, size_t ws_size, hipStream_t stream) {
    static int grid = 0;
    if (grid == 0) {
        if (n_in != 25 || in_sizes[0] != NTOK * DM || out_size != NTOK * DM || ws_size < WS_END) {
            fprintf(stderr, "kernel_launch: unexpected problem: n_in %d in0 %d out %d ws %zu (need %zu)\n", n_in, n_in > 0 ? in_sizes[0] : -1, out_size, ws_size, (size_t)WS_END); grid = -1; return; }
        int dev = 0, cus = 0, per_cu = 0;
        if (hipGetDevice(&dev) != hipSuccess || hipDeviceGetAttribute(&cus, hipDeviceAttributeMultiprocessorCount, dev) != hipSuccess) { fprintf(stderr, "kernel_launch: device query failed\n"); grid = -1; return; }
        if (hipFuncSetAttribute((const void*)fwd_kernel, hipFuncAttributeMaxDynamicSharedMemorySize, LDS_BYTES) != hipSuccess) { fprintf(stderr, "kernel_launch: hipFuncSetAttribute failed\n"); grid = -1; return; }
        if (hipOccupancyMaxActiveBlocksPerMultiprocessor(&per_cu, (const void*)fwd_kernel, NTHREADS, LDS_BYTES) != hipSuccess || per_cu < 1)
            fprintf(stderr, "kernel_launch: note: occupancy query reports %d workgroups per CU\n", per_cu);
        (void)hipGetLastError();
        grid = cus;
        if (grid != 256) fprintf(stderr, "kernel_launch: note: %d CUs (built for 256)\n", grid);
        if (NTOK % grid != 0 || grid > 256) grid = 256;
    }
    if (grid < 0) return;
    (void)hipMemsetAsync((char*)d_ws + WS_CTL, 0, CTL_ZERO_BYTES, stream);
    Args a{};
    for (int i = 0; i < 25; ++i) a.in[i] = (const float*)d_in[i];
    a.out = (float*)d_out; a.ws = (unsigned char*)d_ws;
#if MK_ONE_LAUNCH
    a.ph_lo = 0; a.ph_hi = NPHASES;
    hipLaunchKernelGGL(fwd_kernel, dim3(grid), dim3(NTHREADS), LDS_BYTES, stream, a);
#else
    for (int k = 0; k < NPHASES; ++k) { a.ph_lo = k; a.ph_hi = k + 1; hipLaunchKernelGGL(fwd_kernel, dim3(grid), dim3(NTHREADS), LDS_BYTES, stream, a); }
#endif
    const hipError_t le = hipPeekAtLastError();
    if (le != hipSuccess) fprintf(stderr, "kernel_launch: launch failed: %s\n", hipGetErrorName(le));
}
```

```cpp
#include <hip/hip_runtime.h>
#include <cstdio>
#include <cstdint>
namespace pg8 {
#define PG8_LAS __attribute__((address_space(3)))
typedef unsigned short bf16_t;
typedef short bf16x8 __attribute__((ext_vector_type(8)));
typedef float f32x4 __attribute__((ext_vector_type(4)));
typedef unsigned u32x4 __attribute__((ext_vector_type(4)));
typedef int v4i __attribute__((ext_vector_type(4)));
typedef int v8i __attribute__((ext_vector_type(8)));
constexpr int BM = 256, BK = 64, HALF = 128, HTB = HALF * BK * 2  , STAGE_BYTES = 8 * HTB, NXCD = 8, WGM = 8;

__host__ __device__ __forceinline__ int lds_byte(int r, int c) { const int st = (r >> 4) * 2 + (c >> 5), rr = r & 15, cc = c & 31, ob = rr * 64 + cc * 2; return st * 1024 + (ob ^ (((ob >> 9) & 1) << 5)); }
__host__ __device__ __forceinline__ void stage_rc(int b, int& R, int& C) { const int st = b / 1024, sb = b % 1024, swz = sb ^ (((sb >> 9) & 1) << 5); R = (st >> 1) * 16 + swz / 64; C = (st & 1) * 32 + (swz % 64) / 2; }
__host__ __device__ __forceinline__ int perm32(int rho) { const int n = rho >> 4, i = rho & 15; return 8 * (i >> 2) + 4 * n + (i & 3); }

struct Unit { int pm, pn, be; };
struct Gemm { const bf16_t* A; const bf16_t* Bt; int M, N, K; size_t bstride; };

struct StaticOrder {
    int nM, nN, nwg, G, c, rep;
    __host__ __device__ void init(int M, int N, int G_, int c_, int rep_ = 1) { nM = M / BM; nN = N / BM; nwg = nM * nN; G = G_; c = c_; rep = rep_; }
    __host__ __device__ bool next(int i, Unit& u) const {
        const long L = (long)i * G + c; if (L >= (long)nwg * rep) return false;
        int wgid = (int)(L % nwg); { const int q = nwg / NXCD, r = nwg % NXCD, xcd = wgid % NXCD, off = wgid / NXCD; wgid = (xcd < r ? xcd * (q + 1) : r * (q + 1) + (xcd - r) * q) + off; }
        const int nig = WGM * nN, gid = wgid / nig, fm = gid * WGM, gsz = (nM - fm) < WGM ? (nM - fm) : WGM;
        u.pm = fm + ((wgid % nig) % gsz); u.pn = (wgid % nig) / gsz; u.be = 0; return true;
    }
    __device__ __forceinline__ void a_ready(const Unit&) const {}
    __device__ __forceinline__ void done(const Unit&) const {}
};
struct MoeOrder {
    StaticOrder so; int tile0, s1, s2, s3, s4, s5, s6, s7;
    __device__ __forceinline__ bool next(int i, Unit& u) const {
        if (!so.next(i, u)) return false;
        const int t = tile0 + u.pm;
        u.be = (t >= s1) + (t >= s2) + (t >= s3) + (t >= s4) + (t >= s5) + (t >= s6) + (t >= s7); return true;
    }
    __device__ __forceinline__ void a_ready(const Unit&) const {}
    __device__ __forceinline__ void done(const Unit&) const {}
};

__device__ __forceinline__ unsigned cvt_pk_bf16(float lo, float hi) { unsigned r; asm volatile("v_cvt_pk_bf16_f32 %0, %1, %2" : "=v"(r) : "v"(lo), "v"(hi)); return r; }

struct EpiBf16 {
    static constexpr bool PERM = true, AFTER_DRAIN = false;
    bf16_t* O; int ldc; float scale, scale0; int n0tiles;
    __device__ __forceinline__ void operator()(const f32x4 (&acc)[2][2][4][2], const Unit& u, int wr, int wc, int fr, int fq) const {
        const int row0 = u.pm * BM + wr * 64 + fr, col0 = u.pn * BM + wc * 32 + 8 * fq;
        const float sc = (u.pn < n0tiles) ? scale0 : scale;
#pragma unroll
        for (int ai = 0; ai < 2; ++ai)
#pragma unroll
            for (int m = 0; m < 4; ++m) { bf16_t* rowp = O + (size_t)(row0 + ai * HALF + m * 16) * ldc + col0;
#pragma unroll
                for (int bj = 0; bj < 2; ++bj) { const f32x4 v0 = acc[ai][bj][m][0] * sc, v1 = acc[ai][bj][m][1] * sc;
                    u32x4 w; w.x = cvt_pk_bf16(v0[0], v0[1]); w.y = cvt_pk_bf16(v0[2], v0[3]); w.z = cvt_pk_bf16(v1[0], v1[1]); w.w = cvt_pk_bf16(v1[2], v1[3]);
                    *(u32x4*)(rowp + bj * HALF) = w; } }
    }
};
__device__ __forceinline__ float silu_mul(float g, float u) { return g * u * __builtin_amdgcn_rcpf(1.0f + __builtin_amdgcn_exp2f(g * -1.4426950408889634f)); }
struct EpiSwiGLU {
    static constexpr bool PERM = true, AFTER_DRAIN = false;
    bf16_t* H; int ldh;
    __device__ __forceinline__ void operator()(const f32x4 (&acc)[2][2][4][2], const Unit& u, int wr, int wc, int fr, int fq) const {
        const int row0 = u.pm * BM + wr * 64 + fr, col0 = u.pn * HALF + wc * 32 + 8 * fq;
#pragma unroll
        for (int ai = 0; ai < 2; ++ai)
#pragma unroll
            for (int m = 0; m < 4; ++m) { bf16_t* rowp = H + (size_t)(row0 + ai * HALF + m * 16) * ldh + col0;
                const f32x4 g0 = acc[ai][0][m][0], g1 = acc[ai][0][m][1], u0 = acc[ai][1][m][0], u1 = acc[ai][1][m][1];
                u32x4 w; w.x = cvt_pk_bf16(silu_mul(g0[0], u0[0]), silu_mul(g0[1], u0[1])); w.y = cvt_pk_bf16(silu_mul(g0[2], u0[2]), silu_mul(g0[3], u0[3]));
                w.z = cvt_pk_bf16(silu_mul(g1[0], u1[0]), silu_mul(g1[1], u1[1])); w.w = cvt_pk_bf16(silu_mul(g1[2], u1[2]), silu_mul(g1[3], u1[3]));
                *(u32x4*)rowp = w; }
    }
};
__device__ __forceinline__ unsigned pk4_fp8(float a, float b, float c, float d) { int w = __builtin_amdgcn_cvt_pk_fp8_f32(a, b, 0, false); w = __builtin_amdgcn_cvt_pk_fp8_f32(c, d, w, true); return (unsigned)w; }
__device__ __forceinline__ unsigned pk4_i8(float a, float b, float c, float d, float s) {
    const int ia = __float2int_rn(fminf(fmaxf(a * s, -127.f), 127.f)), ib = __float2int_rn(fminf(fmaxf(b * s, -127.f), 127.f));
    const int ic = __float2int_rn(fminf(fmaxf(c * s, -127.f), 127.f)), id = __float2int_rn(fminf(fmaxf(d * s, -127.f), 127.f));
    return (unsigned)(ia & 255) | ((unsigned)(ib & 255) << 8) | ((unsigned)(ic & 255) << 16) | ((unsigned)id << 24);
}
struct EpiSwiGLU8 {
    static constexpr bool PERM = true, AFTER_DRAIN = false;
    unsigned char* H; int ldh; float sc;
    __device__ __forceinline__ void operator()(const f32x4 (&acc)[2][2][4][2], const Unit& u, int wr, int wc, int fr, int fq) const {
        const int row0 = u.pm * BM + wr * 64 + fr, col0 = u.pn * HALF + wc * 32 + 8 * fq;
        typedef unsigned u32x2 __attribute__((ext_vector_type(2)));
#pragma unroll
        for (int ai = 0; ai < 2; ++ai)
#pragma unroll
            for (int m = 0; m < 4; ++m) { unsigned char* rowp = H + (size_t)(row0 + ai * HALF + m * 16) * ldh + col0;
                const f32x4 g0 = acc[ai][0][m][0] * sc, g1 = acc[ai][0][m][1] * sc, u0 = acc[ai][1][m][0] * sc, u1 = acc[ai][1][m][1] * sc;
                u32x2 w; w.x = pk4_fp8(silu_mul(g0[0], u0[0]), silu_mul(g0[1], u0[1]), silu_mul(g0[2], u0[2]), silu_mul(g0[3], u0[3]));
                w.y = pk4_fp8(silu_mul(g1[0], u1[0]), silu_mul(g1[1], u1[1]), silu_mul(g1[2], u1[2]), silu_mul(g1[3], u1[3]));
                *(u32x2*)rowp = w; }
    }
};
struct EpiResF32 {
    static constexpr bool PERM = false, AFTER_DRAIN = false;
    const float* res; float* out; int ldc; float alpha, scale;
    __device__ __forceinline__ void operator()(const f32x4 (&acc)[2][2][4][2], const Unit& u, int wr, int wc, int fr, int fq) const {
        const int row0 = u.pm * BM + wr * 64 + fr, col0 = u.pn * BM + wc * 32 + 4 * fq;
#pragma unroll
        for (int ai = 0; ai < 2; ++ai)
#pragma unroll
            for (int m = 0; m < 4; ++m) { const size_t off = (size_t)(row0 + ai * HALF + m * 16) * ldc + col0;
                f32x4 rv[2][2];
#pragma unroll
                for (int bj = 0; bj < 2; ++bj)
#pragma unroll
                    for (int n = 0; n < 2; ++n) rv[bj][n] = *(const f32x4*)(res + off + bj * HALF + n * 16);
#pragma unroll
                for (int bj = 0; bj < 2; ++bj)
#pragma unroll
                    for (int n = 0; n < 2; ++n) *(f32x4*)(out + off + bj * HALF + n * 16) = rv[bj][n] * alpha + acc[ai][bj][m][n] * scale;
                asm volatile("" ::: "memory"); }
    }
};

__device__ __forceinline__ void mfma8(f32x4& c, const v8i a, const v8i b, const int scl) { asm volatile("v_mfma_scale_f32_16x16x128_f8f6f4 %0, %1, %2, %0, %3, %3 op_sel_hi:[0,0,0]" : "+v"(c) : "v"(a), "v"(b), "v"(scl)); }
template <class Epi, class Sched, bool ALIGN_EPI = false, bool SP2 = false, int OPK = 0>
__device__ __forceinline__ void gemm_phase(PG8_LAS unsigned char* lds, const Gemm g, const Sched& S, const Epi& E) {
    const int tid = threadIdx.x, wid = __builtin_amdgcn_readfirstlane(tid >> 6), lane = tid & 63, wr = wid >> 2, wc = wid & 3, fr = lane & 15, fq = lane >> 4;
    const int K = g.K, nt = K / BK;
    unsigned voffA[2], voffB[2];
#pragma unroll
    for (int i = 0; i < 2; ++i) { int R, C; stage_rc(tid * 16 + i * 8192, R, C); const int Rb = Epi::PERM ? ((R & ~31) + perm32(R & 31)) : R;
        voffA[i] = (unsigned)(R * K + C) * 2u; voffB[i] = (unsigned)(Rb * K + C) * 2u; }
    const size_t kstep = (size_t)(BK * 2);
    const size_t hstep = (size_t)HALF * K * 2;
    const size_t tstep = 2 * hstep;
    const unsigned ldsw = (unsigned)wid * 1024u;
    const int aoff = lds_byte(wr * 64 + fr, fq * 8), boff = lds_byte(wc * 32 + fr, fq * 8);
#define PG8_SA(b, h) (((b) * 2 + (h)) * HTB)
#define PG8_SB(b, h) ((4 + (b) * 2 + (h)) * HTB)
#define PG8_STAGE(bufoff, gbase, voff) do { _Pragma("unroll") for (int _i = 0; _i < 2; ++_i) \
        __builtin_amdgcn_global_load_lds((const unsigned*)((const char*)(gbase) + (voff)[_i]), (PG8_LAS unsigned*)(lds + (bufoff) + ldsw + _i * 8192), 16, 0, 0); } while (0)
#define PG8_LDA(dst, b, h) do { if constexpr (OPK == 1) { _Pragma("unroll") for (int m = 0; m < 4; ++m) { dst##8[m][0] = *(const PG8_LAS v4i*)(lds + PG8_SA(b, h) + aoff + m * 2048); dst##8[m][1] = *(const PG8_LAS v4i*)(lds + PG8_SA(b, h) + aoff + m * 2048 + 1024); } } \
    else { _Pragma("unroll") for (int m = 0; m < 4; ++m) _Pragma("unroll") for (int k = 0; k < 2; ++k) dst[m][k] = *(const PG8_LAS bf16x8*)(lds + PG8_SA(b, h) + aoff + m * 2048 + k * 1024); } } while (0)
#define PG8_LDB(dst, b, h) do { if constexpr (OPK == 1) { _Pragma("unroll") for (int n = 0; n < 2; ++n) { dst##8[n][0] = *(const PG8_LAS v4i*)(lds + PG8_SB(b, h) + boff + n * 2048); dst##8[n][1] = *(const PG8_LAS v4i*)(lds + PG8_SB(b, h) + boff + n * 2048 + 1024); } } \
    else { _Pragma("unroll") for (int n = 0; n < 2; ++n) _Pragma("unroll") for (int k = 0; k < 2; ++k) dst[n][k] = *(const PG8_LAS bf16x8*)(lds + PG8_SB(b, h) + boff + n * 2048 + k * 1024); } } while (0)
#define PG8_MMA(ai, bj, At, Bt) do { __builtin_amdgcn_s_setprio(1); if constexpr (OPK == 1) { _Pragma("unroll") for (int m = 0; m < 4; ++m) _Pragma("unroll") for (int n = 0; n < 2; ++n) \
        mfma8(acc[ai][bj][m][n], __builtin_shufflevector(Bt##8[n][0], Bt##8[n][1], 0, 1, 2, 3, 4, 5, 6, 7), __builtin_shufflevector(At##8[m][0], At##8[m][1], 0, 1, 2, 3, 4, 5, 6, 7), scl8); } \
    else if constexpr (OPK == 2) { _Pragma("unroll") for (int m = 0; m < 4; ++m) _Pragma("unroll") for (int n = 0; n < 2; ++n) _Pragma("unroll") for (int k = 0; k < 2; ++k) \
        acc[ai][bj][m][n] = __builtin_bit_cast(f32x4, __builtin_amdgcn_mfma_i32_16x16x64_i8(__builtin_bit_cast(v4i, Bt[n][k]), __builtin_bit_cast(v4i, At[m][k]), __builtin_bit_cast(v4i, acc[ai][bj][m][n]), 0, 0, 0)); } \
    else { _Pragma("unroll") for (int m = 0; m < 4; ++m) _Pragma("unroll") for (int n = 0; n < 2; ++n) _Pragma("unroll") for (int k = 0; k < 2; ++k) \
        acc[ai][bj][m][n] = __builtin_amdgcn_mfma_f32_16x16x32_bf16(Bt[n][k], At[m][k], acc[ai][bj][m][n], 0, 0, 0); } __builtin_amdgcn_s_setprio(0); } while (0)
#define PG8_WAIT_V(n) asm volatile("s_waitcnt vmcnt(" #n ")" ::: "memory")
#define PG8_WAIT_L(n) asm volatile("s_waitcnt lgkmcnt(" #n ")" ::: "memory")
#define PG8_BAR __builtin_amdgcn_s_barrier()
#define PG8_SCHED __builtin_amdgcn_sched_barrier(0)
    Unit cur, nxt; int ui = 0;
    if (!S.next(0, cur)) return;
    f32x4 acc[2][2][4][2];
#pragma unroll
    for (int a = 0; a < 2; ++a)
#pragma unroll
        for (int b = 0; b < 2; ++b)
#pragma unroll
            for (int m = 0; m < 4; ++m)
#pragma unroll
                for (int n = 0; n < 2; ++n) acc[a][b][m][n] = (f32x4){0.f, 0.f, 0.f, 0.f};
    bf16x8 At[4][2], B0[2][2], B1[2][2];
    v4i At8[4][2], B08[2][2], B18[2][2];
    int scl8 = 0x7F7F7F7F; asm volatile("" : "+v"(scl8));
    const char* cA = (const char*)g.A + (size_t)cur.pm * tstep; const char* cB = (const char*)g.Bt + (size_t)cur.be * g.bstride + (size_t)cur.pn * tstep;
    S.a_ready(cur);
    if constexpr (SP2) {
        PG8_STAGE(PG8_SB(0, 0), cB, voffB); PG8_STAGE(PG8_SB(0, 1), cB + hstep, voffB); PG8_STAGE(PG8_SA(0, 0), cA, voffA); PG8_STAGE(PG8_SA(0, 1), cA + hstep, voffA);
        if (wr == 1) PG8_BAR;
        PG8_WAIT_V(2); PG8_BAR;
        PG8_STAGE(PG8_SB(1, 0), cB + kstep, voffB); PG8_STAGE(PG8_SA(1, 0), cA + kstep, voffA); PG8_STAGE(PG8_SB(1, 1), cB + hstep + kstep, voffB);
        PG8_WAIT_V(6); PG8_BAR;
    } else {
        PG8_STAGE(PG8_SB(0, 0), cB, voffB); PG8_STAGE(PG8_SA(0, 0), cA, voffA); PG8_STAGE(PG8_SB(0, 1), cB + hstep, voffB); PG8_STAGE(PG8_SA(0, 1), cA + hstep, voffA);
        if (wr == 1) PG8_BAR;
        PG8_WAIT_V(4); PG8_BAR;
        PG8_STAGE(PG8_SB(1, 0), cB + kstep, voffB); PG8_STAGE(PG8_SA(1, 0), cA + kstep, voffA); PG8_STAGE(PG8_SB(1, 1), cB + hstep + kstep, voffB);
        PG8_WAIT_V(6); PG8_BAR;
    }
    for (;;) {
        const bool has_next = S.next(ui + 1, nxt);
        const char* nA = has_next ? (const char*)g.A + (size_t)nxt.pm * tstep : cA; const char* nB = has_next ? (const char*)g.Bt + (size_t)nxt.be * g.bstride + (size_t)nxt.pn * tstep : cB;
#pragma unroll 1
        for (int t = 0; t < nt; t += 2) {
            const bool last = (t == nt - 2);
            const char* a1 = cA + (size_t)(t + 1) * kstep;
            const char* a2 = last ? nA : cA + (size_t)(t + 2) * kstep; const char* b2 = last ? nB : cB + (size_t)(t + 2) * kstep;
            const char* a3 = a2 + kstep; const char* b3 = b2 + kstep;
            if (last && has_next) S.a_ready(nxt);
            if constexpr (SP2) {
            PG8_LDB(B0, 0, 0); PG8_LDB(B1, 0, 1); PG8_SCHED; PG8_LDA(At, 0, 0); PG8_STAGE(PG8_SA(1, 1), a1 + hstep, voffA);
            PG8_WAIT_V(8); PG8_WAIT_L(0); PG8_BAR; PG8_MMA(0, 0, At, B0); PG8_MMA(0, 1, At, B1); PG8_BAR; PG8_SCHED;
            PG8_LDA(At, 0, 1); PG8_STAGE(PG8_SB(0, 0), b2, voffB); PG8_STAGE(PG8_SB(0, 1), b2 + hstep, voffB); PG8_STAGE(PG8_SA(0, 0), a2, voffA);
            PG8_WAIT_V(8); PG8_WAIT_L(0); PG8_BAR; PG8_MMA(1, 0, At, B0); PG8_MMA(1, 1, At, B1); PG8_BAR; PG8_SCHED;
            PG8_LDB(B0, 1, 0); PG8_LDB(B1, 1, 1); PG8_SCHED; PG8_LDA(At, 1, 0); PG8_STAGE(PG8_SA(0, 1), a2 + hstep, voffA);
            PG8_WAIT_V(8); PG8_WAIT_L(0); PG8_BAR; PG8_MMA(0, 0, At, B0); PG8_MMA(0, 1, At, B1); PG8_BAR; PG8_SCHED;
            PG8_LDA(At, 1, 1); PG8_STAGE(PG8_SB(1, 0), b3, voffB); PG8_STAGE(PG8_SB(1, 1), b3 + hstep, voffB); PG8_STAGE(PG8_SA(1, 0), a3, voffA);
            PG8_WAIT_V(8); PG8_WAIT_L(0); PG8_BAR; PG8_MMA(1, 0, At, B0); PG8_MMA(1, 1, At, B1); PG8_BAR; PG8_SCHED;
            } else {
            PG8_LDB(B0, 0, 0); PG8_SCHED; PG8_LDA(At, 0, 0); PG8_STAGE(PG8_SA(1, 1), a1 + hstep, voffA);
            PG8_WAIT_L(8); PG8_BAR; PG8_WAIT_L(0); PG8_MMA(0, 0, At, B0); PG8_BAR; PG8_SCHED;
            PG8_LDB(B1, 0, 1); PG8_STAGE(PG8_SB(0, 0), b2, voffB);
            PG8_BAR; PG8_WAIT_L(0); PG8_MMA(0, 1, At, B1); PG8_BAR;
            PG8_LDA(At, 0, 1); PG8_STAGE(PG8_SA(0, 0), a2, voffA);
            PG8_BAR; PG8_WAIT_L(0); PG8_MMA(1, 0, At, B0); PG8_BAR; PG8_SCHED;
            PG8_STAGE(PG8_SB(0, 1), b2 + hstep, voffB);
            PG8_WAIT_V(6); PG8_BAR; PG8_MMA(1, 1, At, B1); PG8_BAR;
            PG8_LDB(B0, 1, 0); PG8_SCHED; PG8_LDA(At, 1, 0); PG8_STAGE(PG8_SA(0, 1), a2 + hstep, voffA);
            PG8_WAIT_L(8); PG8_BAR; PG8_WAIT_L(0); PG8_MMA(0, 0, At, B0); PG8_BAR; PG8_SCHED;
            PG8_LDB(B1, 1, 1); PG8_STAGE(PG8_SB(1, 0), b3, voffB);
            PG8_BAR; PG8_WAIT_L(0); PG8_MMA(0, 1, At, B1); PG8_BAR;
            PG8_LDA(At, 1, 1); PG8_STAGE(PG8_SA(1, 0), a3, voffA);
            PG8_BAR; PG8_WAIT_L(0); PG8_MMA(1, 0, At, B0); PG8_BAR; PG8_SCHED;
            PG8_STAGE(PG8_SB(1, 1), b3 + hstep, voffB);
            PG8_WAIT_V(6); PG8_BAR; PG8_MMA(1, 1, At, B1); PG8_BAR;
            }
        }
        if constexpr (OPK == 1) asm volatile("s_nop 15\n\ts_nop 15" ::: "memory");
        if constexpr (OPK == 2) {
#pragma unroll
            for (int a = 0; a < 2; ++a)
#pragma unroll
                for (int b = 0; b < 2; ++b)
#pragma unroll
                    for (int m = 0; m < 4; ++m)
#pragma unroll
                        for (int n = 0; n < 2; ++n) { const v4i iv = __builtin_bit_cast(v4i, acc[a][b][m][n]); acc[a][b][m][n] = (f32x4){(float)iv[0], (float)iv[1], (float)iv[2], (float)iv[3]}; }
        }
        if constexpr (ALIGN_EPI) { if (wr == 0) PG8_BAR; }
        if constexpr (!Epi::AFTER_DRAIN) { E(acc, cur, wr, wc, fr, fq); S.done(cur); }
        if (!has_next) break;
#pragma unroll
        for (int a = 0; a < 2; ++a)
#pragma unroll
            for (int b = 0; b < 2; ++b)
#pragma unroll
                for (int m = 0; m < 4; ++m)
#pragma unroll
                    for (int n = 0; n < 2; ++n) acc[a][b][m][n] = (f32x4){0.f, 0.f, 0.f, 0.f};
        cur = nxt; cA = nA; cB = nB; ++ui;
        if constexpr (ALIGN_EPI) { if (wr == 1) PG8_BAR; }
    }
    PG8_WAIT_V(0);
    if constexpr (!ALIGN_EPI) { if (wr == 0) PG8_BAR; }
    PG8_BAR;
    if constexpr (Epi::AFTER_DRAIN) { E.fused(acc, cur, wr, wc, fr, fq, lds, wid, lane); S.done(cur); }
#undef PG8_SA
#undef PG8_SB
#undef PG8_STAGE
#undef PG8_LDA
#undef PG8_LDB
#undef PG8_MMA
#undef PG8_WAIT_V
#undef PG8_WAIT_L
#undef PG8_BAR
#undef PG8_SCHED
}
}

constexpr int BATCH = 2, SEQ = 16384, DM = 1024, NTOK = BATCH * SEQ;
constexpr int CHK = 64, NCHUNK = SEQ / CHK;
constexpr int INC = 1792, KOFF = 512, VOFF = 640, XBOFF = 768, GBOFF = 1280;
constexpr int LRUW = 512, DFF = 2816, DFE = 3584, NEXP = 8;
constexpr int MAXTILES = 264, PASS_TILES = 128, NPASS = 3;
constexpr float ALPHA = 1.41421356237309515f, LN_EPS = 1e-5f, RMS_EPS = 1e-6f, LOG2E = 1.4426950408889634f, QSCALE = 0.125f * LOG2E;
constexpr int NWAVES = 8, NTHREADS = 512;

constexpr size_t MiB = 1u << 20;
constexpr size_t WS_CTL = 0, CTL_ZERO_BYTES = 64 * 1024;
constexpr size_t WS_LUT = 1 * MiB;
constexpr size_t WS_GATEW = 1 * MiB + 64 * 1024;
constexpr size_t WS_HIST = 1 * MiB + 512 * 1024;
constexpr size_t WS_META = 1 * MiB + 576 * 1024;
constexpr size_t WS_TOKE = 2 * MiB, WS_TOKW = 2 * MiB + 256 * 1024, WS_TOKPOS = 2 * MiB + 512 * 1024;
constexpr size_t WS_LRUP = 3 * MiB, WS_LRUE = 4 * MiB, WS_HIN = 5 * MiB;
constexpr size_t WS_WEGU = 8 * MiB, WS_WED = 64 * MiB;
constexpr size_t WS_WIN = 92 * MiB, WS_WOUT = 99 * MiB, WS_WGU = 103 * MiB, WS_WD = 114 * MiB;
constexpr size_t WS_A = 120 * MiB;
constexpr size_t WS_ZH = 184 * MiB;
constexpr size_t WS_HL = 296 * MiB, WS_PA = 328 * MiB;
constexpr size_t WS_XS = 120 * MiB;
constexpr size_t WS_Y2 = 186 * MiB;
constexpr size_t WS_HM = 318 * MiB;
constexpr size_t WS_END = 430 * MiB;
constexpr float SA_X = 127.0f / 6.0f, SW_IN = 127.0f * 32.0f / 6.0f, SW_GU = 127.0f * 32.0f / 6.0f;
constexpr float WSC_OUT = 128.0f;
constexpr float WSC_D = 256.0f;
static_assert(WS_WED + (size_t)NEXP * DM * DFE <= WS_WIN && WS_WD + (size_t)DM * DFF * 2 <= WS_A && WS_A + (size_t)NTOK * DM * 2 <= WS_ZH && WS_ZH + (size_t)NTOK * DFF * 2 <= WS_END, "ws map");
static_assert(WS_ZH + (size_t)NTOK * INC * 2 <= WS_HL && WS_HL + (size_t)NTOK * LRUW * 2 <= WS_PA && WS_PA + (size_t)NTOK * LRUW * 2 <= WS_ZH + (size_t)NTOK * DFF * 2, "ws map (LRU)");
static_assert(WS_XS + (size_t)MAXTILES * 256 * DM <= WS_Y2 && WS_Y2 + (size_t)MAXTILES * 256 * DM * 2 <= WS_HM && WS_HM + (size_t)PASS_TILES * 256 * DFE <= WS_END, "ws map (MoE)");
constexpr int CW_BAR = 0;

constexpr int RING_BYTES = 131072;
constexpr int LDS_LUT = RING_BYTES;
constexpr int LDS_CTAB = LDS_LUT + 8192;
constexpr int CT_CB = 4 * 512, CT_BR = 5 * 512, CT_BI = 6 * 512, CT_SP = 7 * 512;
constexpr int LDS_MISC = LDS_CTAB + 16384;
constexpr int LDS_POS = LDS_MISC + 256;
constexpr int LDS_BYTES = 159744;
static_assert(LDS_POS + 1024 <= LDS_BYTES, "LDS map");

#define GAS __attribute__((address_space(1)))
#define LAS __attribute__((address_space(3)))
typedef unsigned short bf16;
typedef unsigned v4u __attribute__((ext_vector_type(4)));
typedef unsigned v2u __attribute__((ext_vector_type(2)));
typedef float f32x4 __attribute__((ext_vector_type(4)));
typedef float f32x16 __attribute__((ext_vector_type(16)));
typedef short bf16x8 __attribute__((ext_vector_type(8)));
typedef short s16x4 __attribute__((ext_vector_type(4)));
#define LDS_WAIT() asm volatile("s_waitcnt lgkmcnt(0)" ::: "memory")
#define VM_WAIT() asm volatile("s_waitcnt vmcnt(0)" ::: "memory")
__device__ __forceinline__ unsigned pk2(float lo, float hi) { return pg8::cvt_pk_bf16(lo, hi); }
__device__ __forceinline__ float bf2f(unsigned short h) { return __uint_as_float((unsigned)h << 16); }
__device__ __forceinline__ float bflo(unsigned w) { return __uint_as_float(w << 16); }
__device__ __forceinline__ float bfhi(unsigned w) { return __uint_as_float(w & 0xffff0000u); }
__device__ __forceinline__ float wave_sum(float v) {
#pragma unroll
    for (int o = 1; o < 64; o <<= 1) v += __shfl_xor(v, o);
    return v;
}
__device__ __forceinline__ float fast_sigmoid(float x) { return __builtin_amdgcn_rcpf(1.0f + __builtin_amdgcn_exp2f(x * -LOG2E)); }
__device__ __forceinline__ float gelu_tanh(float x) {
    const float t = 1.5957691216057308f * (x + 0.044715f * x * x * x);
    return x * fast_sigmoid(t);
}

#define XB_TMO      128
#define XB_XCNT(j)  (256  + 64 * (j))
#define XB_XSUB(j)  (1280 + 64 * (j))
#define XB_XGEN(j)  (2304 + 64 * (j))
#define XB_TOP      3328
#define XB_TOPGEN   3392
#define XCD_BAR_WORDS 3456
#define XB_SPIN_CAP (1u << 18)

__device__ __forceinline__ unsigned xb_ld(unsigned* p)              { return __hip_atomic_load(p, __ATOMIC_RELAXED, __HIP_MEMORY_SCOPE_AGENT); }
__device__ __forceinline__ unsigned xb_add(unsigned* p, unsigned v) { return __hip_atomic_fetch_add(p, v, __ATOMIC_RELAXED, __HIP_MEMORY_SCOPE_AGENT); }
__device__ __forceinline__ unsigned xb_xcc_id() { return (unsigned)__builtin_amdgcn_s_getreg((3 << 11) | 20) & 0xFu; }
#define XB_SPIN(cond, bar) do { unsigned _sp = 0; while (cond) { __builtin_amdgcn_s_sleep(1); \
    if ((++_sp & 255u) == 0u) { if (xb_ld(&(bar)[XB_TMO])) break; if (_sp > XB_SPIN_CAP) { atomicAdd(&(bar)[XB_TMO], 1u); break; } } } } while (0)

struct XcdBarrier {
    unsigned* bar; unsigned x;
    volatile LAS unsigned* st;
};

__device__ __forceinline__ XcdBarrier xcd_barrier_post(unsigned* bar, volatile LAS unsigned* st) {
    XcdBarrier b; b.bar = bar; b.x = xb_xcc_id(); b.st = st;
    if (threadIdx.x == 0) (void)xb_add(&bar[XB_XCNT(b.x)], 1u);
    return b;
}
__device__ __forceinline__ void xcd_barrier_complete(unsigned* bar, unsigned x, unsigned& nloc, unsigned& nx) {
    const unsigned G = gridDim.x * gridDim.y * gridDim.z;
    unsigned sum, cnt, mine, sp = 0u;
    for (;;) {
        sum = 0u; cnt = 0u; mine = 0u;
#pragma unroll
        for (unsigned j = 0; j < 16; ++j) { const unsigned c = xb_ld(&bar[XB_XCNT(j)]); sum += c; cnt += (c > 0u) ? 1u : 0u; mine = (j == x) ? c : mine; }
        if (sum == G) break;
        __builtin_amdgcn_s_sleep(1);
        if ((++sp & 255u) == 0u) { if (xb_ld(&bar[XB_TMO])) break; if (sp > XB_SPIN_CAP) { atomicAdd(&bar[XB_TMO], 1u); break; } }
    }
    nloc = mine > 0u ? mine : 1u; nx = cnt > 0u ? cnt : 1u;
}

__device__ __forceinline__ void xcd_barrier(const XcdBarrier& b) {
    asm volatile("s_waitcnt vmcnt(0)" ::: "memory");
    __syncthreads();
    if (threadIdx.x == 0) {
        unsigned* bar = b.bar;
        __builtin_amdgcn_s_waitcnt(0);
        unsigned nloc = b.st[0], nx = b.st[1];
        if (nloc == 0u) { xcd_barrier_complete(bar, b.x, nloc, nx); b.st[0] = nloc; b.st[1] = nx; }
        const unsigned old = xb_add(&bar[XB_XSUB(b.x)], 1u);
        const unsigned gen = old / nloc;
        if (old + 1u == (gen + 1u) * nloc) {
            __builtin_amdgcn_fence(__ATOMIC_RELEASE, "agent");
            asm volatile("s_waitcnt vmcnt(0)" ::: "memory");
            const unsigned og = xb_add(&bar[XB_TOP], 1u);
            const unsigned tg = og / nx;
            if (og + 1u == (tg + 1u) * nx) xb_add(&bar[XB_TOPGEN], 1u);
            else XB_SPIN(xb_ld(&bar[XB_TOPGEN]) == tg, bar);
            __builtin_amdgcn_fence(__ATOMIC_ACQUIRE, "agent");
            xb_add(&bar[XB_XGEN(b.x)], 1u);
            asm volatile("s_waitcnt vmcnt(0)" ::: "memory");
        } else {
            XB_SPIN(xb_ld(&bar[XB_XGEN(b.x)]) == gen, bar);
            __builtin_amdgcn_fence(__ATOMIC_ACQUIRE, "agent");
            asm volatile("s_waitcnt vmcnt(0)" ::: "memory");
        }
    }
    __syncthreads();
}

struct Args { const float* in[25]; float* out; unsigned char* ws; int ph_lo, ph_hi; };
struct Frame {
    LAS unsigned char* lds;
    int tid, lane, wave, G, blk;
};

__device__ __forceinline__ void p0_transpose_item(const float* W, int K, int N, bf16* WT, int mode, const float* ksA, const float* ksB, float nscale, int nscale_cols, LAS float* scr, int item, int lane) {
    const int nblk = N / 32, kb = item / nblk, nb = item % nblk, k0 = 64 * kb, n0 = 32 * nb;
    const float* ks = ksA ? (k0 < 512 ? ksA + k0 : ksB + (k0 - 512)) : nullptr;
#pragma unroll
    for (int i = 0; i < 32; ++i) { const int kk = 2 * i + (lane >> 5); float v = W[(size_t)(k0 + kk) * N + n0 + (lane & 31)]; if (ks) v *= ks[kk]; scr[kk * 33 + (lane & 31)] = v; }
    LDS_WAIT(); asm volatile("" ::: "memory");
    const int drow0 = (mode == 0) ? n0 : ((n0 >> 7) * 256 + (n0 & 127) + (mode == 2 ? 128 : 0));
    const float sc = (n0 < nscale_cols) ? nscale : 1.0f;
    const int c = lane & 7;
#pragma unroll
    for (int j = 0; j < 4; ++j) { const int n = (lane >> 3) + 8 * j; const LAS float* s = scr + (8 * c) * 33 + n;
        v4u o; o.x = pk2(s[0 * 33] * sc, s[1 * 33] * sc); o.y = pk2(s[2 * 33] * sc, s[3 * 33] * sc); o.z = pk2(s[4 * 33] * sc, s[5 * 33] * sc); o.w = pk2(s[6 * 33] * sc, s[7 * 33] * sc);
        *(v4u*)(WT + (size_t)(drow0 + n) * K + k0 + 8 * c) = o; }
    LDS_WAIT(); asm volatile("" ::: "memory");
}
template <int KIND  >
__device__ __forceinline__ void p0_transpose_item_f8(const float* W, int K, int N, unsigned char* WT, int mode, float scale, LAS float* scr, int item, int lane, const float* ksA = nullptr, const float* ksB = nullptr, float nscale = 1.0f, int nscale_cols = 0) {
    const int nblk = N / 32, kb = item / nblk, nb = item % nblk, k0 = 64 * kb, n0 = 32 * nb;
    const float* ks = ksA ? (k0 < 512 ? ksA + k0 : ksB + (k0 - 512)) : nullptr;
    if (n0 < nscale_cols) scale *= nscale;
#pragma unroll
    for (int i = 0; i < 32; ++i) { const int kk = 2 * i + (lane >> 5); float v = W[(size_t)(k0 + kk) * N + n0 + (lane & 31)] * scale; if (ks) v *= ks[kk]; scr[kk * 33 + (lane & 31)] = v; }
    LDS_WAIT(); asm volatile("" ::: "memory");
    const int drow0 = (mode == 0) ? n0 : ((n0 >> 7) * 256 + (n0 & 127) + (mode == 2 ? 128 : 0));
    const int c = lane & 3;
#pragma unroll
    for (int j = 0; j < 2; ++j) { const int n = (lane >> 2) + 16 * j; const LAS float* s = scr + (16 * c) * 33 + n;
        v4u o;
        if (KIND == 1) { o.x = pg8::pk4_fp8(s[0 * 33], s[1 * 33], s[2 * 33], s[3 * 33]); o.y = pg8::pk4_fp8(s[4 * 33], s[5 * 33], s[6 * 33], s[7 * 33]);
            o.z = pg8::pk4_fp8(s[8 * 33], s[9 * 33], s[10 * 33], s[11 * 33]); o.w = pg8::pk4_fp8(s[12 * 33], s[13 * 33], s[14 * 33], s[15 * 33]); }
        else { o.x = pg8::pk4_i8(s[0 * 33], s[1 * 33], s[2 * 33], s[3 * 33], 1.0f); o.y = pg8::pk4_i8(s[4 * 33], s[5 * 33], s[6 * 33], s[7 * 33], 1.0f);
            o.z = pg8::pk4_i8(s[8 * 33], s[9 * 33], s[10 * 33], s[11 * 33], 1.0f); o.w = pg8::pk4_i8(s[12 * 33], s[13 * 33], s[14 * 33], s[15 * 33], 1.0f); }
        *(v4u*)(WT + (size_t)(drow0 + n) * K + k0 + 16 * c) = o; }
    LDS_WAIT(); asm volatile("" ::: "memory");
}
__device__ __forceinline__ int t5_bucket(int rel) {
    const int n = rel < 0 ? -rel : rel;
    int v;
    if (n < 8) v = n;
    else { v = 8 + (n >= 12) + (n >= 16) + (n >= 23) + (n >= 32) + (n >= 46) + (n >= 64) + (n >= 91); }
    return (rel > 0 ? 16 : 0) + v;
}
__device__ __forceinline__ void p0_prologue(const Frame& F, const Args& A) {
    unsigned char* ws = A.ws;
    LAS float* scr = (LAS float*)(F.lds + F.wave * 8448);
    const int gw = F.blk * NWAVES + F.wave, NGW = F.G * NWAVES;
    bf16* WIN = (bf16*)(ws + WS_WIN); bf16* WOUT = (bf16*)(ws + WS_WOUT); bf16* WGU = (bf16*)(ws + WS_WGU); bf16* WD = (bf16*)(ws + WS_WD);
    unsigned char* WEGU = ws + WS_WEGU; unsigned char* WED = ws + WS_WED;
    constexpr int I_IN = (DM / 64) * (INC / 32), I_OUT = (DM / 64) * (DM / 32), I_GU = (DM / 64) * (DFF / 32), I_D = (DFF / 64) * (DM / 32);
    constexpr int I_EGU = (DM / 64) * (DFE / 32), I_ED = (DFE / 64) * (DM / 32);
    constexpr int NITEMS = 2 * I_IN + 2 * I_OUT + 2 * I_GU + I_D + NEXP * (2 * I_EGU + I_ED);
    for (int it = gw; it < NITEMS; it += NGW) {
        int r = it;
        if (r < 2 * I_IN) { const int l = r / I_IN; r -= l * I_IN;
            p0_transpose_item_f8<2>(A.in[2] + (size_t)l * DM * INC, DM, INC, (unsigned char*)WIN + (size_t)l * INC * DM, 0, SW_IN, scr, r, F.lane); continue; }
        r -= 2 * I_IN;
        if (r < 2 * I_OUT) { const int l = r / I_OUT; r -= l * I_OUT;
            p0_transpose_item_f8<1>(A.in[13] + (size_t)l * DM * DM, DM, DM, (unsigned char*)WOUT + (size_t)l * DM * DM, 0, WSC_OUT, scr, r, F.lane, A.in[11] + l * 512, A.in[12] + l * 512); continue; }
        r -= 2 * I_OUT;
        if (r < I_GU) { p0_transpose_item_f8<2>(A.in[16], DM, DFF, (unsigned char*)WGU, 1, SW_GU, scr, r, F.lane); continue; }
        r -= I_GU;
        if (r < I_GU) { p0_transpose_item_f8<2>(A.in[17], DM, DFF, (unsigned char*)WGU, 2, SW_GU, scr, r, F.lane); continue; }
        r -= I_GU;
        if (r < I_D) { p0_transpose_item_f8<1>(A.in[18], DFF, DM, (unsigned char*)WD, 0, WSC_D, scr, r, F.lane); continue; }
        r -= I_D;
        { constexpr int PER_E = 2 * I_EGU + I_ED; const int e = r / PER_E; r -= e * PER_E;
          if (r < I_EGU) { p0_transpose_item_f8<2>(A.in[20] + (size_t)e * DM * DFE, DM, DFE, WEGU + (size_t)e * 2 * DFE * DM, 1, SW_GU, scr, r, F.lane); continue; }
          r -= I_EGU;
          if (r < I_EGU) { p0_transpose_item_f8<2>(A.in[21] + (size_t)e * DM * DFE, DM, DFE, WEGU + (size_t)e * 2 * DFE * DM, 2, SW_GU, scr, r, F.lane); continue; }
          r -= I_EGU;
          p0_transpose_item_f8<1>(A.in[22] + (size_t)e * DFE * DM, DFE, DM, WED + (size_t)e * DM * DFE, 0, WSC_D, scr, r, F.lane); }
    }
    { const f32x4* x4 = (const f32x4*)A.in[0]; v4u* o = (v4u*)(ws + WS_A);
      const size_t n16 = (size_t)NTOK * DM / 16, stride = (size_t)F.G * NTHREADS;
      for (size_t i0 = (size_t)F.blk * NTHREADS + F.tid; i0 < n16; i0 += 4 * stride) {
          f32x4 a[4][4];
#pragma unroll
          for (int u = 0; u < 4; ++u) { const size_t i = i0 + u * stride; if (i < n16) {
#pragma unroll
              for (int q = 0; q < 4; ++q) a[u][q] = x4[4 * i + q]; } }
#pragma unroll
          for (int u = 0; u < 4; ++u) { const size_t i = i0 + u * stride; if (i < n16) { v4u w;
              w.x = pg8::pk4_i8(a[u][0].x, a[u][0].y, a[u][0].z, a[u][0].w, SA_X); w.y = pg8::pk4_i8(a[u][1].x, a[u][1].y, a[u][1].z, a[u][1].w, SA_X);
              w.z = pg8::pk4_i8(a[u][2].x, a[u][2].y, a[u][2].z, a[u][2].w, SA_X); w.w = pg8::pk4_i8(a[u][3].x, a[u][3].y, a[u][3].z, a[u][3].w, SA_X); o[i] = w; } } } }
    { bf16* GW = (bf16*)(ws + WS_GATEW);
      for (int i = F.blk * NTHREADS + F.tid; i < 2 * 2 * 8 * 64 * 64; i += F.G * NTHREADS) {
          const int d = i & 63, e = (i >> 6) & 63, n = (i >> 12) & 7, g = (i >> 15) & 1, l = i >> 16;
          const float v = (g ? A.in[8] : A.in[6])[(((size_t)l * 8 + n) * 64 + d) * 64 + e];
          GW[i] = (bf16)(pk2(v, v) & 0xffffu); } }
    if (F.blk == 0 && F.tid < 256) { float* LUT = (float*)(ws + WS_LUT); const int rel = F.tid - 191; const int bk = t5_bucket(rel);
#pragma unroll
        for (int h = 0; h < 8; ++h) LUT[h * 256 + F.tid] = A.in[1][bk * 8 + h] * LOG2E; }
}

template <int D> __device__ __forceinline__ float dpp_shr(float v, float idv) { return __builtin_bit_cast(float, __builtin_amdgcn_update_dpp(__builtin_bit_cast(int, idv), __builtin_bit_cast(int, v), 0x110 + D, 0xF, 0xF, false)); }
__device__ __forceinline__ float dpp_ror1(float v) { return __builtin_bit_cast(float, __builtin_amdgcn_update_dpp(0, __builtin_bit_cast(int, v), 0x121, 0xF, 0xF, false)); }
template <int D> __device__ __forceinline__ void scan_step(float& P, float& H) { const float P1 = dpp_shr<D>(P, 1.0f), H1 = dpp_shr<D>(H, 0.0f); H = P * H1 + H; P = P * P1; }
__device__ __forceinline__ void lru_tables(const Frame& F, const Args& A, int l) {
    LAS float* ct = (LAS float*)(F.lds + LDS_CTAB);
    const int ch = F.tid;
#pragma unroll
    for (int w = 0; w < 4; ++w) ct[w * 512 + ch] = A.in[4][(l * 4 + w) * LRUW + ch];
    ct[CT_CB + ch] = A.in[5][l * LRUW + ch]; ct[CT_BR + ch] = A.in[7][l * LRUW + ch]; ct[CT_BI + ch] = A.in[9][l * LRUW + ch];
    ct[CT_SP + ch] = 8.0f * log1pf(__expf(-A.in[10][l * LRUW + ch]));
}
struct LruNb { bf16x8 wr[2], wi[2]; v2u gb[4]; f32x4 hin; };
template <bool FINAL, int PART  >
__device__ __forceinline__ void lru_load_nb(LruNb& L, int nb, const bf16* Z, size_t row0, int n, int fr, int fq, const bf16* gwr, const bf16* gwi, const float* HinRow) {
    const int ch0 = 64 * n + 16 * nb + 4 * fq;
    if (PART & 1) {
#pragma unroll
        for (int ks = 0; ks < 2; ++ks) { L.wr[ks] = *(const bf16x8*)(gwr + (16 * nb + fr) * 64 + 32 * ks + 8 * fq); L.wi[ks] = *(const bf16x8*)(gwi + (16 * nb + fr) * 64 + 32 * ks + 8 * fq); }
    }
    if (FINAL && (PART & 2)) {
#pragma unroll
        for (int m = 0; m < 4; ++m) L.gb[m] = *(const v2u*)(Z + (row0 + 16 * m + fr) * INC + GBOFF + ch0);
        L.hin = *(const f32x4*)(HinRow + ch0);
    }
}
template <bool FINAL>
__device__ __forceinline__ void lru_tile(const bf16* Z, int b, int c, int n, int lane, const bf16* gwr, const bf16* gwi, const LAS float* ct,
                                         float* outP, float* outE, const float* Hin, LAS float* yl, bf16* HLg, bf16* PAg) {
    const int fr = lane & 15, fq = lane >> 4;
    const size_t seq0 = (size_t)b * SEQ, row0 = seq0 + (size_t)CHK * c;
    const float* HinRow = Hin + ((size_t)b * NCHUNK + c) * LRUW;
    LruNb cur, nxt;
    lru_load_nb<FINAL, 1>(cur, 0, Z, row0, n, fr, fq, gwr, gwi, HinRow);
    v4u xv[2][4][4];
    bf16x8 xa[4][2];
#define LRU_LOADXV(ks) do { _Pragma("unroll") for (int m = 0; m < 4; ++m) _Pragma("unroll") for (int w = 0; w < 4; ++w) { const int tt = CHK * c + 16 * m + fr + w - 3; \
        xv[ks][m][w] = *(const v4u*)(Z + (seq0 + (tt < 0 ? 0 : tt)) * INC + XBOFF + 64 * n + 32 * (ks) + 8 * fq); } } while (0)
#define LRU_CONV(ks) do { const int ch = 64 * n + 32 * (ks) + 8 * fq; float cw[4][8], cb[8]; \
        _Pragma("unroll") for (int w = 0; w < 4; ++w) { const f32x4 a = *(const LAS f32x4*)(ct + w * 512 + ch), bq = *(const LAS f32x4*)(ct + w * 512 + ch + 4); \
            cw[w][0] = a.x; cw[w][1] = a.y; cw[w][2] = a.z; cw[w][3] = a.w; cw[w][4] = bq.x; cw[w][5] = bq.y; cw[w][6] = bq.z; cw[w][7] = bq.w; } \
        { const f32x4 a = *(const LAS f32x4*)(ct + CT_CB + ch), bq = *(const LAS f32x4*)(ct + CT_CB + ch + 4); cb[0] = a.x; cb[1] = a.y; cb[2] = a.z; cb[3] = a.w; cb[4] = bq.x; cb[5] = bq.y; cb[6] = bq.z; cb[7] = bq.w; } \
        _Pragma("unroll") for (int m = 0; m < 4; ++m) { float a8[8]; \
            _Pragma("unroll") for (int j = 0; j < 8; ++j) a8[j] = cb[j]; \
            _Pragma("unroll") for (int w = 0; w < 4; ++w) { const int tt = CHK * c + 16 * m + fr + w - 3; const float mk = (tt >= 0) ? 1.0f : 0.0f; const v4u v = xv[ks][m][w]; \
                a8[0] += mk * cw[w][0] * bflo(v.x); a8[1] += mk * cw[w][1] * bfhi(v.x); a8[2] += mk * cw[w][2] * bflo(v.y); a8[3] += mk * cw[w][3] * bfhi(v.y); \
                a8[4] += mk * cw[w][4] * bflo(v.z); a8[5] += mk * cw[w][5] * bfhi(v.z); a8[6] += mk * cw[w][6] * bflo(v.w); a8[7] += mk * cw[w][7] * bfhi(v.w); } \
            v4u p; p.x = pk2(a8[0], a8[1]); p.y = pk2(a8[2], a8[3]); p.z = pk2(a8[4], a8[5]); p.w = pk2(a8[6], a8[7]); \
            xa[m][ks] = __builtin_bit_cast(bf16x8, p); } } while (0)
    if (FINAL) {
        LRU_LOADXV(0); asm volatile("" ::: "memory"); LRU_CONV(0); asm volatile("" ::: "memory");
        LRU_LOADXV(1); asm volatile("" ::: "memory"); LRU_CONV(1);
    } else {
        LRU_LOADXV(0); LRU_LOADXV(1); asm volatile("" ::: "memory"); LRU_CONV(0); LRU_CONV(1);
    }
#undef LRU_LOADXV
#undef LRU_CONV
    lru_load_nb<FINAL, 2>(cur, 0, Z, row0, n, fr, fq, gwr, gwi, HinRow);
#pragma unroll 1
    for (int nb = 0; nb < 4; ++nb) {
        const int ch0 = 64 * n + 16 * nb + 4 * fq;
        if (nb < 3) lru_load_nb<FINAL, 1>(nxt, nb + 1, Z, row0, n, fr, fq, gwr, gwi, HinRow);
        if (nb > 0) lru_load_nb<FINAL, 2>(cur, nb, Z, row0, n, fr, fq, gwr, gwi, HinRow);
        asm volatile("" ::: "memory");
        bf16x8 idf[2];
#pragma unroll
        for (int ks = 0; ks < 2; ++ks)
#pragma unroll
            for (int j = 0; j < 8; ++j) idf[ks][j] = (32 * ks + 8 * fq + j == 16 * nb + fr) ? (short)0x3F80 : (short)0;
        const f32x4 brv = *(const LAS f32x4*)(ct + CT_BR + ch0), biv = *(const LAS f32x4*)(ct + CT_BI + ch0), spv = *(const LAS f32x4*)(ct + CT_SP + ch0);
        f32x4 dr[4], di[4], dx[4];
#pragma unroll
        for (int m = 0; m < 4; ++m) { dr[m] = (f32x4){0.f, 0.f, 0.f, 0.f}; di[m] = dr[m]; dx[m] = dr[m];
#pragma unroll
            for (int ks = 0; ks < 2; ++ks) {
                dr[m] = __builtin_amdgcn_mfma_f32_16x16x32_bf16(cur.wr[ks], xa[m][ks], dr[m], 0, 0, 0);
                di[m] = __builtin_amdgcn_mfma_f32_16x16x32_bf16(cur.wi[ks], xa[m][ks], di[m], 0, 0, 0);
                dx[m] = __builtin_amdgcn_mfma_f32_16x16x32_bf16(idf[ks], xa[m][ks], dx[m], 0, 0, 0); } }
        float cP[4], cH[4];
#pragma unroll
        for (int r = 0; r < 4; ++r) { cP[r] = 1.0f; cH[r] = FINAL ? cur.hin[r] : 0.0f; }
#pragma unroll
        for (int m = 0; m < 4; ++m) {
            float P[4], H[4];
#pragma unroll
            for (int r = 0; r < 4; ++r) {
                const float rg = fast_sigmoid(dr[m][r] + brv[r]), ig = fast_sigmoid(di[m][r] + biv[r]);
                const float la = -rg * spv[r];
                const float a = __builtin_amdgcn_exp2f(la * LOG2E);
                const float x2 = 2.0f * la;
                const float om = (x2 > -0.02f) ? -x2 * (1.0f + x2 * (0.5f + x2 * (1.0f / 6.0f))) : (1.0f - a * a);
                const float u = __builtin_amdgcn_sqrtf(fmaxf(om, 0.f)) * (ig * dx[m][r]);
                P[r] = (fr == 0) ? a * cP[r] : a; H[r] = (fr == 0) ? a * cH[r] + u : u;
            }
#pragma unroll
            for (int r = 0; r < 4; ++r) { scan_step<1>(P[r], H[r]); scan_step<2>(P[r], H[r]); scan_step<4>(P[r], H[r]); scan_step<8>(P[r], H[r]); }
            if (!FINAL) {
                const size_t o = (row0 + 16 * m + fr) * LRUW + ch0;
                v2u wh, wp; wh.x = pk2(H[0], H[1]); wh.y = pk2(H[2], H[3]); wp.x = pk2(P[0], P[1]); wp.y = pk2(P[2], P[3]);
                *(v2u*)(HLg + o) = wh; *(v2u*)(PAg + o) = wp;
            }
            if (FINAL) {
                const v2u g = cur.gb[m];
                f32x4 y; y[0] = gelu_tanh(bflo(g.x)) * H[0]; y[1] = gelu_tanh(bfhi(g.x)) * H[1]; y[2] = gelu_tanh(bflo(g.y)) * H[2]; y[3] = gelu_tanh(bfhi(g.y)) * H[3];
                *(LAS f32x4*)(yl + (16 * m + fr) * LRUW + ch0) = y;
            }
#pragma unroll
            for (int r = 0; r < 4; ++r) { cP[r] = dpp_ror1(P[r]); cH[r] = dpp_ror1(H[r]); }
        }
        if (!FINAL) { if (fr == 0) { const size_t o = ((size_t)b * NCHUNK + c) * LRUW + ch0;
            *(f32x4*)(outP + o) = (f32x4){cP[0], cP[1], cP[2], cP[3]}; *(f32x4*)(outE + o) = (f32x4){cH[0], cH[1], cH[2], cH[3]}; } }
        cur.wr[0] = nxt.wr[0]; cur.wr[1] = nxt.wr[1]; cur.wi[0] = nxt.wi[0]; cur.wi[1] = nxt.wi[1];
    }
}

__device__ __forceinline__ void p_lru_summary(const Frame& F, const Args& A, int l, int nrep) {
    unsigned char* ws = A.ws;
    const bf16* Z = (const bf16*)(ws + WS_ZH);
    const bf16* GW = (const bf16*)(ws + WS_GATEW) + (size_t)l * 2 * 8 * 4096;
    lru_tables(F, A, l); __syncthreads();
    for (int it = F.blk; it < BATCH * NCHUNK * nrep; it += F.G) {
        const int b = (it >> 8) & 1, c = it & 255, n = F.wave;
        lru_tile<false>(Z, b, c, n, F.lane, GW + n * 4096, GW + 8 * 4096 + n * 4096, (const LAS float*)(F.lds + LDS_CTAB), (float*)(ws + WS_LRUP), (float*)(ws + WS_LRUE), (const float*)(ws + WS_HIN), nullptr, (bf16*)(ws + WS_HL), (bf16*)(ws + WS_PA));
    }
}
__device__ __forceinline__ void p_lru_carry(const Frame& F, const Args& A) {
    unsigned char* ws = A.ws;
    const float* Pg = (const float*)(ws + WS_LRUP); const float* Eg = (const float*)(ws + WS_LRUE); float* Hg = (float*)(ws + WS_HIN);
    const int gw = F.blk * NWAVES + F.wave, NGW = F.G * NWAVES;
    for (int p = gw; p < BATCH * LRUW; p += NGW) {
        const int b = p >> 9, ch = p & 511;
        float pk[4], ek[4];
#pragma unroll
        for (int k = 0; k < 4; ++k) { const size_t o = ((size_t)b * NCHUNK + 4 * F.lane + k) * LRUW + ch; pk[k] = Pg[o]; ek[k] = Eg[o]; }
        float P = pk[0], H = ek[0];
#pragma unroll
        for (int k = 1; k < 4; ++k) { H = pk[k] * H + ek[k]; P = pk[k] * P; }
#pragma unroll
        for (int d = 1; d < 64; d <<= 1) { const float P1 = __shfl_up(P, d), H1 = __shfl_up(H, d); if (F.lane >= d) { H = P * H1 + H; P = P * P1; } }
        float h = __shfl_up(H, 1); if (F.lane == 0) h = 0.f;
#pragma unroll
        for (int k = 0; k < 4; ++k) { Hg[((size_t)b * NCHUNK + 4 * F.lane + k) * LRUW + ch] = h; h = pk[k] * h + ek[k]; }
    }
}

__device__ __forceinline__ int crow(int r, int hi) { return (r & 3) + 8 * (r >> 2) + 4 * hi; }
__device__ __forceinline__ s16x4 vtr(const LAS unsigned char* p) { return __builtin_bit_cast(s16x4, __builtin_amdgcn_ds_read_tr16_b64_v4i16((LAS s16x4*)p)); }
__device__ __forceinline__ void p_mixer(const Frame& F, const Args& A, int l, int nrep) {
    unsigned char* ws = A.ws;
    const bf16* Z = (const bf16*)(ws + WS_ZH);
    unsigned char* Y8 = ws + WS_A;
    const bf16* GW = (const bf16*)(ws + WS_GATEW) + (size_t)l * 2 * 8 * 4096;
    LAS unsigned char* Kl = F.lds;
    LAS unsigned char* Vl = F.lds + 49152;
    LAS bf16* ya = (LAS bf16*)F.lds;
    LAS float* lut = (LAS float*)(F.lds + LDS_LUT);
    const int lane = F.lane, wave = F.wave, r32 = lane & 31, hi = lane >> 5;
    { const float* LUTg = (const float*)(ws + WS_LUT); for (int i = F.tid; i < 2048; i += NTHREADS) lut[i] = LUTg[i]; }
    const float sinkv = A.in[3][l * 8 + wave] * LOG2E;
    const int kvh = wave >> 2;
    for (int it = F.blk; it < BATCH * NCHUNK * nrep; it += F.G) {
        const int b = (it >> 8) & 1, c = it & 255;
        const size_t row0 = (size_t)b * SEQ + (size_t)CHK * c;
        const int T0 = (c >= 2) ? 0 : 2 - c;
        __syncthreads();
        {   const float* hinr = (const float*)(ws + WS_HIN) + ((size_t)b * NCHUNK + c) * LRUW + 8 * lane;
            const f32x4 hi0 = *(const f32x4*)hinr, hi1 = *(const f32x4*)(hinr + 4);
            const bf16* HLg = (const bf16*)(ws + WS_HL); const bf16* PAg = (const bf16*)(ws + WS_PA);
            v4u vh[8], vp[8], vg[8];
#pragma unroll
            for (int i = 0; i < 8; ++i) { const size_t r = row0 + 8 * wave + i;
                vh[i] = *(const v4u*)(HLg + r * LRUW + 8 * lane); vp[i] = *(const v4u*)(PAg + r * LRUW + 8 * lane); vg[i] = *(const v4u*)(Z + r * INC + GBOFF + 8 * lane); }
            asm volatile("" ::: "memory");
#pragma unroll
            for (int i = 0; i < 8; ++i) { const size_t r = row0 + 8 * wave + i;
                float y[8];
                y[0] = gelu_tanh(bflo(vg[i].x)) * (bflo(vh[i].x) + bflo(vp[i].x) * hi0.x); y[1] = gelu_tanh(bfhi(vg[i].x)) * (bfhi(vh[i].x) + bfhi(vp[i].x) * hi0.y);
                y[2] = gelu_tanh(bflo(vg[i].y)) * (bflo(vh[i].y) + bflo(vp[i].y) * hi0.z); y[3] = gelu_tanh(bfhi(vg[i].y)) * (bfhi(vh[i].y) + bfhi(vp[i].y) * hi0.w);
                y[4] = gelu_tanh(bflo(vg[i].z)) * (bflo(vh[i].z) + bflo(vp[i].z) * hi1.x); y[5] = gelu_tanh(bfhi(vg[i].z)) * (bfhi(vh[i].z) + bfhi(vp[i].z) * hi1.y);
                y[6] = gelu_tanh(bflo(vg[i].w)) * (bflo(vh[i].w) + bflo(vp[i].w) * hi1.z); y[7] = gelu_tanh(bfhi(vg[i].w)) * (bfhi(vh[i].w) + bfhi(vp[i].w) * hi1.w);
                const float ss = wave_sum((y[0] * y[0] + y[1] * y[1]) + (y[2] * y[2] + y[3] * y[3]) + (y[4] * y[4] + y[5] * y[5]) + (y[6] * y[6] + y[7] * y[7]));
                const float rstd = 1.0f / sqrtf(ss * (1.0f / 512.0f) + RMS_EPS);
                v2u w; w.x = pg8::pk4_fp8(y[0] * rstd, y[1] * rstd, y[2] * rstd, y[3] * rstd); w.y = pg8::pk4_fp8(y[4] * rstd, y[5] * rstd, y[6] * rstd, y[7] * rstd);
                *(v2u*)(Y8 + r * DM + 512 + 8 * lane) = w; }
        }
#pragma unroll
        for (int h2 = 0; h2 < 2; ++h2)
#pragma unroll
            for (int T = 0; T < 3; ++T) {
                v4u kq = (v4u){0u, 0u, 0u, 0u}, vq = kq;
                if (T >= T0) { const size_t cr = row0 + (size_t)CHK * T - 2 * CHK;
                    kq = *(const v4u*)(Z + (cr + lane) * INC + KOFF + 64 * h2 + 8 * wave);
                    vq = *(const v4u*)(Z + (cr + 16 * (wave & 3) + (lane >> 2)) * INC + VOFF + 64 * h2 + 32 * (wave >> 2) + 8 * (lane & 3)); }
                *(LAS v4u*)(Kl + (h2 * 3 + T) * 8192 + wave * 1024 + lane * 16) = kq;
                *(LAS v4u*)(Vl + (h2 * 3 + T) * 8192 + wave * 1024 + lane * 16) = vq;
            }
        __syncthreads();
        unsigned opk[2][2][8];
#pragma unroll
        for (int qb = 0; qb < 2; ++qb) {
            const int qi = 32 * qb + r32;
            bf16x8 qr[4];
#pragma unroll
            for (int d0 = 0; d0 < 4; ++d0) qr[d0] = *(const bf16x8*)(Z + (row0 + qi) * INC + 64 * wave + 16 * d0 + 8 * hi);
            f32x16 s[3][2];
            const LAS float* lutq = lut + wave * 256 + 63 - qi;
#pragma unroll
            for (int T = 0; T < 3; ++T) {
#pragma unroll
                for (int hf = 0; hf < 2; ++hf)
#pragma unroll
                    for (int r = 0; r < 16; ++r) s[T][hf][r] = lutq[64 * T + 32 * hf + crow(r, hi)];
                const LAS unsigned char* kb = Kl + (kvh * 3 + T) * 8192 + hi * 1024 + r32 * 16;
#pragma unroll
                for (int d0 = 0; d0 < 4; ++d0) {
                    const bf16x8 b0 = *(const LAS bf16x8*)(kb + d0 * 2048), b1 = *(const LAS bf16x8*)(kb + d0 * 2048 + 512);
                    s[T][0] = __builtin_amdgcn_mfma_f32_32x32x16_bf16(b0, qr[d0], s[T][0], 0, 0, 0);
                    s[T][1] = __builtin_amdgcn_mfma_f32_32x32x16_bf16(b1, qr[d0], s[T][1], 0, 0, 0);
                }
                if (T < T0) {
#pragma unroll
                    for (int hf = 0; hf < 2; ++hf)
#pragma unroll
                        for (int r = 0; r < 16; ++r) s[T][hf][r] = -1e30f;
                }
            }
            float mx = sinkv;
#pragma unroll
            for (int T = 0; T < 3; ++T)
#pragma unroll
                for (int hf = 0; hf < 2; ++hf)
#pragma unroll
                    for (int r = 0; r < 16; ++r) mx = fmaxf(mx, s[T][hf][r]);
            mx = fmaxf(mx, __shfl_xor(mx, 32));
            float lsum = 0.f;
#pragma unroll
            for (int T = 0; T < 3; ++T)
#pragma unroll
                for (int hf = 0; hf < 2; ++hf)
#pragma unroll
                    for (int r = 0; r < 16; ++r) { const float p = __builtin_amdgcn_exp2f(s[T][hf][r] - mx); s[T][hf][r] = p; lsum += p; }
            lsum += __shfl_xor(lsum, 32);
            lsum += __builtin_amdgcn_exp2f(sinkv - mx);
            const float inv = 1.0f / lsum;
            f32x16 o[2]; o[0] = (f32x16){0.f, 0.f, 0.f, 0.f, 0.f, 0.f, 0.f, 0.f, 0.f, 0.f, 0.f, 0.f, 0.f, 0.f, 0.f, 0.f}; o[1] = o[0];
#pragma unroll
            for (int T = 0; T < 3; ++T) {
                v4u pw[4];
#pragma unroll
                for (int k = 0; k < 4; ++k) { const int hf = k >> 1, r0 = (k & 1) * 8;
                    pw[k].x = pk2(s[T][hf][r0 + 0], s[T][hf][r0 + 1]); pw[k].y = pk2(s[T][hf][r0 + 2], s[T][hf][r0 + 3]);
                    pw[k].z = pk2(s[T][hf][r0 + 4], s[T][hf][r0 + 5]); pw[k].w = pk2(s[T][hf][r0 + 6], s[T][hf][r0 + 7]); }
                const LAS unsigned char* vb = Vl + (kvh * 3 + T) * 8192 + ((lane >> 4) & 1) * 32 + (lane & 3) * 8 + (4 * hi + ((lane & 15) >> 2)) * 64;
#pragma unroll
                for (int d0 = 0; d0 < 2; ++d0)
#pragma unroll
                    for (int ks = 0; ks < 4; ++ks) {
                        const s16x4 lo = vtr(vb + d0 * 4096 + ks * 1024), hv = vtr(vb + d0 * 4096 + ks * 1024 + 512);
                        const bf16x8 vf = (bf16x8){lo[0], lo[1], lo[2], lo[3], hv[0], hv[1], hv[2], hv[3]};
                        o[d0] = __builtin_amdgcn_mfma_f32_32x32x16_bf16(vf, __builtin_bit_cast(bf16x8, pw[ks]), o[d0], 0, 0, 0);
                    }
            }
#pragma unroll
            for (int d0 = 0; d0 < 2; ++d0)
#pragma unroll
                for (int r = 0; r < 16; r += 2) opk[qb][d0][r >> 1] = pk2(o[d0][r] * inv, o[d0][r + 1] * inv);
        }
        __syncthreads();
#pragma unroll
        for (int qb = 0; qb < 2; ++qb)
#pragma unroll
            for (int d0 = 0; d0 < 2; ++d0)
#pragma unroll
                for (int g = 0; g < 4; ++g) { v2u w; w.x = opk[qb][d0][2 * g]; w.y = opk[qb][d0][2 * g + 1];
                    *(LAS v2u*)(ya + (32 * qb + r32) * 512 + 64 * wave + 32 * d0 + 8 * g + 4 * hi) = w; }
        __syncthreads();
#pragma unroll
        for (int i = 0; i < 8; ++i) { const int tok = 8 * wave + i;
            const v4u w0 = *(const LAS v4u*)(ya + tok * 512 + 8 * lane);
            const float x0 = bflo(w0.x), x1 = bfhi(w0.x), x2 = bflo(w0.y), x3 = bfhi(w0.y), x4 = bflo(w0.z), x5 = bfhi(w0.z), x6 = bflo(w0.w), x7 = bfhi(w0.w);
            const float ss = wave_sum((x0 * x0 + x1 * x1) + (x2 * x2 + x3 * x3) + (x4 * x4 + x5 * x5) + (x6 * x6 + x7 * x7));
            const float rstd = 1.0f / sqrtf(ss * (1.0f / 512.0f) + RMS_EPS);
            v2u w; w.x = pg8::pk4_fp8(x0 * rstd, x1 * rstd, x2 * rstd, x3 * rstd); w.y = pg8::pk4_fp8(x4 * rstd, x5 * rstd, x6 * rstd, x7 * rstd);
            *(v2u*)(Y8 + (row0 + tok) * DM + 8 * lane) = w; }
    }
}

template <int MODE>
__device__ __forceinline__ void p_layernorm(const Frame& F, const Args& A, const float* gam, const float* bet) {
    unsigned char* ws = A.ws;
    float* X = A.out;
    bf16* XB = (bf16*)(ws + WS_A);
    const bf16* Y2 = (const bf16*)(ws + WS_Y2);
    const int* TP = (const int*)(ws + WS_TOKPOS); const float* TW = (const float*)(ws + WS_TOKW);
    LAS unsigned* misc = (LAS unsigned*)(F.lds + LDS_MISC);
    const int lane = F.lane;
    if (MODE == 1) { if (F.tid < 8) misc[F.tid] = 0u; __syncthreads(); }
    f32x4 gv[4], bv[4];
#pragma unroll
    for (int j = 0; j < 4; ++j) { gv[j] = *(const f32x4*)(gam + 4 * lane + 256 * j); bv[j] = *(const f32x4*)(bet + 4 * lane + 256 * j); }
    const int rpw = NTOK / F.G;
    const int m0 = F.blk * rpw;
    f32x4 v[4], nv[4]; v2u ya[4], yb[4], nya[4], nyb[4]; float w0 = 0.f, w1 = 0.f, nw0 = 0.f, nw1 = 0.f; int np0 = 0, np1 = 0;
    {   const int m = m0 + F.wave;
        const f32x4* xr = (const f32x4*)(X + (size_t)m * DM) + lane;
#pragma unroll
        for (int j = 0; j < 4; ++j) v[j] = xr[64 * j];
        if (MODE == 2) { const int p0 = TP[2 * m], p1 = TP[2 * m + 1]; w0 = TW[2 * m]; w1 = TW[2 * m + 1];
            const v2u* y0 = (const v2u*)(Y2 + (size_t)p0 * DM) + lane; const v2u* y1 = (const v2u*)(Y2 + (size_t)p1 * DM) + lane;
#pragma unroll
            for (int j = 0; j < 4; ++j) { ya[j] = y0[64 * j]; yb[j] = y1[64 * j]; }
            if (F.wave + NWAVES < rpw) { np0 = TP[2 * (m + NWAVES)]; np1 = TP[2 * (m + NWAVES) + 1]; nw0 = TW[2 * (m + NWAVES)]; nw1 = TW[2 * (m + NWAVES) + 1]; } }
    }
    for (int i = F.wave; i < rpw; i += NWAVES) {
        const int m = m0 + i;
        f32x4* xr = (f32x4*)(X + (size_t)m * DM) + lane;
        const bool more = (i + NWAVES < rpw);
        float nnw0 = 0.f, nnw1 = 0.f; int nnp0 = 0, nnp1 = 0;
        if (more) {
            const f32x4* xn = (const f32x4*)(X + (size_t)(m + NWAVES) * DM) + lane;
#pragma unroll
            for (int j = 0; j < 4; ++j) nv[j] = xn[64 * j];
            if (MODE == 2) {
                const v2u* y0 = (const v2u*)(Y2 + (size_t)np0 * DM) + lane; const v2u* y1 = (const v2u*)(Y2 + (size_t)np1 * DM) + lane;
#pragma unroll
                for (int j = 0; j < 4; ++j) { nya[j] = y0[64 * j]; nyb[j] = y1[64 * j]; }
                if (i + 2 * NWAVES < rpw) { nnp0 = TP[2 * (m + 2 * NWAVES)]; nnp1 = TP[2 * (m + 2 * NWAVES) + 1]; nnw0 = TW[2 * (m + 2 * NWAVES)]; nnw1 = TW[2 * (m + 2 * NWAVES) + 1]; }
            }
        }
        asm volatile("" ::: "memory");
        if (MODE == 2) {
#pragma unroll
            for (int j = 0; j < 4; ++j) { const v2u a = ya[j], c = yb[j];
                v[j].x = ALPHA * v[j].x + w0 * bflo(a.x) + w1 * bflo(c.x); v[j].y = ALPHA * v[j].y + w0 * bfhi(a.x) + w1 * bfhi(c.x);
                v[j].z = ALPHA * v[j].z + w0 * bflo(a.y) + w1 * bflo(c.y); v[j].w = ALPHA * v[j].w + w0 * bfhi(a.y) + w1 * bfhi(c.y); }
        }
        float s = 0.f;
#pragma unroll
        for (int j = 0; j < 4; ++j) s += (v[j].x + v[j].y) + (v[j].z + v[j].w);
        const float mean = wave_sum(s) * (1.f / DM); float s2 = 0.f;
#pragma unroll
        for (int j = 0; j < 4; ++j) { v[j] = v[j] - mean; s2 += (v[j].x * v[j].x + v[j].y * v[j].y) + (v[j].z * v[j].z + v[j].w * v[j].w); }
        const float rstd = 1.f / sqrtf(wave_sum(s2) * (1.f / DM) + LN_EPS);
#pragma unroll
        for (int j = 0; j < 4; ++j) { v[j] = v[j] * rstd * gv[j] + bv[j]; xr[64 * j] = v[j]; }
        if (MODE == 3) {
            unsigned* o4 = (unsigned*)((unsigned char*)XB + (size_t)m * DM) + lane;
#pragma unroll
            for (int j = 0; j < 4; ++j) o4[64 * j] = pg8::pk4_i8(v[j].x, v[j].y, v[j].z, v[j].w, SA_X);
        }
        if (MODE == 0) {
            v2u* o8 = (v2u*)(XB + (size_t)m * DM) + lane;
#pragma unroll
            for (int j = 0; j < 4; ++j) { v2u w; w.x = pk2(v[j].x, v[j].y); w.y = pk2(v[j].z, v[j].w); o8[64 * j] = w; }
        }
        if (MODE == 1) {
            const float* RW = A.in[19];
            float lg[8];
#pragma unroll
            for (int e = 0; e < 8; ++e) lg[e] = 0.f;
#pragma unroll
            for (int j = 0; j < 4; ++j)
#pragma unroll
                for (int q = 0; q < 4; ++q) { const int k = 4 * lane + 256 * j + q; const f32x4 a = *(const f32x4*)(RW + k * 8), c = *(const f32x4*)(RW + k * 8 + 4); const float xv = v[j][q];
                    lg[0] += xv * a.x; lg[1] += xv * a.y; lg[2] += xv * a.z; lg[3] += xv * a.w; lg[4] += xv * c.x; lg[5] += xv * c.y; lg[6] += xv * c.z; lg[7] += xv * c.w; }
#pragma unroll
            for (int e = 0; e < 8; ++e) lg[e] = wave_sum(lg[e]);
            int e0 = 0; float v0 = lg[0];
#pragma unroll
            for (int e = 1; e < 8; ++e) if (lg[e] > v0) { v0 = lg[e]; e0 = e; }
            int e1 = -1; float v1 = -3.0e38f;
#pragma unroll
            for (int e = 0; e < 8; ++e) if (e != e0 && lg[e] > v1) { v1 = lg[e]; e1 = e; }
            const float g0 = 1.0f / (1.0f + __expf(v1 - v0)), g1 = 1.0f - g0;
            if (lane == 0) { int* te = (int*)(ws + WS_TOKE) + 2 * m; float* tw = (float*)(ws + WS_TOKW) + 2 * m; te[0] = e0; te[1] = e1; tw[0] = g0; tw[1] = g1;
                atomicAdd((unsigned*)(misc + e0), 1u); atomicAdd((unsigned*)(misc + e1), 1u); }
        }
        if (more) {
#pragma unroll
            for (int j = 0; j < 4; ++j) v[j] = nv[j];
            if (MODE == 2) {
#pragma unroll
                for (int j = 0; j < 4; ++j) { ya[j] = nya[j]; yb[j] = nyb[j]; }
                w0 = nw0; w1 = nw1; np0 = nnp0; np1 = nnp1; nw0 = nnw0; nw1 = nnw1; }
        }
    }
    if (MODE == 1) { __syncthreads(); if (F.tid < 8) ((unsigned*)(ws + WS_HIST))[F.blk * 8 + F.tid] = misc[F.tid]; }
}

__device__ __forceinline__ void p_route(const Frame& F, const Args& A) {
    unsigned char* ws = A.ws;
    LAS unsigned* misc = (LAS unsigned*)(F.lds + LDS_MISC);
    LAS int* posl = (LAS int*)(F.lds + LDS_POS);
    const unsigned* hist = (const unsigned*)(ws + WS_HIST);
    const int lane = F.lane, rpw = NTOK / F.G;
    {
        const int e = F.wave; unsigned tot = 0u, bef = 0u;
        for (int v = lane; v < F.G; v += 64) { const unsigned h = hist[v * 8 + e]; tot += h; if (v < F.blk) bef += h; }
#pragma unroll
        for (int o = 1; o < 64; o <<= 1) { tot += __shfl_xor(tot, o); bef += __shfl_xor(bef, o); }
        if (lane == 0) { misc[16 + e] = tot; misc[24 + e] = bef; }
    }
    __syncthreads();
    int seg[9]; seg[0] = 0;
#pragma unroll
    for (int e = 0; e < 8; ++e) seg[e + 1] = seg[e] + (int)((misc[16 + e] + 255u) >> 8);
    if (F.blk == 0 && F.tid == 0) { int* meta = (int*)(ws + WS_META);
#pragma unroll
        for (int e = 0; e < 9; ++e) meta[e] = seg[e];
        meta[9] = seg[8]; }
    if (F.wave == 0) {
        const int* te = (const int*)(ws + WS_TOKE); int* tp = (int*)(ws + WS_TOKPOS); int* rt = nullptr; (void)rt;
        unsigned run[8];
#pragma unroll
        for (int e = 0; e < 8; ++e) run[e] = (unsigned)seg[e] * 256u + misc[24 + e];
        for (int h = 0; h < rpw; h += 64) {
            const int m = F.blk * rpw + h + lane;
#pragma unroll
            for (int k = 0; k < 2; ++k) {
                const int ek = te[2 * m + k]; int pos = 0;
#pragma unroll
                for (int e = 0; e < 8; ++e) { const unsigned long long mask = __ballot(ek == e);
                    if (ek == e) pos = (int)(run[e] + (unsigned)__popcll(mask & ((1ull << lane) - 1ull)));
                    run[e] += (unsigned)__popcll(mask); }
                tp[2 * m + k] = pos; posl[2 * (h + lane) + k] = pos;
            }
        }
    }
    __syncthreads();
    {
        const float* X = A.out; unsigned char* XS = ws + WS_XS;
        f32x4 a, b, c, d, na, nb, nc, nd;
        { const f32x4* xr = (const f32x4*)(X + (size_t)(F.blk * rpw + F.wave) * DM) + 4 * lane; a = xr[0]; b = xr[1]; c = xr[2]; d = xr[3]; }
        for (int i = F.wave; i < rpw; i += NWAVES) {
            const int m = F.blk * rpw + i; const int p0 = posl[2 * i], p1 = posl[2 * i + 1];
            const bool more = (i + NWAVES < rpw);
            if (more) { const f32x4* xr = (const f32x4*)(X + (size_t)(m + NWAVES) * DM) + 4 * lane; na = xr[0]; nb = xr[1]; nc = xr[2]; nd = xr[3]; }
            asm volatile("" ::: "memory");
            v4u w; w.x = pg8::pk4_i8(a.x, a.y, a.z, a.w, SA_X); w.y = pg8::pk4_i8(b.x, b.y, b.z, b.w, SA_X); w.z = pg8::pk4_i8(c.x, c.y, c.z, c.w, SA_X); w.w = pg8::pk4_i8(d.x, d.y, d.z, d.w, SA_X);
            *((v4u*)(XS + (size_t)p0 * DM) + lane) = w; *((v4u*)(XS + (size_t)p1 * DM) + lane) = w;
            if (more) { a = na; b = nb; c = nc; d = nd; }
        }
    }
    if (F.blk < 8) {
        int r0 = 0, r1 = 0;
#pragma unroll
        for (int e = 0; e < 8; ++e) if (e == F.blk) { r0 = seg[e] * 256 + (int)misc[16 + e]; r1 = seg[e + 1] * 256; }
        v4u* XS4 = (v4u*)(ws + WS_XS);
        for (size_t i = (size_t)r0 * 64 + F.tid; i < (size_t)r1 * 64; i += NTHREADS) XS4[i] = (v4u){0u, 0u, 0u, 0u};
    }
}

#ifndef MK_ONE_LAUNCH
#define MK_ONE_LAUNCH 1
#endif
constexpr int PH_MOE = 17, PH_FINAL = PH_MOE + 2 * NPASS, NPHASES = PH_FINAL + 1;

#ifndef PH_MASK
#define PH_MASK 0xFFFFFFFFu
#endif
#ifndef DUP_MASK
#define DUP_MASK 0u
#endif
#define NREP(k) ((((unsigned)DUP_MASK >> (k)) & 1u) ? 2 : 1)
#define IN(k) (((PH_MASK >> (k)) & 1u) && lo <= (k) && (k) < hi)
#define SEAM(k) do { if (MK_ONE_LAUNCH && lo <= (k) && (k) + 1 < hi) xcd_barrier(bar); } while (0)
template <int l>
__device__ __forceinline__ void layer_phases(const Frame& F, const Args& args, const XcdBarrier& bar, const int lo, const int hi) {
    unsigned char* ws = args.ws;
        const int pb = 1 + 9 * l;
        const float* xres = (l == 0) ? args.in[0] : args.out;
        if (IN(pb + 0)) {
            pg8::Gemm g{(const bf16*)(ws + WS_A), (const bf16*)(ws + WS_WIN + (size_t)l * INC * DM), NTOK, INC, DM / 2, 0};
            pg8::StaticOrder S; S.init(NTOK, INC, F.G, F.blk, NREP(pb + 0));
            pg8::EpiBf16 E{(bf16*)(ws + WS_ZH), INC, 1.0f / (SA_X * SW_IN), QSCALE / (SA_X * SW_IN), 2};
            pg8::gemm_phase<pg8::EpiBf16, pg8::StaticOrder, true, true, 2>(F.lds, g, S, E);
            SEAM(pb + 0);
        }
        if (IN(pb + 1)) { p_lru_summary(F, args, l, NREP(pb + 1)); SEAM(pb + 1); }
        if (IN(pb + 2)) for (int rep_ = 0; rep_ < NREP(pb + 2); ++rep_) { p_lru_carry(F, args); SEAM(pb + 2); }
        if (IN(pb + 3)) { p_mixer(F, args, l, NREP(pb + 3)); SEAM(pb + 3); }
        if (IN(pb + 4)) {
            pg8::Gemm g{(const bf16*)(ws + WS_A), (const bf16*)(ws + WS_WOUT + (size_t)l * DM * DM), NTOK, DM, DM / 2, 0};
            pg8::StaticOrder S; S.init(NTOK, DM, F.G, F.blk, NREP(pb + 4));
            pg8::EpiResF32 E{xres, args.out, DM, ALPHA, 1.0f / WSC_OUT};
            pg8::gemm_phase<pg8::EpiResF32, pg8::StaticOrder, true, true, 1>(F.lds, g, S, E);
            SEAM(pb + 4);
        }
        if (l == 0) {
            if (IN(6)) for (int rep_ = 0; rep_ < NREP(6); ++rep_) { p_layernorm<3>(F, args, args.in[14], args.in[15]); SEAM(6); }
            if (IN(7)) {
                pg8::Gemm g{(const bf16*)(ws + WS_A), (const bf16*)(ws + WS_WGU), NTOK, 2 * DFF, DM / 2, 0};
                pg8::StaticOrder S; S.init(NTOK, 2 * DFF, F.G, F.blk, NREP(7));
                pg8::EpiSwiGLU8 E{ws + WS_ZH, DFF, 1.0f / (SA_X * SW_GU)};
                pg8::gemm_phase<pg8::EpiSwiGLU8, pg8::StaticOrder, true, true, 2>(F.lds, g, S, E);
                SEAM(7);
            }
            if (IN(8)) {
                pg8::Gemm g{(const bf16*)(ws + WS_ZH), (const bf16*)(ws + WS_WD), NTOK, DM, DFF / 2, 0};
                pg8::StaticOrder S; S.init(NTOK, DM, F.G, F.blk, NREP(8));
                pg8::EpiResF32 E{args.out, args.out, DM, ALPHA, 1.0f / WSC_D};
                pg8::gemm_phase<pg8::EpiResF32, pg8::StaticOrder, true, true, 1>(F.lds, g, S, E);
                SEAM(8);
            }
            if (IN(9)) for (int rep_ = 0; rep_ < NREP(9); ++rep_) { p_layernorm<3>(F, args, args.in[23], args.in[24]); SEAM(9); }
        } else {
            if (IN(15)) for (int rep_ = 0; rep_ < NREP(15); ++rep_) { p_layernorm<1>(F, args, args.in[14] + DM, args.in[15] + DM); SEAM(15); }
            if (IN(16)) for (int rep_ = 0; rep_ < NREP(16); ++rep_) { p_route(F, args); SEAM(16); }
            for (int p = 0; p < NPASS; ++p) {
                int s1 = 0, s2 = 0, s3 = 0, s4 = 0, s5 = 0, s6 = 0, s7 = 0, nt = 0;
                if (IN(PH_MOE + 2 * p) || IN(PH_MOE + 1 + 2 * p)) { const int* meta = (const int*)(ws + WS_META);
                    s1 = __builtin_amdgcn_readfirstlane(meta[1]); s2 = __builtin_amdgcn_readfirstlane(meta[2]); s3 = __builtin_amdgcn_readfirstlane(meta[3]); s4 = __builtin_amdgcn_readfirstlane(meta[4]);
                    s5 = __builtin_amdgcn_readfirstlane(meta[5]); s6 = __builtin_amdgcn_readfirstlane(meta[6]); s7 = __builtin_amdgcn_readfirstlane(meta[7]); nt = __builtin_amdgcn_readfirstlane(meta[9]); }
                int nm = nt - PASS_TILES * p; nm = nm > PASS_TILES ? PASS_TILES : nm;
                if (IN(PH_MOE + 2 * p)) {
                    if (nm > 0) {
                        pg8::Gemm g{(const bf16*)(ws + WS_XS + (size_t)p * PASS_TILES * 256 * DM), (const bf16*)(ws + WS_WEGU), nm * 256, 2 * DFE, DM / 2, (size_t)2 * DFE * DM};
                        pg8::MoeOrder S; S.so.init(nm * 256, 2 * DFE, F.G, F.blk, NREP(PH_MOE + 2 * p)); S.tile0 = p * PASS_TILES; S.s1 = s1; S.s2 = s2; S.s3 = s3; S.s4 = s4; S.s5 = s5; S.s6 = s6; S.s7 = s7;
                        pg8::EpiSwiGLU8 E{ws + WS_HM, DFE, 1.0f / (SA_X * SW_GU)};
                        pg8::gemm_phase<pg8::EpiSwiGLU8, pg8::MoeOrder, true, true, 2>(F.lds, g, S, E);
                    }
                    SEAM(PH_MOE + 2 * p);
                }
                if (IN(PH_MOE + 1 + 2 * p)) {
                    if (nm > 0) {
                        pg8::Gemm g{(const bf16*)(ws + WS_HM), (const bf16*)(ws + WS_WED), nm * 256, DM, DFE / 2, (size_t)DM * DFE};
                        pg8::MoeOrder S; S.so.init(nm * 256, DM, F.G, F.blk, NREP(PH_MOE + 1 + 2 * p)); S.tile0 = p * PASS_TILES; S.s1 = s1; S.s2 = s2; S.s3 = s3; S.s4 = s4; S.s5 = s5; S.s6 = s6; S.s7 = s7;
                        pg8::EpiBf16 E{(bf16*)(ws + WS_Y2) + (size_t)p * PASS_TILES * 256 * DM, DM, 1.0f / WSC_D, 1.0f / WSC_D, 0};
                        pg8::gemm_phase<pg8::EpiBf16, pg8::MoeOrder, true, true, 1>(F.lds, g, S, E);
                    }
                    SEAM(PH_MOE + 1 + 2 * p);
                }
            }
            if (IN(PH_FINAL)) for (int rep_ = 0; rep_ < NREP(PH_FINAL); ++rep_) { p_layernorm<2>(F, args, args.in[23] + DM, args.in[24] + DM); }
        }
}
__global__ void __launch_bounds__(NTHREADS, 2) fwd_kernel(Args args) {
    extern __shared__ __attribute__((aligned(16))) unsigned char lds_raw[];
    Frame F;
    F.lds = (LAS unsigned char*)lds_raw;
    F.tid = threadIdx.x; F.lane = F.tid & 63; F.wave = __builtin_amdgcn_readfirstlane(F.tid >> 6);
    F.G = gridDim.x; F.blk = blockIdx.x;
    unsigned char* ws = args.ws;
    volatile LAS unsigned* MISC = (volatile LAS unsigned*)(F.lds + LDS_MISC);
    if (F.tid < 64) MISC[F.tid] = 0u;
    __syncthreads();
    XcdBarrier bar; bar.bar = (unsigned*)(ws + WS_CTL) + CW_BAR; bar.x = 0; bar.st = nullptr;
    if (MK_ONE_LAUNCH) bar = xcd_barrier_post((unsigned*)(ws + WS_CTL) + CW_BAR, MISC + 8);
    const int lo = args.ph_lo, hi = args.ph_hi;

    if (IN(0)) for (int rep_ = 0; rep_ < NREP(0); ++rep_) { p0_prologue(F, args); SEAM(0); }

    layer_phases<0>(F, args, bar, lo, hi);
    layer_phases<1>(F, args, bar, lo, hi);
}

extern "C" void kernel_launch(void* const* d_in, const int* in_sizes, int n_in, void* d_out, int out_size, void* d_ws, size_t ws_size, hipStream_t stream) {
    static int grid = 0;
    if (grid == 0) {
        if (n_in != 25 || in_sizes[0] != NTOK * DM || out_size != NTOK * DM || ws_size < WS_END) {
            fprintf(stderr, "kernel_launch: unexpected problem: n_in %d in0 %d out %d ws %zu (need %zu)\n", n_in, n_in > 0 ? in_sizes[0] : -1, out_size, ws_size, (size_t)WS_END); grid = -1; return; }
        int dev = 0, cus = 0, per_cu = 0;
        if (hipGetDevice(&dev) != hipSuccess || hipDeviceGetAttribute(&cus, hipDeviceAttributeMultiprocessorCount, dev) != hipSuccess) { fprintf(stderr, "kernel_launch: device query failed\n"); grid = -1; return; }
        if (hipFuncSetAttribute((const void*)fwd_kernel, hipFuncAttributeMaxDynamicSharedMemorySize, LDS_BYTES) != hipSuccess) { fprintf(stderr, "kernel_launch: hipFuncSetAttribute failed\n"); grid = -1; return; }
        if (hipOccupancyMaxActiveBlocksPerMultiprocessor(&per_cu, (const void*)fwd_kernel, NTHREADS, LDS_BYTES) != hipSuccess || per_cu < 1)
            fprintf(stderr, "kernel_launch: note: occupancy query reports %d workgroups per CU\n", per_cu);
        (void)hipGetLastError();
        grid = cus;
        if (grid != 256) fprintf(stderr, "kernel_launch: note: %d CUs (built for 256)\n", grid);
        if (NTOK % grid != 0 || grid > 256) grid = 256;
    }
    if (grid < 0) return;
    (void)hipMemsetAsync((char*)d_ws + WS_CTL, 0, CTL_ZERO_BYTES, stream);
    Args a{};
    for (int i = 0; i < 25; ++i) a.in[i] = (const float*)d_in[i];
    a.out = (float*)d_out; a.ws = (unsigned char*)d_ws;
#if MK_ONE_LAUNCH
    a.ph_lo = 0; a.ph_hi = NPHASES;
    hipLaunchKernelGGL(fwd_kernel, dim3(grid), dim3(NTHREADS), LDS_BYTES, stream, a);
#else
    for (int k = 0; k < NPHASES; ++k) { a.ph_lo = k; a.ph_hi = k + 1; hipLaunchKernelGGL(fwd_kernel, dim3(grid), dim3(NTHREADS), LDS_BYTES, stream, a); }
#endif
    const hipError_t le = hipPeekAtLastError();
    if (le != hipSuccess) fprintf(stderr, "kernel_launch: launch failed: %s\n", hipGetErrorName(le));
}
```

```cpp
#include <hip/hip_runtime.h>
#include <cstdio>
#include <cstdint>
namespace pg8 {
#define PG8_LAS __attribute__((address_space(3)))
typedef unsigned short bf16_t;
typedef short bf16x8 __attribute__((ext_vector_type(8)));
typedef float f32x4 __attribute__((ext_vector_type(4)));
typedef unsigned u32x4 __attribute__((ext_vector_type(4)));
typedef int v4i __attribute__((ext_vector_type(4)));
typedef int v8i __attribute__((ext_vector_type(8)));
constexpr int BM = 256, BK = 64, HALF = 128, HTB = HALF * BK * 2  , STAGE_BYTES = 8 * HTB, NXCD = 8, WGM = 8;

__host__ __device__ __forceinline__ int lds_byte(int r, int c) { const int st = (r >> 4) * 2 + (c >> 5), rr = r & 15, cc = c & 31, ob = rr * 64 + cc * 2; return st * 1024 + (ob ^ (((ob >> 9) & 1) << 5)); }
__host__ __device__ __forceinline__ void stage_rc(int b, int& R, int& C) { const int st = b / 1024, sb = b % 1024, swz = sb ^ (((sb >> 9) & 1) << 5); R = (st >> 1) * 16 + swz / 64; C = (st & 1) * 32 + (swz % 64) / 2; }
__host__ __device__ __forceinline__ int perm32(int rho) { const int n = rho >> 4, i = rho & 15; return 8 * (i >> 2) + 4 * n + (i & 3); }

struct Unit { int pm, pn, be; };
struct Gemm { const bf16_t* A; const bf16_t* Bt; int M, N, K; size_t bstride; };

struct StaticOrder {
    int nM, nN, nwg, G, c, rep;
    __host__ __device__ void init(int M, int N, int G_, int c_, int rep_ = 1) { nM = M / BM; nN = N / BM; nwg = nM * nN; G = G_; c = c_; rep = rep_; }
    __host__ __device__ bool next(int i, Unit& u) const {
        const long L = (long)i * G + c; if (L >= (long)nwg * rep) return false;
        int wgid = (int)(L % nwg); { const int q = nwg / NXCD, r = nwg % NXCD, xcd = wgid % NXCD, off = wgid / NXCD; wgid = (xcd < r ? xcd * (q + 1) : r * (q + 1) + (xcd - r) * q) + off; }
        const int nig = WGM * nN, gid = wgid / nig, fm = gid * WGM, gsz = (nM - fm) < WGM ? (nM - fm) : WGM;
        u.pm = fm + ((wgid % nig) % gsz); u.pn = (wgid % nig) / gsz; u.be = 0; return true;
    }
    __device__ __forceinline__ void a_ready(const Unit&) const {}
    __device__ __forceinline__ void done(const Unit&) const {}
};
struct MoeOrder {
    StaticOrder so; int tile0, s1, s2, s3, s4, s5, s6, s7;
    __device__ __forceinline__ bool next(int i, Unit& u) const {
        if (!so.next(i, u)) return false;
        const int t = tile0 + u.pm;
        u.be = (t >= s1) + (t >= s2) + (t >= s3) + (t >= s4) + (t >= s5) + (t >= s6) + (t >= s7); return true;
    }
    __device__ __forceinline__ void a_ready(const Unit&) const {}
    __device__ __forceinline__ void done(const Unit&) const {}
};

__device__ __forceinline__ unsigned cvt_pk_bf16(float lo, float hi) { unsigned r; asm volatile("v_cvt_pk_bf16_f32 %0, %1, %2" : "=v"(r) : "v"(lo), "v"(hi)); return r; }

struct EpiBf16 {
    static constexpr bool PERM = true, AFTER_DRAIN = false;
    bf16_t* O; int ldc; float scale, scale0; int n0tiles;
    __device__ __forceinline__ void operator()(const f32x4 (&acc)[2][2][4][2], const Unit& u, int wr, int wc, int fr, int fq) const {
        const int row0 = u.pm * BM + wr * 64 + fr, col0 = u.pn * BM + wc * 32 + 8 * fq;
        const float sc = (u.pn < n0tiles) ? scale0 : scale;
#pragma unroll
        for (int ai = 0; ai < 2; ++ai)
#pragma unroll
            for (int m = 0; m < 4; ++m) { bf16_t* rowp = O + (size_t)(row0 + ai * HALF + m * 16) * ldc + col0;
#pragma unroll
                for (int bj = 0; bj < 2; ++bj) { const f32x4 v0 = acc[ai][bj][m][0] * sc, v1 = acc[ai][bj][m][1] * sc;
                    u32x4 w; w.x = cvt_pk_bf16(v0[0], v0[1]); w.y = cvt_pk_bf16(v0[2], v0[3]); w.z = cvt_pk_bf16(v1[0], v1[1]); w.w = cvt_pk_bf16(v1[2], v1[3]);
                    *(u32x4*)(rowp + bj * HALF) = w; } }
    }
};
__device__ __forceinline__ float silu_mul(float g, float u) { return g * u * __builtin_amdgcn_rcpf(1.0f + __builtin_amdgcn_exp2f(g * -1.4426950408889634f)); }
struct EpiSwiGLU {
    static constexpr bool PERM = true, AFTER_DRAIN = false;
    bf16_t* H; int ldh;
    __device__ __forceinline__ void operator()(const f32x4 (&acc)[2][2][4][2], const Unit& u, int wr, int wc, int fr, int fq) const {
        const int row0 = u.pm * BM + wr * 64 + fr, col0 = u.pn * HALF + wc * 32 + 8 * fq;
#pragma unroll
        for (int ai = 0; ai < 2; ++ai)
#pragma unroll
            for (int m = 0; m < 4; ++m) { bf16_t* rowp = H + (size_t)(row0 + ai * HALF + m * 16) * ldh + col0;
                const f32x4 g0 = acc[ai][0][m][0], g1 = acc[ai][0][m][1], u0 = acc[ai][1][m][0], u1 = acc[ai][1][m][1];
                u32x4 w; w.x = cvt_pk_bf16(silu_mul(g0[0], u0[0]), silu_mul(g0[1], u0[1])); w.y = cvt_pk_bf16(silu_mul(g0[2], u0[2]), silu_mul(g0[3], u0[3]));
                w.z = cvt_pk_bf16(silu_mul(g1[0], u1[0]), silu_mul(g1[1], u1[1])); w.w = cvt_pk_bf16(silu_mul(g1[2], u1[2]), silu_mul(g1[3], u1[3]));
                *(u32x4*)rowp = w; }
    }
};
__device__ __forceinline__ unsigned pk4_fp8(float a, float b, float c, float d) { int w = __builtin_amdgcn_cvt_pk_fp8_f32(a, b, 0, false); w = __builtin_amdgcn_cvt_pk_fp8_f32(c, d, w, true); return (unsigned)w; }
__device__ __forceinline__ unsigned pk4_i8(float a, float b, float c, float d, float s) {
    const int ia = __float2int_rn(fminf(fmaxf(a * s, -127.f), 127.f)), ib = __float2int_rn(fminf(fmaxf(b * s, -127.f), 127.f));
    const int ic = __float2int_rn(fminf(fmaxf(c * s, -127.f), 127.f)), id = __float2int_rn(fminf(fmaxf(d * s, -127.f), 127.f));
    return (unsigned)(ia & 255) | ((unsigned)(ib & 255) << 8) | ((unsigned)(ic & 255) << 16) | ((unsigned)id << 24);
}
struct EpiSwiGLU8 {
    static constexpr bool PERM = true, AFTER_DRAIN = false;
    unsigned char* H; int ldh; float sc;
    __device__ __forceinline__ void operator()(const f32x4 (&acc)[2][2][4][2], const Unit& u, int wr, int wc, int fr, int fq) const {
        const int row0 = u.pm * BM + wr * 64 + fr, col0 = u.pn * HALF + wc * 32 + 8 * fq;
        typedef unsigned u32x2 __attribute__((ext_vector_type(2)));
#pragma unroll
        for (int ai = 0; ai < 2; ++ai)
#pragma unroll
            for (int m = 0; m < 4; ++m) { unsigned char* rowp = H + (size_t)(row0 + ai * HALF + m * 16) * ldh + col0;
                const f32x4 g0 = acc[ai][0][m][0] * sc, g1 = acc[ai][0][m][1] * sc, u0 = acc[ai][1][m][0] * sc, u1 = acc[ai][1][m][1] * sc;
                u32x2 w; w.x = pk4_fp8(silu_mul(g0[0], u0[0]), silu_mul(g0[1], u0[1]), silu_mul(g0[2], u0[2]), silu_mul(g0[3], u0[3]));
                w.y = pk4_fp8(silu_mul(g1[0], u1[0]), silu_mul(g1[1], u1[1]), silu_mul(g1[2], u1[2]), silu_mul(g1[3], u1[3]));
                *(u32x2*)rowp = w; }
    }
};
struct EpiResF32 {
    static constexpr bool PERM = false, AFTER_DRAIN = false;
    const float* res; float* out; int ldc; float alpha, scale;
    __device__ __forceinline__ void operator()(const f32x4 (&acc)[2][2][4][2], const Unit& u, int wr, int wc, int fr, int fq) const {
        const int row0 = u.pm * BM + wr * 64 + fr, col0 = u.pn * BM + wc * 32 + 4 * fq;
#pragma unroll
        for (int ai = 0; ai < 2; ++ai)
#pragma unroll
            for (int m = 0; m < 4; ++m) { const size_t off = (size_t)(row0 + ai * HALF + m * 16) * ldc + col0;
                f32x4 rv[2][2];
#pragma unroll
                for (int bj = 0; bj < 2; ++bj)
#pragma unroll
                    for (int n = 0; n < 2; ++n) rv[bj][n] = *(const f32x4*)(res + off + bj * HALF + n * 16);
#pragma unroll
                for (int bj = 0; bj < 2; ++bj)
#pragma unroll
                    for (int n = 0; n < 2; ++n) *(f32x4*)(out + off + bj * HALF + n * 16) = rv[bj][n] * alpha + acc[ai][bj][m][n] * scale;
                asm volatile("" ::: "memory"); }
    }
};

__device__ __forceinline__ void mfma8(f32x4& c, const v8i a, const v8i b, const int scl) { asm volatile("v_mfma_scale_f32_16x16x128_f8f6f4 %0, %1, %2, %0, %3, %3 op_sel_hi:[0,0,0]" : "+v"(c) : "v"(a), "v"(b), "v"(scl)); }
template <class Epi, class Sched, bool ALIGN_EPI = false, bool SP2 = false, int OPK = 0>
__device__ __forceinline__ void gemm_phase(PG8_LAS unsigned char* lds, const Gemm g, const Sched& S, const Epi& E) {
    const int tid = threadIdx.x, wid = __builtin_amdgcn_readfirstlane(tid >> 6), lane = tid & 63, wr = wid >> 2, wc = wid & 3, fr = lane & 15, fq = lane >> 4;
    const int K = g.K, nt = K / BK;
    unsigned voffA[2], voffB[2];
#pragma unroll
    for (int i = 0; i < 2; ++i) { int R, C; stage_rc(tid * 16 + i * 8192, R, C); const int Rb = Epi::PERM ? ((R & ~31) + perm32(R & 31)) : R;
        voffA[i] = (unsigned)(R * K + C) * 2u; voffB[i] = (unsigned)(Rb * K + C) * 2u; }
    const size_t kstep = (size_t)(BK * 2);
    const size_t hstep = (size_t)HALF * K * 2;
    const size_t tstep = 2 * hstep;
    const unsigned ldsw = (unsigned)wid * 1024u;
    const int aoff = lds_byte(wr * 64 + fr, fq * 8), boff = lds_byte(wc * 32 + fr, fq * 8);
#define PG8_SA(b, h) (((b) * 2 + (h)) * HTB)
#define PG8_SB(b, h) ((4 + (b) * 2 + (h)) * HTB)
#define PG8_STAGE(bufoff, gbase, voff) do { _Pragma("unroll") for (int _i = 0; _i < 2; ++_i) \
        __builtin_amdgcn_global_load_lds((const unsigned*)((const char*)(gbase) + (voff)[_i]), (PG8_LAS unsigned*)(lds + (bufoff) + ldsw + _i * 8192), 16, 0, 0); } while (0)
#define PG8_LDA(dst, b, h) do { if constexpr (OPK == 1) { _Pragma("unroll") for (int m = 0; m < 4; ++m) { dst##8[m][0] = *(const PG8_LAS v4i*)(lds + PG8_SA(b, h) + aoff + m * 2048); dst##8[m][1] = *(const PG8_LAS v4i*)(lds + PG8_SA(b, h) + aoff + m * 2048 + 1024); } } \
    else { _Pragma("unroll") for (int m = 0; m < 4; ++m) _Pragma("unroll") for (int k = 0; k < 2; ++k) dst[m][k] = *(const PG8_LAS bf16x8*)(lds + PG8_SA(b, h) + aoff + m * 2048 + k * 1024); } } while (0)
#define PG8_LDB(dst, b, h) do { if constexpr (OPK == 1) { _Pragma("unroll") for (int n = 0; n < 2; ++n) { dst##8[n][0] = *(const PG8_LAS v4i*)(lds + PG8_SB(b, h) + boff + n * 2048); dst##8[n][1] = *(const PG8_LAS v4i*)(lds + PG8_SB(b, h) + boff + n * 2048 + 1024); } } \
    else { _Pragma("unroll") for (int n = 0; n < 2; ++n) _Pragma("unroll") for (int k = 0; k < 2; ++k) dst[n][k] = *(const PG8_LAS bf16x8*)(lds + PG8_SB(b, h) + boff + n * 2048 + k * 1024); } } while (0)
#define PG8_MMA(ai, bj, At, Bt) do { __builtin_amdgcn_s_setprio(1); if constexpr (OPK == 1) { _Pragma("unroll") for (int m = 0; m < 4; ++m) _Pragma("unroll") for (int n = 0; n < 2; ++n) \
        mfma8(acc[ai][bj][m][n], __builtin_shufflevector(Bt##8[n][0], Bt##8[n][1], 0, 1, 2, 3, 4, 5, 6, 7), __builtin_shufflevector(At##8[m][0], At##8[m][1], 0, 1, 2, 3, 4, 5, 6, 7), scl8); } \
    else if constexpr (OPK == 2) { _Pragma("unroll") for (int m = 0; m < 4; ++m) _Pragma("unroll") for (int n = 0; n < 2; ++n) _Pragma("unroll") for (int k = 0; k < 2; ++k) \
        acc[ai][bj][m][n] = __builtin_bit_cast(f32x4, __builtin_amdgcn_mfma_i32_16x16x64_i8(__builtin_bit_cast(v4i, Bt[n][k]), __builtin_bit_cast(v4i, At[m][k]), __builtin_bit_cast(v4i, acc[ai][bj][m][n]), 0, 0, 0)); } \
    else { _Pragma("unroll") for (int m = 0; m < 4; ++m) _Pragma("unroll") for (int n = 0; n < 2; ++n) _Pragma("unroll") for (int k = 0; k < 2; ++k) \
        acc[ai][bj][m][n] = __builtin_amdgcn_mfma_f32_16x16x32_bf16(Bt[n][k], At[m][k], acc[ai][bj][m][n], 0, 0, 0); } __builtin_amdgcn_s_setprio(0); } while (0)
#define PG8_WAIT_V(n) asm volatile("s_waitcnt vmcnt(" #n ")" ::: "memory")
#define PG8_WAIT_L(n) asm volatile("s_waitcnt lgkmcnt(" #n ")" ::: "memory")
#define PG8_BAR __builtin_amdgcn_s_barrier()
#define PG8_SCHED __builtin_amdgcn_sched_barrier(0)
    Unit cur, nxt; int ui = 0;
    if (!S.next(0, cur)) return;
    f32x4 acc[2][2][4][2];
#pragma unroll
    for (int a = 0; a < 2; ++a)
#pragma unroll
        for (int b = 0; b < 2; ++b)
#pragma unroll
            for (int m = 0; m < 4; ++m)
#pragma unroll
                for (int n = 0; n < 2; ++n) acc[a][b][m][n] = (f32x4){0.f, 0.f, 0.f, 0.f};
    bf16x8 At[4][2], B0[2][2], B1[2][2];
    v4i At8[4][2], B08[2][2], B18[2][2];
    int scl8 = 0x7F7F7F7F; asm volatile("" : "+v"(scl8));
    const char* cA = (const char*)g.A + (size_t)cur.pm * tstep; const char* cB = (const char*)g.Bt + (size_t)cur.be * g.bstride + (size_t)cur.pn * tstep;
    S.a_ready(cur);
    if constexpr (SP2) {
        PG8_STAGE(PG8_SB(0, 0), cB, voffB); PG8_STAGE(PG8_SB(0, 1), cB + hstep, voffB); PG8_STAGE(PG8_SA(0, 0), cA, voffA); PG8_STAGE(PG8_SA(0, 1), cA + hstep, voffA);
        if (wr == 1) PG8_BAR;
        PG8_WAIT_V(2); PG8_BAR;
        PG8_STAGE(PG8_SB(1, 0), cB + kstep, voffB); PG8_STAGE(PG8_SA(1, 0), cA + kstep, voffA); PG8_STAGE(PG8_SB(1, 1), cB + hstep + kstep, voffB);
        PG8_WAIT_V(6); PG8_BAR;
    } else {
        PG8_STAGE(PG8_SB(0, 0), cB, voffB); PG8_STAGE(PG8_SA(0, 0), cA, voffA); PG8_STAGE(PG8_SB(0, 1), cB + hstep, voffB); PG8_STAGE(PG8_SA(0, 1), cA + hstep, voffA);
        if (wr == 1) PG8_BAR;
        PG8_WAIT_V(4); PG8_BAR;
        PG8_STAGE(PG8_SB(1, 0), cB + kstep, voffB); PG8_STAGE(PG8_SA(1, 0), cA + kstep, voffA); PG8_STAGE(PG8_SB(1, 1), cB + hstep + kstep, voffB);
        PG8_WAIT_V(6); PG8_BAR;
    }
    for (;;) {
        const bool has_next = S.next(ui + 1, nxt);
        const char* nA = has_next ? (const char*)g.A + (size_t)nxt.pm * tstep : cA; const char* nB = has_next ? (const char*)g.Bt + (size_t)nxt.be * g.bstride + (size_t)nxt.pn * tstep : cB;
#pragma unroll 1
        for (int t = 0; t < nt; t += 2) {
            const bool last = (t == nt - 2);
            const char* a1 = cA + (size_t)(t + 1) * kstep;
            const char* a2 = last ? nA : cA + (size_t)(t + 2) * kstep; const char* b2 = last ? nB : cB + (size_t)(t + 2) * kstep;
            const char* a3 = a2 + kstep; const char* b3 = b2 + kstep;
            if (last && has_next) S.a_ready(nxt);
            if constexpr (SP2) {
            PG8_LDB(B0, 0, 0); PG8_LDB(B1, 0, 1); PG8_SCHED; PG8_LDA(At, 0, 0); PG8_STAGE(PG8_SA(1, 1), a1 + hstep, voffA);
            PG8_WAIT_V(8); PG8_WAIT_L(0); PG8_BAR; PG8_MMA(0, 0, At, B0); PG8_MMA(0, 1, At, B1); PG8_BAR; PG8_SCHED;
            PG8_LDA(At, 0, 1); PG8_STAGE(PG8_SB(0, 0), b2, voffB); PG8_STAGE(PG8_SB(0, 1), b2 + hstep, voffB); PG8_STAGE(PG8_SA(0, 0), a2, voffA);
            PG8_WAIT_V(8); PG8_WAIT_L(0); PG8_BAR; PG8_MMA(1, 0, At, B0); PG8_MMA(1, 1, At, B1); PG8_BAR; PG8_SCHED;
            PG8_LDB(B0, 1, 0); PG8_LDB(B1, 1, 1); PG8_SCHED; PG8_LDA(At, 1, 0); PG8_STAGE(PG8_SA(0, 1), a2 + hstep, voffA);
            PG8_WAIT_V(8); PG8_WAIT_L(0); PG8_BAR; PG8_MMA(0, 0, At, B0); PG8_MMA(0, 1, At, B1); PG8_BAR; PG8_SCHED;
            PG8_LDA(At, 1, 1); PG8_STAGE(PG8_SB(1, 0), b3, voffB); PG8_STAGE(PG8_SB(1, 1), b3 + hstep, voffB); PG8_STAGE(PG8_SA(1, 0), a3, voffA);
            PG8_WAIT_V(8); PG8_WAIT_L(0); PG8_BAR; PG8_MMA(1, 0, At, B0); PG8_MMA(1, 1, At, B1); PG8_BAR; PG8_SCHED;
            } else {
            PG8_LDB(B0, 0, 0); PG8_SCHED; PG8_LDA(At, 0, 0); PG8_STAGE(PG8_SA(1, 1), a1 + hstep, voffA);
            PG8_WAIT_L(8); PG8_BAR; PG8_WAIT_L(0); PG8_MMA(0, 0, At, B0); PG8_BAR; PG8_SCHED;
            PG8_LDB(B1, 0, 1); PG8_STAGE(PG8_SB(0, 0), b2, voffB);
            PG8_BAR; PG8_WAIT_L(0); PG8_MMA(0, 1, At, B1); PG8_BAR;
            PG8_LDA(At, 0, 1); PG8_STAGE(PG8_SA(0, 0), a2, voffA);
            PG8_BAR; PG8_WAIT_L(0); PG8_MMA(1, 0, At, B0); PG8_BAR; PG8_SCHED;
            PG8_STAGE(PG8_SB(0, 1), b2 + hstep, voffB);
            PG8_WAIT_V(6); PG8_BAR; PG8_MMA(1, 1, At, B1); PG8_BAR;
            PG8_LDB(B0, 1, 0); PG8_SCHED; PG8_LDA(At, 1, 0); PG8_STAGE(PG8_SA(0, 1), a2 + hstep, voffA);
            PG8_WAIT_L(8); PG8_BAR; PG8_WAIT_L(0); PG8_MMA(0, 0, At, B0); PG8_BAR; PG8_SCHED;
            PG8_LDB(B1, 1, 1); PG8_STAGE(PG8_SB(1, 0), b3, voffB);
            PG8_BAR; PG8_WAIT_L(0); PG8_MMA(0, 1, At, B1); PG8_BAR;
            PG8_LDA(At, 1, 1); PG8_STAGE(PG8_SA(1, 0), a3, voffA);
            PG8_BAR; PG8_WAIT_L(0); PG8_MMA(1, 0, At, B0); PG8_BAR; PG8_SCHED;
            PG8_STAGE(PG8_SB(1, 1), b3 + hstep, voffB);
            PG8_WAIT_V(6); PG8_BAR; PG8_MMA(1, 1, At, B1); PG8_BAR;
            }
        }
        if constexpr (OPK == 1) asm volatile("s_nop 15\n\ts_nop 15" ::: "memory");
        if constexpr (OPK == 2) {
#pragma unroll
            for (int a = 0; a < 2; ++a)
#pragma unroll
                for (int b = 0; b < 2; ++b)
#pragma unroll
                    for (int m = 0; m < 4; ++m)
#pragma unroll
                        for (int n = 0; n < 2; ++n) { const v4i iv = __builtin_bit_cast(v4i, acc[a][b][m][n]); acc[a][b][m][n] = (f32x4){(float)iv[0], (float)iv[1], (float)iv[2], (float)iv[3]}; }
        }
        if constexpr (ALIGN_EPI) { if (wr == 0) PG8_BAR; }
        if constexpr (!Epi::AFTER_DRAIN) { E(acc, cur, wr, wc, fr, fq); S.done(cur); }
        if (!has_next) break;
#pragma unroll
        for (int a = 0; a < 2; ++a)
#pragma unroll
            for (int b = 0; b < 2; ++b)
#pragma unroll
                for (int m = 0; m < 4; ++m)
#pragma unroll
                    for (int n = 0; n < 2; ++n) acc[a][b][m][n] = (f32x4){0.f, 0.f, 0.f, 0.f};
        cur = nxt; cA = nA; cB = nB; ++ui;
        if constexpr (ALIGN_EPI) { if (wr == 1) PG8_BAR; }
    }
    PG8_WAIT_V(0);
    if constexpr (!ALIGN_EPI) { if (wr == 0) PG8_BAR; }
    PG8_BAR;
    if constexpr (Epi::AFTER_DRAIN) { E.fused(acc, cur, wr, wc, fr, fq, lds, wid, lane); S.done(cur); }
#undef PG8_SA
#undef PG8_SB
#undef PG8_STAGE
#undef PG8_LDA
#undef PG8_LDB
#undef PG8_MMA
#undef PG8_WAIT_V
#undef PG8_WAIT_L
#undef PG8_BAR
#undef PG8_SCHED
}
}

constexpr int BATCH = 2, SEQ = 16384, DM = 1024, NTOK = BATCH * SEQ;
constexpr int CHK = 64, NCHUNK = SEQ / CHK;
constexpr int INC = 1792, KOFF = 512, VOFF = 640, XBOFF = 768, GBOFF = 1280;
constexpr int LRUW = 512, DFF = 2816, DFE = 3584, NEXP = 8;
constexpr int MAXTILES = 264, PASS_TILES = 264, NPASS = 1;
constexpr float ALPHA = 1.41421356237309515f, LN_EPS = 1e-5f, RMS_EPS = 1e-6f, LOG2E = 1.4426950408889634f, QSCALE = 0.125f * LOG2E;
constexpr int NWAVES = 8, NTHREADS = 512;

constexpr size_t MiB = 1u << 20;
constexpr size_t WS_CTL = 0, CTL_ZERO_BYTES = 64 * 1024;
constexpr size_t WS_LUT = 1 * MiB;
constexpr size_t WS_GATEW = 1 * MiB + 64 * 1024;
constexpr size_t WS_HIST = 1 * MiB + 512 * 1024;
constexpr size_t WS_META = 1 * MiB + 576 * 1024;
constexpr size_t WS_TOKE = 2 * MiB, WS_TOKW = 2 * MiB + 256 * 1024, WS_TOKPOS = 2 * MiB + 512 * 1024;
constexpr size_t WS_LRUP = 3 * MiB, WS_LRUE = 4 * MiB, WS_HIN = 5 * MiB;
constexpr size_t WS_WEGU = 8 * MiB, WS_WED = 64 * MiB;
constexpr size_t WS_WIN = 92 * MiB, WS_WOUT = 99 * MiB, WS_WGU = 103 * MiB, WS_WD = 114 * MiB;
constexpr size_t WS_A = 120 * MiB;
constexpr size_t WS_ZH = 184 * MiB;
constexpr size_t WS_HL = 296 * MiB, WS_PA = 328 * MiB;
constexpr size_t WS_XS = 120 * MiB;
constexpr size_t WS_Y2 = 120 * MiB;
constexpr size_t WS_HM = 252 * MiB;
constexpr size_t WS_END = 483 * MiB;
constexpr float SA_X = 127.0f / 6.0f, SW_IN = 127.0f * 32.0f / 6.0f, SW_GU = 127.0f * 32.0f / 6.0f;
constexpr float WSC_OUT = 128.0f;
constexpr float WSC_D = 256.0f;
static_assert(WS_WED + (size_t)NEXP * DM * DFE <= WS_WIN && WS_WD + (size_t)DM * DFF * 2 <= WS_A && WS_A + (size_t)NTOK * DM * 2 <= WS_ZH && WS_ZH + (size_t)NTOK * DFF * 2 <= WS_END, "ws map");
static_assert(WS_ZH + (size_t)NTOK * INC * 2 <= WS_HL && WS_HL + (size_t)NTOK * LRUW * 2 <= WS_PA && WS_PA + (size_t)NTOK * LRUW * 2 <= WS_ZH + (size_t)NTOK * DFF * 2, "ws map (LRU)");
static_assert(NPASS == 1 && WS_XS == WS_Y2 && WS_Y2 + (size_t)MAXTILES * 256 * DM * 2 <= WS_HM && WS_HM + (size_t)PASS_TILES * 256 * DFE <= WS_END, "ws map (MoE)");
constexpr int CW_BAR = 0;

constexpr int RING_BYTES = 131072;
constexpr int LDS_LUT = RING_BYTES;
constexpr int LDS_CTAB = LDS_LUT + 8192;
constexpr int CT_CB = 4 * 512, CT_BR = 5 * 512, CT_BI = 6 * 512, CT_SP = 7 * 512;
constexpr int LDS_MISC = LDS_CTAB + 16384;
constexpr int LDS_POS = LDS_MISC + 256;
constexpr int LDS_BYTES = 159744;
static_assert(LDS_POS + 1024 <= LDS_BYTES, "LDS map");

#define GAS __attribute__((address_space(1)))
#define LAS __attribute__((address_space(3)))
typedef unsigned short bf16;
typedef unsigned v4u __attribute__((ext_vector_type(4)));
typedef unsigned v2u __attribute__((ext_vector_type(2)));
typedef float f32x4 __attribute__((ext_vector_type(4)));
typedef float f32x16 __attribute__((ext_vector_type(16)));
typedef short bf16x8 __attribute__((ext_vector_type(8)));
typedef short s16x4 __attribute__((ext_vector_type(4)));
#define LDS_WAIT() asm volatile("s_waitcnt lgkmcnt(0)" ::: "memory")
#define VM_WAIT() asm volatile("s_waitcnt vmcnt(0)" ::: "memory")
__device__ __forceinline__ unsigned pk2(float lo, float hi) { return pg8::cvt_pk_bf16(lo, hi); }
__device__ __forceinline__ float bf2f(unsigned short h) { return __uint_as_float((unsigned)h << 16); }
__device__ __forceinline__ float bflo(unsigned w) { return __uint_as_float(w << 16); }
__device__ __forceinline__ float bfhi(unsigned w) { return __uint_as_float(w & 0xffff0000u); }
__device__ __forceinline__ float wave_sum(float v) {
#pragma unroll
    for (int o = 1; o < 64; o <<= 1) v += __shfl_xor(v, o);
    return v;
}
__device__ __forceinline__ float fast_sigmoid(float x) { return __builtin_amdgcn_rcpf(1.0f + __builtin_amdgcn_exp2f(x * -LOG2E)); }
__device__ __forceinline__ float gelu_tanh(float x) {
    const float t = 1.5957691216057308f * (x + 0.044715f * x * x * x);
    return x * fast_sigmoid(t);
}

#define XB_TMO      128
#define XB_XCNT(j)  (256  + 64 * (j))
#define XB_XSUB(j)  (1280 + 64 * (j))
#define XB_XGEN(j)  (2304 + 64 * (j))
#define XB_TOP      3328
#define XB_TOPGEN   3392
#define XCD_BAR_WORDS 3456
#define XB_SPIN_CAP (1u << 18)

__device__ __forceinline__ unsigned xb_ld(unsigned* p)              { return __hip_atomic_load(p, __ATOMIC_RELAXED, __HIP_MEMORY_SCOPE_AGENT); }
__device__ __forceinline__ unsigned xb_add(unsigned* p, unsigned v) { return __hip_atomic_fetch_add(p, v, __ATOMIC_RELAXED, __HIP_MEMORY_SCOPE_AGENT); }
__device__ __forceinline__ unsigned xb_xcc_id() { return (unsigned)__builtin_amdgcn_s_getreg((3 << 11) | 20) & 0xFu; }
#define XB_SPIN(cond, bar) do { unsigned _sp = 0; while (cond) { __builtin_amdgcn_s_sleep(1); \
    if ((++_sp & 255u) == 0u) { if (xb_ld(&(bar)[XB_TMO])) break; if (_sp > XB_SPIN_CAP) { atomicAdd(&(bar)[XB_TMO], 1u); break; } } } } while (0)

struct XcdBarrier {
    unsigned* bar; unsigned x;
    volatile LAS unsigned* st;
};

__device__ __forceinline__ XcdBarrier xcd_barrier_post(unsigned* bar, volatile LAS unsigned* st) {
    XcdBarrier b; b.bar = bar; b.x = xb_xcc_id(); b.st = st;
    if (threadIdx.x == 0) (void)xb_add(&bar[XB_XCNT(b.x)], 1u);
    return b;
}
__device__ __forceinline__ void xcd_barrier_complete(unsigned* bar, unsigned x, unsigned& nloc, unsigned& nx) {
    const unsigned G = gridDim.x * gridDim.y * gridDim.z;
    unsigned sum, cnt, mine, sp = 0u;
    for (;;) {
        sum = 0u; cnt = 0u; mine = 0u;
#pragma unroll
        for (unsigned j = 0; j < 16; ++j) { const unsigned c = xb_ld(&bar[XB_XCNT(j)]); sum += c; cnt += (c > 0u) ? 1u : 0u; mine = (j == x) ? c : mine; }
        if (sum == G) break;
        __builtin_amdgcn_s_sleep(1);
        if ((++sp & 255u) == 0u) { if (xb_ld(&bar[XB_TMO])) break; if (sp > XB_SPIN_CAP) { atomicAdd(&bar[XB_TMO], 1u); break; } }
    }
    nloc = mine > 0u ? mine : 1u; nx = cnt > 0u ? cnt : 1u;
}

__device__ __forceinline__ void xcd_barrier(const XcdBarrier& b) {
    asm volatile("s_waitcnt vmcnt(0)" ::: "memory");
    __syncthreads();
    if (threadIdx.x == 0) {
        unsigned* bar = b.bar;
        __builtin_amdgcn_s_waitcnt(0);
        unsigned nloc = b.st[0], nx = b.st[1];
        if (nloc == 0u) { xcd_barrier_complete(bar, b.x, nloc, nx); b.st[0] = nloc; b.st[1] = nx; }
        const unsigned old = xb_add(&bar[XB_XSUB(b.x)], 1u);
        const unsigned gen = old / nloc;
        if (old + 1u == (gen + 1u) * nloc) {
            __builtin_amdgcn_fence(__ATOMIC_RELEASE, "agent");
            asm volatile("s_waitcnt vmcnt(0)" ::: "memory");
            const unsigned og = xb_add(&bar[XB_TOP], 1u);
            const unsigned tg = og / nx;
            if (og + 1u == (tg + 1u) * nx) xb_add(&bar[XB_TOPGEN], 1u);
            else XB_SPIN(xb_ld(&bar[XB_TOPGEN]) == tg, bar);
            __builtin_amdgcn_fence(__ATOMIC_ACQUIRE, "agent");
            xb_add(&bar[XB_XGEN(b.x)], 1u);
            asm volatile("s_waitcnt vmcnt(0)" ::: "memory");
        } else {
            XB_SPIN(xb_ld(&bar[XB_XGEN(b.x)]) == gen, bar);
            __builtin_amdgcn_fence(__ATOMIC_ACQUIRE, "agent");
            asm volatile("s_waitcnt vmcnt(0)" ::: "memory");
        }
    }
    __syncthreads();
}

struct Args { const float* in[25]; float* out; unsigned char* ws; int ph_lo, ph_hi; };
struct Frame {
    LAS unsigned char* lds;
    int tid, lane, wave, G, blk;
};

__device__ __forceinline__ void p0_transpose_item(const float* W, int K, int N, bf16* WT, int mode, const float* ksA, const float* ksB, float nscale, int nscale_cols, LAS float* scr, int item, int lane) {
    const int nblk = N / 32, kb = item / nblk, nb = item % nblk, k0 = 64 * kb, n0 = 32 * nb;
    const float* ks = ksA ? (k0 < 512 ? ksA + k0 : ksB + (k0 - 512)) : nullptr;
#pragma unroll
    for (int i = 0; i < 32; ++i) { const int kk = 2 * i + (lane >> 5); float v = W[(size_t)(k0 + kk) * N + n0 + (lane & 31)]; if (ks) v *= ks[kk]; scr[kk * 33 + (lane & 31)] = v; }
    LDS_WAIT(); asm volatile("" ::: "memory");
    const int drow0 = (mode == 0) ? n0 : ((n0 >> 7) * 256 + (n0 & 127) + (mode == 2 ? 128 : 0));
    const float sc = (n0 < nscale_cols) ? nscale : 1.0f;
    const int c = lane & 7;
#pragma unroll
    for (int j = 0; j < 4; ++j) { const int n = (lane >> 3) + 8 * j; const LAS float* s = scr + (8 * c) * 33 + n;
        v4u o; o.x = pk2(s[0 * 33] * sc, s[1 * 33] * sc); o.y = pk2(s[2 * 33] * sc, s[3 * 33] * sc); o.z = pk2(s[4 * 33] * sc, s[5 * 33] * sc); o.w = pk2(s[6 * 33] * sc, s[7 * 33] * sc);
        *(v4u*)(WT + (size_t)(drow0 + n) * K + k0 + 8 * c) = o; }
    LDS_WAIT(); asm volatile("" ::: "memory");
}
template <int KIND  >
__device__ __forceinline__ void p0_transpose_item_f8(const float* W, int K, int N, unsigned char* WT, int mode, float scale, LAS float* scr, int item, int lane, const float* ksA = nullptr, const float* ksB = nullptr, float nscale = 1.0f, int nscale_cols = 0) {
    const int nblk = N / 32, kb = item / nblk, nb = item % nblk, k0 = 64 * kb, n0 = 32 * nb;
    const float* ks = ksA ? (k0 < 512 ? ksA + k0 : ksB + (k0 - 512)) : nullptr;
    if (n0 < nscale_cols) scale *= nscale;
#pragma unroll
    for (int i = 0; i < 32; ++i) { const int kk = 2 * i + (lane >> 5); float v = W[(size_t)(k0 + kk) * N + n0 + (lane & 31)] * scale; if (ks) v *= ks[kk]; scr[kk * 33 + (lane & 31)] = v; }
    LDS_WAIT(); asm volatile("" ::: "memory");
    const int drow0 = (mode == 0) ? n0 : ((n0 >> 7) * 256 + (n0 & 127) + (mode == 2 ? 128 : 0));
    const int c = lane & 3;
#pragma unroll
    for (int j = 0; j < 2; ++j) { const int n = (lane >> 2) + 16 * j; const LAS float* s = scr + (16 * c) * 33 + n;
        v4u o;
        if (KIND == 1) { o.x = pg8::pk4_fp8(s[0 * 33], s[1 * 33], s[2 * 33], s[3 * 33]); o.y = pg8::pk4_fp8(s[4 * 33], s[5 * 33], s[6 * 33], s[7 * 33]);
            o.z = pg8::pk4_fp8(s[8 * 33], s[9 * 33], s[10 * 33], s[11 * 33]); o.w = pg8::pk4_fp8(s[12 * 33], s[13 * 33], s[14 * 33], s[15 * 33]); }
        else { o.x = pg8::pk4_i8(s[0 * 33], s[1 * 33], s[2 * 33], s[3 * 33], 1.0f); o.y = pg8::pk4_i8(s[4 * 33], s[5 * 33], s[6 * 33], s[7 * 33], 1.0f);
            o.z = pg8::pk4_i8(s[8 * 33], s[9 * 33], s[10 * 33], s[11 * 33], 1.0f); o.w = pg8::pk4_i8(s[12 * 33], s[13 * 33], s[14 * 33], s[15 * 33], 1.0f); }
        *(v4u*)(WT + (size_t)(drow0 + n) * K + k0 + 16 * c) = o; }
    LDS_WAIT(); asm volatile("" ::: "memory");
}
__device__ __forceinline__ int t5_bucket(int rel) {
    const int n = rel < 0 ? -rel : rel;
    int v;
    if (n < 8) v = n;
    else { v = 8 + (n >= 12) + (n >= 16) + (n >= 23) + (n >= 32) + (n >= 46) + (n >= 64) + (n >= 91); }
    return (rel > 0 ? 16 : 0) + v;
}
__device__ __forceinline__ void p0_prologue(const Frame& F, const Args& A) {
    unsigned char* ws = A.ws;
    LAS float* scr = (LAS float*)(F.lds + F.wave * 8448);
    const int gw = F.blk * NWAVES + F.wave, NGW = F.G * NWAVES;
    bf16* WIN = (bf16*)(ws + WS_WIN); bf16* WOUT = (bf16*)(ws + WS_WOUT); bf16* WGU = (bf16*)(ws + WS_WGU); bf16* WD = (bf16*)(ws + WS_WD);
    unsigned char* WEGU = ws + WS_WEGU; unsigned char* WED = ws + WS_WED;
    constexpr int I_IN = (DM / 64) * (INC / 32), I_OUT = (DM / 64) * (DM / 32), I_GU = (DM / 64) * (DFF / 32), I_D = (DFF / 64) * (DM / 32);
    constexpr int I_EGU = (DM / 64) * (DFE / 32), I_ED = (DFE / 64) * (DM / 32);
    constexpr int NITEMS = 2 * I_IN + 2 * I_OUT + 2 * I_GU + I_D + NEXP * (2 * I_EGU + I_ED);
    struct Item { const float* src; unsigned char* dst; const float* ks; int K, N, k0, n0, mode, kind; float scale; };
    auto decode = [&](int it, Item& d) {
        int r = it; d.ks = nullptr;
        if (r < 2 * I_IN) { const int l = r / I_IN; r -= l * I_IN; d.src = A.in[2] + (size_t)l * DM * INC; d.K = DM; d.N = INC; d.dst = (unsigned char*)WIN + (size_t)l * INC * DM; d.mode = 0; d.kind = 2; d.scale = SW_IN; }
        else if ((r -= 2 * I_IN) < 2 * I_OUT) { const int l = r / I_OUT; r -= l * I_OUT; d.src = A.in[13] + (size_t)l * DM * DM; d.K = DM; d.N = DM; d.dst = (unsigned char*)WOUT + (size_t)l * DM * DM; d.mode = 0; d.kind = 1; d.scale = WSC_OUT; d.ks = A.in[11] + l * 512; }
        else if ((r -= 2 * I_OUT) < I_GU) { d.src = A.in[16]; d.K = DM; d.N = DFF; d.dst = (unsigned char*)WGU; d.mode = 1; d.kind = 2; d.scale = SW_GU; }
        else if ((r -= I_GU) < I_GU) { d.src = A.in[17]; d.K = DM; d.N = DFF; d.dst = (unsigned char*)WGU; d.mode = 2; d.kind = 2; d.scale = SW_GU; }
        else if ((r -= I_GU) < I_D) { d.src = A.in[18]; d.K = DFF; d.N = DM; d.dst = (unsigned char*)WD; d.mode = 0; d.kind = 1; d.scale = WSC_D; }
        else { r -= I_D; constexpr int PER_E = 2 * I_EGU + I_ED; const int e = r / PER_E; r -= e * PER_E;
            if (r < I_EGU) { d.src = A.in[20] + (size_t)e * DM * DFE; d.K = DM; d.N = DFE; d.dst = WEGU + (size_t)e * 2 * DFE * DM; d.mode = 1; d.kind = 2; d.scale = SW_GU; }
            else if ((r -= I_EGU) < I_EGU) { d.src = A.in[21] + (size_t)e * DM * DFE; d.K = DM; d.N = DFE; d.dst = WEGU + (size_t)e * 2 * DFE * DM; d.mode = 2; d.kind = 2; d.scale = SW_GU; }
            else { r -= I_EGU; d.src = A.in[22] + (size_t)e * DFE * DM; d.K = DFE; d.N = DM; d.dst = WED + (size_t)e * DM * DFE; d.mode = 0; d.kind = 1; d.scale = WSC_D; } }
        const int nblk = d.N / 32; d.k0 = 64 * (r / nblk); d.n0 = 32 * (r % nblk);
        if (d.ks) d.ks = (d.k0 < 512) ? d.ks + d.k0 : (A.in[12] + (d.ks - A.in[11]) + (d.k0 - 512));
    };
    float v[32], nv[32]; Item cur, nxt;
    int it = gw;
    if (it < NITEMS) { decode(it, cur);
#pragma unroll
        for (int i = 0; i < 32; ++i) v[i] = cur.src[(size_t)(cur.k0 + 2 * i + (F.lane >> 5)) * cur.N + cur.n0 + (F.lane & 31)]; }
    for (; it < NITEMS; it += NGW) {
        const bool more = it + NGW < NITEMS;
        if (more) { decode(it + NGW, nxt);
#pragma unroll
            for (int i = 0; i < 32; ++i) nv[i] = nxt.src[(size_t)(nxt.k0 + 2 * i + (F.lane >> 5)) * nxt.N + nxt.n0 + (F.lane & 31)]; }
        asm volatile("" ::: "memory");
#pragma unroll
        for (int i = 0; i < 32; ++i) { const int kk = 2 * i + (F.lane >> 5); float x = v[i] * cur.scale; if (cur.ks) x *= cur.ks[kk]; scr[kk * 33 + (F.lane & 31)] = x; }
        LDS_WAIT(); asm volatile("" ::: "memory");
        {   const int drow0 = (cur.mode == 0) ? cur.n0 : ((cur.n0 >> 7) * 256 + (cur.n0 & 127) + (cur.mode == 2 ? 128 : 0));
            const int c = F.lane & 3;
#pragma unroll
            for (int j = 0; j < 2; ++j) { const int n = (F.lane >> 2) + 16 * j; const LAS float* s = scr + (16 * c) * 33 + n;
                v4u o;
                if (cur.kind == 1) { o.x = pg8::pk4_fp8(s[0 * 33], s[1 * 33], s[2 * 33], s[3 * 33]); o.y = pg8::pk4_fp8(s[4 * 33], s[5 * 33], s[6 * 33], s[7 * 33]);
                    o.z = pg8::pk4_fp8(s[8 * 33], s[9 * 33], s[10 * 33], s[11 * 33]); o.w = pg8::pk4_fp8(s[12 * 33], s[13 * 33], s[14 * 33], s[15 * 33]); }
                else { o.x = pg8::pk4_i8(s[0 * 33], s[1 * 33], s[2 * 33], s[3 * 33], 1.0f); o.y = pg8::pk4_i8(s[4 * 33], s[5 * 33], s[6 * 33], s[7 * 33], 1.0f);
                    o.z = pg8::pk4_i8(s[8 * 33], s[9 * 33], s[10 * 33], s[11 * 33], 1.0f); o.w = pg8::pk4_i8(s[12 * 33], s[13 * 33], s[14 * 33], s[15 * 33], 1.0f); }
                *(v4u*)(cur.dst + (size_t)(drow0 + n) * cur.K + cur.k0 + 16 * c) = o; }
        }
        LDS_WAIT(); asm volatile("" ::: "memory");
        if (more) { cur = nxt;
#pragma unroll
            for (int i = 0; i < 32; ++i) v[i] = nv[i]; }
    }
    { const f32x4* x4 = (const f32x4*)A.in[0]; v4u* o = (v4u*)(ws + WS_A);
      const size_t n16 = (size_t)NTOK * DM / 16, stride = (size_t)F.G * NTHREADS;
      for (size_t i0 = (size_t)F.blk * NTHREADS + F.tid; i0 < n16; i0 += 4 * stride) {
          f32x4 a[4][4];
#pragma unroll
          for (int u = 0; u < 4; ++u) { const size_t i = i0 + u * stride; if (i < n16) {
#pragma unroll
              for (int q = 0; q < 4; ++q) a[u][q] = x4[4 * i + q]; } }
#pragma unroll
          for (int u = 0; u < 4; ++u) { const size_t i = i0 + u * stride; if (i < n16) { v4u w;
              w.x = pg8::pk4_i8(a[u][0].x, a[u][0].y, a[u][0].z, a[u][0].w, SA_X); w.y = pg8::pk4_i8(a[u][1].x, a[u][1].y, a[u][1].z, a[u][1].w, SA_X);
              w.z = pg8::pk4_i8(a[u][2].x, a[u][2].y, a[u][2].z, a[u][2].w, SA_X); w.w = pg8::pk4_i8(a[u][3].x, a[u][3].y, a[u][3].z, a[u][3].w, SA_X); o[i] = w; } } } }
    { bf16* GW = (bf16*)(ws + WS_GATEW);
      for (int i = F.blk * NTHREADS + F.tid; i < 2 * 2 * 8 * 64 * 64; i += F.G * NTHREADS) {
          const int d = i & 63, e = (i >> 6) & 63, n = (i >> 12) & 7, g = (i >> 15) & 1, l = i >> 16;
          const float v = (g ? A.in[8] : A.in[6])[(((size_t)l * 8 + n) * 64 + d) * 64 + e];
          GW[i] = (bf16)(pk2(v, v) & 0xffffu); } }
    if (F.blk == 0 && F.tid < 256) { float* LUT = (float*)(ws + WS_LUT); const int rel = F.tid - 191; const int bk = t5_bucket(rel);
#pragma unroll
        for (int h = 0; h < 8; ++h) LUT[h * 256 + F.tid] = A.in[1][bk * 8 + h] * LOG2E; }
}

template <int D> __device__ __forceinline__ float dpp_shr(float v, float idv) { return __builtin_bit_cast(float, __builtin_amdgcn_update_dpp(__builtin_bit_cast(int, idv), __builtin_bit_cast(int, v), 0x110 + D, 0xF, 0xF, false)); }
__device__ __forceinline__ float dpp_ror1(float v) { return __builtin_bit_cast(float, __builtin_amdgcn_update_dpp(0, __builtin_bit_cast(int, v), 0x121, 0xF, 0xF, false)); }
template <int D> __device__ __forceinline__ void scan_step(float& P, float& H) { const float P1 = dpp_shr<D>(P, 1.0f), H1 = dpp_shr<D>(H, 0.0f); H = P * H1 + H; P = P * P1; }
__device__ __forceinline__ void lru_tables(const Frame& F, const Args& A, int l) {
    LAS float* ct = (LAS float*)(F.lds + LDS_CTAB);
    const int ch = F.tid;
#pragma unroll
    for (int w = 0; w < 4; ++w) ct[w * 512 + ch] = A.in[4][(l * 4 + w) * LRUW + ch];
    ct[CT_CB + ch] = A.in[5][l * LRUW + ch]; ct[CT_BR + ch] = A.in[7][l * LRUW + ch]; ct[CT_BI + ch] = A.in[9][l * LRUW + ch];
    ct[CT_SP + ch] = 8.0f * log1pf(__expf(-A.in[10][l * LRUW + ch]));
}
struct LruNb { bf16x8 wr[2], wi[2]; v2u gb[4]; f32x4 hin; };
template <bool FINAL, int PART  >
__device__ __forceinline__ void lru_load_nb(LruNb& L, int nb, const bf16* Z, size_t row0, int n, int fr, int fq, const bf16* gwr, const bf16* gwi, const float* HinRow) {
    const int ch0 = 64 * n + 16 * nb + 4 * fq;
    if (PART & 1) {
#pragma unroll
        for (int ks = 0; ks < 2; ++ks) { L.wr[ks] = *(const bf16x8*)(gwr + (16 * nb + fr) * 64 + 32 * ks + 8 * fq); L.wi[ks] = *(const bf16x8*)(gwi + (16 * nb + fr) * 64 + 32 * ks + 8 * fq); }
    }
    if (FINAL && (PART & 2)) {
#pragma unroll
        for (int m = 0; m < 4; ++m) L.gb[m] = *(const v2u*)(Z + (row0 + 16 * m + fr) * INC + GBOFF + ch0);
        L.hin = *(const f32x4*)(HinRow + ch0);
    }
}
template <bool FINAL>
__device__ __forceinline__ void lru_tile(const bf16* Z, int b, int c, int n, int lane, const bf16* gwr, const bf16* gwi, const LAS float* ct,
                                         float* outP, float* outE, const float* Hin, LAS float* yl, bf16* HLg, bf16* PAg) {
    const int fr = lane & 15, fq = lane >> 4;
    const size_t seq0 = (size_t)b * SEQ, row0 = seq0 + (size_t)CHK * c;
    const float* HinRow = Hin + ((size_t)b * NCHUNK + c) * LRUW;
    LruNb cur, nxt;
    lru_load_nb<FINAL, 1>(cur, 0, Z, row0, n, fr, fq, gwr, gwi, HinRow);
    v4u xv[2][4][4];
    bf16x8 xa[4][2];
#define LRU_LOADXV(ks) do { _Pragma("unroll") for (int m = 0; m < 4; ++m) _Pragma("unroll") for (int w = 0; w < 4; ++w) { const int tt = CHK * c + 16 * m + fr + w - 3; \
        xv[ks][m][w] = *(const v4u*)(Z + (seq0 + (tt < 0 ? 0 : tt)) * INC + XBOFF + 64 * n + 32 * (ks) + 8 * fq); } } while (0)
#define LRU_CONV(ks) do { const int ch = 64 * n + 32 * (ks) + 8 * fq; float cw[4][8], cb[8]; \
        _Pragma("unroll") for (int w = 0; w < 4; ++w) { const f32x4 a = *(const LAS f32x4*)(ct + w * 512 + ch), bq = *(const LAS f32x4*)(ct + w * 512 + ch + 4); \
            cw[w][0] = a.x; cw[w][1] = a.y; cw[w][2] = a.z; cw[w][3] = a.w; cw[w][4] = bq.x; cw[w][5] = bq.y; cw[w][6] = bq.z; cw[w][7] = bq.w; } \
        { const f32x4 a = *(const LAS f32x4*)(ct + CT_CB + ch), bq = *(const LAS f32x4*)(ct + CT_CB + ch + 4); cb[0] = a.x; cb[1] = a.y; cb[2] = a.z; cb[3] = a.w; cb[4] = bq.x; cb[5] = bq.y; cb[6] = bq.z; cb[7] = bq.w; } \
        _Pragma("unroll") for (int m = 0; m < 4; ++m) { float a8[8]; \
            _Pragma("unroll") for (int j = 0; j < 8; ++j) a8[j] = cb[j]; \
            _Pragma("unroll") for (int w = 0; w < 4; ++w) { v4u v = xv[ks][m][w]; \
                if (c == 0 && m == 0 && w < 3) { if (fr + w - 3 < 0) v = (v4u){0u, 0u, 0u, 0u}; }     \
                a8[0] += cw[w][0] * bflo(v.x); a8[1] += cw[w][1] * bfhi(v.x); a8[2] += cw[w][2] * bflo(v.y); a8[3] += cw[w][3] * bfhi(v.y); \
                a8[4] += cw[w][4] * bflo(v.z); a8[5] += cw[w][5] * bfhi(v.z); a8[6] += cw[w][6] * bflo(v.w); a8[7] += cw[w][7] * bfhi(v.w); } \
            v4u p; p.x = pk2(a8[0], a8[1]); p.y = pk2(a8[2], a8[3]); p.z = pk2(a8[4], a8[5]); p.w = pk2(a8[6], a8[7]); \
            xa[m][ks] = __builtin_bit_cast(bf16x8, p); } } while (0)
    if (FINAL) {
        LRU_LOADXV(0); asm volatile("" ::: "memory"); LRU_CONV(0); asm volatile("" ::: "memory");
        LRU_LOADXV(1); asm volatile("" ::: "memory"); LRU_CONV(1);
    } else {
        LRU_LOADXV(0); LRU_LOADXV(1); asm volatile("" ::: "memory"); LRU_CONV(0); LRU_CONV(1);
    }
#undef LRU_LOADXV
#undef LRU_CONV
    lru_load_nb<FINAL, 2>(cur, 0, Z, row0, n, fr, fq, gwr, gwi, HinRow);
#pragma unroll 1
    for (int nb = 0; nb < 4; ++nb) {
        const int ch0 = 64 * n + 16 * nb + 4 * fq;
        if (nb < 3) lru_load_nb<FINAL, 1>(nxt, nb + 1, Z, row0, n, fr, fq, gwr, gwi, HinRow);
        if (nb > 0) lru_load_nb<FINAL, 2>(cur, nb, Z, row0, n, fr, fq, gwr, gwi, HinRow);
        asm volatile("" ::: "memory");
        bf16x8 idf[2];
#pragma unroll
        for (int ks = 0; ks < 2; ++ks)
#pragma unroll
            for (int j = 0; j < 8; ++j) idf[ks][j] = (32 * ks + 8 * fq + j == 16 * nb + fr) ? (short)0x3F80 : (short)0;
        const f32x4 brv = *(const LAS f32x4*)(ct + CT_BR + ch0), biv = *(const LAS f32x4*)(ct + CT_BI + ch0), spv = *(const LAS f32x4*)(ct + CT_SP + ch0);
        f32x4 dr[4], di[4], dx[4];
#pragma unroll
        for (int m = 0; m < 4; ++m) { dr[m] = (f32x4){0.f, 0.f, 0.f, 0.f}; di[m] = dr[m]; dx[m] = dr[m];
#pragma unroll
            for (int ks = 0; ks < 2; ++ks) {
                dr[m] = __builtin_amdgcn_mfma_f32_16x16x32_bf16(cur.wr[ks], xa[m][ks], dr[m], 0, 0, 0);
                di[m] = __builtin_amdgcn_mfma_f32_16x16x32_bf16(cur.wi[ks], xa[m][ks], di[m], 0, 0, 0);
                dx[m] = __builtin_amdgcn_mfma_f32_16x16x32_bf16(idf[ks], xa[m][ks], dx[m], 0, 0, 0); } }
        float cP[4], cH[4];
#pragma unroll
        for (int r = 0; r < 4; ++r) { cP[r] = 1.0f; cH[r] = FINAL ? cur.hin[r] : 0.0f; }
#pragma unroll
        for (int m = 0; m < 4; ++m) {
            float P[4], H[4];
#pragma unroll
            for (int r = 0; r < 4; ++r) {
                const float rg = fast_sigmoid(dr[m][r] + brv[r]), ig = fast_sigmoid(di[m][r] + biv[r]);
                const float la = -rg * spv[r];
                const float a = __builtin_amdgcn_exp2f(la * LOG2E);
                const float u = __builtin_amdgcn_sqrtf(fmaxf(1.0f - a * a, 0.f)) * (ig * dx[m][r]);
                P[r] = (fr == 0) ? a * cP[r] : a; H[r] = (fr == 0) ? a * cH[r] + u : u;
            }
#pragma unroll
            for (int r = 0; r < 4; ++r) { scan_step<1>(P[r], H[r]); scan_step<2>(P[r], H[r]); scan_step<4>(P[r], H[r]); scan_step<8>(P[r], H[r]); }
            if (!FINAL) {
                const size_t o = (row0 + 16 * m + fr) * LRUW + ch0;
                v2u wh, wp; wh.x = pk2(H[0], H[1]); wh.y = pk2(H[2], H[3]); wp.x = pk2(P[0], P[1]); wp.y = pk2(P[2], P[3]);
                *(v2u*)(HLg + o) = wh; *(v2u*)(PAg + o) = wp;
            }
            if (FINAL) {
                const v2u g = cur.gb[m];
                f32x4 y; y[0] = gelu_tanh(bflo(g.x)) * H[0]; y[1] = gelu_tanh(bfhi(g.x)) * H[1]; y[2] = gelu_tanh(bflo(g.y)) * H[2]; y[3] = gelu_tanh(bfhi(g.y)) * H[3];
                *(LAS f32x4*)(yl + (16 * m + fr) * LRUW + ch0) = y;
            }
#pragma unroll
            for (int r = 0; r < 4; ++r) { cP[r] = dpp_ror1(P[r]); cH[r] = dpp_ror1(H[r]); }
        }
        if (!FINAL) { if (fr == 0) { const size_t o = ((size_t)b * NCHUNK + c) * LRUW + ch0;
            *(f32x4*)(outP + o) = (f32x4){cP[0], cP[1], cP[2], cP[3]}; *(f32x4*)(outE + o) = (f32x4){cH[0], cH[1], cH[2], cH[3]}; } }
        cur.wr[0] = nxt.wr[0]; cur.wr[1] = nxt.wr[1]; cur.wi[0] = nxt.wi[0]; cur.wi[1] = nxt.wi[1];
    }
}

__device__ __forceinline__ void p_lru_summary(const Frame& F, const Args& A, int l, int nrep) {
    unsigned char* ws = A.ws;
    const bf16* Z = (const bf16*)(ws + WS_ZH);
    const bf16* GW = (const bf16*)(ws + WS_GATEW) + (size_t)l * 2 * 8 * 4096;
    lru_tables(F, A, l); __syncthreads();
    for (int it = F.blk; it < BATCH * NCHUNK * nrep; it += F.G) {
        const int b = (it >> 8) & 1, c = it & 255, n = F.wave;
        lru_tile<false>(Z, b, c, n, F.lane, GW + n * 4096, GW + 8 * 4096 + n * 4096, (const LAS float*)(F.lds + LDS_CTAB), (float*)(ws + WS_LRUP), (float*)(ws + WS_LRUE), (const float*)(ws + WS_HIN), nullptr, (bf16*)(ws + WS_HL), (bf16*)(ws + WS_PA));
    }
}
__device__ __forceinline__ void p_lru_carry(const Frame& F, const Args& A) {
    unsigned char* ws = A.ws;
    const float* Pg = (const float*)(ws + WS_LRUP); const float* Eg = (const float*)(ws + WS_LRUE); float* Hg = (float*)(ws + WS_HIN);
    const int gw = F.blk * NWAVES + F.wave, NGW = F.G * NWAVES;
    for (int p = gw; p < BATCH * LRUW; p += NGW) {
        const int b = p >> 9, ch = p & 511;
        float pk[4], ek[4];
#pragma unroll
        for (int k = 0; k < 4; ++k) { const size_t o = ((size_t)b * NCHUNK + 4 * F.lane + k) * LRUW + ch; pk[k] = Pg[o]; ek[k] = Eg[o]; }
        float P = pk[0], H = ek[0];
#pragma unroll
        for (int k = 1; k < 4; ++k) { H = pk[k] * H + ek[k]; P = pk[k] * P; }
#pragma unroll
        for (int d = 1; d < 64; d <<= 1) { const float P1 = __shfl_up(P, d), H1 = __shfl_up(H, d); if (F.lane >= d) { H = P * H1 + H; P = P * P1; } }
        float h = __shfl_up(H, 1); if (F.lane == 0) h = 0.f;
#pragma unroll
        for (int k = 0; k < 4; ++k) { Hg[((size_t)b * NCHUNK + 4 * F.lane + k) * LRUW + ch] = h; h = pk[k] * h + ek[k]; }
    }
}

__device__ __forceinline__ int crow(int r, int hi) { return (r & 3) + 8 * (r >> 2) + 4 * hi; }
__device__ __forceinline__ s16x4 vtr(const LAS unsigned char* p) { return __builtin_bit_cast(s16x4, __builtin_amdgcn_ds_read_tr16_b64_v4i16((LAS s16x4*)p)); }
__device__ __forceinline__ void p_mixer(const Frame& F, const Args& A, int l, int nrep) {
    unsigned char* ws = A.ws;
    const bf16* Z = (const bf16*)(ws + WS_ZH);
    unsigned char* Y8 = ws + WS_A;
    const bf16* GW = (const bf16*)(ws + WS_GATEW) + (size_t)l * 2 * 8 * 4096;
    LAS unsigned char* Kl = F.lds;
    LAS unsigned char* Vl = F.lds + 49152;
    LAS bf16* ya = (LAS bf16*)F.lds;
    LAS float* lut = (LAS float*)(F.lds + LDS_LUT);
    const int lane = F.lane, wave = F.wave, r32 = lane & 31, hi = lane >> 5;
    { const float* LUTg = (const float*)(ws + WS_LUT); for (int i = F.tid; i < 2048; i += NTHREADS) lut[i] = LUTg[i]; }
    const float sinkv = A.in[3][l * 8 + wave] * LOG2E;
    const int kvh = wave >> 2;
    for (int it = F.blk; it < BATCH * NCHUNK * nrep; it += F.G) {
        const int b = (it >> 8) & 1, c = it & 255;
        const size_t row0 = (size_t)b * SEQ + (size_t)CHK * c;
        const int T0 = (c >= 2) ? 0 : 2 - c;
        __syncthreads();
        v4u kq[2][3], vq[2][3];
#pragma unroll
        for (int h2 = 0; h2 < 2; ++h2)
#pragma unroll
            for (int T = 0; T < 3; ++T) {
                kq[h2][T] = (v4u){0u, 0u, 0u, 0u}; vq[h2][T] = kq[h2][T];
                if (T >= T0) { const size_t cr = row0 + (size_t)CHK * T - 2 * CHK;
                    kq[h2][T] = *(const v4u*)(Z + (cr + lane) * INC + KOFF + 64 * h2 + 8 * wave);
                    vq[h2][T] = *(const v4u*)(Z + (cr + 16 * (wave & 3) + (lane >> 2)) * INC + VOFF + 64 * h2 + 32 * (wave >> 2) + 8 * (lane & 3)); }
            }
        {   const float* hinr = (const float*)(ws + WS_HIN) + ((size_t)b * NCHUNK + c) * LRUW + 8 * lane;
            const f32x4 hi0 = *(const f32x4*)hinr, hi1 = *(const f32x4*)(hinr + 4);
            const bf16* HLg = (const bf16*)(ws + WS_HL); const bf16* PAg = (const bf16*)(ws + WS_PA);
            v4u vh[8], vp[8], vg[8];
#pragma unroll
            for (int i = 0; i < 8; ++i) { const size_t r = row0 + 8 * wave + i;
                vh[i] = *(const v4u*)(HLg + r * LRUW + 8 * lane); vp[i] = *(const v4u*)(PAg + r * LRUW + 8 * lane); vg[i] = *(const v4u*)(Z + r * INC + GBOFF + 8 * lane); }
            asm volatile("" ::: "memory");
#pragma unroll
            for (int i = 0; i < 8; ++i) { const size_t r = row0 + 8 * wave + i;
                float y[8];
                y[0] = gelu_tanh(bflo(vg[i].x)) * (bflo(vh[i].x) + bflo(vp[i].x) * hi0.x); y[1] = gelu_tanh(bfhi(vg[i].x)) * (bfhi(vh[i].x) + bfhi(vp[i].x) * hi0.y);
                y[2] = gelu_tanh(bflo(vg[i].y)) * (bflo(vh[i].y) + bflo(vp[i].y) * hi0.z); y[3] = gelu_tanh(bfhi(vg[i].y)) * (bfhi(vh[i].y) + bfhi(vp[i].y) * hi0.w);
                y[4] = gelu_tanh(bflo(vg[i].z)) * (bflo(vh[i].z) + bflo(vp[i].z) * hi1.x); y[5] = gelu_tanh(bfhi(vg[i].z)) * (bfhi(vh[i].z) + bfhi(vp[i].z) * hi1.y);
                y[6] = gelu_tanh(bflo(vg[i].w)) * (bflo(vh[i].w) + bflo(vp[i].w) * hi1.z); y[7] = gelu_tanh(bfhi(vg[i].w)) * (bfhi(vh[i].w) + bfhi(vp[i].w) * hi1.w);
                const float ss = wave_sum((y[0] * y[0] + y[1] * y[1]) + (y[2] * y[2] + y[3] * y[3]) + (y[4] * y[4] + y[5] * y[5]) + (y[6] * y[6] + y[7] * y[7]));
                const float rstd = 1.0f / sqrtf(ss * (1.0f / 512.0f) + RMS_EPS);
                v2u w; w.x = pg8::pk4_fp8(y[0] * rstd, y[1] * rstd, y[2] * rstd, y[3] * rstd); w.y = pg8::pk4_fp8(y[4] * rstd, y[5] * rstd, y[6] * rstd, y[7] * rstd);
                *(v2u*)(Y8 + r * DM + 512 + 8 * lane) = w; }
        }
#pragma unroll
        for (int h2 = 0; h2 < 2; ++h2)
#pragma unroll
            for (int T = 0; T < 3; ++T) {
                *(LAS v4u*)(Kl + (h2 * 3 + T) * 8192 + wave * 1024 + lane * 16) = kq[h2][T];
                *(LAS v4u*)(Vl + (h2 * 3 + T) * 8192 + wave * 1024 + lane * 16) = vq[h2][T];
            }
        __syncthreads();
        unsigned opk[2][2][8];
#pragma unroll
        for (int qb = 0; qb < 2; ++qb) {
            const int qi = 32 * qb + r32;
            bf16x8 qr[4];
#pragma unroll
            for (int d0 = 0; d0 < 4; ++d0) qr[d0] = *(const bf16x8*)(Z + (row0 + qi) * INC + 64 * wave + 16 * d0 + 8 * hi);
            f32x16 s[3][2];
            const LAS float* lutq = lut + wave * 256 + 63 - qi;
#pragma unroll
            for (int T = 0; T < 3; ++T) {
#pragma unroll
                for (int hf = 0; hf < 2; ++hf)
#pragma unroll
                    for (int r = 0; r < 16; ++r) s[T][hf][r] = lutq[64 * T + 32 * hf + crow(r, hi)];
                const LAS unsigned char* kb = Kl + (kvh * 3 + T) * 8192 + hi * 1024 + r32 * 16;
#pragma unroll
                for (int d0 = 0; d0 < 4; ++d0) {
                    const bf16x8 b0 = *(const LAS bf16x8*)(kb + d0 * 2048), b1 = *(const LAS bf16x8*)(kb + d0 * 2048 + 512);
                    s[T][0] = __builtin_amdgcn_mfma_f32_32x32x16_bf16(b0, qr[d0], s[T][0], 0, 0, 0);
                    s[T][1] = __builtin_amdgcn_mfma_f32_32x32x16_bf16(b1, qr[d0], s[T][1], 0, 0, 0);
                }
                if (T < T0) {
#pragma unroll
                    for (int hf = 0; hf < 2; ++hf)
#pragma unroll
                        for (int r = 0; r < 16; ++r) s[T][hf][r] = -1e30f;
                }
            }
            float mx = sinkv;
#pragma unroll
            for (int T = 0; T < 3; ++T)
#pragma unroll
                for (int hf = 0; hf < 2; ++hf)
#pragma unroll
                    for (int r = 0; r < 16; ++r) mx = fmaxf(mx, s[T][hf][r]);
            mx = fmaxf(mx, __shfl_xor(mx, 32));
            float lsum = 0.f;
#pragma unroll
            for (int T = 0; T < 3; ++T)
#pragma unroll
                for (int hf = 0; hf < 2; ++hf)
#pragma unroll
                    for (int r = 0; r < 16; ++r) { const float p = __builtin_amdgcn_exp2f(s[T][hf][r] - mx); s[T][hf][r] = p; lsum += p; }
            lsum += __shfl_xor(lsum, 32);
            lsum += __builtin_amdgcn_exp2f(sinkv - mx);
            const float inv = 1.0f / lsum;
            f32x16 o[2]; o[0] = (f32x16){0.f, 0.f, 0.f, 0.f, 0.f, 0.f, 0.f, 0.f, 0.f, 0.f, 0.f, 0.f, 0.f, 0.f, 0.f, 0.f}; o[1] = o[0];
#pragma unroll
            for (int T = 0; T < 3; ++T) {
                v4u pw[4];
#pragma unroll
                for (int k = 0; k < 4; ++k) { const int hf = k >> 1, r0 = (k & 1) * 8;
                    pw[k].x = pk2(s[T][hf][r0 + 0], s[T][hf][r0 + 1]); pw[k].y = pk2(s[T][hf][r0 + 2], s[T][hf][r0 + 3]);
                    pw[k].z = pk2(s[T][hf][r0 + 4], s[T][hf][r0 + 5]); pw[k].w = pk2(s[T][hf][r0 + 6], s[T][hf][r0 + 7]); }
                const LAS unsigned char* vb = Vl + (kvh * 3 + T) * 8192 + ((lane >> 4) & 1) * 32 + (lane & 3) * 8 + (4 * hi + ((lane & 15) >> 2)) * 64;
#pragma unroll
                for (int d0 = 0; d0 < 2; ++d0)
#pragma unroll
                    for (int ks = 0; ks < 4; ++ks) {
                        const s16x4 lo = vtr(vb + d0 * 4096 + ks * 1024), hv = vtr(vb + d0 * 4096 + ks * 1024 + 512);
                        const bf16x8 vf = (bf16x8){lo[0], lo[1], lo[2], lo[3], hv[0], hv[1], hv[2], hv[3]};
                        o[d0] = __builtin_amdgcn_mfma_f32_32x32x16_bf16(vf, __builtin_bit_cast(bf16x8, pw[ks]), o[d0], 0, 0, 0);
                    }
            }
#pragma unroll
            for (int d0 = 0; d0 < 2; ++d0)
#pragma unroll
                for (int r = 0; r < 16; r += 2) opk[qb][d0][r >> 1] = pk2(o[d0][r] * inv, o[d0][r + 1] * inv);
        }
        __syncthreads();
#pragma unroll
        for (int qb = 0; qb < 2; ++qb)
#pragma unroll
            for (int d0 = 0; d0 < 2; ++d0)
#pragma unroll
                for (int g = 0; g < 4; ++g) { v2u w; w.x = opk[qb][d0][2 * g]; w.y = opk[qb][d0][2 * g + 1];
                    *(LAS v2u*)(ya + (32 * qb + r32) * 512 + 64 * wave + 32 * d0 + 8 * g + 4 * hi) = w; }
        __syncthreads();
#pragma unroll
        for (int i = 0; i < 8; ++i) { const int tok = 8 * wave + i;
            const v4u w0 = *(const LAS v4u*)(ya + tok * 512 + 8 * lane);
            const float x0 = bflo(w0.x), x1 = bfhi(w0.x), x2 = bflo(w0.y), x3 = bfhi(w0.y), x4 = bflo(w0.z), x5 = bfhi(w0.z), x6 = bflo(w0.w), x7 = bfhi(w0.w);
            const float ss = wave_sum((x0 * x0 + x1 * x1) + (x2 * x2 + x3 * x3) + (x4 * x4 + x5 * x5) + (x6 * x6 + x7 * x7));
            const float rstd = 1.0f / sqrtf(ss * (1.0f / 512.0f) + RMS_EPS);
            v2u w; w.x = pg8::pk4_fp8(x0 * rstd, x1 * rstd, x2 * rstd, x3 * rstd); w.y = pg8::pk4_fp8(x4 * rstd, x5 * rstd, x6 * rstd, x7 * rstd);
            *(v2u*)(Y8 + (row0 + tok) * DM + 8 * lane) = w; }
    }
}

template <int MODE>
__device__ __forceinline__ void p_layernorm(const Frame& F, const Args& A, const float* gam, const float* bet) {
    unsigned char* ws = A.ws;
    float* X = A.out;
    bf16* XB = (bf16*)(ws + WS_A);
    const bf16* Y2 = (const bf16*)(ws + WS_Y2);
    const int* TP = (const int*)(ws + WS_TOKPOS); const float* TW = (const float*)(ws + WS_TOKW);
    LAS unsigned* misc = (LAS unsigned*)(F.lds + LDS_MISC);
    const int lane = F.lane;
    if (MODE == 1) { if (F.tid < 8) misc[F.tid] = 0u; __syncthreads(); }
    f32x4 gv[4], bv[4];
#pragma unroll
    for (int j = 0; j < 4; ++j) { gv[j] = *(const f32x4*)(gam + 4 * lane + 256 * j); bv[j] = *(const f32x4*)(bet + 4 * lane + 256 * j); }
    const int rpw = NTOK / F.G;
    const int m0 = F.blk * rpw;
    f32x4 v[4], nv[4]; v2u ya[4], yb[4], nya[4], nyb[4]; float w0 = 0.f, w1 = 0.f, nw0 = 0.f, nw1 = 0.f; int np0 = 0, np1 = 0;
    {   const int m = m0 + F.wave;
        const f32x4* xr = (const f32x4*)(X + (size_t)m * DM) + lane;
#pragma unroll
        for (int j = 0; j < 4; ++j) v[j] = xr[64 * j];
        if (MODE == 2) { const int p0 = TP[2 * m], p1 = TP[2 * m + 1]; w0 = TW[2 * m]; w1 = TW[2 * m + 1];
            const v2u* y0 = (const v2u*)(Y2 + (size_t)p0 * DM) + lane; const v2u* y1 = (const v2u*)(Y2 + (size_t)p1 * DM) + lane;
#pragma unroll
            for (int j = 0; j < 4; ++j) { ya[j] = y0[64 * j]; yb[j] = y1[64 * j]; }
            if (F.wave + NWAVES < rpw) { np0 = TP[2 * (m + NWAVES)]; np1 = TP[2 * (m + NWAVES) + 1]; nw0 = TW[2 * (m + NWAVES)]; nw1 = TW[2 * (m + NWAVES) + 1]; } }
    }
    for (int i = F.wave; i < rpw; i += NWAVES) {
        const int m = m0 + i;
        f32x4* xr = (f32x4*)(X + (size_t)m * DM) + lane;
        const bool more = (i + NWAVES < rpw);
        float nnw0 = 0.f, nnw1 = 0.f; int nnp0 = 0, nnp1 = 0;
        if (more) {
            const f32x4* xn = (const f32x4*)(X + (size_t)(m + NWAVES) * DM) + lane;
#pragma unroll
            for (int j = 0; j < 4; ++j) nv[j] = xn[64 * j];
            if (MODE == 2) {
                const v2u* y0 = (const v2u*)(Y2 + (size_t)np0 * DM) + lane; const v2u* y1 = (const v2u*)(Y2 + (size_t)np1 * DM) + lane;
#pragma unroll
                for (int j = 0; j < 4; ++j) { nya[j] = y0[64 * j]; nyb[j] = y1[64 * j]; }
                if (i + 2 * NWAVES < rpw) { nnp0 = TP[2 * (m + 2 * NWAVES)]; nnp1 = TP[2 * (m + 2 * NWAVES) + 1]; nnw0 = TW[2 * (m + 2 * NWAVES)]; nnw1 = TW[2 * (m + 2 * NWAVES) + 1]; }
            }
        }
        asm volatile("" ::: "memory");
        if (MODE == 2) {
#pragma unroll
            for (int j = 0; j < 4; ++j) { const v2u a = ya[j], c = yb[j];
                v[j].x = ALPHA * v[j].x + w0 * bflo(a.x) + w1 * bflo(c.x); v[j].y = ALPHA * v[j].y + w0 * bfhi(a.x) + w1 * bfhi(c.x);
                v[j].z = ALPHA * v[j].z + w0 * bflo(a.y) + w1 * bflo(c.y); v[j].w = ALPHA * v[j].w + w0 * bfhi(a.y) + w1 * bfhi(c.y); }
        }
        float s = 0.f;
#pragma unroll
        for (int j = 0; j < 4; ++j) s += (v[j].x + v[j].y) + (v[j].z + v[j].w);
        const float mean = wave_sum(s) * (1.f / DM); float s2 = 0.f;
#pragma unroll
        for (int j = 0; j < 4; ++j) { v[j] = v[j] - mean; s2 += (v[j].x * v[j].x + v[j].y * v[j].y) + (v[j].z * v[j].z + v[j].w * v[j].w); }
        const float rstd = 1.f / sqrtf(wave_sum(s2) * (1.f / DM) + LN_EPS);
#pragma unroll
        for (int j = 0; j < 4; ++j) { v[j] = v[j] * rstd * gv[j] + bv[j]; xr[64 * j] = v[j]; }
        if (MODE == 3) {
            unsigned* o4 = (unsigned*)((unsigned char*)XB + (size_t)m * DM) + lane;
#pragma unroll
            for (int j = 0; j < 4; ++j) o4[64 * j] = pg8::pk4_i8(v[j].x, v[j].y, v[j].z, v[j].w, SA_X);
        }
        if (MODE == 0) {
            v2u* o8 = (v2u*)(XB + (size_t)m * DM) + lane;
#pragma unroll
            for (int j = 0; j < 4; ++j) { v2u w; w.x = pk2(v[j].x, v[j].y); w.y = pk2(v[j].z, v[j].w); o8[64 * j] = w; }
        }
        if (MODE == 1) {
            const float* RW = A.in[19];
            float lg[8];
#pragma unroll
            for (int e = 0; e < 8; ++e) lg[e] = 0.f;
#pragma unroll
            for (int j = 0; j < 4; ++j)
#pragma unroll
                for (int q = 0; q < 4; ++q) { const int k = 4 * lane + 256 * j + q; const f32x4 a = *(const f32x4*)(RW + k * 8), c = *(const f32x4*)(RW + k * 8 + 4); const float xv = v[j][q];
                    lg[0] += xv * a.x; lg[1] += xv * a.y; lg[2] += xv * a.z; lg[3] += xv * a.w; lg[4] += xv * c.x; lg[5] += xv * c.y; lg[6] += xv * c.z; lg[7] += xv * c.w; }
#pragma unroll
            for (int e = 0; e < 8; ++e) lg[e] = wave_sum(lg[e]);
            int e0 = 0; float v0 = lg[0];
#pragma unroll
            for (int e = 1; e < 8; ++e) if (lg[e] > v0) { v0 = lg[e]; e0 = e; }
            int e1 = -1; float v1 = -3.0e38f;
#pragma unroll
            for (int e = 0; e < 8; ++e) if (e != e0 && lg[e] > v1) { v1 = lg[e]; e1 = e; }
            const float g0 = 1.0f / (1.0f + __expf(v1 - v0)), g1 = 1.0f - g0;
            if (lane == 0) { int* te = (int*)(ws + WS_TOKE) + 2 * m; float* tw = (float*)(ws + WS_TOKW) + 2 * m; te[0] = e0; te[1] = e1; tw[0] = g0; tw[1] = g1;
                atomicAdd((unsigned*)(misc + e0), 1u); atomicAdd((unsigned*)(misc + e1), 1u); }
        }
        if (more) {
#pragma unroll
            for (int j = 0; j < 4; ++j) v[j] = nv[j];
            if (MODE == 2) {
#pragma unroll
                for (int j = 0; j < 4; ++j) { ya[j] = nya[j]; yb[j] = nyb[j]; }
                w0 = nw0; w1 = nw1; np0 = nnp0; np1 = nnp1; nw0 = nnw0; nw1 = nnw1; }
        }
    }
    if (MODE == 1) { __syncthreads(); if (F.tid < 8) ((unsigned*)(ws + WS_HIST))[F.blk * 8 + F.tid] = misc[F.tid]; }
}

__device__ __forceinline__ void p_route(const Frame& F, const Args& A) {
    unsigned char* ws = A.ws;
    LAS unsigned* misc = (LAS unsigned*)(F.lds + LDS_MISC);
    LAS int* posl = (LAS int*)(F.lds + LDS_POS);
    const unsigned* hist = (const unsigned*)(ws + WS_HIST);
    const int lane = F.lane, rpw = NTOK / F.G;
    {
        const int e = F.wave; unsigned tot = 0u, bef = 0u;
        for (int v = lane; v < F.G; v += 64) { const unsigned h = hist[v * 8 + e]; tot += h; if (v < F.blk) bef += h; }
#pragma unroll
        for (int o = 1; o < 64; o <<= 1) { tot += __shfl_xor(tot, o); bef += __shfl_xor(bef, o); }
        if (lane == 0) { misc[16 + e] = tot; misc[24 + e] = bef; }
    }
    __syncthreads();
    int seg[9]; seg[0] = 0;
#pragma unroll
    for (int e = 0; e < 8; ++e) seg[e + 1] = seg[e] + (int)((misc[16 + e] + 255u) >> 8);
    if (F.blk == 0 && F.tid == 0) { int* meta = (int*)(ws + WS_META);
#pragma unroll
        for (int e = 0; e < 9; ++e) meta[e] = seg[e];
        meta[9] = seg[8]; }
    if (F.wave == 0) {
        const int* te = (const int*)(ws + WS_TOKE); int* tp = (int*)(ws + WS_TOKPOS); int* rt = nullptr; (void)rt;
        unsigned run[8];
#pragma unroll
        for (int e = 0; e < 8; ++e) run[e] = (unsigned)seg[e] * 256u + misc[24 + e];
        for (int h = 0; h < rpw; h += 64) {
            const int m = F.blk * rpw + h + lane;
#pragma unroll
            for (int k = 0; k < 2; ++k) {
                const int ek = te[2 * m + k]; int pos = 0;
#pragma unroll
                for (int e = 0; e < 8; ++e) { const unsigned long long mask = __ballot(ek == e);
                    if (ek == e) pos = (int)(run[e] + (unsigned)__popcll(mask & ((1ull << lane) - 1ull)));
                    run[e] += (unsigned)__popcll(mask); }
                tp[2 * m + k] = pos; posl[2 * (h + lane) + k] = pos;
            }
        }
    }
    __syncthreads();
    {
        const float* X = A.out; unsigned char* XS = ws + WS_XS;
        f32x4 a, b, c, d, na, nb, nc, nd;
        { const f32x4* xr = (const f32x4*)(X + (size_t)(F.blk * rpw + F.wave) * DM) + 4 * lane; a = xr[0]; b = xr[1]; c = xr[2]; d = xr[3]; }
        for (int i = F.wave; i < rpw; i += NWAVES) {
            const int m = F.blk * rpw + i; const int p0 = posl[2 * i], p1 = posl[2 * i + 1];
            const bool more = (i + NWAVES < rpw);
            if (more) { const f32x4* xr = (const f32x4*)(X + (size_t)(m + NWAVES) * DM) + 4 * lane; na = xr[0]; nb = xr[1]; nc = xr[2]; nd = xr[3]; }
            asm volatile("" ::: "memory");
            v4u w; w.x = pg8::pk4_i8(a.x, a.y, a.z, a.w, SA_X); w.y = pg8::pk4_i8(b.x, b.y, b.z, b.w, SA_X); w.z = pg8::pk4_i8(c.x, c.y, c.z, c.w, SA_X); w.w = pg8::pk4_i8(d.x, d.y, d.z, d.w, SA_X);
            *((v4u*)(XS + (size_t)p0 * DM) + lane) = w; *((v4u*)(XS + (size_t)p1 * DM) + lane) = w;
            if (more) { a = na; b = nb; c = nc; d = nd; }
        }
    }
    if (F.blk < 8) {
        int r0 = 0, r1 = 0;
#pragma unroll
        for (int e = 0; e < 8; ++e) if (e == F.blk) { r0 = seg[e] * 256 + (int)misc[16 + e]; r1 = seg[e + 1] * 256; }
        v4u* XS4 = (v4u*)(ws + WS_XS);
        for (size_t i = (size_t)r0 * 64 + F.tid; i < (size_t)r1 * 64; i += NTHREADS) XS4[i] = (v4u){0u, 0u, 0u, 0u};
    }
}

#ifndef MK_ONE_LAUNCH
#define MK_ONE_LAUNCH 1
#endif
constexpr int PH_MOE = 17, PH_FINAL = PH_MOE + 2 * NPASS, NPHASES = PH_FINAL + 1;

#ifndef PH_MASK
#define PH_MASK 0xFFFFFFFFu
#endif
#ifndef DUP_MASK
#define DUP_MASK 0u
#endif
#define NREP(k) ((((unsigned)DUP_MASK >> (k)) & 1u) ? 2 : 1)
#define IN(k) (((PH_MASK >> (k)) & 1u) && lo <= (k) && (k) < hi)
#define SEAM(k) do { if (MK_ONE_LAUNCH && lo <= (k) && (k) + 1 < hi) xcd_barrier(bar); } while (0)
template <int l>
__device__ __forceinline__ void layer_phases(const Frame& F, const Args& args, const XcdBarrier& bar, const int lo, const int hi) {
    unsigned char* ws = args.ws;
        const int pb = 1 + 9 * l;
        const float* xres = (l == 0) ? args.in[0] : args.out;
        if (IN(pb + 0)) {
            pg8::Gemm g{(const bf16*)(ws + WS_A), (const bf16*)(ws + WS_WIN + (size_t)l * INC * DM), NTOK, INC, DM / 2, 0};
            pg8::StaticOrder S; S.init(NTOK, INC, F.G, F.blk, NREP(pb + 0));
            pg8::EpiBf16 E{(bf16*)(ws + WS_ZH), INC, 1.0f / (SA_X * SW_IN), QSCALE / (SA_X * SW_IN), 2};
            pg8::gemm_phase<pg8::EpiBf16, pg8::StaticOrder, true, true, 2>(F.lds, g, S, E);
            SEAM(pb + 0);
        }
        if (IN(pb + 1)) { p_lru_summary(F, args, l, NREP(pb + 1)); SEAM(pb + 1); }
        if (IN(pb + 2)) for (int rep_ = 0; rep_ < NREP(pb + 2); ++rep_) { p_lru_carry(F, args); SEAM(pb + 2); }
        if (IN(pb + 3)) { p_mixer(F, args, l, NREP(pb + 3)); SEAM(pb + 3); }
        if (IN(pb + 4)) {
            pg8::Gemm g{(const bf16*)(ws + WS_A), (const bf16*)(ws + WS_WOUT + (size_t)l * DM * DM), NTOK, DM, DM / 2, 0};
            pg8::StaticOrder S; S.init(NTOK, DM, F.G, F.blk, NREP(pb + 4));
            pg8::EpiResF32 E{xres, args.out, DM, ALPHA, 1.0f / WSC_OUT};
            pg8::gemm_phase<pg8::EpiResF32, pg8::StaticOrder, true, true, 1>(F.lds, g, S, E);
            SEAM(pb + 4);
        }
        if (l == 0) {
            if (IN(6)) for (int rep_ = 0; rep_ < NREP(6); ++rep_) { p_layernorm<3>(F, args, args.in[14], args.in[15]); SEAM(6); }
            if (IN(7)) {
                pg8::Gemm g{(const bf16*)(ws + WS_A), (const bf16*)(ws + WS_WGU), NTOK, 2 * DFF, DM / 2, 0};
                pg8::StaticOrder S; S.init(NTOK, 2 * DFF, F.G, F.blk, NREP(7));
                pg8::EpiSwiGLU8 E{ws + WS_ZH, DFF, 1.0f / (SA_X * SW_GU)};
                pg8::gemm_phase<pg8::EpiSwiGLU8, pg8::StaticOrder, true, true, 2>(F.lds, g, S, E);
                SEAM(7);
            }
            if (IN(8)) {
                pg8::Gemm g{(const bf16*)(ws + WS_ZH), (const bf16*)(ws + WS_WD), NTOK, DM, DFF / 2, 0};
                pg8::StaticOrder S; S.init(NTOK, DM, F.G, F.blk, NREP(8));
                pg8::EpiResF32 E{args.out, args.out, DM, ALPHA, 1.0f / WSC_D};
                pg8::gemm_phase<pg8::EpiResF32, pg8::StaticOrder, true, true, 1>(F.lds, g, S, E);
                SEAM(8);
            }
            if (IN(9)) for (int rep_ = 0; rep_ < NREP(9); ++rep_) { p_layernorm<3>(F, args, args.in[23], args.in[24]); SEAM(9); }
        } else {
            if (IN(15)) for (int rep_ = 0; rep_ < NREP(15); ++rep_) { p_layernorm<1>(F, args, args.in[14] + DM, args.in[15] + DM); SEAM(15); }
            if (IN(16)) for (int rep_ = 0; rep_ < NREP(16); ++rep_) { p_route(F, args); SEAM(16); }
            for (int p = 0; p < NPASS; ++p) {
                int s1 = 0, s2 = 0, s3 = 0, s4 = 0, s5 = 0, s6 = 0, s7 = 0, nt = 0;
                if (IN(PH_MOE + 2 * p) || IN(PH_MOE + 1 + 2 * p)) { const int* meta = (const int*)(ws + WS_META);
                    s1 = __builtin_amdgcn_readfirstlane(meta[1]); s2 = __builtin_amdgcn_readfirstlane(meta[2]); s3 = __builtin_amdgcn_readfirstlane(meta[3]); s4 = __builtin_amdgcn_readfirstlane(meta[4]);
                    s5 = __builtin_amdgcn_readfirstlane(meta[5]); s6 = __builtin_amdgcn_readfirstlane(meta[6]); s7 = __builtin_amdgcn_readfirstlane(meta[7]); nt = __builtin_amdgcn_readfirstlane(meta[9]); }
                int nm = nt - PASS_TILES * p; nm = nm > PASS_TILES ? PASS_TILES : nm;
                if (IN(PH_MOE + 2 * p)) {
                    if (nm > 0) {
                        pg8::Gemm g{(const bf16*)(ws + WS_XS + (size_t)p * PASS_TILES * 256 * DM), (const bf16*)(ws + WS_WEGU), nm * 256, 2 * DFE, DM / 2, (size_t)2 * DFE * DM};
                        pg8::MoeOrder S; S.so.init(nm * 256, 2 * DFE, F.G, F.blk, NREP(PH_MOE + 2 * p)); S.tile0 = p * PASS_TILES; S.s1 = s1; S.s2 = s2; S.s3 = s3; S.s4 = s4; S.s5 = s5; S.s6 = s6; S.s7 = s7;
                        pg8::EpiSwiGLU8 E{ws + WS_HM, DFE, 1.0f / (SA_X * SW_GU)};
                        pg8::gemm_phase<pg8::EpiSwiGLU8, pg8::MoeOrder, true, true, 2>(F.lds, g, S, E);
                    }
                    SEAM(PH_MOE + 2 * p);
                }
                if (IN(PH_MOE + 1 + 2 * p)) {
                    if (nm > 0) {
                        pg8::Gemm g{(const bf16*)(ws + WS_HM), (const bf16*)(ws + WS_WED), nm * 256, DM, DFE / 2, (size_t)DM * DFE};
                        pg8::MoeOrder S; S.so.init(nm * 256, DM, F.G, F.blk, NREP(PH_MOE + 1 + 2 * p)); S.tile0 = p * PASS_TILES; S.s1 = s1; S.s2 = s2; S.s3 = s3; S.s4 = s4; S.s5 = s5; S.s6 = s6; S.s7 = s7;
                        pg8::EpiBf16 E{(bf16*)(ws + WS_Y2) + (size_t)p * PASS_TILES * 256 * DM, DM, 1.0f / WSC_D, 1.0f / WSC_D, 0};
                        pg8::gemm_phase<pg8::EpiBf16, pg8::MoeOrder, true, true, 1>(F.lds, g, S, E);
                    }
                    SEAM(PH_MOE + 1 + 2 * p);
                }
            }
            if (IN(PH_FINAL)) for (int rep_ = 0; rep_ < NREP(PH_FINAL); ++rep_) { p_layernorm<2>(F, args, args.in[23] + DM, args.in[24] + DM); }
        }
}
__global__ void __launch_bounds__(NTHREADS, 2) fwd_kernel(Args args) {
    extern __shared__ __attribute__((aligned(16))) unsigned char lds_raw[];
    Frame F;
    F.lds = (LAS unsigned char*)lds_raw;
    F.tid = threadIdx.x; F.lane = F.tid & 63; F.wave = __builtin_amdgcn_readfirstlane(F.tid >> 6);
    F.G = gridDim.x; F.blk = blockIdx.x;
    unsigned char* ws = args.ws;
    volatile LAS unsigned* MISC = (volatile LAS unsigned*)(F.lds + LDS_MISC);
    if (F.tid < 64) MISC[F.tid] = 0u;
    __syncthreads();
    XcdBarrier bar; bar.bar = (unsigned*)(ws + WS_CTL) + CW_BAR; bar.x = 0; bar.st = nullptr;
    if (MK_ONE_LAUNCH) bar = xcd_barrier_post((unsigned*)(ws + WS_CTL) + CW_BAR, MISC + 8);
    const int lo = args.ph_lo, hi = args.ph_hi;

    if (IN(0)) for (int rep_ = 0; rep_ < NREP(0); ++rep_) { p0_prologue(F, args); SEAM(0); }

    layer_phases<0>(F, args, bar, lo, hi);
    layer_phases<1>(F, args, bar, lo, hi);
}

extern "C" void kernel_launch(void* const* d_in, const int* in_sizes, int n_in, void* d_out, int out_size, void* d_ws, size_t ws_size, hipStream_t stream) {
    static int grid = 0;
    if (grid == 0) {
        if (n_in != 25 || in_sizes[0] != NTOK * DM || out_size != NTOK * DM || ws_size < WS_END) {
            fprintf(stderr, "kernel_launch: unexpected problem: n_in %d in0 %d out %d ws %zu (need %zu)\n", n_in, n_in > 0 ? in_sizes[0] : -1, out_size, ws_size, (size_t)WS_END); grid = -1; return; }
        int dev = 0, cus = 0, per_cu = 0;
        if (hipGetDevice(&dev) != hipSuccess || hipDeviceGetAttribute(&cus, hipDeviceAttributeMultiprocessorCount, dev) != hipSuccess) { fprintf(stderr, "kernel_launch: device query failed\n"); grid = -1; return; }
        if (hipFuncSetAttribute((const void*)fwd_kernel, hipFuncAttributeMaxDynamicSharedMemorySize, LDS_BYTES) != hipSuccess) { fprintf(stderr, "kernel_launch: hipFuncSetAttribute failed\n"); grid = -1; return; }
        if (hipOccupancyMaxActiveBlocksPerMultiprocessor(&per_cu, (const void*)fwd_kernel, NTHREADS, LDS_BYTES) != hipSuccess || per_cu < 1)
            fprintf(stderr, "kernel_launch: note: occupancy query reports %d workgroups per CU\n", per_cu);
        (void)hipGetLastError();
        grid = cus;
        if (grid != 256) fprintf(stderr, "kernel_launch: note: %d CUs (built for 256)\n", grid);
        if (NTOK % grid != 0 || grid > 256) grid = 256;
    }
    if (grid < 0) return;
    (void)hipMemsetAsync((char*)d_ws + WS_CTL, 0, CTL_ZERO_BYTES, stream);
    Args a{};
    for (int i = 0; i < 25; ++i) a.in[i] = (const float*)d_in[i];
    a.out = (float*)d_out; a.ws = (unsigned char*)d_ws;
#if MK_ONE_LAUNCH
    a.ph_lo = 0; a.ph_hi = NPHASES;
    hipLaunchKernelGGL(fwd_kernel, dim3(grid), dim3(NTHREADS), LDS_BYTES, stream, a);
#else
    for (int k = 0; k < NPHASES; ++k) { a.ph_lo = k; a.ph_hi = k + 1; hipLaunchKernelGGL(fwd_kernel, dim3(grid), dim3(NTHREADS), LDS_BYTES, stream, a); }
#endif
    const hipError_t le = hipPeekAtLastError();
    if (le != hipSuccess) fprintf(stderr, "kernel_launch: launch failed: %s\n", hipGetErrorName(le));
}
```

```cpp
#include <hip/hip_runtime.h>
#include <cstdio>
#include <cstdint>
namespace pg8 {
#define PG8_LAS __attribute__((address_space(3)))
typedef unsigned short bf16_t;
typedef short bf16x8 __attribute__((ext_vector_type(8)));
typedef float f32x4 __attribute__((ext_vector_type(4)));
typedef unsigned u32x4 __attribute__((ext_vector_type(4)));
typedef int v4i __attribute__((ext_vector_type(4)));
typedef int v8i __attribute__((ext_vector_type(8)));
constexpr int BM = 256, BK = 64, HALF = 128, HTB = HALF * BK * 2  , STAGE_BYTES = 8 * HTB, NXCD = 8, WGM = 8;

__host__ __device__ __forceinline__ int lds_byte(int r, int c) { const int st = (r >> 4) * 2 + (c >> 5), rr = r & 15, cc = c & 31, ob = rr * 64 + cc * 2; return st * 1024 + (ob ^ (((ob >> 9) & 1) << 5)); }
__host__ __device__ __forceinline__ void stage_rc(int b, int& R, int& C) { const int st = b / 1024, sb = b % 1024, swz = sb ^ (((sb >> 9) & 1) << 5); R = (st >> 1) * 16 + swz / 64; C = (st & 1) * 32 + (swz % 64) / 2; }
__host__ __device__ __forceinline__ int perm32(int rho) { const int n = rho >> 4, i = rho & 15; return 8 * (i >> 2) + 4 * n + (i & 3); }

struct Unit { int pm, pn, be; };
struct Gemm { const bf16_t* A; const bf16_t* Bt; int M, N, K; size_t bstride; };

struct StaticOrder {
    int nM, nN, nwg, G, c, rep;
    __host__ __device__ void init(int M, int N, int G_, int c_, int rep_ = 1) { nM = M / BM; nN = N / BM; nwg = nM * nN; G = G_; c = c_; rep = rep_; }
    __host__ __device__ bool next(int i, Unit& u) const {
        const long L = (long)i * G + c; if (L >= (long)nwg * rep) return false;
        int wgid = (int)(L % nwg); { const int q = nwg / NXCD, r = nwg % NXCD, xcd = wgid % NXCD, off = wgid / NXCD; wgid = (xcd < r ? xcd * (q + 1) : r * (q + 1) + (xcd - r) * q) + off; }
        const int nig = WGM * nN, gid = wgid / nig, fm = gid * WGM, gsz = (nM - fm) < WGM ? (nM - fm) : WGM;
        u.pm = fm + ((wgid % nig) % gsz); u.pn = (wgid % nig) / gsz; u.be = 0; return true;
    }
    __device__ __forceinline__ void a_ready(const Unit&) const {}
    __device__ __forceinline__ void done(const Unit&) const {}
};
struct MoeOrder {
    StaticOrder so; int tile0, s1, s2, s3, s4, s5, s6, s7;
    __device__ __forceinline__ bool next(int i, Unit& u) const {
        if (!so.next(i, u)) return false;
        const int t = tile0 + u.pm;
        u.be = (t >= s1) + (t >= s2) + (t >= s3) + (t >= s4) + (t >= s5) + (t >= s6) + (t >= s7); return true;
    }
    __device__ __forceinline__ void a_ready(const Unit&) const {}
    __device__ __forceinline__ void done(const Unit&) const {}
};

__device__ __forceinline__ unsigned cvt_pk_bf16(float lo, float hi) { unsigned r; asm volatile("v_cvt_pk_bf16_f32 %0, %1, %2" : "=v"(r) : "v"(lo), "v"(hi)); return r; }

struct EpiBf16 {
    static constexpr bool PERM = true, AFTER_DRAIN = false;
    bf16_t* O; int ldc; float scale, scale0; int n0tiles;
    __device__ __forceinline__ void operator()(const f32x4 (&acc)[2][2][4][2], const Unit& u, int wr, int wc, int fr, int fq) const {
        const int row0 = u.pm * BM + wr * 64 + fr, col0 = u.pn * BM + wc * 32 + 8 * fq;
        const float sc = (u.pn < n0tiles) ? scale0 : scale;
#pragma unroll
        for (int ai = 0; ai < 2; ++ai)
#pragma unroll
            for (int m = 0; m < 4; ++m) { bf16_t* rowp = O + (size_t)(row0 + ai * HALF + m * 16) * ldc + col0;
#pragma unroll
                for (int bj = 0; bj < 2; ++bj) { const f32x4 v0 = acc[ai][bj][m][0] * sc, v1 = acc[ai][bj][m][1] * sc;
                    u32x4 w; w.x = cvt_pk_bf16(v0[0], v0[1]); w.y = cvt_pk_bf16(v0[2], v0[3]); w.z = cvt_pk_bf16(v1[0], v1[1]); w.w = cvt_pk_bf16(v1[2], v1[3]);
                    *(u32x4*)(rowp + bj * HALF) = w; } }
    }
};
__device__ __forceinline__ float silu_mul(float g, float u) { return g * u * __builtin_amdgcn_rcpf(1.0f + __builtin_amdgcn_exp2f(g * -1.4426950408889634f)); }
struct EpiSwiGLU {
    static constexpr bool PERM = true, AFTER_DRAIN = false;
    bf16_t* H; int ldh;
    __device__ __forceinline__ void operator()(const f32x4 (&acc)[2][2][4][2], const Unit& u, int wr, int wc, int fr, int fq) const {
        const int row0 = u.pm * BM + wr * 64 + fr, col0 = u.pn * HALF + wc * 32 + 8 * fq;
#pragma unroll
        for (int ai = 0; ai < 2; ++ai)
#pragma unroll
            for (int m = 0; m < 4; ++m) { bf16_t* rowp = H + (size_t)(row0 + ai * HALF + m * 16) * ldh + col0;
                const f32x4 g0 = acc[ai][0][m][0], g1 = acc[ai][0][m][1], u0 = acc[ai][1][m][0], u1 = acc[ai][1][m][1];
                u32x4 w; w.x = cvt_pk_bf16(silu_mul(g0[0], u0[0]), silu_mul(g0[1], u0[1])); w.y = cvt_pk_bf16(silu_mul(g0[2], u0[2]), silu_mul(g0[3], u0[3]));
                w.z = cvt_pk_bf16(silu_mul(g1[0], u1[0]), silu_mul(g1[1], u1[1])); w.w = cvt_pk_bf16(silu_mul(g1[2], u1[2]), silu_mul(g1[3], u1[3]));
                *(u32x4*)rowp = w; }
    }
};
__device__ __forceinline__ unsigned pk4_fp8(float a, float b, float c, float d) { int w = __builtin_amdgcn_cvt_pk_fp8_f32(a, b, 0, false); w = __builtin_amdgcn_cvt_pk_fp8_f32(c, d, w, true); return (unsigned)w; }
__device__ __forceinline__ unsigned pk4_i8(float a, float b, float c, float d, float s) {
    const int ia = __float2int_rn(fminf(fmaxf(a * s, -127.f), 127.f)), ib = __float2int_rn(fminf(fmaxf(b * s, -127.f), 127.f));
    const int ic = __float2int_rn(fminf(fmaxf(c * s, -127.f), 127.f)), id = __float2int_rn(fminf(fmaxf(d * s, -127.f), 127.f));
    return (unsigned)(ia & 255) | ((unsigned)(ib & 255) << 8) | ((unsigned)(ic & 255) << 16) | ((unsigned)id << 24);
}
struct EpiSwiGLU8 {
    static constexpr bool PERM = true, AFTER_DRAIN = false;
    unsigned char* H; int ldh; float sc;
    __device__ __forceinline__ void operator()(const f32x4 (&acc)[2][2][4][2], const Unit& u, int wr, int wc, int fr, int fq) const {
        const int row0 = u.pm * BM + wr * 64 + fr, col0 = u.pn * HALF + wc * 32 + 8 * fq;
        typedef unsigned u32x2 __attribute__((ext_vector_type(2)));
#pragma unroll
        for (int ai = 0; ai < 2; ++ai)
#pragma unroll
            for (int m = 0; m < 4; ++m) { unsigned char* rowp = H + (size_t)(row0 + ai * HALF + m * 16) * ldh + col0;
                const f32x4 g0 = acc[ai][0][m][0] * sc, g1 = acc[ai][0][m][1] * sc, u0 = acc[ai][1][m][0] * sc, u1 = acc[ai][1][m][1] * sc;
                u32x2 w; w.x = pk4_fp8(silu_mul(g0[0], u0[0]), silu_mul(g0[1], u0[1]), silu_mul(g0[2], u0[2]), silu_mul(g0[3], u0[3]));
                w.y = pk4_fp8(silu_mul(g1[0], u1[0]), silu_mul(g1[1], u1[1]), silu_mul(g1[2], u1[2]), silu_mul(g1[3], u1[3]));
                *(u32x2*)rowp = w; }
    }
};
struct EpiResBf16 {
    static constexpr bool PERM = true, AFTER_DRAIN = false;
    const float* res; bf16_t* out; int ldc; float alpha, scale;
    __device__ __forceinline__ void operator()(const f32x4 (&acc)[2][2][4][2], const Unit& u, int wr, int wc, int fr, int fq) const {
        const int row0 = u.pm * BM + wr * 64 + fr, col0 = u.pn * BM + wc * 32 + 8 * fq;
#pragma unroll
        for (int ai = 0; ai < 2; ++ai)
#pragma unroll
            for (int m = 0; m < 4; ++m) { const size_t off = (size_t)(row0 + ai * HALF + m * 16) * ldc + col0;
                f32x4 rv[2][2];
#pragma unroll
                for (int bj = 0; bj < 2; ++bj)
#pragma unroll
                    for (int n = 0; n < 2; ++n) rv[bj][n] = *(const f32x4*)(res + off + bj * HALF + n * 4);
#pragma unroll
                for (int bj = 0; bj < 2; ++bj) { const f32x4 v0 = rv[bj][0] * alpha + acc[ai][bj][m][0] * scale, v1 = rv[bj][1] * alpha + acc[ai][bj][m][1] * scale;
                    u32x4 w; w.x = cvt_pk_bf16(v0[0], v0[1]); w.y = cvt_pk_bf16(v0[2], v0[3]); w.z = cvt_pk_bf16(v1[0], v1[1]); w.w = cvt_pk_bf16(v1[2], v1[3]);
                    *(u32x4*)(out + off + bj * HALF) = w; }
                asm volatile("" ::: "memory"); }
    }
};
struct EpiResF32 {
    static constexpr bool PERM = false, AFTER_DRAIN = false;
    const float* res; float* out; int ldc; float alpha, scale;
    __device__ __forceinline__ void operator()(const f32x4 (&acc)[2][2][4][2], const Unit& u, int wr, int wc, int fr, int fq) const {
        const int row0 = u.pm * BM + wr * 64 + fr, col0 = u.pn * BM + wc * 32 + 4 * fq;
#pragma unroll
        for (int ai = 0; ai < 2; ++ai)
#pragma unroll
            for (int m = 0; m < 4; ++m) { const size_t off = (size_t)(row0 + ai * HALF + m * 16) * ldc + col0;
                f32x4 rv[2][2];
#pragma unroll
                for (int bj = 0; bj < 2; ++bj)
#pragma unroll
                    for (int n = 0; n < 2; ++n) rv[bj][n] = *(const f32x4*)(res + off + bj * HALF + n * 16);
#pragma unroll
                for (int bj = 0; bj < 2; ++bj)
#pragma unroll
                    for (int n = 0; n < 2; ++n) *(f32x4*)(out + off + bj * HALF + n * 16) = rv[bj][n] * alpha + acc[ai][bj][m][n] * scale;
                asm volatile("" ::: "memory"); }
    }
};

__device__ __forceinline__ void mfma8(f32x4& c, const v8i a, const v8i b, const int scl) { asm volatile("v_mfma_scale_f32_16x16x128_f8f6f4 %0, %1, %2, %0, %3, %3 op_sel_hi:[0,0,0]" : "+v"(c) : "v"(a), "v"(b), "v"(scl)); }
template <class Epi, class Sched, bool ALIGN_EPI = false, bool SP2 = false, int OPK = 0>
__device__ __forceinline__ void gemm_phase(PG8_LAS unsigned char* lds, const Gemm g, const Sched& S, const Epi& E) {
    const int tid = threadIdx.x, wid = __builtin_amdgcn_readfirstlane(tid >> 6), lane = tid & 63, wr = wid >> 2, wc = wid & 3, fr = lane & 15, fq = lane >> 4;
    const int K = g.K, nt = K / BK;
    unsigned voffA[2], voffB[2];
#pragma unroll
    for (int i = 0; i < 2; ++i) { int R, C; stage_rc(tid * 16 + i * 8192, R, C); const int Rb = Epi::PERM ? ((R & ~31) + perm32(R & 31)) : R;
        voffA[i] = (unsigned)(R * K + C) * 2u; voffB[i] = (unsigned)(Rb * K + C) * 2u; }
    const size_t kstep = (size_t)(BK * 2);
    const size_t hstep = (size_t)HALF * K * 2;
    const size_t tstep = 2 * hstep;
    const unsigned ldsw = (unsigned)wid * 1024u;
    const int aoff = lds_byte(wr * 64 + fr, fq * 8), boff = lds_byte(wc * 32 + fr, fq * 8);
#define PG8_SA(b, h) (((b) * 2 + (h)) * HTB)
#define PG8_SB(b, h) ((4 + (b) * 2 + (h)) * HTB)
#define PG8_STAGE(bufoff, gbase, voff) do { _Pragma("unroll") for (int _i = 0; _i < 2; ++_i) \
        __builtin_amdgcn_global_load_lds((const unsigned*)((const char*)(gbase) + (voff)[_i]), (PG8_LAS unsigned*)(lds + (bufoff) + ldsw + _i * 8192), 16, 0, 0); } while (0)
#define PG8_LDA(dst, b, h) do { if constexpr (OPK == 1) { _Pragma("unroll") for (int m = 0; m < 4; ++m) { dst##8[m][0] = *(const PG8_LAS v4i*)(lds + PG8_SA(b, h) + aoff + m * 2048); dst##8[m][1] = *(const PG8_LAS v4i*)(lds + PG8_SA(b, h) + aoff + m * 2048 + 1024); } } \
    else { _Pragma("unroll") for (int m = 0; m < 4; ++m) _Pragma("unroll") for (int k = 0; k < 2; ++k) dst[m][k] = *(const PG8_LAS bf16x8*)(lds + PG8_SA(b, h) + aoff + m * 2048 + k * 1024); } } while (0)
#define PG8_LDB(dst, b, h) do { if constexpr (OPK == 1) { _Pragma("unroll") for (int n = 0; n < 2; ++n) { dst##8[n][0] = *(const PG8_LAS v4i*)(lds + PG8_SB(b, h) + boff + n * 2048); dst##8[n][1] = *(const PG8_LAS v4i*)(lds + PG8_SB(b, h) + boff + n * 2048 + 1024); } } \
    else { _Pragma("unroll") for (int n = 0; n < 2; ++n) _Pragma("unroll") for (int k = 0; k < 2; ++k) dst[n][k] = *(const PG8_LAS bf16x8*)(lds + PG8_SB(b, h) + boff + n * 2048 + k * 1024); } } while (0)
#define PG8_MMA(ai, bj, At, Bt) do { __builtin_amdgcn_s_setprio(1); if constexpr (OPK == 1) { _Pragma("unroll") for (int m = 0; m < 4; ++m) _Pragma("unroll") for (int n = 0; n < 2; ++n) \
        mfma8(acc[ai][bj][m][n], __builtin_shufflevector(Bt##8[n][0], Bt##8[n][1], 0, 1, 2, 3, 4, 5, 6, 7), __builtin_shufflevector(At##8[m][0], At##8[m][1], 0, 1, 2, 3, 4, 5, 6, 7), scl8); } \
    else if constexpr (OPK == 2) { _Pragma("unroll") for (int m = 0; m < 4; ++m) _Pragma("unroll") for (int n = 0; n < 2; ++n) _Pragma("unroll") for (int k = 0; k < 2; ++k) \
        acc[ai][bj][m][n] = __builtin_bit_cast(f32x4, __builtin_amdgcn_mfma_i32_16x16x64_i8(__builtin_bit_cast(v4i, Bt[n][k]), __builtin_bit_cast(v4i, At[m][k]), __builtin_bit_cast(v4i, acc[ai][bj][m][n]), 0, 0, 0)); } \
    else { _Pragma("unroll") for (int m = 0; m < 4; ++m) _Pragma("unroll") for (int n = 0; n < 2; ++n) _Pragma("unroll") for (int k = 0; k < 2; ++k) \
        acc[ai][bj][m][n] = __builtin_amdgcn_mfma_f32_16x16x32_bf16(Bt[n][k], At[m][k], acc[ai][bj][m][n], 0, 0, 0); } __builtin_amdgcn_s_setprio(0); } while (0)
#define PG8_WAIT_V(n) asm volatile("s_waitcnt vmcnt(" #n ")" ::: "memory")
#define PG8_WAIT_L(n) asm volatile("s_waitcnt lgkmcnt(" #n ")" ::: "memory")
#define PG8_BAR __builtin_amdgcn_s_barrier()
#define PG8_SCHED __builtin_amdgcn_sched_barrier(0)
    Unit cur, nxt; int ui = 0;
    if (!S.next(0, cur)) return;
    f32x4 acc[2][2][4][2];
#pragma unroll
    for (int a = 0; a < 2; ++a)
#pragma unroll
        for (int b = 0; b < 2; ++b)
#pragma unroll
            for (int m = 0; m < 4; ++m)
#pragma unroll
                for (int n = 0; n < 2; ++n) acc[a][b][m][n] = (f32x4){0.f, 0.f, 0.f, 0.f};
    bf16x8 At[4][2], B0[2][2], B1[2][2];
    v4i At8[4][2], B08[2][2], B18[2][2];
    int scl8 = 0x7F7F7F7F; asm volatile("" : "+v"(scl8));
    const char* cA = (const char*)g.A + (size_t)cur.pm * tstep; const char* cB = (const char*)g.Bt + (size_t)cur.be * g.bstride + (size_t)cur.pn * tstep;
    S.a_ready(cur);
    if constexpr (SP2) {
        PG8_STAGE(PG8_SB(0, 0), cB, voffB); PG8_STAGE(PG8_SB(0, 1), cB + hstep, voffB); PG8_STAGE(PG8_SA(0, 0), cA, voffA); PG8_STAGE(PG8_SA(0, 1), cA + hstep, voffA);
        if (wr == 1) PG8_BAR;
        PG8_WAIT_V(2); PG8_BAR;
        PG8_STAGE(PG8_SB(1, 0), cB + kstep, voffB); PG8_STAGE(PG8_SA(1, 0), cA + kstep, voffA); PG8_STAGE(PG8_SB(1, 1), cB + hstep + kstep, voffB);
        PG8_WAIT_V(6); PG8_BAR;
    } else {
        PG8_STAGE(PG8_SB(0, 0), cB, voffB); PG8_STAGE(PG8_SA(0, 0), cA, voffA); PG8_STAGE(PG8_SB(0, 1), cB + hstep, voffB); PG8_STAGE(PG8_SA(0, 1), cA + hstep, voffA);
        if (wr == 1) PG8_BAR;
        PG8_WAIT_V(4); PG8_BAR;
        PG8_STAGE(PG8_SB(1, 0), cB + kstep, voffB); PG8_STAGE(PG8_SA(1, 0), cA + kstep, voffA); PG8_STAGE(PG8_SB(1, 1), cB + hstep + kstep, voffB);
        PG8_WAIT_V(6); PG8_BAR;
    }
    for (;;) {
        const bool has_next = S.next(ui + 1, nxt);
        const char* nA = has_next ? (const char*)g.A + (size_t)nxt.pm * tstep : cA; const char* nB = has_next ? (const char*)g.Bt + (size_t)nxt.be * g.bstride + (size_t)nxt.pn * tstep : cB;
#pragma unroll 1
        for (int t = 0; t < nt; t += 2) {
            const bool last = (t == nt - 2);
            const char* a1 = cA + (size_t)(t + 1) * kstep;
            const char* a2 = last ? nA : cA + (size_t)(t + 2) * kstep; const char* b2 = last ? nB : cB + (size_t)(t + 2) * kstep;
            const char* a3 = a2 + kstep; const char* b3 = b2 + kstep;
            if (last && has_next) S.a_ready(nxt);
            if constexpr (SP2) {
            PG8_LDB(B0, 0, 0); PG8_LDB(B1, 0, 1); PG8_SCHED; PG8_LDA(At, 0, 0); PG8_STAGE(PG8_SA(1, 1), a1 + hstep, voffA);
            PG8_WAIT_V(8); PG8_WAIT_L(0); PG8_BAR; PG8_MMA(0, 0, At, B0); PG8_MMA(0, 1, At, B1); PG8_BAR; PG8_SCHED;
            PG8_LDA(At, 0, 1); PG8_STAGE(PG8_SB(0, 0), b2, voffB); PG8_STAGE(PG8_SB(0, 1), b2 + hstep, voffB); PG8_STAGE(PG8_SA(0, 0), a2, voffA);
            PG8_WAIT_V(8); PG8_WAIT_L(0); PG8_BAR; PG8_MMA(1, 0, At, B0); PG8_MMA(1, 1, At, B1); PG8_BAR; PG8_SCHED;
            PG8_LDB(B0, 1, 0); PG8_LDB(B1, 1, 1); PG8_SCHED; PG8_LDA(At, 1, 0); PG8_STAGE(PG8_SA(0, 1), a2 + hstep, voffA);
            PG8_WAIT_V(8); PG8_WAIT_L(0); PG8_BAR; PG8_MMA(0, 0, At, B0); PG8_MMA(0, 1, At, B1); PG8_BAR; PG8_SCHED;
            PG8_LDA(At, 1, 1); PG8_STAGE(PG8_SB(1, 0), b3, voffB); PG8_STAGE(PG8_SB(1, 1), b3 + hstep, voffB); PG8_STAGE(PG8_SA(1, 0), a3, voffA);
            PG8_WAIT_V(8); PG8_WAIT_L(0); PG8_BAR; PG8_MMA(1, 0, At, B0); PG8_MMA(1, 1, At, B1); PG8_BAR; PG8_SCHED;
            } else {
            PG8_LDB(B0, 0, 0); PG8_SCHED; PG8_LDA(At, 0, 0); PG8_STAGE(PG8_SA(1, 1), a1 + hstep, voffA);
            PG8_WAIT_L(8); PG8_BAR; PG8_WAIT_L(0); PG8_MMA(0, 0, At, B0); PG8_BAR; PG8_SCHED;
            PG8_LDB(B1, 0, 1); PG8_STAGE(PG8_SB(0, 0), b2, voffB);
            PG8_BAR; PG8_WAIT_L(0); PG8_MMA(0, 1, At, B1); PG8_BAR;
            PG8_LDA(At, 0, 1); PG8_STAGE(PG8_SA(0, 0), a2, voffA);
            PG8_BAR; PG8_WAIT_L(0); PG8_MMA(1, 0, At, B0); PG8_BAR; PG8_SCHED;
            PG8_STAGE(PG8_SB(0, 1), b2 + hstep, voffB);
            PG8_WAIT_V(6); PG8_BAR; PG8_MMA(1, 1, At, B1); PG8_BAR;
            PG8_LDB(B0, 1, 0); PG8_SCHED; PG8_LDA(At, 1, 0); PG8_STAGE(PG8_SA(0, 1), a2 + hstep, voffA);
            PG8_WAIT_L(8); PG8_BAR; PG8_WAIT_L(0); PG8_MMA(0, 0, At, B0); PG8_BAR; PG8_SCHED;
            PG8_LDB(B1, 1, 1); PG8_STAGE(PG8_SB(1, 0), b3, voffB);
            PG8_BAR; PG8_WAIT_L(0); PG8_MMA(0, 1, At, B1); PG8_BAR;
            PG8_LDA(At, 1, 1); PG8_STAGE(PG8_SA(1, 0), a3, voffA);
            PG8_BAR; PG8_WAIT_L(0); PG8_MMA(1, 0, At, B0); PG8_BAR; PG8_SCHED;
            PG8_STAGE(PG8_SB(1, 1), b3 + hstep, voffB);
            PG8_WAIT_V(6); PG8_BAR; PG8_MMA(1, 1, At, B1); PG8_BAR;
            }
        }
        if constexpr (OPK == 1) asm volatile("s_nop 15\n\ts_nop 15" ::: "memory");
        if constexpr (OPK == 2) {
#pragma unroll
            for (int a = 0; a < 2; ++a)
#pragma unroll
                for (int b = 0; b < 2; ++b)
#pragma unroll
                    for (int m = 0; m < 4; ++m)
#pragma unroll
                        for (int n = 0; n < 2; ++n) { const v4i iv = __builtin_bit_cast(v4i, acc[a][b][m][n]); acc[a][b][m][n] = (f32x4){(float)iv[0], (float)iv[1], (float)iv[2], (float)iv[3]}; }
        }
        if constexpr (ALIGN_EPI) { if (wr == 0) PG8_BAR; }
        if constexpr (!Epi::AFTER_DRAIN) { E(acc, cur, wr, wc, fr, fq); S.done(cur); }
        if (!has_next) break;
#pragma unroll
        for (int a = 0; a < 2; ++a)
#pragma unroll
            for (int b = 0; b < 2; ++b)
#pragma unroll
                for (int m = 0; m < 4; ++m)
#pragma unroll
                    for (int n = 0; n < 2; ++n) acc[a][b][m][n] = (f32x4){0.f, 0.f, 0.f, 0.f};
        cur = nxt; cA = nA; cB = nB; ++ui;
        if constexpr (ALIGN_EPI) { if (wr == 1) PG8_BAR; }
    }
    PG8_WAIT_V(0);
    if constexpr (!ALIGN_EPI) { if (wr == 0) PG8_BAR; }
    PG8_BAR;
    if constexpr (Epi::AFTER_DRAIN) { E.fused(acc, cur, wr, wc, fr, fq, lds, wid, lane); S.done(cur); }
#undef PG8_SA
#undef PG8_SB
#undef PG8_STAGE
#undef PG8_LDA
#undef PG8_LDB
#undef PG8_MMA
#undef PG8_WAIT_V
#undef PG8_WAIT_L
#undef PG8_BAR
#undef PG8_SCHED
}
}

constexpr int BATCH = 2, SEQ = 16384, DM = 1024, NTOK = BATCH * SEQ;
constexpr int CHK = 64, NCHUNK = SEQ / CHK;
constexpr int INC = 1792, KOFF = 512, VOFF = 640, XBOFF = 768, GBOFF = 1280;
constexpr int LRUW = 512, DFF = 2816, DFE = 3584, NEXP = 8;
constexpr int MAXTILES = 264, PASS_TILES = 264, NPASS = 1;
constexpr float ALPHA = 1.41421356237309515f, LN_EPS = 1e-5f, RMS_EPS = 1e-6f, LOG2E = 1.4426950408889634f, QSCALE = 0.125f * LOG2E;
constexpr int NWAVES = 8, NTHREADS = 512;

constexpr size_t MiB = 1u << 20;
constexpr size_t WS_CTL = 0, CTL_ZERO_BYTES = 64 * 1024;
constexpr size_t WS_LUT = 1 * MiB;
constexpr size_t WS_GATEW = 1 * MiB + 64 * 1024;
constexpr size_t WS_HIST = 1 * MiB + 512 * 1024;
constexpr size_t WS_META = 1 * MiB + 576 * 1024;
constexpr size_t WS_TOKE = 2 * MiB, WS_TOKW = 2 * MiB + 256 * 1024, WS_TOKPOS = 2 * MiB + 512 * 1024;
constexpr size_t WS_LRUP = 3 * MiB, WS_LRUE = 4 * MiB, WS_HIN = 5 * MiB;
constexpr size_t WS_WEGU = 8 * MiB, WS_WED = 64 * MiB;
constexpr size_t WS_WIN = 92 * MiB, WS_WOUT = 99 * MiB, WS_WGU = 103 * MiB, WS_WD = 114 * MiB;
constexpr size_t WS_A = 120 * MiB;
constexpr size_t WS_TB = 152 * MiB;
constexpr size_t WS_ZH = 216 * MiB;
constexpr size_t WS_HL = 328 * MiB, WS_PA = 360 * MiB;
constexpr size_t WS_XS = 120 * MiB;
constexpr size_t WS_Y2 = 120 * MiB;
constexpr size_t WS_HM = 252 * MiB;
constexpr size_t WS_END = 483 * MiB;
constexpr float SA_X = 127.0f / 6.0f, SW_IN = 127.0f * 32.0f / 6.0f, SW_GU = 127.0f * 32.0f / 6.0f;
constexpr float WSC_OUT = 128.0f;
constexpr float WSC_D = 256.0f;
static_assert(WS_WED + (size_t)NEXP * DM * DFE <= WS_WIN && WS_WD + (size_t)DM * DFF * 2 <= WS_A && WS_A + (size_t)NTOK * DM <= WS_TB && WS_TB + (size_t)NTOK * DM * 2 <= WS_ZH && WS_ZH + (size_t)NTOK * DFF * 2 <= WS_END, "ws map");
static_assert(WS_ZH + (size_t)NTOK * INC * 2 <= WS_HL && WS_HL + (size_t)NTOK * LRUW * 2 <= WS_PA && WS_PA + (size_t)NTOK * LRUW * 2 <= WS_ZH + (size_t)NTOK * DFF * 2, "ws map (LRU)");
static_assert(NPASS == 1 && WS_XS == WS_Y2 && WS_Y2 + (size_t)MAXTILES * 256 * DM * 2 <= WS_HM && WS_HM + (size_t)PASS_TILES * 256 * DFE <= WS_END, "ws map (MoE)");
constexpr int CW_BAR = 0;

constexpr int RING_BYTES = 131072;
constexpr int LDS_LUT = RING_BYTES;
constexpr int LDS_CTAB = LDS_LUT + 8192;
constexpr int CT_CB = 4 * 512, CT_BR = 5 * 512, CT_BI = 6 * 512, CT_SP = 7 * 512;
constexpr int LDS_MISC = LDS_CTAB + 16384;
constexpr int LDS_POS = LDS_MISC + 256;
constexpr int LDS_BYTES = 159744;
static_assert(LDS_POS + 1024 <= LDS_BYTES, "LDS map");

#define GAS __attribute__((address_space(1)))
#define LAS __attribute__((address_space(3)))
typedef unsigned short bf16;
typedef unsigned v4u __attribute__((ext_vector_type(4)));
typedef unsigned v2u __attribute__((ext_vector_type(2)));
typedef float f32x4 __attribute__((ext_vector_type(4)));
typedef float f32x16 __attribute__((ext_vector_type(16)));
typedef short bf16x8 __attribute__((ext_vector_type(8)));
typedef short s16x4 __attribute__((ext_vector_type(4)));
#define LDS_WAIT() asm volatile("s_waitcnt lgkmcnt(0)" ::: "memory")
#define VM_WAIT() asm volatile("s_waitcnt vmcnt(0)" ::: "memory")
__device__ __forceinline__ unsigned pk2(float lo, float hi) { return pg8::cvt_pk_bf16(lo, hi); }
__device__ __forceinline__ float bf2f(unsigned short h) { return __uint_as_float((unsigned)h << 16); }
__device__ __forceinline__ float bflo(unsigned w) { return __uint_as_float(w << 16); }
__device__ __forceinline__ float bfhi(unsigned w) { return __uint_as_float(w & 0xffff0000u); }
__device__ __forceinline__ float wave_sum(float v) {
#pragma unroll
    for (int o = 1; o < 64; o <<= 1) v += __shfl_xor(v, o);
    return v;
}
__device__ __forceinline__ float fast_sigmoid(float x) { return __builtin_amdgcn_rcpf(1.0f + __builtin_amdgcn_exp2f(x * -LOG2E)); }
__device__ __forceinline__ float gelu_tanh(float x) {
    const float t = 1.5957691216057308f * (x + 0.044715f * x * x * x);
    return x * fast_sigmoid(t);
}

#define XB_TMO      128
#define XB_XCNT(j)  (256  + 64 * (j))
#define XB_XSUB(j)  (1280 + 64 * (j))
#define XB_XGEN(j)  (2304 + 64 * (j))
#define XB_TOP      3328
#define XB_TOPGEN   3392
#define XCD_BAR_WORDS 3456
#define XB_SPIN_CAP (1u << 18)

__device__ __forceinline__ unsigned xb_ld(unsigned* p)              { return __hip_atomic_load(p, __ATOMIC_RELAXED, __HIP_MEMORY_SCOPE_AGENT); }
__device__ __forceinline__ unsigned xb_add(unsigned* p, unsigned v) { return __hip_atomic_fetch_add(p, v, __ATOMIC_RELAXED, __HIP_MEMORY_SCOPE_AGENT); }
__device__ __forceinline__ unsigned xb_xcc_id() { return (unsigned)__builtin_amdgcn_s_getreg((3 << 11) | 20) & 0xFu; }
#define XB_SPIN(cond, bar) do { unsigned _sp = 0; while (cond) { __builtin_amdgcn_s_sleep(1); \
    if ((++_sp & 255u) == 0u) { if (xb_ld(&(bar)[XB_TMO])) break; if (_sp > XB_SPIN_CAP) { atomicAdd(&(bar)[XB_TMO], 1u); break; } } } } while (0)

struct XcdBarrier {
    unsigned* bar; unsigned x;
    volatile LAS unsigned* st;
};

__device__ __forceinline__ XcdBarrier xcd_barrier_post(unsigned* bar, volatile LAS unsigned* st) {
    XcdBarrier b; b.bar = bar; b.x = xb_xcc_id(); b.st = st;
    if (threadIdx.x == 0) (void)xb_add(&bar[XB_XCNT(b.x)], 1u);
    return b;
}
__device__ __forceinline__ void xcd_barrier_complete(unsigned* bar, unsigned x, unsigned& nloc, unsigned& nx) {
    const unsigned G = gridDim.x * gridDim.y * gridDim.z;
    unsigned sum, cnt, mine, sp = 0u;
    for (;;) {
        sum = 0u; cnt = 0u; mine = 0u;
#pragma unroll
        for (unsigned j = 0; j < 16; ++j) { const unsigned c = xb_ld(&bar[XB_XCNT(j)]); sum += c; cnt += (c > 0u) ? 1u : 0u; mine = (j == x) ? c : mine; }
        if (sum == G) break;
        __builtin_amdgcn_s_sleep(1);
        if ((++sp & 255u) == 0u) { if (xb_ld(&bar[XB_TMO])) break; if (sp > XB_SPIN_CAP) { atomicAdd(&bar[XB_TMO], 1u); break; } }
    }
    nloc = mine > 0u ? mine : 1u; nx = cnt > 0u ? cnt : 1u;
}

__device__ __forceinline__ void xcd_barrier(const XcdBarrier& b) {
    asm volatile("s_waitcnt vmcnt(0)" ::: "memory");
    __syncthreads();
    if (threadIdx.x == 0) {
        unsigned* bar = b.bar;
        __builtin_amdgcn_s_waitcnt(0);
        unsigned nloc = b.st[0], nx = b.st[1];
        if (nloc == 0u) { xcd_barrier_complete(bar, b.x, nloc, nx); b.st[0] = nloc; b.st[1] = nx; }
        const unsigned old = xb_add(&bar[XB_XSUB(b.x)], 1u);
        const unsigned gen = old / nloc;
        if (old + 1u == (gen + 1u) * nloc) {
            __builtin_amdgcn_fence(__ATOMIC_RELEASE, "agent");
            asm volatile("s_waitcnt vmcnt(0)" ::: "memory");
            const unsigned og = xb_add(&bar[XB_TOP], 1u);
            const unsigned tg = og / nx;
            if (og + 1u == (tg + 1u) * nx) xb_add(&bar[XB_TOPGEN], 1u);
            else XB_SPIN(xb_ld(&bar[XB_TOPGEN]) == tg, bar);
            __builtin_amdgcn_fence(__ATOMIC_ACQUIRE, "agent");
            xb_add(&bar[XB_XGEN(b.x)], 1u);
            asm volatile("s_waitcnt vmcnt(0)" ::: "memory");
        } else {
            XB_SPIN(xb_ld(&bar[XB_XGEN(b.x)]) == gen, bar);
            __builtin_amdgcn_fence(__ATOMIC_ACQUIRE, "agent");
            asm volatile("s_waitcnt vmcnt(0)" ::: "memory");
        }
    }
    __syncthreads();
}

struct Args { const float* in[25]; float* out; unsigned char* ws; int ph_lo, ph_hi; };
struct Frame {
    LAS unsigned char* lds;
    int tid, lane, wave, G, blk;
};

__device__ __forceinline__ void p0_transpose_item(const float* W, int K, int N, bf16* WT, int mode, const float* ksA, const float* ksB, float nscale, int nscale_cols, LAS float* scr, int item, int lane) {
    const int nblk = N / 32, kb = item / nblk, nb = item % nblk, k0 = 64 * kb, n0 = 32 * nb;
    const float* ks = ksA ? (k0 < 512 ? ksA + k0 : ksB + (k0 - 512)) : nullptr;
#pragma unroll
    for (int i = 0; i < 32; ++i) { const int kk = 2 * i + (lane >> 5); float v = W[(size_t)(k0 + kk) * N + n0 + (lane & 31)]; if (ks) v *= ks[kk]; scr[kk * 33 + (lane & 31)] = v; }
    LDS_WAIT(); asm volatile("" ::: "memory");
    const int drow0 = (mode == 0) ? n0 : ((n0 >> 7) * 256 + (n0 & 127) + (mode == 2 ? 128 : 0));
    const float sc = (n0 < nscale_cols) ? nscale : 1.0f;
    const int c = lane & 7;
#pragma unroll
    for (int j = 0; j < 4; ++j) { const int n = (lane >> 3) + 8 * j; const LAS float* s = scr + (8 * c) * 33 + n;
        v4u o; o.x = pk2(s[0 * 33] * sc, s[1 * 33] * sc); o.y = pk2(s[2 * 33] * sc, s[3 * 33] * sc); o.z = pk2(s[4 * 33] * sc, s[5 * 33] * sc); o.w = pk2(s[6 * 33] * sc, s[7 * 33] * sc);
        *(v4u*)(WT + (size_t)(drow0 + n) * K + k0 + 8 * c) = o; }
    LDS_WAIT(); asm volatile("" ::: "memory");
}
template <int KIND  >
__device__ __forceinline__ void p0_transpose_item_f8(const float* W, int K, int N, unsigned char* WT, int mode, float scale, LAS float* scr, int item, int lane, const float* ksA = nullptr, const float* ksB = nullptr, float nscale = 1.0f, int nscale_cols = 0) {
    const int nblk = N / 32, kb = item / nblk, nb = item % nblk, k0 = 64 * kb, n0 = 32 * nb;
    const float* ks = ksA ? (k0 < 512 ? ksA + k0 : ksB + (k0 - 512)) : nullptr;
    if (n0 < nscale_cols) scale *= nscale;
#pragma unroll
    for (int i = 0; i < 32; ++i) { const int kk = 2 * i + (lane >> 5); float v = W[(size_t)(k0 + kk) * N + n0 + (lane & 31)] * scale; if (ks) v *= ks[kk]; scr[kk * 33 + (lane & 31)] = v; }
    LDS_WAIT(); asm volatile("" ::: "memory");
    const int drow0 = (mode == 0) ? n0 : ((n0 >> 7) * 256 + (n0 & 127) + (mode == 2 ? 128 : 0));
    const int c = lane & 3;
#pragma unroll
    for (int j = 0; j < 2; ++j) { const int n = (lane >> 2) + 16 * j; const LAS float* s = scr + (16 * c) * 33 + n;
        v4u o;
        if (KIND == 1) { o.x = pg8::pk4_fp8(s[0 * 33], s[1 * 33], s[2 * 33], s[3 * 33]); o.y = pg8::pk4_fp8(s[4 * 33], s[5 * 33], s[6 * 33], s[7 * 33]);
            o.z = pg8::pk4_fp8(s[8 * 33], s[9 * 33], s[10 * 33], s[11 * 33]); o.w = pg8::pk4_fp8(s[12 * 33], s[13 * 33], s[14 * 33], s[15 * 33]); }
        else { o.x = pg8::pk4_i8(s[0 * 33], s[1 * 33], s[2 * 33], s[3 * 33], 1.0f); o.y = pg8::pk4_i8(s[4 * 33], s[5 * 33], s[6 * 33], s[7 * 33], 1.0f);
            o.z = pg8::pk4_i8(s[8 * 33], s[9 * 33], s[10 * 33], s[11 * 33], 1.0f); o.w = pg8::pk4_i8(s[12 * 33], s[13 * 33], s[14 * 33], s[15 * 33], 1.0f); }
        *(v4u*)(WT + (size_t)(drow0 + n) * K + k0 + 16 * c) = o; }
    LDS_WAIT(); asm volatile("" ::: "memory");
}
__device__ __forceinline__ int t5_bucket(int rel) {
    const int n = rel < 0 ? -rel : rel;
    int v;
    if (n < 8) v = n;
    else { v = 8 + (n >= 12) + (n >= 16) + (n >= 23) + (n >= 32) + (n >= 46) + (n >= 64) + (n >= 91); }
    return (rel > 0 ? 16 : 0) + v;
}
__device__ __forceinline__ void p0_prologue(const Frame& F, const Args& A) {
    unsigned char* ws = A.ws;
    LAS float* scr = (LAS float*)(F.lds + F.wave * 8448);
    const int gw = F.blk * NWAVES + F.wave, NGW = F.G * NWAVES;
    bf16* WIN = (bf16*)(ws + WS_WIN); bf16* WOUT = (bf16*)(ws + WS_WOUT); bf16* WGU = (bf16*)(ws + WS_WGU); bf16* WD = (bf16*)(ws + WS_WD);
    unsigned char* WEGU = ws + WS_WEGU; unsigned char* WED = ws + WS_WED;
    constexpr int I_IN = (DM / 64) * (INC / 32), I_OUT = (DM / 64) * (DM / 32), I_GU = (DM / 64) * (DFF / 32), I_D = (DFF / 64) * (DM / 32);
    constexpr int I_EGU = (DM / 64) * (DFE / 32), I_ED = (DFE / 64) * (DM / 32);
    constexpr int NITEMS = 2 * I_IN + 2 * I_OUT + 2 * I_GU + I_D + NEXP * (2 * I_EGU + I_ED);
    struct Item { const float* src; unsigned char* dst; const float* ks; int K, N, k0, n0, mode, kind; float scale; };
    auto decode = [&](int it, Item& d) {
        int r = it; d.ks = nullptr;
        if (r < 2 * I_IN) { const int l = r / I_IN; r -= l * I_IN; d.src = A.in[2] + (size_t)l * DM * INC; d.K = DM; d.N = INC; d.dst = (unsigned char*)WIN + (size_t)l * INC * DM; d.mode = 0; d.kind = 2; d.scale = SW_IN; }
        else if ((r -= 2 * I_IN) < 2 * I_OUT) { const int l = r / I_OUT; r -= l * I_OUT; d.src = A.in[13] + (size_t)l * DM * DM; d.K = DM; d.N = DM; d.dst = (unsigned char*)WOUT + (size_t)l * DM * DM; d.mode = 0; d.kind = 1; d.scale = WSC_OUT; d.ks = A.in[11] + l * 512; }
        else if ((r -= 2 * I_OUT) < I_GU) { d.src = A.in[16]; d.K = DM; d.N = DFF; d.dst = (unsigned char*)WGU; d.mode = 1; d.kind = 2; d.scale = SW_GU; }
        else if ((r -= I_GU) < I_GU) { d.src = A.in[17]; d.K = DM; d.N = DFF; d.dst = (unsigned char*)WGU; d.mode = 2; d.kind = 2; d.scale = SW_GU; }
        else if ((r -= I_GU) < I_D) { d.src = A.in[18]; d.K = DFF; d.N = DM; d.dst = (unsigned char*)WD; d.mode = 0; d.kind = 1; d.scale = WSC_D; }
        else { r -= I_D; constexpr int PER_E = 2 * I_EGU + I_ED; const int e = r / PER_E; r -= e * PER_E;
            if (r < I_EGU) { d.src = A.in[20] + (size_t)e * DM * DFE; d.K = DM; d.N = DFE; d.dst = WEGU + (size_t)e * 2 * DFE * DM; d.mode = 1; d.kind = 2; d.scale = SW_GU; }
            else if ((r -= I_EGU) < I_EGU) { d.src = A.in[21] + (size_t)e * DM * DFE; d.K = DM; d.N = DFE; d.dst = WEGU + (size_t)e * 2 * DFE * DM; d.mode = 2; d.kind = 2; d.scale = SW_GU; }
            else { r -= I_EGU; d.src = A.in[22] + (size_t)e * DFE * DM; d.K = DFE; d.N = DM; d.dst = WED + (size_t)e * DM * DFE; d.mode = 0; d.kind = 1; d.scale = WSC_D; } }
        const int nblk = d.N / 32; d.k0 = 64 * (r / nblk); d.n0 = 32 * (r % nblk);
        if (d.ks) d.ks = (d.k0 < 512) ? d.ks + d.k0 : (A.in[12] + (d.ks - A.in[11]) + (d.k0 - 512));
    };
    float v[32], nv[32]; Item cur, nxt;
    int it = gw;
    if (it < NITEMS) { decode(it, cur);
#pragma unroll
        for (int i = 0; i < 32; ++i) v[i] = cur.src[(size_t)(cur.k0 + 2 * i + (F.lane >> 5)) * cur.N + cur.n0 + (F.lane & 31)]; }
    for (; it < NITEMS; it += NGW) {
        const bool more = it + NGW < NITEMS;
        if (more) { decode(it + NGW, nxt);
#pragma unroll
            for (int i = 0; i < 32; ++i) nv[i] = nxt.src[(size_t)(nxt.k0 + 2 * i + (F.lane >> 5)) * nxt.N + nxt.n0 + (F.lane & 31)]; }
        asm volatile("" ::: "memory");
#pragma unroll
        for (int i = 0; i < 32; ++i) { const int kk = 2 * i + (F.lane >> 5); float x = v[i] * cur.scale; if (cur.ks) x *= cur.ks[kk]; scr[kk * 33 + (F.lane & 31)] = x; }
        LDS_WAIT(); asm volatile("" ::: "memory");
        {   const int drow0 = (cur.mode == 0) ? cur.n0 : ((cur.n0 >> 7) * 256 + (cur.n0 & 127) + (cur.mode == 2 ? 128 : 0));
            const int c = F.lane & 3;
#pragma unroll
            for (int j = 0; j < 2; ++j) { const int n = (F.lane >> 2) + 16 * j; const LAS float* s = scr + (16 * c) * 33 + n;
                v4u o;
                if (cur.kind == 1) { o.x = pg8::pk4_fp8(s[0 * 33], s[1 * 33], s[2 * 33], s[3 * 33]); o.y = pg8::pk4_fp8(s[4 * 33], s[5 * 33], s[6 * 33], s[7 * 33]);
                    o.z = pg8::pk4_fp8(s[8 * 33], s[9 * 33], s[10 * 33], s[11 * 33]); o.w = pg8::pk4_fp8(s[12 * 33], s[13 * 33], s[14 * 33], s[15 * 33]); }
                else { o.x = pg8::pk4_i8(s[0 * 33], s[1 * 33], s[2 * 33], s[3 * 33], 1.0f); o.y = pg8::pk4_i8(s[4 * 33], s[5 * 33], s[6 * 33], s[7 * 33], 1.0f);
                    o.z = pg8::pk4_i8(s[8 * 33], s[9 * 33], s[10 * 33], s[11 * 33], 1.0f); o.w = pg8::pk4_i8(s[12 * 33], s[13 * 33], s[14 * 33], s[15 * 33], 1.0f); }
                *(v4u*)(cur.dst + (size_t)(drow0 + n) * cur.K + cur.k0 + 16 * c) = o; }
        }
        LDS_WAIT(); asm volatile("" ::: "memory");
        if (more) { cur = nxt;
#pragma unroll
            for (int i = 0; i < 32; ++i) v[i] = nv[i]; }
    }
    { const f32x4* x4 = (const f32x4*)A.in[0]; v4u* o = (v4u*)(ws + WS_A);
      const size_t n16 = (size_t)NTOK * DM / 16, stride = (size_t)F.G * NTHREADS;
      for (size_t i0 = (size_t)F.blk * NTHREADS + F.tid; i0 < n16; i0 += 4 * stride) {
          f32x4 a[4][4];
#pragma unroll
          for (int u = 0; u < 4; ++u) { const size_t i = i0 + u * stride; if (i < n16) {
#pragma unroll
              for (int q = 0; q < 4; ++q) a[u][q] = x4[4 * i + q]; } }
#pragma unroll
          for (int u = 0; u < 4; ++u) { const size_t i = i0 + u * stride; if (i < n16) { v4u w;
              w.x = pg8::pk4_i8(a[u][0].x, a[u][0].y, a[u][0].z, a[u][0].w, SA_X); w.y = pg8::pk4_i8(a[u][1].x, a[u][1].y, a[u][1].z, a[u][1].w, SA_X);
              w.z = pg8::pk4_i8(a[u][2].x, a[u][2].y, a[u][2].z, a[u][2].w, SA_X); w.w = pg8::pk4_i8(a[u][3].x, a[u][3].y, a[u][3].z, a[u][3].w, SA_X); o[i] = w; } } } }
    { bf16* GW = (bf16*)(ws + WS_GATEW);
      for (int i = F.blk * NTHREADS + F.tid; i < 2 * 2 * 8 * 64 * 64; i += F.G * NTHREADS) {
          const int d = i & 63, e = (i >> 6) & 63, n = (i >> 12) & 7, g = (i >> 15) & 1, l = i >> 16;
          const float v = (g ? A.in[8] : A.in[6])[(((size_t)l * 8 + n) * 64 + d) * 64 + e];
          GW[i] = (bf16)(pk2(v, v) & 0xffffu); } }
    if (F.blk == 0 && F.tid < 256) { float* LUT = (float*)(ws + WS_LUT); const int rel = F.tid - 191; const int bk = t5_bucket(rel);
#pragma unroll
        for (int h = 0; h < 8; ++h) LUT[h * 256 + F.tid] = A.in[1][bk * 8 + h] * LOG2E; }
}

template <int D> __device__ __forceinline__ float dpp_shr(float v, float idv) { return __builtin_bit_cast(float, __builtin_amdgcn_update_dpp(__builtin_bit_cast(int, idv), __builtin_bit_cast(int, v), 0x110 + D, 0xF, 0xF, false)); }
__device__ __forceinline__ float dpp_ror1(float v) { return __builtin_bit_cast(float, __builtin_amdgcn_update_dpp(0, __builtin_bit_cast(int, v), 0x121, 0xF, 0xF, false)); }
template <int D> __device__ __forceinline__ void scan_step(float& P, float& H) { const float P1 = dpp_shr<D>(P, 1.0f), H1 = dpp_shr<D>(H, 0.0f); H = P * H1 + H; P = P * P1; }
__device__ __forceinline__ void lru_tables(const Frame& F, const Args& A, int l) {
    LAS float* ct = (LAS float*)(F.lds + LDS_CTAB);
    const int ch = F.tid;
#pragma unroll
    for (int w = 0; w < 4; ++w) ct[w * 512 + ch] = A.in[4][(l * 4 + w) * LRUW + ch];
    ct[CT_CB + ch] = A.in[5][l * LRUW + ch]; ct[CT_BR + ch] = A.in[7][l * LRUW + ch]; ct[CT_BI + ch] = A.in[9][l * LRUW + ch];
    ct[CT_SP + ch] = 8.0f * log1pf(__expf(-A.in[10][l * LRUW + ch]));
}
struct LruNb { bf16x8 wr[2], wi[2]; v2u gb[4]; f32x4 hin; };
template <bool FINAL, int PART  >
__device__ __forceinline__ void lru_load_nb(LruNb& L, int nb, const bf16* Z, size_t row0, int n, int fr, int fq, const bf16* gwr, const bf16* gwi, const float* HinRow) {
    const int ch0 = 64 * n + 16 * nb + 4 * fq;
    if (PART & 1) {
#pragma unroll
        for (int ks = 0; ks < 2; ++ks) { L.wr[ks] = *(const bf16x8*)(gwr + (16 * nb + fr) * 64 + 32 * ks + 8 * fq); L.wi[ks] = *(const bf16x8*)(gwi + (16 * nb + fr) * 64 + 32 * ks + 8 * fq); }
    }
    if (FINAL && (PART & 2)) {
#pragma unroll
        for (int m = 0; m < 4; ++m) L.gb[m] = *(const v2u*)(Z + (row0 + 16 * m + fr) * INC + GBOFF + ch0);
        L.hin = *(const f32x4*)(HinRow + ch0);
    }
}
template <bool FINAL>
__device__ __forceinline__ void lru_tile(const bf16* Z, int b, int c, int n, int lane, const bf16* gwr, const bf16* gwi, const LAS float* ct,
                                         float* outP, float* outE, const float* Hin, LAS float* yl, bf16* HLg, bf16* PAg) {
    const int fr = lane & 15, fq = lane >> 4;
    const size_t seq0 = (size_t)b * SEQ, row0 = seq0 + (size_t)CHK * c;
    const float* HinRow = Hin + ((size_t)b * NCHUNK + c) * LRUW;
    LruNb cur, nxt;
    lru_load_nb<FINAL, 1>(cur, 0, Z, row0, n, fr, fq, gwr, gwi, HinRow);
    v4u xv[2][4][4];
    bf16x8 xa[4][2];
#define LRU_LOADXV(ks) do { _Pragma("unroll") for (int m = 0; m < 4; ++m) _Pragma("unroll") for (int w = 0; w < 4; ++w) { const int tt = CHK * c + 16 * m + fr + w - 3; \
        xv[ks][m][w] = *(const v4u*)(Z + (seq0 + (tt < 0 ? 0 : tt)) * INC + XBOFF + 64 * n + 32 * (ks) + 8 * fq); } } while (0)
#define LRU_CONV(ks) do { const int ch = 64 * n + 32 * (ks) + 8 * fq; float cw[4][8], cb[8]; \
        _Pragma("unroll") for (int w = 0; w < 4; ++w) { const f32x4 a = *(const LAS f32x4*)(ct + w * 512 + ch), bq = *(const LAS f32x4*)(ct + w * 512 + ch + 4); \
            cw[w][0] = a.x; cw[w][1] = a.y; cw[w][2] = a.z; cw[w][3] = a.w; cw[w][4] = bq.x; cw[w][5] = bq.y; cw[w][6] = bq.z; cw[w][7] = bq.w; } \
        { const f32x4 a = *(const LAS f32x4*)(ct + CT_CB + ch), bq = *(const LAS f32x4*)(ct + CT_CB + ch + 4); cb[0] = a.x; cb[1] = a.y; cb[2] = a.z; cb[3] = a.w; cb[4] = bq.x; cb[5] = bq.y; cb[6] = bq.z; cb[7] = bq.w; } \
        _Pragma("unroll") for (int m = 0; m < 4; ++m) { float a8[8]; \
            _Pragma("unroll") for (int j = 0; j < 8; ++j) a8[j] = cb[j]; \
            _Pragma("unroll") for (int w = 0; w < 4; ++w) { v4u v = xv[ks][m][w]; \
                if (c == 0 && m == 0 && w < 3) { if (fr + w - 3 < 0) v = (v4u){0u, 0u, 0u, 0u}; }     \
                a8[0] += cw[w][0] * bflo(v.x); a8[1] += cw[w][1] * bfhi(v.x); a8[2] += cw[w][2] * bflo(v.y); a8[3] += cw[w][3] * bfhi(v.y); \
                a8[4] += cw[w][4] * bflo(v.z); a8[5] += cw[w][5] * bfhi(v.z); a8[6] += cw[w][6] * bflo(v.w); a8[7] += cw[w][7] * bfhi(v.w); } \
            v4u p; p.x = pk2(a8[0], a8[1]); p.y = pk2(a8[2], a8[3]); p.z = pk2(a8[4], a8[5]); p.w = pk2(a8[6], a8[7]); \
            xa[m][ks] = __builtin_bit_cast(bf16x8, p); } } while (0)
    if (FINAL) {
        LRU_LOADXV(0); asm volatile("" ::: "memory"); LRU_CONV(0); asm volatile("" ::: "memory");
        LRU_LOADXV(1); asm volatile("" ::: "memory"); LRU_CONV(1);
    } else {
        LRU_LOADXV(0); LRU_LOADXV(1); asm volatile("" ::: "memory"); LRU_CONV(0); LRU_CONV(1);
    }
#undef LRU_LOADXV
#undef LRU_CONV
    lru_load_nb<FINAL, 2>(cur, 0, Z, row0, n, fr, fq, gwr, gwi, HinRow);
#pragma unroll 1
    for (int nb = 0; nb < 4; ++nb) {
        const int ch0 = 64 * n + 16 * nb + 4 * fq;
        if (nb < 3) lru_load_nb<FINAL, 1>(nxt, nb + 1, Z, row0, n, fr, fq, gwr, gwi, HinRow);
        if (nb > 0) lru_load_nb<FINAL, 2>(cur, nb, Z, row0, n, fr, fq, gwr, gwi, HinRow);
        asm volatile("" ::: "memory");
        bf16x8 idf[2];
#pragma unroll
        for (int ks = 0; ks < 2; ++ks)
#pragma unroll
            for (int j = 0; j < 8; ++j) idf[ks][j] = (32 * ks + 8 * fq + j == 16 * nb + fr) ? (short)0x3F80 : (short)0;
        const f32x4 brv = *(const LAS f32x4*)(ct + CT_BR + ch0), biv = *(const LAS f32x4*)(ct + CT_BI + ch0), spv = *(const LAS f32x4*)(ct + CT_SP + ch0);
        f32x4 dr[4], di[4], dx[4];
#pragma unroll
        for (int m = 0; m < 4; ++m) { dr[m] = (f32x4){0.f, 0.f, 0.f, 0.f}; di[m] = dr[m]; dx[m] = dr[m];
#pragma unroll
            for (int ks = 0; ks < 2; ++ks) {
                dr[m] = __builtin_amdgcn_mfma_f32_16x16x32_bf16(cur.wr[ks], xa[m][ks], dr[m], 0, 0, 0);
                di[m] = __builtin_amdgcn_mfma_f32_16x16x32_bf16(cur.wi[ks], xa[m][ks], di[m], 0, 0, 0);
                dx[m] = __builtin_amdgcn_mfma_f32_16x16x32_bf16(idf[ks], xa[m][ks], dx[m], 0, 0, 0); } }
        float cP[4], cH[4];
#pragma unroll
        for (int r = 0; r < 4; ++r) { cP[r] = 1.0f; cH[r] = FINAL ? cur.hin[r] : 0.0f; }
#pragma unroll
        for (int m = 0; m < 4; ++m) {
            float P[4], H[4];
#pragma unroll
            for (int r = 0; r < 4; ++r) {
                const float rg = fast_sigmoid(dr[m][r] + brv[r]), ig = fast_sigmoid(di[m][r] + biv[r]);
                const float la = -rg * spv[r];
                const float a = __builtin_amdgcn_exp2f(la * LOG2E);
                const float u = __builtin_amdgcn_sqrtf(fmaxf(1.0f - a * a, 0.f)) * (ig * dx[m][r]);
                P[r] = (fr == 0) ? a * cP[r] : a; H[r] = (fr == 0) ? a * cH[r] + u : u;
            }
#pragma unroll
            for (int r = 0; r < 4; ++r) { scan_step<1>(P[r], H[r]); scan_step<2>(P[r], H[r]); scan_step<4>(P[r], H[r]); scan_step<8>(P[r], H[r]); }
            if (!FINAL) {
                const size_t o = (row0 + 16 * m + fr) * LRUW + ch0;
                v2u wh, wp; wh.x = pk2(H[0], H[1]); wh.y = pk2(H[2], H[3]); wp.x = pk2(P[0], P[1]); wp.y = pk2(P[2], P[3]);
                *(v2u*)(HLg + o) = wh; *(v2u*)(PAg + o) = wp;
            }
            if (FINAL) {
                const v2u g = cur.gb[m];
                f32x4 y; y[0] = gelu_tanh(bflo(g.x)) * H[0]; y[1] = gelu_tanh(bfhi(g.x)) * H[1]; y[2] = gelu_tanh(bflo(g.y)) * H[2]; y[3] = gelu_tanh(bfhi(g.y)) * H[3];
                *(LAS f32x4*)(yl + (16 * m + fr) * LRUW + ch0) = y;
            }
#pragma unroll
            for (int r = 0; r < 4; ++r) { cP[r] = dpp_ror1(P[r]); cH[r] = dpp_ror1(H[r]); }
        }
        if (!FINAL) { if (fr == 0) { const size_t o = ((size_t)b * NCHUNK + c) * LRUW + ch0;
            *(f32x4*)(outP + o) = (f32x4){cP[0], cP[1], cP[2], cP[3]}; *(f32x4*)(outE + o) = (f32x4){cH[0], cH[1], cH[2], cH[3]}; } }
        cur.wr[0] = nxt.wr[0]; cur.wr[1] = nxt.wr[1]; cur.wi[0] = nxt.wi[0]; cur.wi[1] = nxt.wi[1];
    }
}

__device__ __forceinline__ void p_lru_summary(const Frame& F, const Args& A, int l, int nrep) {
    unsigned char* ws = A.ws;
    const bf16* Z = (const bf16*)(ws + WS_ZH);
    const bf16* GW = (const bf16*)(ws + WS_GATEW) + (size_t)l * 2 * 8 * 4096;
    lru_tables(F, A, l); __syncthreads();
    for (int it = F.blk; it < BATCH * NCHUNK * nrep; it += F.G) {
        const int b = (it >> 8) & 1, c = it & 255, n = F.wave;
        lru_tile<false>(Z, b, c, n, F.lane, GW + n * 4096, GW + 8 * 4096 + n * 4096, (const LAS float*)(F.lds + LDS_CTAB), (float*)(ws + WS_LRUP), (float*)(ws + WS_LRUE), (const float*)(ws + WS_HIN), nullptr, (bf16*)(ws + WS_HL), (bf16*)(ws + WS_PA));
    }
}
__device__ __forceinline__ void p_lru_carry(const Frame& F, const Args& A) {
    unsigned char* ws = A.ws;
    const float* Pg = (const float*)(ws + WS_LRUP); const float* Eg = (const float*)(ws + WS_LRUE); float* Hg = (float*)(ws + WS_HIN);
    const int gw = F.blk * NWAVES + F.wave, NGW = F.G * NWAVES;
    for (int p = gw; p < BATCH * LRUW; p += NGW) {
        const int b = p >> 9, ch = p & 511;
        float pk[4], ek[4];
#pragma unroll
        for (int k = 0; k < 4; ++k) { const size_t o = ((size_t)b * NCHUNK + 4 * F.lane + k) * LRUW + ch; pk[k] = Pg[o]; ek[k] = Eg[o]; }
        float P = pk[0], H = ek[0];
#pragma unroll
        for (int k = 1; k < 4; ++k) { H = pk[k] * H + ek[k]; P = pk[k] * P; }
#pragma unroll
        for (int d = 1; d < 64; d <<= 1) { const float P1 = __shfl_up(P, d), H1 = __shfl_up(H, d); if (F.lane >= d) { H = P * H1 + H; P = P * P1; } }
        float h = __shfl_up(H, 1); if (F.lane == 0) h = 0.f;
#pragma unroll
        for (int k = 0; k < 4; ++k) { Hg[((size_t)b * NCHUNK + 4 * F.lane + k) * LRUW + ch] = h; h = pk[k] * h + ek[k]; }
    }
}

__device__ __forceinline__ int crow(int r, int hi) { return (r & 3) + 8 * (r >> 2) + 4 * hi; }
__device__ __forceinline__ s16x4 vtr(const LAS unsigned char* p) { return __builtin_bit_cast(s16x4, __builtin_amdgcn_ds_read_tr16_b64_v4i16((LAS s16x4*)p)); }
__device__ __forceinline__ void p_mixer(const Frame& F, const Args& A, int l, int nrep) {
    unsigned char* ws = A.ws;
    const bf16* Z = (const bf16*)(ws + WS_ZH);
    unsigned char* Y8 = ws + WS_A;
    const bf16* GW = (const bf16*)(ws + WS_GATEW) + (size_t)l * 2 * 8 * 4096;
    LAS unsigned char* Kl = F.lds;
    LAS unsigned char* Vl = F.lds + 49152;
    LAS bf16* ya = (LAS bf16*)F.lds;
    LAS float* lut = (LAS float*)(F.lds + LDS_LUT);
    const int lane = F.lane, wave = F.wave, r32 = lane & 31, hi = lane >> 5;
    { const float* LUTg = (const float*)(ws + WS_LUT); for (int i = F.tid; i < 2048; i += NTHREADS) lut[i] = LUTg[i]; }
    const float sinkv = A.in[3][l * 8 + wave] * LOG2E;
    const int kvh = wave >> 2;
    for (int it = F.blk; it < BATCH * NCHUNK * nrep; it += F.G) {
        const int b = (it >> 8) & 1, c = it & 255;
        const size_t row0 = (size_t)b * SEQ + (size_t)CHK * c;
        const int T0 = (c >= 2) ? 0 : 2 - c;
        __syncthreads();
        v4u kq[2][3], vq[2][3];
#pragma unroll
        for (int h2 = 0; h2 < 2; ++h2)
#pragma unroll
            for (int T = 0; T < 3; ++T) {
                kq[h2][T] = (v4u){0u, 0u, 0u, 0u}; vq[h2][T] = kq[h2][T];
                if (T >= T0) { const size_t cr = row0 + (size_t)CHK * T - 2 * CHK;
                    kq[h2][T] = *(const v4u*)(Z + (cr + lane) * INC + KOFF + 64 * h2 + 8 * wave);
                    vq[h2][T] = *(const v4u*)(Z + (cr + 16 * (wave & 3) + (lane >> 2)) * INC + VOFF + 64 * h2 + 32 * (wave >> 2) + 8 * (lane & 3)); }
            }
        {   const float* hinr = (const float*)(ws + WS_HIN) + ((size_t)b * NCHUNK + c) * LRUW + 8 * lane;
            const f32x4 hi0 = *(const f32x4*)hinr, hi1 = *(const f32x4*)(hinr + 4);
            const bf16* HLg = (const bf16*)(ws + WS_HL); const bf16* PAg = (const bf16*)(ws + WS_PA);
            v4u vh[8], vp[8], vg[8];
#pragma unroll
            for (int i = 0; i < 8; ++i) { const size_t r = row0 + 8 * wave + i;
                vh[i] = *(const v4u*)(HLg + r * LRUW + 8 * lane); vp[i] = *(const v4u*)(PAg + r * LRUW + 8 * lane); vg[i] = *(const v4u*)(Z + r * INC + GBOFF + 8 * lane); }
            asm volatile("" ::: "memory");
#pragma unroll
            for (int i = 0; i < 8; ++i) { const size_t r = row0 + 8 * wave + i;
                float y[8];
                y[0] = gelu_tanh(bflo(vg[i].x)) * (bflo(vh[i].x) + bflo(vp[i].x) * hi0.x); y[1] = gelu_tanh(bfhi(vg[i].x)) * (bfhi(vh[i].x) + bfhi(vp[i].x) * hi0.y);
                y[2] = gelu_tanh(bflo(vg[i].y)) * (bflo(vh[i].y) + bflo(vp[i].y) * hi0.z); y[3] = gelu_tanh(bfhi(vg[i].y)) * (bfhi(vh[i].y) + bfhi(vp[i].y) * hi0.w);
                y[4] = gelu_tanh(bflo(vg[i].z)) * (bflo(vh[i].z) + bflo(vp[i].z) * hi1.x); y[5] = gelu_tanh(bfhi(vg[i].z)) * (bfhi(vh[i].z) + bfhi(vp[i].z) * hi1.y);
                y[6] = gelu_tanh(bflo(vg[i].w)) * (bflo(vh[i].w) + bflo(vp[i].w) * hi1.z); y[7] = gelu_tanh(bfhi(vg[i].w)) * (bfhi(vh[i].w) + bfhi(vp[i].w) * hi1.w);
                const float ss = wave_sum((y[0] * y[0] + y[1] * y[1]) + (y[2] * y[2] + y[3] * y[3]) + (y[4] * y[4] + y[5] * y[5]) + (y[6] * y[6] + y[7] * y[7]));
                const float rstd = 1.0f / sqrtf(ss * (1.0f / 512.0f) + RMS_EPS);
                v2u w; w.x = pg8::pk4_fp8(y[0] * rstd, y[1] * rstd, y[2] * rstd, y[3] * rstd); w.y = pg8::pk4_fp8(y[4] * rstd, y[5] * rstd, y[6] * rstd, y[7] * rstd);
                *(v2u*)(Y8 + r * DM + 512 + 8 * lane) = w; }
        }
#pragma unroll
        for (int h2 = 0; h2 < 2; ++h2)
#pragma unroll
            for (int T = 0; T < 3; ++T) {
                *(LAS v4u*)(Kl + (h2 * 3 + T) * 8192 + wave * 1024 + lane * 16) = kq[h2][T];
                *(LAS v4u*)(Vl + (h2 * 3 + T) * 8192 + wave * 1024 + lane * 16) = vq[h2][T];
            }
        __syncthreads();
        unsigned opk[2][2][8];
#pragma unroll
        for (int qb = 0; qb < 2; ++qb) {
            const int qi = 32 * qb + r32;
            bf16x8 qr[4];
#pragma unroll
            for (int d0 = 0; d0 < 4; ++d0) qr[d0] = *(const bf16x8*)(Z + (row0 + qi) * INC + 64 * wave + 16 * d0 + 8 * hi);
            f32x16 s[3][2];
            const LAS float* lutq = lut + wave * 256 + 63 - qi;
#pragma unroll
            for (int T = 0; T < 3; ++T) {
#pragma unroll
                for (int hf = 0; hf < 2; ++hf)
#pragma unroll
                    for (int r = 0; r < 16; ++r) s[T][hf][r] = lutq[64 * T + 32 * hf + crow(r, hi)];
                const LAS unsigned char* kb = Kl + (kvh * 3 + T) * 8192 + hi * 1024 + r32 * 16;
#pragma unroll
                for (int d0 = 0; d0 < 4; ++d0) {
                    const bf16x8 b0 = *(const LAS bf16x8*)(kb + d0 * 2048), b1 = *(const LAS bf16x8*)(kb + d0 * 2048 + 512);
                    s[T][0] = __builtin_amdgcn_mfma_f32_32x32x16_bf16(b0, qr[d0], s[T][0], 0, 0, 0);
                    s[T][1] = __builtin_amdgcn_mfma_f32_32x32x16_bf16(b1, qr[d0], s[T][1], 0, 0, 0);
                }
                if (T < T0) {
#pragma unroll
                    for (int hf = 0; hf < 2; ++hf)
#pragma unroll
                        for (int r = 0; r < 16; ++r) s[T][hf][r] = -1e30f;
                }
            }
            float mx = sinkv;
#pragma unroll
            for (int T = 0; T < 3; ++T)
#pragma unroll
                for (int hf = 0; hf < 2; ++hf)
#pragma unroll
                    for (int r = 0; r < 16; ++r) mx = fmaxf(mx, s[T][hf][r]);
            mx = fmaxf(mx, __shfl_xor(mx, 32));
            float lsum = 0.f;
#pragma unroll
            for (int T = 0; T < 3; ++T)
#pragma unroll
                for (int hf = 0; hf < 2; ++hf)
#pragma unroll
                    for (int r = 0; r < 16; ++r) { const float p = __builtin_amdgcn_exp2f(s[T][hf][r] - mx); s[T][hf][r] = p; lsum += p; }
            lsum += __shfl_xor(lsum, 32);
            lsum += __builtin_amdgcn_exp2f(sinkv - mx);
            const float inv = 1.0f / lsum;
            f32x16 o[2]; o[0] = (f32x16){0.f, 0.f, 0.f, 0.f, 0.f, 0.f, 0.f, 0.f, 0.f, 0.f, 0.f, 0.f, 0.f, 0.f, 0.f, 0.f}; o[1] = o[0];
#pragma unroll
            for (int T = 0; T < 3; ++T) {
                v4u pw[4];
#pragma unroll
                for (int k = 0; k < 4; ++k) { const int hf = k >> 1, r0 = (k & 1) * 8;
                    pw[k].x = pk2(s[T][hf][r0 + 0], s[T][hf][r0 + 1]); pw[k].y = pk2(s[T][hf][r0 + 2], s[T][hf][r0 + 3]);
                    pw[k].z = pk2(s[T][hf][r0 + 4], s[T][hf][r0 + 5]); pw[k].w = pk2(s[T][hf][r0 + 6], s[T][hf][r0 + 7]); }
                const LAS unsigned char* vb = Vl + (kvh * 3 + T) * 8192 + ((lane >> 4) & 1) * 32 + (lane & 3) * 8 + (4 * hi + ((lane & 15) >> 2)) * 64;
#pragma unroll
                for (int d0 = 0; d0 < 2; ++d0)
#pragma unroll
                    for (int ks = 0; ks < 4; ++ks) {
                        const s16x4 lo = vtr(vb + d0 * 4096 + ks * 1024), hv = vtr(vb + d0 * 4096 + ks * 1024 + 512);
                        const bf16x8 vf = (bf16x8){lo[0], lo[1], lo[2], lo[3], hv[0], hv[1], hv[2], hv[3]};
                        o[d0] = __builtin_amdgcn_mfma_f32_32x32x16_bf16(vf, __builtin_bit_cast(bf16x8, pw[ks]), o[d0], 0, 0, 0);
                    }
            }
#pragma unroll
            for (int d0 = 0; d0 < 2; ++d0)
#pragma unroll
                for (int r = 0; r < 16; r += 2) opk[qb][d0][r >> 1] = pk2(o[d0][r] * inv, o[d0][r + 1] * inv);
        }
        __syncthreads();
#pragma unroll
        for (int qb = 0; qb < 2; ++qb)
#pragma unroll
            for (int d0 = 0; d0 < 2; ++d0)
#pragma unroll
                for (int g = 0; g < 4; ++g) { v2u w; w.x = opk[qb][d0][2 * g]; w.y = opk[qb][d0][2 * g + 1];
                    *(LAS v2u*)(ya + (32 * qb + r32) * 512 + 64 * wave + 32 * d0 + 8 * g + 4 * hi) = w; }
        __syncthreads();
#pragma unroll
        for (int i = 0; i < 8; ++i) { const int tok = 8 * wave + i;
            const v4u w0 = *(const LAS v4u*)(ya + tok * 512 + 8 * lane);
            const float x0 = bflo(w0.x), x1 = bfhi(w0.x), x2 = bflo(w0.y), x3 = bfhi(w0.y), x4 = bflo(w0.z), x5 = bfhi(w0.z), x6 = bflo(w0.w), x7 = bfhi(w0.w);
            const float ss = wave_sum((x0 * x0 + x1 * x1) + (x2 * x2 + x3 * x3) + (x4 * x4 + x5 * x5) + (x6 * x6 + x7 * x7));
            const float rstd = 1.0f / sqrtf(ss * (1.0f / 512.0f) + RMS_EPS);
            v2u w; w.x = pg8::pk4_fp8(x0 * rstd, x1 * rstd, x2 * rstd, x3 * rstd); w.y = pg8::pk4_fp8(x4 * rstd, x5 * rstd, x6 * rstd, x7 * rstd);
            *(v2u*)(Y8 + (row0 + tok) * DM + 8 * lane) = w; }
    }
}

struct LnRow { f32x4 x[2][2]; v4u a[2], b[2]; };
template <int MODE>
__device__ __forceinline__ void ln_load_row(LnRow& L, const float* xres, const bf16* TB, const bf16* Y2, int m, int p0, int p1, int lane) {
#pragma unroll
    for (int j = 0; j < 2; ++j) {
#pragma unroll
        for (int h = 0; h < 2; ++h) L.x[j][h] = *(const f32x4*)(xres + (size_t)m * DM + 8 * lane + 512 * j + 4 * h);
        if (MODE != 2) L.a[j] = *(const v4u*)(TB + (size_t)m * DM + 8 * lane + 512 * j);
        else { L.a[j] = *(const v4u*)(Y2 + (size_t)p0 * DM + 8 * lane + 512 * j); L.b[j] = *(const v4u*)(Y2 + (size_t)p1 * DM + 8 * lane + 512 * j); }
    }
}
template <int MODE>
__device__ __forceinline__ void p_layernorm(const Frame& F, const Args& A, const float* gam, const float* bet, const float* xres) {
    unsigned char* ws = A.ws;
    float* X = A.out;
    unsigned char* XB = ws + WS_A;
    const bf16* TB = (const bf16*)(ws + WS_TB);
    const bf16* Y2 = (const bf16*)(ws + WS_Y2);
    LAS unsigned* misc = (LAS unsigned*)(F.lds + LDS_MISC);
    const int lane = F.lane;
    LAS float* rwl = (LAS float*)F.lds;
    if (MODE == 1) { if (F.tid < 8) misc[F.tid] = 0u;
        for (int k = F.tid; k < DM; k += NTHREADS) { const f32x4 a = *(const f32x4*)(A.in[19] + k * 8), c = *(const f32x4*)(A.in[19] + k * 8 + 4);
            const int q = 8 * (k >> 9) + (k & 7), lk = (k & 511) >> 3; *(LAS f32x4*)(rwl + (q * 64 + lk) * 8) = a; *(LAS f32x4*)(rwl + (q * 64 + lk) * 8 + 4) = c; }
        __syncthreads(); }
    f32x4 gv[2][2], bv[2][2];
#pragma unroll
    for (int j = 0; j < 2; ++j)
#pragma unroll
        for (int h = 0; h < 2; ++h) { gv[j][h] = *(const f32x4*)(gam + 8 * lane + 512 * j + 4 * h); bv[j][h] = *(const f32x4*)(bet + 8 * lane + 512 * j + 4 * h); }
    const int rpw = NTOK / F.G, nt = rpw / NWAVES;
    const int m0 = F.blk * rpw + F.wave;
    int P0 = 0, P1 = 0; float W0 = 0.f, W1 = 0.f;
    if (MODE == 2) { if (lane < nt) { const int m = m0 + NWAVES * lane; P0 = ((const int*)(ws + WS_TOKPOS))[2 * m]; P1 = ((const int*)(ws + WS_TOKPOS))[2 * m + 1];
        W0 = ((const float*)(ws + WS_TOKW))[2 * m]; W1 = ((const float*)(ws + WS_TOKW))[2 * m + 1]; } }
    LnRow cur[2], nxt[2];
#pragma unroll
    for (int r = 0; r < 2; ++r) ln_load_row<MODE>(cur[r], xres, TB, Y2, m0 + NWAVES * r, __shfl(P0, r), __shfl(P1, r), lane);
    for (int t = 0; t < nt; t += 2) {
        if (t + 2 < nt) {
#pragma unroll
            for (int r = 0; r < 2; ++r) ln_load_row<MODE>(nxt[r], xres, TB, Y2, m0 + NWAVES * (t + 2 + r), __shfl(P0, t + 2 + r), __shfl(P1, t + 2 + r), lane);
        }
        asm volatile("" ::: "memory");
#pragma unroll
        for (int r = 0; r < 2; ++r) {
            const int m = m0 + NWAVES * (t + r);
            const LnRow& L = cur[r];
            float v[16];
            if (MODE != 2) {
#pragma unroll
                for (int j = 0; j < 2; ++j) { const v4u a = L.a[j]; const f32x4 x0 = L.x[j][0], x1 = L.x[j][1];
                    v[8 * j + 0] = ALPHA * x0.x + bflo(a.x); v[8 * j + 1] = ALPHA * x0.y + bfhi(a.x); v[8 * j + 2] = ALPHA * x0.z + bflo(a.y); v[8 * j + 3] = ALPHA * x0.w + bfhi(a.y);
                    v[8 * j + 4] = ALPHA * x1.x + bflo(a.z); v[8 * j + 5] = ALPHA * x1.y + bfhi(a.z); v[8 * j + 6] = ALPHA * x1.z + bflo(a.w); v[8 * j + 7] = ALPHA * x1.w + bfhi(a.w); }
            } else {
                const float w0 = __shfl(W0, t + r), w1 = __shfl(W1, t + r);
#pragma unroll
                for (int j = 0; j < 2; ++j) { const v4u a = L.a[j], c = L.b[j]; const f32x4 x0 = L.x[j][0], x1 = L.x[j][1];
                    v[8 * j + 0] = ALPHA * x0.x + w0 * bflo(a.x) + w1 * bflo(c.x); v[8 * j + 1] = ALPHA * x0.y + w0 * bfhi(a.x) + w1 * bfhi(c.x);
                    v[8 * j + 2] = ALPHA * x0.z + w0 * bflo(a.y) + w1 * bflo(c.y); v[8 * j + 3] = ALPHA * x0.w + w0 * bfhi(a.y) + w1 * bfhi(c.y);
                    v[8 * j + 4] = ALPHA * x1.x + w0 * bflo(a.z) + w1 * bflo(c.z); v[8 * j + 5] = ALPHA * x1.y + w0 * bfhi(a.z) + w1 * bfhi(c.z);
                    v[8 * j + 6] = ALPHA * x1.z + w0 * bflo(a.w) + w1 * bflo(c.w); v[8 * j + 7] = ALPHA * x1.w + w0 * bfhi(a.w) + w1 * bfhi(c.w); }
            }
            float s = 0.f;
#pragma unroll
            for (int q = 0; q < 16; ++q) s += v[q];
            const float mean = wave_sum(s) * (1.f / DM); float s2 = 0.f;
#pragma unroll
            for (int q = 0; q < 16; ++q) { v[q] -= mean; s2 += v[q] * v[q]; }
            const float rstd = __builtin_amdgcn_rsqf(wave_sum(s2) * (1.f / DM) + LN_EPS);
#pragma unroll
            for (int j = 0; j < 2; ++j)
#pragma unroll
                for (int h = 0; h < 2; ++h) { f32x4 o;
#pragma unroll
                    for (int e = 0; e < 4; ++e) { o[e] = v[8 * j + 4 * h + e] * rstd * gv[j][h][e] + bv[j][h][e]; v[8 * j + 4 * h + e] = o[e]; }
                    *(f32x4*)(X + (size_t)m * DM + 8 * lane + 512 * j + 4 * h) = o; }
            if (MODE == 3) {
#pragma unroll
                for (int j = 0; j < 2; ++j) { v2u w;
                    w.x = pg8::pk4_i8(v[8 * j], v[8 * j + 1], v[8 * j + 2], v[8 * j + 3], SA_X); w.y = pg8::pk4_i8(v[8 * j + 4], v[8 * j + 5], v[8 * j + 6], v[8 * j + 7], SA_X);
                    *(v2u*)(XB + (size_t)m * DM + 8 * lane + 512 * j) = w; }
            }
            if (MODE == 1) {
                float lg[8];
#pragma unroll
                for (int e = 0; e < 8; ++e) lg[e] = 0.f;
#pragma unroll
                for (int q = 0; q < 16; ++q) { const f32x4 a = *(const LAS f32x4*)(rwl + (q * 64 + lane) * 8), c = *(const LAS f32x4*)(rwl + (q * 64 + lane) * 8 + 4); const float xq = v[q];
                    lg[0] += xq * a.x; lg[1] += xq * a.y; lg[2] += xq * a.z; lg[3] += xq * a.w; lg[4] += xq * c.x; lg[5] += xq * c.y; lg[6] += xq * c.z; lg[7] += xq * c.w; }
#pragma unroll
                for (int e = 0; e < 8; ++e) lg[e] = wave_sum(lg[e]);
                int e0 = 0; float v0 = lg[0];
#pragma unroll
                for (int e = 1; e < 8; ++e) if (lg[e] > v0) { v0 = lg[e]; e0 = e; }
                int e1 = -1; float v1 = -3.0e38f;
#pragma unroll
                for (int e = 0; e < 8; ++e) if (e != e0 && lg[e] > v1) { v1 = lg[e]; e1 = e; }
                const float g0 = 1.0f / (1.0f + __expf(v1 - v0)), g1 = 1.0f - g0;
                if (lane == 0) { int* te = (int*)(ws + WS_TOKE) + 2 * m; float* tw = (float*)(ws + WS_TOKW) + 2 * m; te[0] = e0; te[1] = e1; tw[0] = g0; tw[1] = g1;
                    atomicAdd((unsigned*)(misc + e0), 1u); atomicAdd((unsigned*)(misc + e1), 1u); }
            }
        }
        if (t + 2 < nt) { cur[0] = nxt[0]; cur[1] = nxt[1]; }
    }
    if (MODE == 1) { __syncthreads(); if (F.tid < 8) ((unsigned*)(ws + WS_HIST))[F.blk * 8 + F.tid] = misc[F.tid]; }
}

__device__ __forceinline__ void p_route(const Frame& F, const Args& A) {
    unsigned char* ws = A.ws;
    LAS unsigned* misc = (LAS unsigned*)(F.lds + LDS_MISC);
    LAS int* posl = (LAS int*)(F.lds + LDS_POS);
    const unsigned* hist = (const unsigned*)(ws + WS_HIST);
    const int lane = F.lane, rpw = NTOK / F.G;
    {
        const int e = F.wave; unsigned tot = 0u, bef = 0u;
        for (int v = lane; v < F.G; v += 64) { const unsigned h = hist[v * 8 + e]; tot += h; if (v < F.blk) bef += h; }
#pragma unroll
        for (int o = 1; o < 64; o <<= 1) { tot += __shfl_xor(tot, o); bef += __shfl_xor(bef, o); }
        if (lane == 0) { misc[16 + e] = tot; misc[24 + e] = bef; }
    }
    __syncthreads();
    int seg[9]; seg[0] = 0;
#pragma unroll
    for (int e = 0; e < 8; ++e) seg[e + 1] = seg[e] + (int)((misc[16 + e] + 255u) >> 8);
    if (F.blk == 0 && F.tid == 0) { int* meta = (int*)(ws + WS_META);
#pragma unroll
        for (int e = 0; e < 9; ++e) meta[e] = seg[e];
        meta[9] = seg[8]; }
    if (F.wave == 0) {
        const int* te = (const int*)(ws + WS_TOKE); int* tp = (int*)(ws + WS_TOKPOS); int* rt = nullptr; (void)rt;
        unsigned run[8];
#pragma unroll
        for (int e = 0; e < 8; ++e) run[e] = (unsigned)seg[e] * 256u + misc[24 + e];
        for (int h = 0; h < rpw; h += 64) {
            const int m = F.blk * rpw + h + lane;
#pragma unroll
            for (int k = 0; k < 2; ++k) {
                const int ek = te[2 * m + k]; int pos = 0;
#pragma unroll
                for (int e = 0; e < 8; ++e) { const unsigned long long mask = __ballot(ek == e);
                    if (ek == e) pos = (int)(run[e] + (unsigned)__popcll(mask & ((1ull << lane) - 1ull)));
                    run[e] += (unsigned)__popcll(mask); }
                tp[2 * m + k] = pos; posl[2 * (h + lane) + k] = pos;
            }
        }
    }
    __syncthreads();
    {
        const float* X = A.out; unsigned char* XS = ws + WS_XS;
        f32x4 a, b, c, d, na, nb, nc, nd;
        { const f32x4* xr = (const f32x4*)(X + (size_t)(F.blk * rpw + F.wave) * DM) + 4 * lane; a = xr[0]; b = xr[1]; c = xr[2]; d = xr[3]; }
        for (int i = F.wave; i < rpw; i += NWAVES) {
            const int m = F.blk * rpw + i; const int p0 = posl[2 * i], p1 = posl[2 * i + 1];
            const bool more = (i + NWAVES < rpw);
            if (more) { const f32x4* xr = (const f32x4*)(X + (size_t)(m + NWAVES) * DM) + 4 * lane; na = xr[0]; nb = xr[1]; nc = xr[2]; nd = xr[3]; }
            asm volatile("" ::: "memory");
            v4u w; w.x = pg8::pk4_i8(a.x, a.y, a.z, a.w, SA_X); w.y = pg8::pk4_i8(b.x, b.y, b.z, b.w, SA_X); w.z = pg8::pk4_i8(c.x, c.y, c.z, c.w, SA_X); w.w = pg8::pk4_i8(d.x, d.y, d.z, d.w, SA_X);
            *((v4u*)(XS + (size_t)p0 * DM) + lane) = w; *((v4u*)(XS + (size_t)p1 * DM) + lane) = w;
            if (more) { a = na; b = nb; c = nc; d = nd; }
        }
    }
    if (F.blk < 8) {
        int r0 = 0, r1 = 0;
#pragma unroll
        for (int e = 0; e < 8; ++e) if (e == F.blk) { r0 = seg[e] * 256 + (int)misc[16 + e]; r1 = seg[e + 1] * 256; }
        v4u* XS4 = (v4u*)(ws + WS_XS);
        for (size_t i = (size_t)r0 * 64 + F.tid; i < (size_t)r1 * 64; i += NTHREADS) XS4[i] = (v4u){0u, 0u, 0u, 0u};
    }
}

#ifndef MK_ONE_LAUNCH
#define MK_ONE_LAUNCH 1
#endif
constexpr int PH_MOE = 17, PH_FINAL = PH_MOE + 2 * NPASS, NPHASES = PH_FINAL + 1;

#ifndef PH_MASK
#define PH_MASK 0xFFFFFFFFu
#endif
#ifndef DUP_MASK
#define DUP_MASK 0u
#endif
#define NREP(k) ((((unsigned)DUP_MASK >> (k)) & 1u) ? 2 : 1)
#define IN(k) (((PH_MASK >> (k)) & 1u) && lo <= (k) && (k) < hi)
#define SEAM(k) do { if (MK_ONE_LAUNCH && lo <= (k) && (k) + 1 < hi) xcd_barrier(bar); } while (0)
template <int l>
__device__ __forceinline__ void layer_phases(const Frame& F, const Args& args, const XcdBarrier& bar, const int lo, const int hi) {
    unsigned char* ws = args.ws;
        const int pb = 1 + 9 * l;
        const float* xres = (l == 0) ? args.in[0] : args.out;
        if (IN(pb + 0)) {
            pg8::Gemm g{(const bf16*)(ws + WS_A), (const bf16*)(ws + WS_WIN + (size_t)l * INC * DM), NTOK, INC, DM / 2, 0};
            pg8::StaticOrder S; S.init(NTOK, INC, F.G, F.blk, NREP(pb + 0));
            pg8::EpiBf16 E{(bf16*)(ws + WS_ZH), INC, 1.0f / (SA_X * SW_IN), QSCALE / (SA_X * SW_IN), 2};
            pg8::gemm_phase<pg8::EpiBf16, pg8::StaticOrder, true, true, 2>(F.lds, g, S, E);
            SEAM(pb + 0);
        }
        if (IN(pb + 1)) { p_lru_summary(F, args, l, NREP(pb + 1)); SEAM(pb + 1); }
        if (IN(pb + 2)) for (int rep_ = 0; rep_ < NREP(pb + 2); ++rep_) { p_lru_carry(F, args); SEAM(pb + 2); }
        if (IN(pb + 3)) { p_mixer(F, args, l, NREP(pb + 3)); SEAM(pb + 3); }
        if (IN(pb + 4)) {
            pg8::Gemm g{(const bf16*)(ws + WS_A), (const bf16*)(ws + WS_WOUT + (size_t)l * DM * DM), NTOK, DM, DM / 2, 0};
            pg8::StaticOrder S; S.init(NTOK, DM, F.G, F.blk, NREP(pb + 4));
            pg8::EpiBf16 E{(bf16*)(ws + WS_TB), DM, 1.0f / WSC_OUT, 1.0f / WSC_OUT, 0};
            pg8::gemm_phase<pg8::EpiBf16, pg8::StaticOrder, true, true, 1>(F.lds, g, S, E);
            SEAM(pb + 4);
        }
        if (l == 0) {
            if (IN(6)) for (int rep_ = 0; rep_ < NREP(6); ++rep_) { p_layernorm<3>(F, args, args.in[14], args.in[15], args.in[0]); SEAM(6); }
            if (IN(7)) {
                pg8::Gemm g{(const bf16*)(ws + WS_A), (const bf16*)(ws + WS_WGU), NTOK, 2 * DFF, DM / 2, 0};
                pg8::StaticOrder S; S.init(NTOK, 2 * DFF, F.G, F.blk, NREP(7));
                pg8::EpiSwiGLU8 E{ws + WS_ZH, DFF, 1.0f / (SA_X * SW_GU)};
                pg8::gemm_phase<pg8::EpiSwiGLU8, pg8::StaticOrder, true, true, 2>(F.lds, g, S, E);
                SEAM(7);
            }
            if (IN(8)) {
                pg8::Gemm g{(const bf16*)(ws + WS_ZH), (const bf16*)(ws + WS_WD), NTOK, DM, DFF / 2, 0};
                pg8::StaticOrder S; S.init(NTOK, DM, F.G, F.blk, NREP(8));
                pg8::EpiBf16 E{(bf16*)(ws + WS_TB), DM, 1.0f / WSC_D, 1.0f / WSC_D, 0};
                pg8::gemm_phase<pg8::EpiBf16, pg8::StaticOrder, true, true, 1>(F.lds, g, S, E);
                SEAM(8);
            }
            if (IN(9)) for (int rep_ = 0; rep_ < NREP(9); ++rep_) { p_layernorm<3>(F, args, args.in[23], args.in[24], args.out); SEAM(9); }
        } else {
            if (IN(15)) for (int rep_ = 0; rep_ < NREP(15); ++rep_) { p_layernorm<1>(F, args, args.in[14] + DM, args.in[15] + DM, args.out); SEAM(15); }
            if (IN(16)) for (int rep_ = 0; rep_ < NREP(16); ++rep_) { p_route(F, args); SEAM(16); }
            for (int p = 0; p < NPASS; ++p) {
                int s1 = 0, s2 = 0, s3 = 0, s4 = 0, s5 = 0, s6 = 0, s7 = 0, nt = 0;
                if (IN(PH_MOE + 2 * p) || IN(PH_MOE + 1 + 2 * p)) { const int* meta = (const int*)(ws + WS_META);
                    s1 = __builtin_amdgcn_readfirstlane(meta[1]); s2 = __builtin_amdgcn_readfirstlane(meta[2]); s3 = __builtin_amdgcn_readfirstlane(meta[3]); s4 = __builtin_amdgcn_readfirstlane(meta[4]);
                    s5 = __builtin_amdgcn_readfirstlane(meta[5]); s6 = __builtin_amdgcn_readfirstlane(meta[6]); s7 = __builtin_amdgcn_readfirstlane(meta[7]); nt = __builtin_amdgcn_readfirstlane(meta[9]); }
                int nm = nt - PASS_TILES * p; nm = nm > PASS_TILES ? PASS_TILES : nm;
                if (IN(PH_MOE + 2 * p)) {
                    if (nm > 0) {
                        pg8::Gemm g{(const bf16*)(ws + WS_XS + (size_t)p * PASS_TILES * 256 * DM), (const bf16*)(ws + WS_WEGU), nm * 256, 2 * DFE, DM / 2, (size_t)2 * DFE * DM};
                        pg8::MoeOrder S; S.so.init(nm * 256, 2 * DFE, F.G, F.blk, NREP(PH_MOE + 2 * p)); S.tile0 = p * PASS_TILES; S.s1 = s1; S.s2 = s2; S.s3 = s3; S.s4 = s4; S.s5 = s5; S.s6 = s6; S.s7 = s7;
                        pg8::EpiSwiGLU8 E{ws + WS_HM, DFE, 1.0f / (SA_X * SW_GU)};
                        pg8::gemm_phase<pg8::EpiSwiGLU8, pg8::MoeOrder, true, true, 2>(F.lds, g, S, E);
                    }
                    SEAM(PH_MOE + 2 * p);
                }
                if (IN(PH_MOE + 1 + 2 * p)) {
                    if (nm > 0) {
                        pg8::Gemm g{(const bf16*)(ws + WS_HM), (const bf16*)(ws + WS_WED), nm * 256, DM, DFE / 2, (size_t)DM * DFE};
                        pg8::MoeOrder S; S.so.init(nm * 256, DM, F.G, F.blk, NREP(PH_MOE + 1 + 2 * p)); S.tile0 = p * PASS_TILES; S.s1 = s1; S.s2 = s2; S.s3 = s3; S.s4 = s4; S.s5 = s5; S.s6 = s6; S.s7 = s7;
                        pg8::EpiBf16 E{(bf16*)(ws + WS_Y2) + (size_t)p * PASS_TILES * 256 * DM, DM, 1.0f / WSC_D, 1.0f / WSC_D, 0};
                        pg8::gemm_phase<pg8::EpiBf16, pg8::MoeOrder, true, true, 1>(F.lds, g, S, E);
                    }
                    SEAM(PH_MOE + 1 + 2 * p);
                }
            }
            if (IN(PH_FINAL)) for (int rep_ = 0; rep_ < NREP(PH_FINAL); ++rep_) { p_layernorm<2>(F, args, args.in[23] + DM, args.in[24] + DM, args.out); }
        }
}
__global__ void __launch_bounds__(NTHREADS, 2) fwd_kernel(Args args) {
    extern __shared__ __attribute__((aligned(16))) unsigned char lds_raw[];
    Frame F;
    F.lds = (LAS unsigned char*)lds_raw;
    F.tid = threadIdx.x; F.lane = F.tid & 63; F.wave = __builtin_amdgcn_readfirstlane(F.tid >> 6);
    F.G = gridDim.x; F.blk = blockIdx.x;
    unsigned char* ws = args.ws;
    volatile LAS unsigned* MISC = (volatile LAS unsigned*)(F.lds + LDS_MISC);
    if (F.tid < 64) MISC[F.tid] = 0u;
    __syncthreads();
    XcdBarrier bar; bar.bar = (unsigned*)(ws + WS_CTL) + CW_BAR; bar.x = 0; bar.st = nullptr;
    if (MK_ONE_LAUNCH) bar = xcd_barrier_post((unsigned*)(ws + WS_CTL) + CW_BAR, MISC + 8);
    const int lo = args.ph_lo, hi = args.ph_hi;

    if (IN(0)) for (int rep_ = 0; rep_ < NREP(0); ++rep_) { p0_prologue(F, args); SEAM(0); }

    layer_phases<0>(F, args, bar, lo, hi);
    layer_phases<1>(F, args, bar, lo, hi);
}

extern "C" void kernel_launch(void* const* d_in, const int* in_sizes, int n_in, void* d_out, int out_size, void* d_ws, size_t ws_size, hipStream_t stream) {
    static int grid = 0;
    if (grid == 0) {
        if (n_in != 25 || in_sizes[0] != NTOK * DM || out_size != NTOK * DM || ws_size < WS_END) {
            fprintf(stderr, "kernel_launch: unexpected problem: n_in %d in0 %d out %d ws %zu (need %zu)\n", n_in, n_in > 0 ? in_sizes[0] : -1, out_size, ws_size, (size_t)WS_END); grid = -1; return; }
        int dev = 0, cus = 0, per_cu = 0;
        if (hipGetDevice(&dev) != hipSuccess || hipDeviceGetAttribute(&cus, hipDeviceAttributeMultiprocessorCount, dev) != hipSuccess) { fprintf(stderr, "kernel_launch: device query failed\n"); grid = -1; return; }
        if (hipFuncSetAttribute((const void*)fwd_kernel, hipFuncAttributeMaxDynamicSharedMemorySize, LDS_BYTES) != hipSuccess) { fprintf(stderr, "kernel_launch: hipFuncSetAttribute failed\n"); grid = -1; return; }
        if (hipOccupancyMaxActiveBlocksPerMultiprocessor(&per_cu, (const void*)fwd_kernel, NTHREADS, LDS_BYTES) != hipSuccess || per_cu < 1)
            fprintf(stderr, "kernel_launch: note: occupancy query reports %d workgroups per CU\n", per_cu);
        (void)hipGetLastError();
        grid = cus;
        if (grid != 256) fprintf(stderr, "kernel_launch: note: %d CUs (built for 256)\n", grid);
        if (NTOK % grid != 0 || grid > 256) grid = 256;
    }
    if (grid < 0) return;
    (void)hipMemsetAsync((char*)d_ws + WS_CTL, 0, CTL_ZERO_BYTES, stream);
    Args a{};
    for (int i = 0; i < 25; ++i) a.in[i] = (const float*)d_in[i];
    a.out = (float*)d_out; a.ws = (unsigned char*)d_ws;
#if MK_ONE_LAUNCH
    a.ph_lo = 0; a.ph_hi = NPHASES;
    hipLaunchKernelGGL(fwd_kernel, dim3(grid), dim3(NTHREADS), LDS_BYTES, stream, a);
#else
    for (int k = 0; k < NPHASES; ++k) { a.ph_lo = k; a.ph_hi = k + 1; hipLaunchKernelGGL(fwd_kernel, dim3(grid), dim3(NTHREADS), LDS_BYTES, stream, a); }
#endif
    const hipError_t le = hipPeekAtLastError();
    if (le != hipSuccess) fprintf(stderr, "kernel_launch: launch failed: %s\n", hipGetErrorName(le));
}
```

```cpp
#include <hip/hip_runtime.h>
#include <cstdio>
#include <cstdint>
namespace pg8 {
#define PG8_LAS __attribute__((address_space(3)))
typedef unsigned short bf16_t;
typedef short bf16x8 __attribute__((ext_vector_type(8)));
typedef float f32x4 __attribute__((ext_vector_type(4)));
typedef unsigned u32x4 __attribute__((ext_vector_type(4)));
typedef int v4i __attribute__((ext_vector_type(4)));
typedef int v8i __attribute__((ext_vector_type(8)));
constexpr int BM = 256, BK = 64, HALF = 128, HTB = HALF * BK * 2  , STAGE_BYTES = 8 * HTB, NXCD = 8, WGM = 8;

__host__ __device__ __forceinline__ int lds_byte(int r, int c) { const int st = (r >> 4) * 2 + (c >> 5), rr = r & 15, cc = c & 31, ob = rr * 64 + cc * 2; return st * 1024 + (ob ^ (((ob >> 9) & 1) << 5)); }
__host__ __device__ __forceinline__ void stage_rc(int b, int& R, int& C) { const int st = b / 1024, sb = b % 1024, swz = sb ^ (((sb >> 9) & 1) << 5); R = (st >> 1) * 16 + swz / 64; C = (st & 1) * 32 + (swz % 64) / 2; }
__host__ __device__ __forceinline__ int perm32(int rho) { const int n = rho >> 4, i = rho & 15; return 8 * (i >> 2) + 4 * n + (i & 3); }

struct Unit { int pm, pn, be; };
struct Gemm { const bf16_t* A; const bf16_t* Bt; int M, N, K; size_t bstride; };

struct StaticOrder {
    int nM, nN, nwg, G, c, rep;
    __host__ __device__ void init(int M, int N, int G_, int c_, int rep_ = 1) { nM = M / BM; nN = N / BM; nwg = nM * nN; G = G_; c = c_; rep = rep_; }
    __host__ __device__ bool next(int i, Unit& u) const {
        const long L = (long)i * G + c; if (L >= (long)nwg * rep) return false;
        int wgid = (int)(L % nwg); { const int q = nwg / NXCD, r = nwg % NXCD, xcd = wgid % NXCD, off = wgid / NXCD; wgid = (xcd < r ? xcd * (q + 1) : r * (q + 1) + (xcd - r) * q) + off; }
        const int nig = WGM * nN, gid = wgid / nig, fm = gid * WGM, gsz = (nM - fm) < WGM ? (nM - fm) : WGM;
        u.pm = fm + ((wgid % nig) % gsz); u.pn = (wgid % nig) / gsz; u.be = 0; return true;
    }
    __device__ __forceinline__ void a_ready(const Unit&) const {}
    __device__ __forceinline__ void done(const Unit&) const {}
};
struct MoeOrder {
    StaticOrder so; int tile0, s1, s2, s3, s4, s5, s6, s7;
    __device__ __forceinline__ bool next(int i, Unit& u) const {
        if (!so.next(i, u)) return false;
        const int t = tile0 + u.pm;
        u.be = (t >= s1) + (t >= s2) + (t >= s3) + (t >= s4) + (t >= s5) + (t >= s6) + (t >= s7); return true;
    }
    __device__ __forceinline__ void a_ready(const Unit&) const {}
    __device__ __forceinline__ void done(const Unit&) const {}
};

__device__ __forceinline__ unsigned cvt_pk_bf16(float lo, float hi) { unsigned r; asm volatile("v_cvt_pk_bf16_f32 %0, %1, %2" : "=v"(r) : "v"(lo), "v"(hi)); return r; }

struct EpiBf16 {
    static constexpr bool PERM = true, AFTER_DRAIN = false;
    bf16_t* O; int ldc; float scale, scale0; int n0tiles;
    __device__ __forceinline__ void operator()(const f32x4 (&acc)[2][2][4][2], const Unit& u, int wr, int wc, int fr, int fq) const {
        const int row0 = u.pm * BM + wr * 64 + fr, col0 = u.pn * BM + wc * 32 + 8 * fq;
        const float sc = (u.pn < n0tiles) ? scale0 : scale;
#pragma unroll
        for (int ai = 0; ai < 2; ++ai)
#pragma unroll
            for (int m = 0; m < 4; ++m) { bf16_t* rowp = O + (size_t)(row0 + ai * HALF + m * 16) * ldc + col0;
#pragma unroll
                for (int bj = 0; bj < 2; ++bj) { const f32x4 v0 = acc[ai][bj][m][0] * sc, v1 = acc[ai][bj][m][1] * sc;
                    u32x4 w; w.x = cvt_pk_bf16(v0[0], v0[1]); w.y = cvt_pk_bf16(v0[2], v0[3]); w.z = cvt_pk_bf16(v1[0], v1[1]); w.w = cvt_pk_bf16(v1[2], v1[3]);
                    *(u32x4*)(rowp + bj * HALF) = w; } }
    }
};
__device__ __forceinline__ float silu_mul(float g, float u) { return g * u * __builtin_amdgcn_rcpf(1.0f + __builtin_amdgcn_exp2f(g * -1.4426950408889634f)); }
struct EpiSwiGLU {
    static constexpr bool PERM = true, AFTER_DRAIN = false;
    bf16_t* H; int ldh;
    __device__ __forceinline__ void operator()(const f32x4 (&acc)[2][2][4][2], const Unit& u, int wr, int wc, int fr, int fq) const {
        const int row0 = u.pm * BM + wr * 64 + fr, col0 = u.pn * HALF + wc * 32 + 8 * fq;
#pragma unroll
        for (int ai = 0; ai < 2; ++ai)
#pragma unroll
            for (int m = 0; m < 4; ++m) { bf16_t* rowp = H + (size_t)(row0 + ai * HALF + m * 16) * ldh + col0;
                const f32x4 g0 = acc[ai][0][m][0], g1 = acc[ai][0][m][1], u0 = acc[ai][1][m][0], u1 = acc[ai][1][m][1];
                u32x4 w; w.x = cvt_pk_bf16(silu_mul(g0[0], u0[0]), silu_mul(g0[1], u0[1])); w.y = cvt_pk_bf16(silu_mul(g0[2], u0[2]), silu_mul(g0[3], u0[3]));
                w.z = cvt_pk_bf16(silu_mul(g1[0], u1[0]), silu_mul(g1[1], u1[1])); w.w = cvt_pk_bf16(silu_mul(g1[2], u1[2]), silu_mul(g1[3], u1[3]));
                *(u32x4*)rowp = w; }
    }
};
__device__ __forceinline__ unsigned pk4_fp8(float a, float b, float c, float d) { int w = __builtin_amdgcn_cvt_pk_fp8_f32(a, b, 0, false); w = __builtin_amdgcn_cvt_pk_fp8_f32(c, d, w, true); return (unsigned)w; }
__device__ __forceinline__ unsigned pk4_i8(float a, float b, float c, float d, float s) {
    const int ia = __float2int_rn(fminf(fmaxf(a * s, -127.f), 127.f)), ib = __float2int_rn(fminf(fmaxf(b * s, -127.f), 127.f));
    const int ic = __float2int_rn(fminf(fmaxf(c * s, -127.f), 127.f)), id = __float2int_rn(fminf(fmaxf(d * s, -127.f), 127.f));
    return (unsigned)(ia & 255) | ((unsigned)(ib & 255) << 8) | ((unsigned)(ic & 255) << 16) | ((unsigned)id << 24);
}
struct EpiSwiGLU8 {
    static constexpr bool PERM = true, AFTER_DRAIN = false;
    unsigned char* H; int ldh; float sc;
    __device__ __forceinline__ void operator()(const f32x4 (&acc)[2][2][4][2], const Unit& u, int wr, int wc, int fr, int fq) const {
        const int row0 = u.pm * BM + wr * 64 + fr, col0 = u.pn * HALF + wc * 32 + 8 * fq;
        typedef unsigned u32x2 __attribute__((ext_vector_type(2)));
#pragma unroll
        for (int ai = 0; ai < 2; ++ai)
#pragma unroll
            for (int m = 0; m < 4; ++m) { unsigned char* rowp = H + (size_t)(row0 + ai * HALF + m * 16) * ldh + col0;
                const f32x4 g0 = acc[ai][0][m][0] * sc, g1 = acc[ai][0][m][1] * sc, u0 = acc[ai][1][m][0] * sc, u1 = acc[ai][1][m][1] * sc;
                u32x2 w; w.x = pk4_fp8(silu_mul(g0[0], u0[0]), silu_mul(g0[1], u0[1]), silu_mul(g0[2], u0[2]), silu_mul(g0[3], u0[3]));
                w.y = pk4_fp8(silu_mul(g1[0], u1[0]), silu_mul(g1[1], u1[1]), silu_mul(g1[2], u1[2]), silu_mul(g1[3], u1[3]));
                *(u32x2*)rowp = w; }
    }
};
struct EpiResBf16 {
    static constexpr bool PERM = true, AFTER_DRAIN = false;
    const float* res; bf16_t* out; int ldc; float alpha, scale;
    __device__ __forceinline__ void operator()(const f32x4 (&acc)[2][2][4][2], const Unit& u, int wr, int wc, int fr, int fq) const {
        const int row0 = u.pm * BM + wr * 64 + fr, col0 = u.pn * BM + wc * 32 + 8 * fq;
#pragma unroll
        for (int ai = 0; ai < 2; ++ai)
#pragma unroll
            for (int m = 0; m < 4; ++m) { const size_t off = (size_t)(row0 + ai * HALF + m * 16) * ldc + col0;
                f32x4 rv[2][2];
#pragma unroll
                for (int bj = 0; bj < 2; ++bj)
#pragma unroll
                    for (int n = 0; n < 2; ++n) rv[bj][n] = *(const f32x4*)(res + off + bj * HALF + n * 4);
#pragma unroll
                for (int bj = 0; bj < 2; ++bj) { const f32x4 v0 = rv[bj][0] * alpha + acc[ai][bj][m][0] * scale, v1 = rv[bj][1] * alpha + acc[ai][bj][m][1] * scale;
                    u32x4 w; w.x = cvt_pk_bf16(v0[0], v0[1]); w.y = cvt_pk_bf16(v0[2], v0[3]); w.z = cvt_pk_bf16(v1[0], v1[1]); w.w = cvt_pk_bf16(v1[2], v1[3]);
                    *(u32x4*)(out + off + bj * HALF) = w; }
                asm volatile("" ::: "memory"); }
    }
};
struct EpiResF32 {
    static constexpr bool PERM = false, AFTER_DRAIN = false;
    const float* res; float* out; int ldc; float alpha, scale;
    __device__ __forceinline__ void operator()(const f32x4 (&acc)[2][2][4][2], const Unit& u, int wr, int wc, int fr, int fq) const {
        const int row0 = u.pm * BM + wr * 64 + fr, col0 = u.pn * BM + wc * 32 + 4 * fq;
#pragma unroll
        for (int ai = 0; ai < 2; ++ai)
#pragma unroll
            for (int m = 0; m < 4; ++m) { const size_t off = (size_t)(row0 + ai * HALF + m * 16) * ldc + col0;
                f32x4 rv[2][2];
#pragma unroll
                for (int bj = 0; bj < 2; ++bj)
#pragma unroll
                    for (int n = 0; n < 2; ++n) rv[bj][n] = *(const f32x4*)(res + off + bj * HALF + n * 16);
#pragma unroll
                for (int bj = 0; bj < 2; ++bj)
#pragma unroll
                    for (int n = 0; n < 2; ++n) *(f32x4*)(out + off + bj * HALF + n * 16) = rv[bj][n] * alpha + acc[ai][bj][m][n] * scale;
                asm volatile("" ::: "memory"); }
    }
};

__device__ __forceinline__ void mfma8(f32x4& c, const v8i a, const v8i b, const int scl) { asm volatile("v_mfma_scale_f32_16x16x128_f8f6f4 %0, %1, %2, %0, %3, %3 op_sel_hi:[0,0,0]" : "+v"(c) : "v"(a), "v"(b), "v"(scl)); }
template <class Epi, class Sched, bool ALIGN_EPI = false, bool SP2 = false, int OPK = 0>
__device__ __forceinline__ void gemm_phase(PG8_LAS unsigned char* lds, const Gemm g, const Sched& S, const Epi& E) {
    const int tid = threadIdx.x, wid = __builtin_amdgcn_readfirstlane(tid >> 6), lane = tid & 63, wr = wid >> 2, wc = wid & 3, fr = lane & 15, fq = lane >> 4;
    const int K = g.K, nt = K / BK;
    unsigned voffA[2], voffB[2];
#pragma unroll
    for (int i = 0; i < 2; ++i) { int R, C; stage_rc(tid * 16 + i * 8192, R, C); const int Rb = Epi::PERM ? ((R & ~31) + perm32(R & 31)) : R;
        voffA[i] = (unsigned)(R * K + C) * 2u; voffB[i] = (unsigned)(Rb * K + C) * 2u; }
    const size_t kstep = (size_t)(BK * 2);
    const size_t hstep = (size_t)HALF * K * 2;
    const size_t tstep = 2 * hstep;
    const unsigned ldsw = (unsigned)wid * 1024u;
    const int aoff = lds_byte(wr * 64 + fr, fq * 8), boff = lds_byte(wc * 32 + fr, fq * 8);
#define PG8_SA(b, h) (((b) * 2 + (h)) * HTB)
#define PG8_SB(b, h) ((4 + (b) * 2 + (h)) * HTB)
#define PG8_STAGE(bufoff, gbase, voff) do { _Pragma("unroll") for (int _i = 0; _i < 2; ++_i) \
        __builtin_amdgcn_global_load_lds((const unsigned*)((const char*)(gbase) + (voff)[_i]), (PG8_LAS unsigned*)(lds + (bufoff) + ldsw + _i * 8192), 16, 0, 0); } while (0)
#define PG8_LDA(dst, b, h) do { if constexpr (OPK == 1) { _Pragma("unroll") for (int m = 0; m < 4; ++m) { dst##8[m][0] = *(const PG8_LAS v4i*)(lds + PG8_SA(b, h) + aoff + m * 2048); dst##8[m][1] = *(const PG8_LAS v4i*)(lds + PG8_SA(b, h) + aoff + m * 2048 + 1024); } } \
    else { _Pragma("unroll") for (int m = 0; m < 4; ++m) _Pragma("unroll") for (int k = 0; k < 2; ++k) dst[m][k] = *(const PG8_LAS bf16x8*)(lds + PG8_SA(b, h) + aoff + m * 2048 + k * 1024); } } while (0)
#define PG8_LDB(dst, b, h) do { if constexpr (OPK == 1) { _Pragma("unroll") for (int n = 0; n < 2; ++n) { dst##8[n][0] = *(const PG8_LAS v4i*)(lds + PG8_SB(b, h) + boff + n * 2048); dst##8[n][1] = *(const PG8_LAS v4i*)(lds + PG8_SB(b, h) + boff + n * 2048 + 1024); } } \
    else { _Pragma("unroll") for (int n = 0; n < 2; ++n) _Pragma("unroll") for (int k = 0; k < 2; ++k) dst[n][k] = *(const PG8_LAS bf16x8*)(lds + PG8_SB(b, h) + boff + n * 2048 + k * 1024); } } while (0)
#define PG8_MMA(ai, bj, At, Bt) do { __builtin_amdgcn_s_setprio(1); if constexpr (OPK == 1) { _Pragma("unroll") for (int m = 0; m < 4; ++m) _Pragma("unroll") for (int n = 0; n < 2; ++n) \
        mfma8(acc[ai][bj][m][n], __builtin_shufflevector(Bt##8[n][0], Bt##8[n][1], 0, 1, 2, 3, 4, 5, 6, 7), __builtin_shufflevector(At##8[m][0], At##8[m][1], 0, 1, 2, 3, 4, 5, 6, 7), scl8); } \
    else if constexpr (OPK == 2) { _Pragma("unroll") for (int m = 0; m < 4; ++m) _Pragma("unroll") for (int n = 0; n < 2; ++n) _Pragma("unroll") for (int k = 0; k < 2; ++k) \
        acc[ai][bj][m][n] = __builtin_bit_cast(f32x4, __builtin_amdgcn_mfma_i32_16x16x64_i8(__builtin_bit_cast(v4i, Bt[n][k]), __builtin_bit_cast(v4i, At[m][k]), __builtin_bit_cast(v4i, acc[ai][bj][m][n]), 0, 0, 0)); } \
    else { _Pragma("unroll") for (int m = 0; m < 4; ++m) _Pragma("unroll") for (int n = 0; n < 2; ++n) _Pragma("unroll") for (int k = 0; k < 2; ++k) \
        acc[ai][bj][m][n] = __builtin_amdgcn_mfma_f32_16x16x32_bf16(Bt[n][k], At[m][k], acc[ai][bj][m][n], 0, 0, 0); } __builtin_amdgcn_s_setprio(0); } while (0)
#define PG8_WAIT_V(n) asm volatile("s_waitcnt vmcnt(" #n ")" ::: "memory")
#define PG8_WAIT_L(n) asm volatile("s_waitcnt lgkmcnt(" #n ")" ::: "memory")
#define PG8_BAR __builtin_amdgcn_s_barrier()
#define PG8_SCHED __builtin_amdgcn_sched_barrier(0)
    Unit cur, nxt; int ui = 0;
    if (!S.next(0, cur)) return;
    f32x4 acc[2][2][4][2];
#pragma unroll
    for (int a = 0; a < 2; ++a)
#pragma unroll
        for (int b = 0; b < 2; ++b)
#pragma unroll
            for (int m = 0; m < 4; ++m)
#pragma unroll
                for (int n = 0; n < 2; ++n) acc[a][b][m][n] = (f32x4){0.f, 0.f, 0.f, 0.f};
    bf16x8 At[4][2], B0[2][2], B1[2][2];
    v4i At8[4][2], B08[2][2], B18[2][2];
    int scl8 = 0x7F7F7F7F; asm volatile("" : "+v"(scl8));
    const char* cA = (const char*)g.A + (size_t)cur.pm * tstep; const char* cB = (const char*)g.Bt + (size_t)cur.be * g.bstride + (size_t)cur.pn * tstep;
    S.a_ready(cur);
    if constexpr (SP2) {
        PG8_STAGE(PG8_SB(0, 0), cB, voffB); PG8_STAGE(PG8_SB(0, 1), cB + hstep, voffB); PG8_STAGE(PG8_SA(0, 0), cA, voffA); PG8_STAGE(PG8_SA(0, 1), cA + hstep, voffA);
        if (wr == 1) PG8_BAR;
        PG8_WAIT_V(2); PG8_BAR;
        PG8_STAGE(PG8_SB(1, 0), cB + kstep, voffB); PG8_STAGE(PG8_SA(1, 0), cA + kstep, voffA); PG8_STAGE(PG8_SB(1, 1), cB + hstep + kstep, voffB);
        PG8_WAIT_V(6); PG8_BAR;
    } else {
        PG8_STAGE(PG8_SB(0, 0), cB, voffB); PG8_STAGE(PG8_SA(0, 0), cA, voffA); PG8_STAGE(PG8_SB(0, 1), cB + hstep, voffB); PG8_STAGE(PG8_SA(0, 1), cA + hstep, voffA);
        if (wr == 1) PG8_BAR;
        PG8_WAIT_V(4); PG8_BAR;
        PG8_STAGE(PG8_SB(1, 0), cB + kstep, voffB); PG8_STAGE(PG8_SA(1, 0), cA + kstep, voffA); PG8_STAGE(PG8_SB(1, 1), cB + hstep + kstep, voffB);
        PG8_WAIT_V(6); PG8_BAR;
    }
    for (;;) {
        const bool has_next = S.next(ui + 1, nxt);
        const char* nA = has_next ? (const char*)g.A + (size_t)nxt.pm * tstep : cA; const char* nB = has_next ? (const char*)g.Bt + (size_t)nxt.be * g.bstride + (size_t)nxt.pn * tstep : cB;
#pragma unroll 1
        for (int t = 0; t < nt; t += 2) {
            const bool last = (t == nt - 2);
            const char* a1 = cA + (size_t)(t + 1) * kstep;
            const char* a2 = last ? nA : cA + (size_t)(t + 2) * kstep; const char* b2 = last ? nB : cB + (size_t)(t + 2) * kstep;
            const char* a3 = a2 + kstep; const char* b3 = b2 + kstep;
            if (last && has_next) S.a_ready(nxt);
            if constexpr (SP2) {
            PG8_LDB(B0, 0, 0); PG8_LDB(B1, 0, 1); PG8_SCHED; PG8_LDA(At, 0, 0); PG8_STAGE(PG8_SA(1, 1), a1 + hstep, voffA);
            PG8_WAIT_V(8); PG8_WAIT_L(0); PG8_BAR; PG8_MMA(0, 0, At, B0); PG8_MMA(0, 1, At, B1); PG8_BAR; PG8_SCHED;
            PG8_LDA(At, 0, 1); PG8_STAGE(PG8_SB(0, 0), b2, voffB); PG8_STAGE(PG8_SB(0, 1), b2 + hstep, voffB); PG8_STAGE(PG8_SA(0, 0), a2, voffA);
            PG8_WAIT_V(8); PG8_WAIT_L(0); PG8_BAR; PG8_MMA(1, 0, At, B0); PG8_MMA(1, 1, At, B1); PG8_BAR; PG8_SCHED;
            PG8_LDB(B0, 1, 0); PG8_LDB(B1, 1, 1); PG8_SCHED; PG8_LDA(At, 1, 0); PG8_STAGE(PG8_SA(0, 1), a2 + hstep, voffA);
            PG8_WAIT_V(8); PG8_WAIT_L(0); PG8_BAR; PG8_MMA(0, 0, At, B0); PG8_MMA(0, 1, At, B1); PG8_BAR; PG8_SCHED;
            PG8_LDA(At, 1, 1); PG8_STAGE(PG8_SB(1, 0), b3, voffB); PG8_STAGE(PG8_SB(1, 1), b3 + hstep, voffB); PG8_STAGE(PG8_SA(1, 0), a3, voffA);
            PG8_WAIT_V(8); PG8_WAIT_L(0); PG8_BAR; PG8_MMA(1, 0, At, B0); PG8_MMA(1, 1, At, B1); PG8_BAR; PG8_SCHED;
            } else {
            PG8_LDB(B0, 0, 0); PG8_SCHED; PG8_LDA(At, 0, 0); PG8_STAGE(PG8_SA(1, 1), a1 + hstep, voffA);
            PG8_WAIT_L(8); PG8_BAR; PG8_WAIT_L(0); PG8_MMA(0, 0, At, B0); PG8_BAR; PG8_SCHED;
            PG8_LDB(B1, 0, 1); PG8_STAGE(PG8_SB(0, 0), b2, voffB);
            PG8_BAR; PG8_WAIT_L(0); PG8_MMA(0, 1, At, B1); PG8_BAR;
            PG8_LDA(At, 0, 1); PG8_STAGE(PG8_SA(0, 0), a2, voffA);
            PG8_BAR; PG8_WAIT_L(0); PG8_MMA(1, 0, At, B0); PG8_BAR; PG8_SCHED;
            PG8_STAGE(PG8_SB(0, 1), b2 + hstep, voffB);
            PG8_WAIT_V(6); PG8_BAR; PG8_MMA(1, 1, At, B1); PG8_BAR;
            PG8_LDB(B0, 1, 0); PG8_SCHED; PG8_LDA(At, 1, 0); PG8_STAGE(PG8_SA(0, 1), a2 + hstep, voffA);
            PG8_WAIT_L(8); PG8_BAR; PG8_WAIT_L(0); PG8_MMA(0, 0, At, B0); PG8_BAR; PG8_SCHED;
            PG8_LDB(B1, 1, 1); PG8_STAGE(PG8_SB(1, 0), b3, voffB);
            PG8_BAR; PG8_WAIT_L(0); PG8_MMA(0, 1, At, B1); PG8_BAR;
            PG8_LDA(At, 1, 1); PG8_STAGE(PG8_SA(1, 0), a3, voffA);
            PG8_BAR; PG8_WAIT_L(0); PG8_MMA(1, 0, At, B0); PG8_BAR; PG8_SCHED;
            PG8_STAGE(PG8_SB(1, 1), b3 + hstep, voffB);
            PG8_WAIT_V(6); PG8_BAR; PG8_MMA(1, 1, At, B1); PG8_BAR;
            }
        }
        if constexpr (OPK == 1) asm volatile("s_nop 15\n\ts_nop 15" ::: "memory");
        if constexpr (OPK == 2) {
#pragma unroll
            for (int a = 0; a < 2; ++a)
#pragma unroll
                for (int b = 0; b < 2; ++b)
#pragma unroll
                    for (int m = 0; m < 4; ++m)
#pragma unroll
                        for (int n = 0; n < 2; ++n) { const v4i iv = __builtin_bit_cast(v4i, acc[a][b][m][n]); acc[a][b][m][n] = (f32x4){(float)iv[0], (float)iv[1], (float)iv[2], (float)iv[3]}; }
        }
        if constexpr (ALIGN_EPI) { if (wr == 0) PG8_BAR; }
        if constexpr (!Epi::AFTER_DRAIN) { E(acc, cur, wr, wc, fr, fq); S.done(cur); }
        if (!has_next) break;
#pragma unroll
        for (int a = 0; a < 2; ++a)
#pragma unroll
            for (int b = 0; b < 2; ++b)
#pragma unroll
                for (int m = 0; m < 4; ++m)
#pragma unroll
                    for (int n = 0; n < 2; ++n) acc[a][b][m][n] = (f32x4){0.f, 0.f, 0.f, 0.f};
        cur = nxt; cA = nA; cB = nB; ++ui;
        if constexpr (ALIGN_EPI) { if (wr == 1) PG8_BAR; }
    }
    PG8_WAIT_V(0);
    if constexpr (!ALIGN_EPI) { if (wr == 0) PG8_BAR; }
    PG8_BAR;
    if constexpr (Epi::AFTER_DRAIN) { E.fused(acc, cur, wr, wc, fr, fq, lds, wid, lane); S.done(cur); }
#undef PG8_SA
#undef PG8_SB
#undef PG8_STAGE
#undef PG8_LDA
#undef PG8_LDB
#undef PG8_MMA
#undef PG8_WAIT_V
#undef PG8_WAIT_L
#undef PG8_BAR
#undef PG8_SCHED
}
}

constexpr int BATCH = 2, SEQ = 16384, DM = 1024, NTOK = BATCH * SEQ;
constexpr int CHK = 64, NCHUNK = SEQ / CHK;
constexpr int INC = 1792, KOFF = 512, VOFF = 640, XBOFF = 768, GBOFF = 1280;
constexpr int LRUW = 512, DFF = 2816, DFE = 3584, NEXP = 8;
constexpr int MAXTILES = 264, PASS_TILES = 264, NPASS = 1;
constexpr float ALPHA = 1.41421356237309515f, LN_EPS = 1e-5f, RMS_EPS = 1e-6f, LOG2E = 1.4426950408889634f, QSCALE = 0.125f * LOG2E;
constexpr int NWAVES = 8, NTHREADS = 512;

constexpr size_t MiB = 1u << 20;
constexpr size_t WS_CTL = 0, CTL_ZERO_BYTES = 64 * 1024;
constexpr size_t WS_LUT = 1 * MiB;
constexpr size_t WS_GATEW = 1 * MiB + 64 * 1024;
constexpr size_t WS_HIST = 1 * MiB + 512 * 1024;
constexpr size_t WS_META = 1 * MiB + 576 * 1024;
constexpr size_t WS_TOKE = 2 * MiB, WS_TOKW = 2 * MiB + 256 * 1024, WS_TOKPOS = 2 * MiB + 512 * 1024;
constexpr size_t WS_LRUP = 3 * MiB, WS_LRUE = 4 * MiB, WS_HIN = 5 * MiB;
constexpr size_t WS_WEGU = 8 * MiB, WS_WED = 64 * MiB;
constexpr size_t WS_WIN = 92 * MiB, WS_WOUT = 99 * MiB, WS_WGU = 103 * MiB, WS_WD = 114 * MiB;
constexpr size_t WS_A = 120 * MiB;
constexpr size_t WS_TB = 152 * MiB;
constexpr size_t WS_ZH = 216 * MiB;
constexpr size_t WS_HL = 328 * MiB, WS_PA = 360 * MiB;
constexpr size_t WS_XR = 400 * MiB;
constexpr size_t WS_XS = 120 * MiB;
constexpr size_t WS_Y2 = 120 * MiB;
constexpr size_t WS_HM = 252 * MiB;
constexpr size_t WS_END = 483 * MiB;
constexpr float SA_X = 127.0f / 6.0f, SW_IN = 127.0f * 32.0f / 6.0f, SW_GU = 127.0f * 32.0f / 6.0f;
constexpr float WSC_OUT = 128.0f;
constexpr float WSC_D = 256.0f;
static_assert(WS_WED + (size_t)NEXP * DM * DFE <= WS_WIN && WS_WD + (size_t)DM * DFF * 2 <= WS_A && WS_A + (size_t)NTOK * DM <= WS_TB && WS_TB + (size_t)NTOK * DM * 2 <= WS_ZH && WS_ZH + (size_t)NTOK * DFF * 2 <= WS_END, "ws map");
static_assert(WS_ZH + (size_t)NTOK * INC * 2 <= WS_HL && WS_HL + (size_t)NTOK * LRUW * 2 <= WS_PA && WS_PA + (size_t)NTOK * LRUW * 2 <= WS_ZH + (size_t)NTOK * DFF * 2, "ws map (LRU)");
static_assert(WS_PA + (size_t)NTOK * LRUW * 2 <= WS_XR && WS_XR + (size_t)NTOK * DM * 2 <= WS_END, "ws map (residual)");
static_assert(NPASS == 1 && WS_XS == WS_Y2 && WS_Y2 + (size_t)MAXTILES * 256 * DM * 2 <= WS_HM && WS_HM + (size_t)PASS_TILES * 256 * DFE <= WS_END, "ws map (MoE)");
constexpr int CW_BAR = 0;

constexpr int RING_BYTES = 131072;
constexpr int LDS_LUT = RING_BYTES;
constexpr int LDS_CTAB = LDS_LUT + 8192;
constexpr int CT_CB = 4 * 512, CT_BR = 5 * 512, CT_BI = 6 * 512, CT_SP = 7 * 512;
constexpr int LDS_MISC = LDS_CTAB + 16384;
constexpr int LDS_POS = LDS_MISC + 256;
constexpr int LDS_BYTES = 159744;
static_assert(LDS_POS + 1024 <= LDS_BYTES, "LDS map");

#define GAS __attribute__((address_space(1)))
#define LAS __attribute__((address_space(3)))
typedef unsigned short bf16;
typedef unsigned v4u __attribute__((ext_vector_type(4)));
typedef unsigned v2u __attribute__((ext_vector_type(2)));
typedef float f32x4 __attribute__((ext_vector_type(4)));
typedef float f32x16 __attribute__((ext_vector_type(16)));
typedef short bf16x8 __attribute__((ext_vector_type(8)));
typedef short s16x4 __attribute__((ext_vector_type(4)));
#define LDS_WAIT() asm volatile("s_waitcnt lgkmcnt(0)" ::: "memory")
#define VM_WAIT() asm volatile("s_waitcnt vmcnt(0)" ::: "memory")
__device__ __forceinline__ unsigned pk2(float lo, float hi) { return pg8::cvt_pk_bf16(lo, hi); }
__device__ __forceinline__ float bf2f(unsigned short h) { return __uint_as_float((unsigned)h << 16); }
__device__ __forceinline__ float bflo(unsigned w) { return __uint_as_float(w << 16); }
__device__ __forceinline__ float bfhi(unsigned w) { return __uint_as_float(w & 0xffff0000u); }
__device__ __forceinline__ float wave_sum(float v) {
#pragma unroll
    for (int o = 1; o < 64; o <<= 1) v += __shfl_xor(v, o);
    return v;
}
__device__ __forceinline__ float fast_sigmoid(float x) { return __builtin_amdgcn_rcpf(1.0f + __builtin_amdgcn_exp2f(x * -LOG2E)); }
__device__ __forceinline__ float gelu_tanh(float x) {
    const float t = 1.5957691216057308f * (x + 0.044715f * x * x * x);
    return x * fast_sigmoid(t);
}

#define XB_TMO      128
#define XB_XCNT(j)  (256  + 64 * (j))
#define XB_XSUB(j)  (1280 + 64 * (j))
#define XB_XGEN(j)  (2304 + 64 * (j))
#define XB_TOP      3328
#define XB_TOPGEN   3392
#define XCD_BAR_WORDS 3456
#define XB_SPIN_CAP (1u << 18)

__device__ __forceinline__ unsigned xb_ld(unsigned* p)              { return __hip_atomic_load(p, __ATOMIC_RELAXED, __HIP_MEMORY_SCOPE_AGENT); }
__device__ __forceinline__ unsigned xb_add(unsigned* p, unsigned v) { return __hip_atomic_fetch_add(p, v, __ATOMIC_RELAXED, __HIP_MEMORY_SCOPE_AGENT); }
__device__ __forceinline__ unsigned xb_xcc_id() { return (unsigned)__builtin_amdgcn_s_getreg((3 << 11) | 20) & 0xFu; }
#define XB_SPIN(cond, bar) do { unsigned _sp = 0; while (cond) { __builtin_amdgcn_s_sleep(1); \
    if ((++_sp & 255u) == 0u) { if (xb_ld(&(bar)[XB_TMO])) break; if (_sp > XB_SPIN_CAP) { atomicAdd(&(bar)[XB_TMO], 1u); break; } } } } while (0)

struct XcdBarrier {
    unsigned* bar; unsigned x;
    volatile LAS unsigned* st;
};

__device__ __forceinline__ XcdBarrier xcd_barrier_post(unsigned* bar, volatile LAS unsigned* st) {
    XcdBarrier b; b.bar = bar; b.x = xb_xcc_id(); b.st = st;
    if (threadIdx.x == 0) (void)xb_add(&bar[XB_XCNT(b.x)], 1u);
    return b;
}
__device__ __forceinline__ void xcd_barrier_complete(unsigned* bar, unsigned x, unsigned& nloc, unsigned& nx) {
    const unsigned G = gridDim.x * gridDim.y * gridDim.z;
    unsigned sum, cnt, mine, sp = 0u;
    for (;;) {
        sum = 0u; cnt = 0u; mine = 0u;
#pragma unroll
        for (unsigned j = 0; j < 16; ++j) { const unsigned c = xb_ld(&bar[XB_XCNT(j)]); sum += c; cnt += (c > 0u) ? 1u : 0u; mine = (j == x) ? c : mine; }
        if (sum == G) break;
        __builtin_amdgcn_s_sleep(1);
        if ((++sp & 255u) == 0u) { if (xb_ld(&bar[XB_TMO])) break; if (sp > XB_SPIN_CAP) { atomicAdd(&bar[XB_TMO], 1u); break; } }
    }
    nloc = mine > 0u ? mine : 1u; nx = cnt > 0u ? cnt : 1u;
}

__device__ __forceinline__ void xcd_barrier(const XcdBarrier& b) {
    asm volatile("s_waitcnt vmcnt(0)" ::: "memory");
    __syncthreads();
    if (threadIdx.x == 0) {
        unsigned* bar = b.bar;
        __builtin_amdgcn_s_waitcnt(0);
        unsigned nloc = b.st[0], nx = b.st[1];
        if (nloc == 0u) { xcd_barrier_complete(bar, b.x, nloc, nx); b.st[0] = nloc; b.st[1] = nx; }
        const unsigned old = xb_add(&bar[XB_XSUB(b.x)], 1u);
        const unsigned gen = old / nloc;
        if (old + 1u == (gen + 1u) * nloc) {
            __builtin_amdgcn_fence(__ATOMIC_RELEASE, "agent");
            asm volatile("s_waitcnt vmcnt(0)" ::: "memory");
            const unsigned og = xb_add(&bar[XB_TOP], 1u);
            const unsigned tg = og / nx;
            if (og + 1u == (tg + 1u) * nx) xb_add(&bar[XB_TOPGEN], 1u);
            else XB_SPIN(xb_ld(&bar[XB_TOPGEN]) == tg, bar);
            __builtin_amdgcn_fence(__ATOMIC_ACQUIRE, "agent");
            xb_add(&bar[XB_XGEN(b.x)], 1u);
            asm volatile("s_waitcnt vmcnt(0)" ::: "memory");
        } else {
            XB_SPIN(xb_ld(&bar[XB_XGEN(b.x)]) == gen, bar);
            __builtin_amdgcn_fence(__ATOMIC_ACQUIRE, "agent");
            asm volatile("s_waitcnt vmcnt(0)" ::: "memory");
        }
    }
    __syncthreads();
}

struct Args { const float* in[25]; float* out; unsigned char* ws; int ph_lo, ph_hi; };
struct Frame {
    LAS unsigned char* lds;
    int tid, lane, wave, G, blk;
};

__device__ __forceinline__ void p0_transpose_item(const float* W, int K, int N, bf16* WT, int mode, const float* ksA, const float* ksB, float nscale, int nscale_cols, LAS float* scr, int item, int lane) {
    const int nblk = N / 32, kb = item / nblk, nb = item % nblk, k0 = 64 * kb, n0 = 32 * nb;
    const float* ks = ksA ? (k0 < 512 ? ksA + k0 : ksB + (k0 - 512)) : nullptr;
#pragma unroll
    for (int i = 0; i < 32; ++i) { const int kk = 2 * i + (lane >> 5); float v = W[(size_t)(k0 + kk) * N + n0 + (lane & 31)]; if (ks) v *= ks[kk]; scr[kk * 33 + (lane & 31)] = v; }
    LDS_WAIT(); asm volatile("" ::: "memory");
    const int drow0 = (mode == 0) ? n0 : ((n0 >> 7) * 256 + (n0 & 127) + (mode == 2 ? 128 : 0));
    const float sc = (n0 < nscale_cols) ? nscale : 1.0f;
    const int c = lane & 7;
#pragma unroll
    for (int j = 0; j < 4; ++j) { const int n = (lane >> 3) + 8 * j; const LAS float* s = scr + (8 * c) * 33 + n;
        v4u o; o.x = pk2(s[0 * 33] * sc, s[1 * 33] * sc); o.y = pk2(s[2 * 33] * sc, s[3 * 33] * sc); o.z = pk2(s[4 * 33] * sc, s[5 * 33] * sc); o.w = pk2(s[6 * 33] * sc, s[7 * 33] * sc);
        *(v4u*)(WT + (size_t)(drow0 + n) * K + k0 + 8 * c) = o; }
    LDS_WAIT(); asm volatile("" ::: "memory");
}
template <int KIND  >
__device__ __forceinline__ void p0_transpose_item_f8(const float* W, int K, int N, unsigned char* WT, int mode, float scale, LAS float* scr, int item, int lane, const float* ksA = nullptr, const float* ksB = nullptr, float nscale = 1.0f, int nscale_cols = 0) {
    const int nblk = N / 32, kb = item / nblk, nb = item % nblk, k0 = 64 * kb, n0 = 32 * nb;
    const float* ks = ksA ? (k0 < 512 ? ksA + k0 : ksB + (k0 - 512)) : nullptr;
    if (n0 < nscale_cols) scale *= nscale;
#pragma unroll
    for (int i = 0; i < 32; ++i) { const int kk = 2 * i + (lane >> 5); float v = W[(size_t)(k0 + kk) * N + n0 + (lane & 31)] * scale; if (ks) v *= ks[kk]; scr[kk * 33 + (lane & 31)] = v; }
    LDS_WAIT(); asm volatile("" ::: "memory");
    const int drow0 = (mode == 0) ? n0 : ((n0 >> 7) * 256 + (n0 & 127) + (mode == 2 ? 128 : 0));
    const int c = lane & 3;
#pragma unroll
    for (int j = 0; j < 2; ++j) { const int n = (lane >> 2) + 16 * j; const LAS float* s = scr + (16 * c) * 33 + n;
        v4u o;
        if (KIND == 1) { o.x = pg8::pk4_fp8(s[0 * 33], s[1 * 33], s[2 * 33], s[3 * 33]); o.y = pg8::pk4_fp8(s[4 * 33], s[5 * 33], s[6 * 33], s[7 * 33]);
            o.z = pg8::pk4_fp8(s[8 * 33], s[9 * 33], s[10 * 33], s[11 * 33]); o.w = pg8::pk4_fp8(s[12 * 33], s[13 * 33], s[14 * 33], s[15 * 33]); }
        else { o.x = pg8::pk4_i8(s[0 * 33], s[1 * 33], s[2 * 33], s[3 * 33], 1.0f); o.y = pg8::pk4_i8(s[4 * 33], s[5 * 33], s[6 * 33], s[7 * 33], 1.0f);
            o.z = pg8::pk4_i8(s[8 * 33], s[9 * 33], s[10 * 33], s[11 * 33], 1.0f); o.w = pg8::pk4_i8(s[12 * 33], s[13 * 33], s[14 * 33], s[15 * 33], 1.0f); }
        *(v4u*)(WT + (size_t)(drow0 + n) * K + k0 + 16 * c) = o; }
    LDS_WAIT(); asm volatile("" ::: "memory");
}
__device__ __forceinline__ int t5_bucket(int rel) {
    const int n = rel < 0 ? -rel : rel;
    int v;
    if (n < 8) v = n;
    else { v = 8 + (n >= 12) + (n >= 16) + (n >= 23) + (n >= 32) + (n >= 46) + (n >= 64) + (n >= 91); }
    return (rel > 0 ? 16 : 0) + v;
}
__device__ __forceinline__ void p0_prologue(const Frame& F, const Args& A) {
    unsigned char* ws = A.ws;
    LAS float* scr = (LAS float*)(F.lds + F.wave * 8448);
    const int gw = F.blk * NWAVES + F.wave, NGW = F.G * NWAVES;
    bf16* WIN = (bf16*)(ws + WS_WIN); bf16* WOUT = (bf16*)(ws + WS_WOUT); bf16* WGU = (bf16*)(ws + WS_WGU); bf16* WD = (bf16*)(ws + WS_WD);
    unsigned char* WEGU = ws + WS_WEGU; unsigned char* WED = ws + WS_WED;
    constexpr int I_IN = (DM / 64) * (INC / 32), I_OUT = (DM / 64) * (DM / 32), I_GU = (DM / 64) * (DFF / 32), I_D = (DFF / 64) * (DM / 32);
    constexpr int I_EGU = (DM / 64) * (DFE / 32), I_ED = (DFE / 64) * (DM / 32);
    constexpr int NITEMS = 2 * I_IN + 2 * I_OUT + 2 * I_GU + I_D + NEXP * (2 * I_EGU + I_ED);
    struct Item { const float* src; unsigned char* dst; const float* ks; int K, N, k0, n0, mode, kind; float scale; };
    auto decode = [&](int it, Item& d) {
        int r = it; d.ks = nullptr;
        if (r < 2 * I_IN) { const int l = r / I_IN; r -= l * I_IN; d.src = A.in[2] + (size_t)l * DM * INC; d.K = DM; d.N = INC; d.dst = (unsigned char*)WIN + (size_t)l * INC * DM; d.mode = 0; d.kind = 2; d.scale = SW_IN; }
        else if ((r -= 2 * I_IN) < 2 * I_OUT) { const int l = r / I_OUT; r -= l * I_OUT; d.src = A.in[13] + (size_t)l * DM * DM; d.K = DM; d.N = DM; d.dst = (unsigned char*)WOUT + (size_t)l * DM * DM; d.mode = 0; d.kind = 1; d.scale = WSC_OUT; d.ks = A.in[11] + l * 512; }
        else if ((r -= 2 * I_OUT) < I_GU) { d.src = A.in[16]; d.K = DM; d.N = DFF; d.dst = (unsigned char*)WGU; d.mode = 1; d.kind = 2; d.scale = SW_GU; }
        else if ((r -= I_GU) < I_GU) { d.src = A.in[17]; d.K = DM; d.N = DFF; d.dst = (unsigned char*)WGU; d.mode = 2; d.kind = 2; d.scale = SW_GU; }
        else if ((r -= I_GU) < I_D) { d.src = A.in[18]; d.K = DFF; d.N = DM; d.dst = (unsigned char*)WD; d.mode = 0; d.kind = 1; d.scale = WSC_D; }
        else { r -= I_D; constexpr int PER_E = 2 * I_EGU + I_ED; const int e = r / PER_E; r -= e * PER_E;
            if (r < I_EGU) { d.src = A.in[20] + (size_t)e * DM * DFE; d.K = DM; d.N = DFE; d.dst = WEGU + (size_t)e * 2 * DFE * DM; d.mode = 1; d.kind = 2; d.scale = SW_GU; }
            else if ((r -= I_EGU) < I_EGU) { d.src = A.in[21] + (size_t)e * DM * DFE; d.K = DM; d.N = DFE; d.dst = WEGU + (size_t)e * 2 * DFE * DM; d.mode = 2; d.kind = 2; d.scale = SW_GU; }
            else { r -= I_EGU; d.src = A.in[22] + (size_t)e * DFE * DM; d.K = DFE; d.N = DM; d.dst = WED + (size_t)e * DM * DFE; d.mode = 0; d.kind = 1; d.scale = WSC_D; } }
        const int nblk = d.N / 32; d.k0 = 64 * (r / nblk); d.n0 = 32 * (r % nblk);
        if (d.ks) d.ks = (d.k0 < 512) ? d.ks + d.k0 : (A.in[12] + (d.ks - A.in[11]) + (d.k0 - 512));
    };
    float v[32], nv[32]; Item cur, nxt;
    int it = gw;
    if (it < NITEMS) { decode(it, cur);
#pragma unroll
        for (int i = 0; i < 32; ++i) v[i] = cur.src[(size_t)(cur.k0 + 2 * i + (F.lane >> 5)) * cur.N + cur.n0 + (F.lane & 31)]; }
    for (; it < NITEMS; it += NGW) {
        const bool more = it + NGW < NITEMS;
        if (more) { decode(it + NGW, nxt);
#pragma unroll
            for (int i = 0; i < 32; ++i) nv[i] = nxt.src[(size_t)(nxt.k0 + 2 * i + (F.lane >> 5)) * nxt.N + nxt.n0 + (F.lane & 31)]; }
        asm volatile("" ::: "memory");
#pragma unroll
        for (int i = 0; i < 32; ++i) { const int kk = 2 * i + (F.lane >> 5); float x = v[i] * cur.scale; if (cur.ks) x *= cur.ks[kk]; scr[kk * 33 + (F.lane & 31)] = x; }
        LDS_WAIT(); asm volatile("" ::: "memory");
        {   const int drow0 = (cur.mode == 0) ? cur.n0 : ((cur.n0 >> 7) * 256 + (cur.n0 & 127) + (cur.mode == 2 ? 128 : 0));
            const int c = F.lane & 3;
#pragma unroll
            for (int j = 0; j < 2; ++j) { const int n = (F.lane >> 2) + 16 * j; const LAS float* s = scr + (16 * c) * 33 + n;
                v4u o;
                if (cur.kind == 1) { o.x = pg8::pk4_fp8(s[0 * 33], s[1 * 33], s[2 * 33], s[3 * 33]); o.y = pg8::pk4_fp8(s[4 * 33], s[5 * 33], s[6 * 33], s[7 * 33]);
                    o.z = pg8::pk4_fp8(s[8 * 33], s[9 * 33], s[10 * 33], s[11 * 33]); o.w = pg8::pk4_fp8(s[12 * 33], s[13 * 33], s[14 * 33], s[15 * 33]); }
                else { o.x = pg8::pk4_i8(s[0 * 33], s[1 * 33], s[2 * 33], s[3 * 33], 1.0f); o.y = pg8::pk4_i8(s[4 * 33], s[5 * 33], s[6 * 33], s[7 * 33], 1.0f);
                    o.z = pg8::pk4_i8(s[8 * 33], s[9 * 33], s[10 * 33], s[11 * 33], 1.0f); o.w = pg8::pk4_i8(s[12 * 33], s[13 * 33], s[14 * 33], s[15 * 33], 1.0f); }
                *(v4u*)(cur.dst + (size_t)(drow0 + n) * cur.K + cur.k0 + 16 * c) = o; }
        }
        LDS_WAIT(); asm volatile("" ::: "memory");
        if (more) { cur = nxt;
#pragma unroll
            for (int i = 0; i < 32; ++i) v[i] = nv[i]; }
    }
    { const f32x4* x4 = (const f32x4*)A.in[0]; v4u* o = (v4u*)(ws + WS_A);
      const size_t n16 = (size_t)NTOK * DM / 16, stride = (size_t)F.G * NTHREADS;
      for (size_t i0 = (size_t)F.blk * NTHREADS + F.tid; i0 < n16; i0 += 4 * stride) {
          f32x4 a[4][4];
#pragma unroll
          for (int u = 0; u < 4; ++u) { const size_t i = i0 + u * stride; if (i < n16) {
#pragma unroll
              for (int q = 0; q < 4; ++q) a[u][q] = x4[4 * i + q]; } }
#pragma unroll
          for (int u = 0; u < 4; ++u) { const size_t i = i0 + u * stride; if (i < n16) { v4u w;
              w.x = pg8::pk4_i8(a[u][0].x, a[u][0].y, a[u][0].z, a[u][0].w, SA_X); w.y = pg8::pk4_i8(a[u][1].x, a[u][1].y, a[u][1].z, a[u][1].w, SA_X);
              w.z = pg8::pk4_i8(a[u][2].x, a[u][2].y, a[u][2].z, a[u][2].w, SA_X); w.w = pg8::pk4_i8(a[u][3].x, a[u][3].y, a[u][3].z, a[u][3].w, SA_X); o[i] = w; } } } }
    { bf16* GW = (bf16*)(ws + WS_GATEW);
      for (int i = F.blk * NTHREADS + F.tid; i < 2 * 2 * 8 * 64 * 64; i += F.G * NTHREADS) {
          const int d = i & 63, e = (i >> 6) & 63, n = (i >> 12) & 7, g = (i >> 15) & 1, l = i >> 16;
          const float v = (g ? A.in[8] : A.in[6])[(((size_t)l * 8 + n) * 64 + d) * 64 + e];
          GW[i] = (bf16)(pk2(v, v) & 0xffffu); } }
    if (F.blk == 0 && F.tid < 256) { float* LUT = (float*)(ws + WS_LUT); const int rel = F.tid - 191; const int bk = t5_bucket(rel);
#pragma unroll
        for (int h = 0; h < 8; ++h) LUT[h * 256 + F.tid] = A.in[1][bk * 8 + h] * LOG2E; }
}

template <int D> __device__ __forceinline__ float dpp_shr(float v, float idv) { return __builtin_bit_cast(float, __builtin_amdgcn_update_dpp(__builtin_bit_cast(int, idv), __builtin_bit_cast(int, v), 0x110 + D, 0xF, 0xF, false)); }
__device__ __forceinline__ float dpp_ror1(float v) { return __builtin_bit_cast(float, __builtin_amdgcn_update_dpp(0, __builtin_bit_cast(int, v), 0x121, 0xF, 0xF, false)); }
template <int D> __device__ __forceinline__ void scan_step(float& P, float& H) { const float P1 = dpp_shr<D>(P, 1.0f), H1 = dpp_shr<D>(H, 0.0f); H = P * H1 + H; P = P * P1; }
__device__ __forceinline__ void lru_tables(const Frame& F, const Args& A, int l) {
    LAS float* ct = (LAS float*)(F.lds + LDS_CTAB);
    const int ch = F.tid;
#pragma unroll
    for (int w = 0; w < 4; ++w) ct[w * 512 + ch] = A.in[4][(l * 4 + w) * LRUW + ch];
    ct[CT_CB + ch] = A.in[5][l * LRUW + ch]; ct[CT_BR + ch] = A.in[7][l * LRUW + ch]; ct[CT_BI + ch] = A.in[9][l * LRUW + ch];
    ct[CT_SP + ch] = 8.0f * log1pf(__expf(-A.in[10][l * LRUW + ch]));
}
struct LruNb { bf16x8 wr[2], wi[2]; v2u gb[4]; f32x4 hin; };
template <bool FINAL, int PART  >
__device__ __forceinline__ void lru_load_nb(LruNb& L, int nb, const bf16* Z, size_t row0, int n, int fr, int fq, const bf16* gwr, const bf16* gwi, const float* HinRow) {
    const int ch0 = 64 * n + 16 * nb + 4 * fq;
    if (PART & 1) {
#pragma unroll
        for (int ks = 0; ks < 2; ++ks) { L.wr[ks] = *(const bf16x8*)(gwr + (16 * nb + fr) * 64 + 32 * ks + 8 * fq); L.wi[ks] = *(const bf16x8*)(gwi + (16 * nb + fr) * 64 + 32 * ks + 8 * fq); }
    }
    if (FINAL && (PART & 2)) {
#pragma unroll
        for (int m = 0; m < 4; ++m) L.gb[m] = *(const v2u*)(Z + (row0 + 16 * m + fr) * INC + GBOFF + ch0);
        L.hin = *(const f32x4*)(HinRow + ch0);
    }
}
template <bool FINAL>
__device__ __forceinline__ void lru_tile(const bf16* Z, int b, int c, int n, int lane, const bf16* gwr, const bf16* gwi, const LAS float* ct,
                                         float* outP, float* outE, const float* Hin, LAS float* yl, bf16* HLg, bf16* PAg) {
    const int fr = lane & 15, fq = lane >> 4;
    const size_t seq0 = (size_t)b * SEQ, row0 = seq0 + (size_t)CHK * c;
    const float* HinRow = Hin + ((size_t)b * NCHUNK + c) * LRUW;
    LruNb cur, nxt;
    lru_load_nb<FINAL, 1>(cur, 0, Z, row0, n, fr, fq, gwr, gwi, HinRow);
    v4u xv[2][4][4];
    bf16x8 xa[4][2];
#define LRU_LOADXV(ks) do { _Pragma("unroll") for (int m = 0; m < 4; ++m) _Pragma("unroll") for (int w = 0; w < 4; ++w) { const int tt = CHK * c + 16 * m + fr + w - 3; \
        xv[ks][m][w] = *(const v4u*)(Z + (seq0 + (tt < 0 ? 0 : tt)) * INC + XBOFF + 64 * n + 32 * (ks) + 8 * fq); } } while (0)
#define LRU_CONV(ks) do { const int ch = 64 * n + 32 * (ks) + 8 * fq; float cw[4][8], cb[8]; \
        _Pragma("unroll") for (int w = 0; w < 4; ++w) { const f32x4 a = *(const LAS f32x4*)(ct + w * 512 + ch), bq = *(const LAS f32x4*)(ct + w * 512 + ch + 4); \
            cw[w][0] = a.x; cw[w][1] = a.y; cw[w][2] = a.z; cw[w][3] = a.w; cw[w][4] = bq.x; cw[w][5] = bq.y; cw[w][6] = bq.z; cw[w][7] = bq.w; } \
        { const f32x4 a = *(const LAS f32x4*)(ct + CT_CB + ch), bq = *(const LAS f32x4*)(ct + CT_CB + ch + 4); cb[0] = a.x; cb[1] = a.y; cb[2] = a.z; cb[3] = a.w; cb[4] = bq.x; cb[5] = bq.y; cb[6] = bq.z; cb[7] = bq.w; } \
        _Pragma("unroll") for (int m = 0; m < 4; ++m) { float a8[8]; \
            _Pragma("unroll") for (int j = 0; j < 8; ++j) a8[j] = cb[j]; \
            _Pragma("unroll") for (int w = 0; w < 4; ++w) { v4u v = xv[ks][m][w]; \
                if (c == 0 && m == 0 && w < 3) { if (fr + w - 3 < 0) v = (v4u){0u, 0u, 0u, 0u}; }     \
                a8[0] += cw[w][0] * bflo(v.x); a8[1] += cw[w][1] * bfhi(v.x); a8[2] += cw[w][2] * bflo(v.y); a8[3] += cw[w][3] * bfhi(v.y); \
                a8[4] += cw[w][4] * bflo(v.z); a8[5] += cw[w][5] * bfhi(v.z); a8[6] += cw[w][6] * bflo(v.w); a8[7] += cw[w][7] * bfhi(v.w); } \
            v4u p; p.x = pk2(a8[0], a8[1]); p.y = pk2(a8[2], a8[3]); p.z = pk2(a8[4], a8[5]); p.w = pk2(a8[6], a8[7]); \
            xa[m][ks] = __builtin_bit_cast(bf16x8, p); } } while (0)
    if (FINAL) {
        LRU_LOADXV(0); asm volatile("" ::: "memory"); LRU_CONV(0); asm volatile("" ::: "memory");
        LRU_LOADXV(1); asm volatile("" ::: "memory"); LRU_CONV(1);
    } else {
        LRU_LOADXV(0); LRU_LOADXV(1); asm volatile("" ::: "memory"); LRU_CONV(0); LRU_CONV(1);
    }
#undef LRU_LOADXV
#undef LRU_CONV
    lru_load_nb<FINAL, 2>(cur, 0, Z, row0, n, fr, fq, gwr, gwi, HinRow);
#pragma unroll 1
    for (int nb = 0; nb < 4; ++nb) {
        const int ch0 = 64 * n + 16 * nb + 4 * fq;
        if (nb < 3) lru_load_nb<FINAL, 1>(nxt, nb + 1, Z, row0, n, fr, fq, gwr, gwi, HinRow);
        if (nb > 0) lru_load_nb<FINAL, 2>(cur, nb, Z, row0, n, fr, fq, gwr, gwi, HinRow);
        asm volatile("" ::: "memory");
        bf16x8 idf[2];
#pragma unroll
        for (int ks = 0; ks < 2; ++ks)
#pragma unroll
            for (int j = 0; j < 8; ++j) idf[ks][j] = (32 * ks + 8 * fq + j == 16 * nb + fr) ? (short)0x3F80 : (short)0;
        const f32x4 brv = *(const LAS f32x4*)(ct + CT_BR + ch0), biv = *(const LAS f32x4*)(ct + CT_BI + ch0), spv = *(const LAS f32x4*)(ct + CT_SP + ch0);
        f32x4 dr[4], di[4], dx[4];
#pragma unroll
        for (int m = 0; m < 4; ++m) { dr[m] = (f32x4){0.f, 0.f, 0.f, 0.f}; di[m] = dr[m]; dx[m] = dr[m];
#pragma unroll
            for (int ks = 0; ks < 2; ++ks) {
                dr[m] = __builtin_amdgcn_mfma_f32_16x16x32_bf16(cur.wr[ks], xa[m][ks], dr[m], 0, 0, 0);
                di[m] = __builtin_amdgcn_mfma_f32_16x16x32_bf16(cur.wi[ks], xa[m][ks], di[m], 0, 0, 0);
                dx[m] = __builtin_amdgcn_mfma_f32_16x16x32_bf16(idf[ks], xa[m][ks], dx[m], 0, 0, 0); } }
        float cP[4], cH[4];
#pragma unroll
        for (int r = 0; r < 4; ++r) { cP[r] = 1.0f; cH[r] = FINAL ? cur.hin[r] : 0.0f; }
#pragma unroll
        for (int m = 0; m < 4; ++m) {
            float P[4], H[4];
#pragma unroll
            for (int r = 0; r < 4; ++r) {
                const float rg = fast_sigmoid(dr[m][r] + brv[r]), ig = fast_sigmoid(di[m][r] + biv[r]);
                const float la = -rg * spv[r];
                const float a = __builtin_amdgcn_exp2f(la * LOG2E);
                const float u = __builtin_amdgcn_sqrtf(fmaxf(1.0f - a * a, 0.f)) * (ig * dx[m][r]);
                P[r] = (fr == 0) ? a * cP[r] : a; H[r] = (fr == 0) ? a * cH[r] + u : u;
            }
#pragma unroll
            for (int r = 0; r < 4; ++r) { scan_step<1>(P[r], H[r]); scan_step<2>(P[r], H[r]); scan_step<4>(P[r], H[r]); scan_step<8>(P[r], H[r]); }
            if (!FINAL) {
                const size_t o = (row0 + 16 * m + fr) * LRUW + ch0;
                v2u wh, wp; wh.x = pk2(H[0], H[1]); wh.y = pk2(H[2], H[3]); wp.x = pk2(P[0], P[1]); wp.y = pk2(P[2], P[3]);
                *(v2u*)(HLg + o) = wh; *(v2u*)(PAg + o) = wp;
            }
            if (FINAL) {
                const v2u g = cur.gb[m];
                f32x4 y; y[0] = gelu_tanh(bflo(g.x)) * H[0]; y[1] = gelu_tanh(bfhi(g.x)) * H[1]; y[2] = gelu_tanh(bflo(g.y)) * H[2]; y[3] = gelu_tanh(bfhi(g.y)) * H[3];
                *(LAS f32x4*)(yl + (16 * m + fr) * LRUW + ch0) = y;
            }
#pragma unroll
            for (int r = 0; r < 4; ++r) { cP[r] = dpp_ror1(P[r]); cH[r] = dpp_ror1(H[r]); }
        }
        if (!FINAL) { if (fr == 0) { const size_t o = ((size_t)b * NCHUNK + c) * LRUW + ch0;
            *(f32x4*)(outP + o) = (f32x4){cP[0], cP[1], cP[2], cP[3]}; *(f32x4*)(outE + o) = (f32x4){cH[0], cH[1], cH[2], cH[3]}; } }
        cur.wr[0] = nxt.wr[0]; cur.wr[1] = nxt.wr[1]; cur.wi[0] = nxt.wi[0]; cur.wi[1] = nxt.wi[1];
    }
}

__device__ __forceinline__ void p_lru_summary(const Frame& F, const Args& A, int l, int nrep) {
    unsigned char* ws = A.ws;
    const bf16* Z = (const bf16*)(ws + WS_ZH);
    const bf16* GW = (const bf16*)(ws + WS_GATEW) + (size_t)l * 2 * 8 * 4096;
    lru_tables(F, A, l); __syncthreads();
    for (int it = F.blk; it < BATCH * NCHUNK * nrep; it += F.G) {
        const int b = (it >> 8) & 1, c = it & 255, n = F.wave;
        lru_tile<false>(Z, b, c, n, F.lane, GW + n * 4096, GW + 8 * 4096 + n * 4096, (const LAS float*)(F.lds + LDS_CTAB), (float*)(ws + WS_LRUP), (float*)(ws + WS_LRUE), (const float*)(ws + WS_HIN), nullptr, (bf16*)(ws + WS_HL), (bf16*)(ws + WS_PA));
    }
}
__device__ __forceinline__ void p_lru_carry(const Frame& F, const Args& A) {
    unsigned char* ws = A.ws;
    const float* Pg = (const float*)(ws + WS_LRUP); const float* Eg = (const float*)(ws + WS_LRUE); float* Hg = (float*)(ws + WS_HIN);
    const int gw = F.blk * NWAVES + F.wave, NGW = F.G * NWAVES;
    for (int p = gw; p < BATCH * LRUW; p += NGW) {
        const int b = p >> 9, ch = p & 511;
        float pk[4], ek[4];
#pragma unroll
        for (int k = 0; k < 4; ++k) { const size_t o = ((size_t)b * NCHUNK + 4 * F.lane + k) * LRUW + ch; pk[k] = Pg[o]; ek[k] = Eg[o]; }
        float P = pk[0], H = ek[0];
#pragma unroll
        for (int k = 1; k < 4; ++k) { H = pk[k] * H + ek[k]; P = pk[k] * P; }
#pragma unroll
        for (int d = 1; d < 64; d <<= 1) { const float P1 = __shfl_up(P, d), H1 = __shfl_up(H, d); if (F.lane >= d) { H = P * H1 + H; P = P * P1; } }
        float h = __shfl_up(H, 1); if (F.lane == 0) h = 0.f;
#pragma unroll
        for (int k = 0; k < 4; ++k) { Hg[((size_t)b * NCHUNK + 4 * F.lane + k) * LRUW + ch] = h; h = pk[k] * h + ek[k]; }
    }
}

__device__ __forceinline__ int crow(int r, int hi) { return (r & 3) + 8 * (r >> 2) + 4 * hi; }
__device__ __forceinline__ s16x4 vtr(const LAS unsigned char* p) { return __builtin_bit_cast(s16x4, __builtin_amdgcn_ds_read_tr16_b64_v4i16((LAS s16x4*)p)); }
__device__ __forceinline__ void p_mixer(const Frame& F, const Args& A, int l, int nrep) {
    unsigned char* ws = A.ws;
    const bf16* Z = (const bf16*)(ws + WS_ZH);
    unsigned char* Y8 = ws + WS_A;
    const bf16* GW = (const bf16*)(ws + WS_GATEW) + (size_t)l * 2 * 8 * 4096;
    LAS unsigned char* Kl = F.lds;
    LAS unsigned char* Vl = F.lds + 49152;
    LAS bf16* ya = (LAS bf16*)F.lds;
    LAS float* lut = (LAS float*)(F.lds + LDS_LUT);
    const int lane = F.lane, wave = F.wave, r32 = lane & 31, hi = lane >> 5;
    { const float* LUTg = (const float*)(ws + WS_LUT); for (int i = F.tid; i < 2048; i += NTHREADS) lut[i] = LUTg[i]; }
    const float sinkv = A.in[3][l * 8 + wave] * LOG2E;
    const int kvh = wave >> 2;
    for (int it = F.blk; it < BATCH * NCHUNK * nrep; it += F.G) {
        const int b = (it >> 8) & 1, c = it & 255;
        const size_t row0 = (size_t)b * SEQ + (size_t)CHK * c;
        const int T0 = (c >= 2) ? 0 : 2 - c;
        __syncthreads();
        v4u kq[2][3], vq[2][3];
#pragma unroll
        for (int h2 = 0; h2 < 2; ++h2)
#pragma unroll
            for (int T = 0; T < 3; ++T) {
                kq[h2][T] = (v4u){0u, 0u, 0u, 0u}; vq[h2][T] = kq[h2][T];
                if (T >= T0) { const size_t cr = row0 + (size_t)CHK * T - 2 * CHK;
                    kq[h2][T] = *(const v4u*)(Z + (cr + lane) * INC + KOFF + 64 * h2 + 8 * wave);
                    vq[h2][T] = *(const v4u*)(Z + (cr + 16 * (wave & 3) + (lane >> 2)) * INC + VOFF + 64 * h2 + 32 * (wave >> 2) + 8 * (lane & 3)); }
            }
        bf16x8 qall[2][4];
#pragma unroll
        for (int qb = 0; qb < 2; ++qb)
#pragma unroll
            for (int d0 = 0; d0 < 4; ++d0) qall[qb][d0] = *(const bf16x8*)(Z + (row0 + 32 * qb + r32) * INC + 64 * wave + 16 * d0 + 8 * hi);
        {   const float* hinr = (const float*)(ws + WS_HIN) + ((size_t)b * NCHUNK + c) * LRUW + 8 * lane;
            const f32x4 hi0 = *(const f32x4*)hinr, hi1 = *(const f32x4*)(hinr + 4);
            const bf16* HLg = (const bf16*)(ws + WS_HL); const bf16* PAg = (const bf16*)(ws + WS_PA);
            v4u vh[8], vp[8], vg[8];
#pragma unroll
            for (int i = 0; i < 8; ++i) { const size_t r = row0 + 8 * wave + i;
                vh[i] = *(const v4u*)(HLg + r * LRUW + 8 * lane); vp[i] = *(const v4u*)(PAg + r * LRUW + 8 * lane); vg[i] = *(const v4u*)(Z + r * INC + GBOFF + 8 * lane); }
            asm volatile("" ::: "memory");
#pragma unroll
            for (int i = 0; i < 8; ++i) { const size_t r = row0 + 8 * wave + i;
                float y[8];
                y[0] = gelu_tanh(bflo(vg[i].x)) * (bflo(vh[i].x) + bflo(vp[i].x) * hi0.x); y[1] = gelu_tanh(bfhi(vg[i].x)) * (bfhi(vh[i].x) + bfhi(vp[i].x) * hi0.y);
                y[2] = gelu_tanh(bflo(vg[i].y)) * (bflo(vh[i].y) + bflo(vp[i].y) * hi0.z); y[3] = gelu_tanh(bfhi(vg[i].y)) * (bfhi(vh[i].y) + bfhi(vp[i].y) * hi0.w);
                y[4] = gelu_tanh(bflo(vg[i].z)) * (bflo(vh[i].z) + bflo(vp[i].z) * hi1.x); y[5] = gelu_tanh(bfhi(vg[i].z)) * (bfhi(vh[i].z) + bfhi(vp[i].z) * hi1.y);
                y[6] = gelu_tanh(bflo(vg[i].w)) * (bflo(vh[i].w) + bflo(vp[i].w) * hi1.z); y[7] = gelu_tanh(bfhi(vg[i].w)) * (bfhi(vh[i].w) + bfhi(vp[i].w) * hi1.w);
                const float ss = wave_sum((y[0] * y[0] + y[1] * y[1]) + (y[2] * y[2] + y[3] * y[3]) + (y[4] * y[4] + y[5] * y[5]) + (y[6] * y[6] + y[7] * y[7]));
                const float rstd = 1.0f / sqrtf(ss * (1.0f / 512.0f) + RMS_EPS);
                v2u w; w.x = pg8::pk4_fp8(y[0] * rstd, y[1] * rstd, y[2] * rstd, y[3] * rstd); w.y = pg8::pk4_fp8(y[4] * rstd, y[5] * rstd, y[6] * rstd, y[7] * rstd);
                *(v2u*)(Y8 + r * DM + 512 + 8 * lane) = w; }
        }
#pragma unroll
        for (int h2 = 0; h2 < 2; ++h2)
#pragma unroll
            for (int T = 0; T < 3; ++T) {
                *(LAS v4u*)(Kl + (h2 * 3 + T) * 8192 + wave * 1024 + lane * 16) = kq[h2][T];
                *(LAS v4u*)(Vl + (h2 * 3 + T) * 8192 + wave * 1024 + lane * 16) = vq[h2][T];
            }
        __syncthreads();
        unsigned opk[2][2][8];
#pragma unroll
        for (int qb = 0; qb < 2; ++qb) {
            const int qi = 32 * qb + r32;
            bf16x8 qr[4];
#pragma unroll
            for (int d0 = 0; d0 < 4; ++d0) qr[d0] = qall[qb][d0];
            f32x16 s[3][2];
            const LAS float* lutq = lut + wave * 256 + 63 - qi;
#pragma unroll
            for (int T = 0; T < 3; ++T) {
#pragma unroll
                for (int hf = 0; hf < 2; ++hf)
#pragma unroll
                    for (int r = 0; r < 16; ++r) s[T][hf][r] = lutq[64 * T + 32 * hf + crow(r, hi)];
                const LAS unsigned char* kb = Kl + (kvh * 3 + T) * 8192 + hi * 1024 + r32 * 16;
#pragma unroll
                for (int d0 = 0; d0 < 4; ++d0) {
                    const bf16x8 b0 = *(const LAS bf16x8*)(kb + d0 * 2048), b1 = *(const LAS bf16x8*)(kb + d0 * 2048 + 512);
                    s[T][0] = __builtin_amdgcn_mfma_f32_32x32x16_bf16(b0, qr[d0], s[T][0], 0, 0, 0);
                    s[T][1] = __builtin_amdgcn_mfma_f32_32x32x16_bf16(b1, qr[d0], s[T][1], 0, 0, 0);
                }
                if (T < T0) {
#pragma unroll
                    for (int hf = 0; hf < 2; ++hf)
#pragma unroll
                        for (int r = 0; r < 16; ++r) s[T][hf][r] = -1e30f;
                }
            }
            float mx = sinkv;
#pragma unroll
            for (int T = 0; T < 3; ++T)
#pragma unroll
                for (int hf = 0; hf < 2; ++hf)
#pragma unroll
                    for (int r = 0; r < 16; ++r) mx = fmaxf(mx, s[T][hf][r]);
            mx = fmaxf(mx, __shfl_xor(mx, 32));
            float lsum = 0.f;
#pragma unroll
            for (int T = 0; T < 3; ++T)
#pragma unroll
                for (int hf = 0; hf < 2; ++hf)
#pragma unroll
                    for (int r = 0; r < 16; ++r) { const float p = __builtin_amdgcn_exp2f(s[T][hf][r] - mx); s[T][hf][r] = p; lsum += p; }
            lsum += __shfl_xor(lsum, 32);
            lsum += __builtin_amdgcn_exp2f(sinkv - mx);
            const float inv = 1.0f / lsum;
            f32x16 o[2]; o[0] = (f32x16){0.f, 0.f, 0.f, 0.f, 0.f, 0.f, 0.f, 0.f, 0.f, 0.f, 0.f, 0.f, 0.f, 0.f, 0.f, 0.f}; o[1] = o[0];
#pragma unroll
            for (int T = 0; T < 3; ++T) {
                v4u pw[4];
#pragma unroll
                for (int k = 0; k < 4; ++k) { const int hf = k >> 1, r0 = (k & 1) * 8;
                    pw[k].x = pk2(s[T][hf][r0 + 0], s[T][hf][r0 + 1]); pw[k].y = pk2(s[T][hf][r0 + 2], s[T][hf][r0 + 3]);
                    pw[k].z = pk2(s[T][hf][r0 + 4], s[T][hf][r0 + 5]); pw[k].w = pk2(s[T][hf][r0 + 6], s[T][hf][r0 + 7]); }
                const LAS unsigned char* vb = Vl + (kvh * 3 + T) * 8192 + ((lane >> 4) & 1) * 32 + (lane & 3) * 8 + (4 * hi + ((lane & 15) >> 2)) * 64;
#pragma unroll
                for (int d0 = 0; d0 < 2; ++d0)
#pragma unroll
                    for (int ks = 0; ks < 4; ++ks) {
                        const s16x4 lo = vtr(vb + d0 * 4096 + ks * 1024), hv = vtr(vb + d0 * 4096 + ks * 1024 + 512);
                        const bf16x8 vf = (bf16x8){lo[0], lo[1], lo[2], lo[3], hv[0], hv[1], hv[2], hv[3]};
                        o[d0] = __builtin_amdgcn_mfma_f32_32x32x16_bf16(vf, __builtin_bit_cast(bf16x8, pw[ks]), o[d0], 0, 0, 0);
                    }
            }
#pragma unroll
            for (int d0 = 0; d0 < 2; ++d0)
#pragma unroll
                for (int r = 0; r < 16; r += 2) opk[qb][d0][r >> 1] = pk2(o[d0][r] * inv, o[d0][r + 1] * inv);
        }
        __syncthreads();
#pragma unroll
        for (int qb = 0; qb < 2; ++qb)
#pragma unroll
            for (int d0 = 0; d0 < 2; ++d0)
#pragma unroll
                for (int g = 0; g < 4; ++g) { v2u w; w.x = opk[qb][d0][2 * g]; w.y = opk[qb][d0][2 * g + 1];
                    *(LAS v2u*)(ya + (32 * qb + r32) * 512 + 64 * wave + 32 * d0 + 8 * g + 4 * hi) = w; }
        __syncthreads();
#pragma unroll
        for (int i = 0; i < 8; ++i) { const int tok = 8 * wave + i;
            const v4u w0 = *(const LAS v4u*)(ya + tok * 512 + 8 * lane);
            const float x0 = bflo(w0.x), x1 = bfhi(w0.x), x2 = bflo(w0.y), x3 = bfhi(w0.y), x4 = bflo(w0.z), x5 = bfhi(w0.z), x6 = bflo(w0.w), x7 = bfhi(w0.w);
            const float ss = wave_sum((x0 * x0 + x1 * x1) + (x2 * x2 + x3 * x3) + (x4 * x4 + x5 * x5) + (x6 * x6 + x7 * x7));
            const float rstd = 1.0f / sqrtf(ss * (1.0f / 512.0f) + RMS_EPS);
            v2u w; w.x = pg8::pk4_fp8(x0 * rstd, x1 * rstd, x2 * rstd, x3 * rstd); w.y = pg8::pk4_fp8(x4 * rstd, x5 * rstd, x6 * rstd, x7 * rstd);
            *(v2u*)(Y8 + (row0 + tok) * DM + 8 * lane) = w; }
    }
}

struct LnRow { f32x4 x[2][2]; v4u xb[2]; v4u a[2], b[2]; };
template <int MODE, bool RES16>
__device__ __forceinline__ void ln_load_row(LnRow& L, const float* xres, const bf16* TB, const bf16* Y2, int m, int p0, int p1, int lane) {
#pragma unroll
    for (int j = 0; j < 2; ++j) {
        if (RES16) L.xb[j] = *(const v4u*)((const bf16*)xres + (size_t)m * DM + 8 * lane + 512 * j);
        else {
#pragma unroll
            for (int h = 0; h < 2; ++h) L.x[j][h] = *(const f32x4*)(xres + (size_t)m * DM + 8 * lane + 512 * j + 4 * h); }
        if (MODE != 2) L.a[j] = *(const v4u*)(TB + (size_t)m * DM + 8 * lane + 512 * j);
        else { L.a[j] = *(const v4u*)(Y2 + (size_t)p0 * DM + 8 * lane + 512 * j); L.b[j] = *(const v4u*)(Y2 + (size_t)p1 * DM + 8 * lane + 512 * j); }
    }
}
template <int MODE, bool RES16 = false, bool OUT16 = false>
__device__ __forceinline__ void p_layernorm(const Frame& F, const Args& A, const float* gam, const float* bet, const float* xres, bf16* xout = nullptr) {
    unsigned char* ws = A.ws;
    float* X = A.out;
    unsigned char* XB = ws + WS_A;
    const bf16* TB = (const bf16*)(ws + WS_TB);
    const bf16* Y2 = (const bf16*)(ws + WS_Y2);
    LAS unsigned* misc = (LAS unsigned*)(F.lds + LDS_MISC);
    const int lane = F.lane;
    LAS float* rwl = (LAS float*)F.lds;
    if (MODE == 1) { if (F.tid < 8) misc[F.tid] = 0u;
        for (int k = F.tid; k < DM; k += NTHREADS) { const f32x4 a = *(const f32x4*)(A.in[19] + k * 8), c = *(const f32x4*)(A.in[19] + k * 8 + 4);
            const int q = 8 * (k >> 9) + (k & 7), lk = (k & 511) >> 3; *(LAS f32x4*)(rwl + (q * 64 + lk) * 8) = a; *(LAS f32x4*)(rwl + (q * 64 + lk) * 8 + 4) = c; }
        __syncthreads(); }
    f32x4 gv[2][2], bv[2][2];
#pragma unroll
    for (int j = 0; j < 2; ++j)
#pragma unroll
        for (int h = 0; h < 2; ++h) { gv[j][h] = *(const f32x4*)(gam + 8 * lane + 512 * j + 4 * h); bv[j][h] = *(const f32x4*)(bet + 8 * lane + 512 * j + 4 * h); }
    const int rpw = NTOK / F.G, nt = rpw / NWAVES;
    const int m0 = F.blk * rpw + F.wave;
    int P0 = 0, P1 = 0; float W0 = 0.f, W1 = 0.f;
    if (MODE == 2) { if (lane < nt) { const int m = m0 + NWAVES * lane; P0 = ((const int*)(ws + WS_TOKPOS))[2 * m]; P1 = ((const int*)(ws + WS_TOKPOS))[2 * m + 1];
        W0 = ((const float*)(ws + WS_TOKW))[2 * m]; W1 = ((const float*)(ws + WS_TOKW))[2 * m + 1]; } }
    constexpr bool DEEP = (MODE != 1);
    LnRow cur[2], nxt[2], nx2[2];
#pragma unroll
    for (int r = 0; r < 2; ++r) ln_load_row<MODE, RES16>(cur[r], xres, TB, Y2, m0 + NWAVES * r, __shfl(P0, r), __shfl(P1, r), lane);
    if (DEEP) {
#pragma unroll
        for (int r = 0; r < 2; ++r) ln_load_row<MODE, RES16>(nxt[r], xres, TB, Y2, m0 + NWAVES * (2 + r), __shfl(P0, 2 + r), __shfl(P1, 2 + r), lane);
    }
    for (int t = 0; t < nt; t += 2) {
        if (DEEP) {
            if (t + 4 < nt) {
#pragma unroll
                for (int r = 0; r < 2; ++r) ln_load_row<MODE, RES16>(nx2[r], xres, TB, Y2, m0 + NWAVES * (t + 4 + r), __shfl(P0, t + 4 + r), __shfl(P1, t + 4 + r), lane);
            }
        } else if (t + 2 < nt) {
#pragma unroll
            for (int r = 0; r < 2; ++r) ln_load_row<MODE, RES16>(nxt[r], xres, TB, Y2, m0 + NWAVES * (t + 2 + r), __shfl(P0, t + 2 + r), __shfl(P1, t + 2 + r), lane);
        }
        asm volatile("" ::: "memory");
#pragma unroll
        for (int r = 0; r < 2; ++r) {
            const int m = m0 + NWAVES * (t + r);
            const LnRow& L = cur[r];
            float v[16];
            if (MODE != 2) {
#pragma unroll
                for (int j = 0; j < 2; ++j) { const v4u a = L.a[j]; f32x4 x0 = L.x[j][0], x1 = L.x[j][1];
                    if (RES16) { const v4u xw = L.xb[j]; x0 = (f32x4){bflo(xw.x), bfhi(xw.x), bflo(xw.y), bfhi(xw.y)}; x1 = (f32x4){bflo(xw.z), bfhi(xw.z), bflo(xw.w), bfhi(xw.w)}; }
                    v[8 * j + 0] = ALPHA * x0.x + bflo(a.x); v[8 * j + 1] = ALPHA * x0.y + bfhi(a.x); v[8 * j + 2] = ALPHA * x0.z + bflo(a.y); v[8 * j + 3] = ALPHA * x0.w + bfhi(a.y);
                    v[8 * j + 4] = ALPHA * x1.x + bflo(a.z); v[8 * j + 5] = ALPHA * x1.y + bfhi(a.z); v[8 * j + 6] = ALPHA * x1.z + bflo(a.w); v[8 * j + 7] = ALPHA * x1.w + bfhi(a.w); }
            } else {
                const float w0 = __shfl(W0, t + r), w1 = __shfl(W1, t + r);
#pragma unroll
                for (int j = 0; j < 2; ++j) { const v4u a = L.a[j], c = L.b[j]; const f32x4 x0 = L.x[j][0], x1 = L.x[j][1];
                    v[8 * j + 0] = ALPHA * x0.x + w0 * bflo(a.x) + w1 * bflo(c.x); v[8 * j + 1] = ALPHA * x0.y + w0 * bfhi(a.x) + w1 * bfhi(c.x);
                    v[8 * j + 2] = ALPHA * x0.z + w0 * bflo(a.y) + w1 * bflo(c.y); v[8 * j + 3] = ALPHA * x0.w + w0 * bfhi(a.y) + w1 * bfhi(c.y);
                    v[8 * j + 4] = ALPHA * x1.x + w0 * bflo(a.z) + w1 * bflo(c.z); v[8 * j + 5] = ALPHA * x1.y + w0 * bfhi(a.z) + w1 * bfhi(c.z);
                    v[8 * j + 6] = ALPHA * x1.z + w0 * bflo(a.w) + w1 * bflo(c.w); v[8 * j + 7] = ALPHA * x1.w + w0 * bfhi(a.w) + w1 * bfhi(c.w); }
            }
            float s = 0.f;
#pragma unroll
            for (int q = 0; q < 16; ++q) s += v[q];
            const float mean = wave_sum(s) * (1.f / DM); float s2 = 0.f;
#pragma unroll
            for (int q = 0; q < 16; ++q) { v[q] -= mean; s2 += v[q] * v[q]; }
            const float rstd = __builtin_amdgcn_rsqf(wave_sum(s2) * (1.f / DM) + LN_EPS);
#pragma unroll
            for (int j = 0; j < 2; ++j) {
#pragma unroll
                for (int h = 0; h < 2; ++h) { f32x4 o;
#pragma unroll
                    for (int e = 0; e < 4; ++e) { o[e] = v[8 * j + 4 * h + e] * rstd * gv[j][h][e] + bv[j][h][e]; v[8 * j + 4 * h + e] = o[e]; }
                    if (!OUT16) *(f32x4*)(X + (size_t)m * DM + 8 * lane + 512 * j + 4 * h) = o; }
                if (OUT16) { v4u w; w.x = pk2(v[8 * j], v[8 * j + 1]); w.y = pk2(v[8 * j + 2], v[8 * j + 3]); w.z = pk2(v[8 * j + 4], v[8 * j + 5]); w.w = pk2(v[8 * j + 6], v[8 * j + 7]);
                    *(v4u*)(xout + (size_t)m * DM + 8 * lane + 512 * j) = w; }
            }
            if (MODE == 3) {
#pragma unroll
                for (int j = 0; j < 2; ++j) { v2u w;
                    w.x = pg8::pk4_i8(v[8 * j], v[8 * j + 1], v[8 * j + 2], v[8 * j + 3], SA_X); w.y = pg8::pk4_i8(v[8 * j + 4], v[8 * j + 5], v[8 * j + 6], v[8 * j + 7], SA_X);
                    *(v2u*)(XB + (size_t)m * DM + 8 * lane + 512 * j) = w; }
            }
            if (MODE == 1) {
                float lg[8];
#pragma unroll
                for (int e = 0; e < 8; ++e) lg[e] = 0.f;
#pragma unroll
                for (int q = 0; q < 16; ++q) { const f32x4 a = *(const LAS f32x4*)(rwl + (q * 64 + lane) * 8), c = *(const LAS f32x4*)(rwl + (q * 64 + lane) * 8 + 4); const float xq = v[q];
                    lg[0] += xq * a.x; lg[1] += xq * a.y; lg[2] += xq * a.z; lg[3] += xq * a.w; lg[4] += xq * c.x; lg[5] += xq * c.y; lg[6] += xq * c.z; lg[7] += xq * c.w; }
#pragma unroll
                for (int e = 0; e < 8; ++e) lg[e] = wave_sum(lg[e]);
                int e0 = 0; float v0 = lg[0];
#pragma unroll
                for (int e = 1; e < 8; ++e) if (lg[e] > v0) { v0 = lg[e]; e0 = e; }
                int e1 = -1; float v1 = -3.0e38f;
#pragma unroll
                for (int e = 0; e < 8; ++e) if (e != e0 && lg[e] > v1) { v1 = lg[e]; e1 = e; }
                const float g0 = 1.0f / (1.0f + __expf(v1 - v0)), g1 = 1.0f - g0;
                if (lane == 0) { int* te = (int*)(ws + WS_TOKE) + 2 * m; float* tw = (float*)(ws + WS_TOKW) + 2 * m; te[0] = e0; te[1] = e1; tw[0] = g0; tw[1] = g1;
                    atomicAdd((unsigned*)(misc + e0), 1u); atomicAdd((unsigned*)(misc + e1), 1u); }
            }
        }
        if (t + 2 < nt) { cur[0] = nxt[0]; cur[1] = nxt[1]; if (DEEP) { nxt[0] = nx2[0]; nxt[1] = nx2[1]; } }
    }
    if (MODE == 1) { __syncthreads(); if (F.tid < 8) ((unsigned*)(ws + WS_HIST))[F.blk * 8 + F.tid] = misc[F.tid]; }
}

__device__ __forceinline__ void p_route(const Frame& F, const Args& A) {
    unsigned char* ws = A.ws;
    LAS unsigned* misc = (LAS unsigned*)(F.lds + LDS_MISC);
    LAS int* posl = (LAS int*)(F.lds + LDS_POS);
    const unsigned* hist = (const unsigned*)(ws + WS_HIST);
    const int lane = F.lane, rpw = NTOK / F.G;
    {
        const int e = F.wave; unsigned tot = 0u, bef = 0u;
        for (int v = lane; v < F.G; v += 64) { const unsigned h = hist[v * 8 + e]; tot += h; if (v < F.blk) bef += h; }
#pragma unroll
        for (int o = 1; o < 64; o <<= 1) { tot += __shfl_xor(tot, o); bef += __shfl_xor(bef, o); }
        if (lane == 0) { misc[16 + e] = tot; misc[24 + e] = bef; }
    }
    __syncthreads();
    int seg[9]; seg[0] = 0;
#pragma unroll
    for (int e = 0; e < 8; ++e) seg[e + 1] = seg[e] + (int)((misc[16 + e] + 255u) >> 8);
    if (F.blk == 0 && F.tid == 0) { int* meta = (int*)(ws + WS_META);
#pragma unroll
        for (int e = 0; e < 9; ++e) meta[e] = seg[e];
        meta[9] = seg[8]; }
    if (F.wave == 0) {
        const int* te = (const int*)(ws + WS_TOKE); int* tp = (int*)(ws + WS_TOKPOS); int* rt = nullptr; (void)rt;
        unsigned run[8];
#pragma unroll
        for (int e = 0; e < 8; ++e) run[e] = (unsigned)seg[e] * 256u + misc[24 + e];
        for (int h = 0; h < rpw; h += 64) {
            const int m = F.blk * rpw + h + lane;
#pragma unroll
            for (int k = 0; k < 2; ++k) {
                const int ek = te[2 * m + k]; int pos = 0;
#pragma unroll
                for (int e = 0; e < 8; ++e) { const unsigned long long mask = __ballot(ek == e);
                    if (ek == e) pos = (int)(run[e] + (unsigned)__popcll(mask & ((1ull << lane) - 1ull)));
                    run[e] += (unsigned)__popcll(mask); }
                tp[2 * m + k] = pos; posl[2 * (h + lane) + k] = pos;
            }
        }
    }
    __syncthreads();
    {
        const float* X = A.out; unsigned char* XS = ws + WS_XS;
        f32x4 cur[2][4], nxt[2][4];
#pragma unroll
        for (int r = 0; r < 2; ++r) { const f32x4* xr = (const f32x4*)(X + (size_t)(F.blk * rpw + F.wave + NWAVES * r) * DM) + 4 * lane;
#pragma unroll
            for (int q = 0; q < 4; ++q) cur[r][q] = xr[q]; }
        for (int i = F.wave; i < rpw; i += 2 * NWAVES) {
            const bool more = (i + 2 * NWAVES < rpw);
            if (more) {
#pragma unroll
                for (int r = 0; r < 2; ++r) { const f32x4* xr = (const f32x4*)(X + (size_t)(F.blk * rpw + i + NWAVES * (2 + r)) * DM) + 4 * lane;
#pragma unroll
                    for (int q = 0; q < 4; ++q) nxt[r][q] = xr[q]; }
            }
            asm volatile("" ::: "memory");
#pragma unroll
            for (int r = 0; r < 2; ++r) { const int ii = i + NWAVES * r; const int p0 = posl[2 * ii], p1 = posl[2 * ii + 1];
                v4u w; w.x = pg8::pk4_i8(cur[r][0].x, cur[r][0].y, cur[r][0].z, cur[r][0].w, SA_X); w.y = pg8::pk4_i8(cur[r][1].x, cur[r][1].y, cur[r][1].z, cur[r][1].w, SA_X);
                w.z = pg8::pk4_i8(cur[r][2].x, cur[r][2].y, cur[r][2].z, cur[r][2].w, SA_X); w.w = pg8::pk4_i8(cur[r][3].x, cur[r][3].y, cur[r][3].z, cur[r][3].w, SA_X);
                *((v4u*)(XS + (size_t)p0 * DM) + lane) = w; *((v4u*)(XS + (size_t)p1 * DM) + lane) = w; }
            if (more) {
#pragma unroll
                for (int r = 0; r < 2; ++r)
#pragma unroll
                    for (int q = 0; q < 4; ++q) cur[r][q] = nxt[r][q]; }
        }
    }
    if (F.blk < 8) {
        int r0 = 0, r1 = 0;
#pragma unroll
        for (int e = 0; e < 8; ++e) if (e == F.blk) { r0 = seg[e] * 256 + (int)misc[16 + e]; r1 = seg[e + 1] * 256; }
        v4u* XS4 = (v4u*)(ws + WS_XS);
        for (size_t i = (size_t)r0 * 64 + F.tid; i < (size_t)r1 * 64; i += NTHREADS) XS4[i] = (v4u){0u, 0u, 0u, 0u};
    }
}

#ifndef MK_ONE_LAUNCH
#define MK_ONE_LAUNCH 1
#endif
constexpr int PH_MOE = 17, PH_FINAL = PH_MOE + 2 * NPASS, NPHASES = PH_FINAL + 1;

#ifndef PH_MASK
#define PH_MASK 0xFFFFFFFFu
#endif
#ifndef DUP_MASK
#define DUP_MASK 0u
#endif
#define NREP(k) ((((unsigned)DUP_MASK >> (k)) & 1u) ? 2 : 1)
#define IN(k) (((PH_MASK >> (k)) & 1u) && lo <= (k) && (k) < hi)
#define SEAM(k) do { if (MK_ONE_LAUNCH && lo <= (k) && (k) + 1 < hi) xcd_barrier(bar); } while (0)
template <int l>
__device__ __forceinline__ void layer_phases(const Frame& F, const Args& args, const XcdBarrier& bar, const int lo, const int hi) {
    unsigned char* ws = args.ws;
        const int pb = 1 + 9 * l;
        const float* xres = (l == 0) ? args.in[0] : args.out;
        if (IN(pb + 0)) {
            pg8::Gemm g{(const bf16*)(ws + WS_A), (const bf16*)(ws + WS_WIN + (size_t)l * INC * DM), NTOK, INC, DM / 2, 0};
            pg8::StaticOrder S; S.init(NTOK, INC, F.G, F.blk, NREP(pb + 0));
            pg8::EpiBf16 E{(bf16*)(ws + WS_ZH), INC, 1.0f / (SA_X * SW_IN), QSCALE / (SA_X * SW_IN), 2};
            pg8::gemm_phase<pg8::EpiBf16, pg8::StaticOrder, true, true, 2>(F.lds, g, S, E);
            SEAM(pb + 0);
        }
        if (IN(pb + 1)) { p_lru_summary(F, args, l, NREP(pb + 1)); SEAM(pb + 1); }
        if (IN(pb + 2)) for (int rep_ = 0; rep_ < NREP(pb + 2); ++rep_) { p_lru_carry(F, args); SEAM(pb + 2); }
        if (IN(pb + 3)) { p_mixer(F, args, l, NREP(pb + 3)); SEAM(pb + 3); }
        if (IN(pb + 4)) {
            pg8::Gemm g{(const bf16*)(ws + WS_A), (const bf16*)(ws + WS_WOUT + (size_t)l * DM * DM), NTOK, DM, DM / 2, 0};
            pg8::StaticOrder S; S.init(NTOK, DM, F.G, F.blk, NREP(pb + 4));
            pg8::EpiBf16 E{(bf16*)(ws + WS_TB), DM, 1.0f / WSC_OUT, 1.0f / WSC_OUT, 0};
            pg8::gemm_phase<pg8::EpiBf16, pg8::StaticOrder, true, true, 1>(F.lds, g, S, E);
            SEAM(pb + 4);
        }
        if (l == 0) {
            if (IN(6)) for (int rep_ = 0; rep_ < NREP(6); ++rep_) { p_layernorm<3, false, true>(F, args, args.in[14], args.in[15], args.in[0], (bf16*)(ws + WS_XR)); SEAM(6); }
            if (IN(7)) {
                pg8::Gemm g{(const bf16*)(ws + WS_A), (const bf16*)(ws + WS_WGU), NTOK, 2 * DFF, DM / 2, 0};
                pg8::StaticOrder S; S.init(NTOK, 2 * DFF, F.G, F.blk, NREP(7));
                pg8::EpiSwiGLU8 E{ws + WS_ZH, DFF, 1.0f / (SA_X * SW_GU)};
                pg8::gemm_phase<pg8::EpiSwiGLU8, pg8::StaticOrder, true, true, 2>(F.lds, g, S, E);
                SEAM(7);
            }
            if (IN(8)) {
                pg8::Gemm g{(const bf16*)(ws + WS_ZH), (const bf16*)(ws + WS_WD), NTOK, DM, DFF / 2, 0};
                pg8::StaticOrder S; S.init(NTOK, DM, F.G, F.blk, NREP(8));
                pg8::EpiBf16 E{(bf16*)(ws + WS_TB), DM, 1.0f / WSC_D, 1.0f / WSC_D, 0};
                pg8::gemm_phase<pg8::EpiBf16, pg8::StaticOrder, true, true, 1>(F.lds, g, S, E);
                SEAM(8);
            }
            if (IN(9)) for (int rep_ = 0; rep_ < NREP(9); ++rep_) { p_layernorm<3, true, true>(F, args, args.in[23], args.in[24], (const float*)(ws + WS_XR), (bf16*)(ws + WS_XR)); SEAM(9); }
        } else {
            if (IN(15)) for (int rep_ = 0; rep_ < NREP(15); ++rep_) { p_layernorm<1, true, false>(F, args, args.in[14] + DM, args.in[15] + DM, (const float*)(ws + WS_XR)); SEAM(15); }
            if (IN(16)) for (int rep_ = 0; rep_ < NREP(16); ++rep_) { p_route(F, args); SEAM(16); }
            for (int p = 0; p < NPASS; ++p) {
                int s1 = 0, s2 = 0, s3 = 0, s4 = 0, s5 = 0, s6 = 0, s7 = 0, nt = 0;
                if (IN(PH_MOE + 2 * p) || IN(PH_MOE + 1 + 2 * p)) { const int* meta = (const int*)(ws + WS_META);
                    s1 = __builtin_amdgcn_readfirstlane(meta[1]); s2 = __builtin_amdgcn_readfirstlane(meta[2]); s3 = __builtin_amdgcn_readfirstlane(meta[3]); s4 = __builtin_amdgcn_readfirstlane(meta[4]);
                    s5 = __builtin_amdgcn_readfirstlane(meta[5]); s6 = __builtin_amdgcn_readfirstlane(meta[6]); s7 = __builtin_amdgcn_readfirstlane(meta[7]); nt = __builtin_amdgcn_readfirstlane(meta[9]); }
                int nm = nt - PASS_TILES * p; nm = nm > PASS_TILES ? PASS_TILES : nm;
                if (IN(PH_MOE + 2 * p)) {
                    if (nm > 0) {
                        pg8::Gemm g{(const bf16*)(ws + WS_XS + (size_t)p * PASS_TILES * 256 * DM), (const bf16*)(ws + WS_WEGU), nm * 256, 2 * DFE, DM / 2, (size_t)2 * DFE * DM};
                        pg8::MoeOrder S; S.so.init(nm * 256, 2 * DFE, F.G, F.blk, NREP(PH_MOE + 2 * p)); S.tile0 = p * PASS_TILES; S.s1 = s1; S.s2 = s2; S.s3 = s3; S.s4 = s4; S.s5 = s5; S.s6 = s6; S.s7 = s7;
                        pg8::EpiSwiGLU8 E{ws + WS_HM, DFE, 1.0f / (SA_X * SW_GU)};
                        pg8::gemm_phase<pg8::EpiSwiGLU8, pg8::MoeOrder, true, true, 2>(F.lds, g, S, E);
                    }
                    SEAM(PH_MOE + 2 * p);
                }
                if (IN(PH_MOE + 1 + 2 * p)) {
                    if (nm > 0) {
                        pg8::Gemm g{(const bf16*)(ws + WS_HM), (const bf16*)(ws + WS_WED), nm * 256, DM, DFE / 2, (size_t)DM * DFE};
                        pg8::MoeOrder S; S.so.init(nm * 256, DM, F.G, F.blk, NREP(PH_MOE + 1 + 2 * p)); S.tile0 = p * PASS_TILES; S.s1 = s1; S.s2 = s2; S.s3 = s3; S.s4 = s4; S.s5 = s5; S.s6 = s6; S.s7 = s7;
                        pg8::EpiBf16 E{(bf16*)(ws + WS_Y2) + (size_t)p * PASS_TILES * 256 * DM, DM, 1.0f / WSC_D, 1.0f / WSC_D, 0};
                        pg8::gemm_phase<pg8::EpiBf16, pg8::MoeOrder, true, true, 1>(F.lds, g, S, E);
                    }
                    SEAM(PH_MOE + 1 + 2 * p);
                }
            }
            if (IN(PH_FINAL)) for (int rep_ = 0; rep_ < NREP(PH_FINAL); ++rep_) { p_layernorm<2>(F, args, args.in[23] + DM, args.in[24] + DM, args.out); }
        }
}
__global__ void __launch_bounds__(NTHREADS, 2) fwd_kernel(Args args) {
    extern __shared__ __attribute__((aligned(16))) unsigned char lds_raw[];
    Frame F;
    F.lds = (LAS unsigned char*)lds_raw;
    F.tid = threadIdx.x; F.lane = F.tid & 63; F.wave = __builtin_amdgcn_readfirstlane(F.tid >> 6);
    F.G = gridDim.x; F.blk = blockIdx.x;
    unsigned char* ws = args.ws;
    volatile LAS unsigned* MISC = (volatile LAS unsigned*)(F.lds + LDS_MISC);
    if (F.tid < 64) MISC[F.tid] = 0u;
    __syncthreads();
    XcdBarrier bar; bar.bar = (unsigned*)(ws + WS_CTL) + CW_BAR; bar.x = 0; bar.st = nullptr;
    if (MK_ONE_LAUNCH) bar = xcd_barrier_post((unsigned*)(ws + WS_CTL) + CW_BAR, MISC + 8);
    const int lo = args.ph_lo, hi = args.ph_hi;

    if (IN(0)) for (int rep_ = 0; rep_ < NREP(0); ++rep_) { p0_prologue(F, args); SEAM(0); }

    layer_phases<0>(F, args, bar, lo, hi);
    layer_phases<1>(F, args, bar, lo, hi);
}

extern "C" void kernel_launch(void* const* d_in, const int* in_sizes, int n_in, void* d_out, int out_size, void* d_ws, size_t ws_size, hipStream_t stream) {
    static int grid = 0;
    if (grid == 0) {
        if (n_in != 25 || in_sizes[0] != NTOK * DM || out_size != NTOK * DM || ws_size < WS_END) {
            fprintf(stderr, "kernel_launch: unexpected problem: n_in %d in0 %d out %d ws %zu (need %zu)\n", n_in, n_in > 0 ? in_sizes[0] : -1, out_size, ws_size, (size_t)WS_END); grid = -1; return; }
        int dev = 0, cus = 0, per_cu = 0;
        if (hipGetDevice(&dev) != hipSuccess || hipDeviceGetAttribute(&cus, hipDeviceAttributeMultiprocessorCount, dev) != hipSuccess) { fprintf(stderr, "kernel_launch: device query failed\n"); grid = -1; return; }
        if (hipFuncSetAttribute((const void*)fwd_kernel, hipFuncAttributeMaxDynamicSharedMemorySize, LDS_BYTES) != hipSuccess) { fprintf(stderr, "kernel_launch: hipFuncSetAttribute failed\n"); grid = -1; return; }
        if (hipOccupancyMaxActiveBlocksPerMultiprocessor(&per_cu, (const void*)fwd_kernel, NTHREADS, LDS_BYTES) != hipSuccess || per_cu < 1)
            fprintf(stderr, "kernel_launch: note: occupancy query reports %d workgroups per CU\n", per_cu);
        (void)hipGetLastError();
        grid = cus;
        if (grid != 256) fprintf(stderr, "kernel_launch: note: %d CUs (built for 256)\n", grid);
        if (NTOK % grid != 0 || grid > 256) grid = 256;
    }
    if (grid < 0) return;
    (void)hipMemsetAsync((char*)d_ws + WS_CTL, 0, CTL_ZERO_BYTES, stream);
    Args a{};
    for (int i = 0; i < 25; ++i) a.in[i] = (const float*)d_in[i];
    a.out = (float*)d_out; a.ws = (unsigned char*)d_ws;
#if MK_ONE_LAUNCH
    a.ph_lo = 0; a.ph_hi = NPHASES;
    hipLaunchKernelGGL(fwd_kernel, dim3(grid), dim3(NTHREADS), LDS_BYTES, stream, a);
#else
    for (int k = 0; k < NPHASES; ++k) { a.ph_lo = k; a.ph_hi = k + 1; hipLaunchKernelGGL(fwd_kernel, dim3(grid), dim3(NTHREADS), LDS_BYTES, stream, a); }
#endif
    const hipError_t le = hipPeekAtLastError();
    if (le != hipSuccess) fprintf(stderr, "kernel_launch: launch failed: %s\n", hipGetErrorName(le));
}
```

```cpp
#include <hip/hip_runtime.h>
#include <cstdio>
#include <cstdint>
namespace pg8 {
#define PG8_LAS __attribute__((address_space(3)))
typedef unsigned short bf16_t;
typedef short bf16x8 __attribute__((ext_vector_type(8)));
typedef float f32x4 __attribute__((ext_vector_type(4)));
typedef unsigned u32x4 __attribute__((ext_vector_type(4)));
typedef int v4i __attribute__((ext_vector_type(4)));
typedef int v8i __attribute__((ext_vector_type(8)));
constexpr int BM = 256, BK = 64, HALF = 128, HTB = HALF * BK * 2  , STAGE_BYTES = 8 * HTB, NXCD = 8, WGM = 8;

__host__ __device__ __forceinline__ int lds_byte(int r, int c) { const int st = (r >> 4) * 2 + (c >> 5), rr = r & 15, cc = c & 31, ob = rr * 64 + cc * 2; return st * 1024 + (ob ^ (((ob >> 9) & 1) << 5)); }
__host__ __device__ __forceinline__ void stage_rc(int b, int& R, int& C) { const int st = b / 1024, sb = b % 1024, swz = sb ^ (((sb >> 9) & 1) << 5); R = (st >> 1) * 16 + swz / 64; C = (st & 1) * 32 + (swz % 64) / 2; }
__host__ __device__ __forceinline__ int perm32(int rho) { const int n = rho >> 4, i = rho & 15; return 8 * (i >> 2) + 4 * n + (i & 3); }

struct Unit { int pm, pn, be; };
struct Gemm { const bf16_t* A; const bf16_t* Bt; int M, N, K; size_t bstride; };

struct StaticOrder {
    int nM, nN, nwg, G, c, rep;
    __host__ __device__ void init(int M, int N, int G_, int c_, int rep_ = 1) { nM = M / BM; nN = N / BM; nwg = nM * nN; G = G_; c = c_; rep = rep_; }
    __host__ __device__ bool next(int i, Unit& u) const {
        const long L = (long)i * G + c; if (L >= (long)nwg * rep) return false;
        int wgid = (int)(L % nwg); { const int q = nwg / NXCD, r = nwg % NXCD, xcd = wgid % NXCD, off = wgid / NXCD; wgid = (xcd < r ? xcd * (q + 1) : r * (q + 1) + (xcd - r) * q) + off; }
        const int nig = WGM * nN, gid = wgid / nig, fm = gid * WGM, gsz = (nM - fm) < WGM ? (nM - fm) : WGM;
        u.pm = fm + ((wgid % nig) % gsz); u.pn = (wgid % nig) / gsz; u.be = 0; return true;
    }
    __device__ __forceinline__ void a_ready(const Unit&) const {}
    __device__ __forceinline__ void done(const Unit&) const {}
};
struct MoeOrder {
    StaticOrder so; int tile0, s1, s2, s3, s4, s5, s6, s7;
    __device__ __forceinline__ bool next(int i, Unit& u) const {
        if (!so.next(i, u)) return false;
        const int t = tile0 + u.pm;
        u.be = (t >= s1) + (t >= s2) + (t >= s3) + (t >= s4) + (t >= s5) + (t >= s6) + (t >= s7); return true;
    }
    __device__ __forceinline__ void a_ready(const Unit&) const {}
    __device__ __forceinline__ void done(const Unit&) const {}
};

__device__ __forceinline__ unsigned cvt_pk_bf16(float lo, float hi) { unsigned r; asm volatile("v_cvt_pk_bf16_f32 %0, %1, %2" : "=v"(r) : "v"(lo), "v"(hi)); return r; }

struct EpiBf16 {
    static constexpr bool PERM = true, AFTER_DRAIN = false;
    bf16_t* O; int ldc; float scale, scale0; int n0tiles;
    __device__ __forceinline__ void operator()(const f32x4 (&acc)[2][2][4][2], const Unit& u, int wr, int wc, int fr, int fq) const {
        const int row0 = u.pm * BM + wr * 64 + fr, col0 = u.pn * BM + wc * 32 + 8 * fq;
        const float sc = (u.pn < n0tiles) ? scale0 : scale;
#pragma unroll
        for (int ai = 0; ai < 2; ++ai)
#pragma unroll
            for (int m = 0; m < 4; ++m) { bf16_t* rowp = O + (size_t)(row0 + ai * HALF + m * 16) * ldc + col0;
#pragma unroll
                for (int bj = 0; bj < 2; ++bj) { const f32x4 v0 = acc[ai][bj][m][0] * sc, v1 = acc[ai][bj][m][1] * sc;
                    u32x4 w; w.x = cvt_pk_bf16(v0[0], v0[1]); w.y = cvt_pk_bf16(v0[2], v0[3]); w.z = cvt_pk_bf16(v1[0], v1[1]); w.w = cvt_pk_bf16(v1[2], v1[3]);
                    *(u32x4*)(rowp + bj * HALF) = w; } }
    }
};
__device__ __forceinline__ float silu_mul(float g, float u) { return g * u * __builtin_amdgcn_rcpf(1.0f + __builtin_amdgcn_exp2f(g * -1.4426950408889634f)); }
struct EpiSwiGLU {
    static constexpr bool PERM = true, AFTER_DRAIN = false;
    bf16_t* H; int ldh;
    __device__ __forceinline__ void operator()(const f32x4 (&acc)[2][2][4][2], const Unit& u, int wr, int wc, int fr, int fq) const {
        const int row0 = u.pm * BM + wr * 64 + fr, col0 = u.pn * HALF + wc * 32 + 8 * fq;
#pragma unroll
        for (int ai = 0; ai < 2; ++ai)
#pragma unroll
            for (int m = 0; m < 4; ++m) { bf16_t* rowp = H + (size_t)(row0 + ai * HALF + m * 16) * ldh + col0;
                const f32x4 g0 = acc[ai][0][m][0], g1 = acc[ai][0][m][1], u0 = acc[ai][1][m][0], u1 = acc[ai][1][m][1];
                u32x4 w; w.x = cvt_pk_bf16(silu_mul(g0[0], u0[0]), silu_mul(g0[1], u0[1])); w.y = cvt_pk_bf16(silu_mul(g0[2], u0[2]), silu_mul(g0[3], u0[3]));
                w.z = cvt_pk_bf16(silu_mul(g1[0], u1[0]), silu_mul(g1[1], u1[1])); w.w = cvt_pk_bf16(silu_mul(g1[2], u1[2]), silu_mul(g1[3], u1[3]));
                *(u32x4*)rowp = w; }
    }
};
__device__ __forceinline__ unsigned pk4_fp8(float a, float b, float c, float d) { int w = __builtin_amdgcn_cvt_pk_fp8_f32(a, b, 0, false); w = __builtin_amdgcn_cvt_pk_fp8_f32(c, d, w, true); return (unsigned)w; }
__device__ __forceinline__ unsigned pk4_i8(float a, float b, float c, float d, float s) {
    const int ia = __float2int_rn(fminf(fmaxf(a * s, -127.f), 127.f)), ib = __float2int_rn(fminf(fmaxf(b * s, -127.f), 127.f));
    const int ic = __float2int_rn(fminf(fmaxf(c * s, -127.f), 127.f)), id = __float2int_rn(fminf(fmaxf(d * s, -127.f), 127.f));
    return (unsigned)(ia & 255) | ((unsigned)(ib & 255) << 8) | ((unsigned)(ic & 255) << 16) | ((unsigned)id << 24);
}
struct EpiSwiGLU8 {
    static constexpr bool PERM = true, AFTER_DRAIN = false;
    unsigned char* H; int ldh; float sc;
    __device__ __forceinline__ void operator()(const f32x4 (&acc)[2][2][4][2], const Unit& u, int wr, int wc, int fr, int fq) const {
        const int row0 = u.pm * BM + wr * 64 + fr, col0 = u.pn * HALF + wc * 32 + 8 * fq;
        typedef unsigned u32x2 __attribute__((ext_vector_type(2)));
#pragma unroll
        for (int ai = 0; ai < 2; ++ai)
#pragma unroll
            for (int m = 0; m < 4; ++m) { unsigned char* rowp = H + (size_t)(row0 + ai * HALF + m * 16) * ldh + col0;
                const f32x4 g0 = acc[ai][0][m][0] * sc, g1 = acc[ai][0][m][1] * sc, u0 = acc[ai][1][m][0] * sc, u1 = acc[ai][1][m][1] * sc;
                u32x2 w; w.x = pk4_fp8(silu_mul(g0[0], u0[0]), silu_mul(g0[1], u0[1]), silu_mul(g0[2], u0[2]), silu_mul(g0[3], u0[3]));
                w.y = pk4_fp8(silu_mul(g1[0], u1[0]), silu_mul(g1[1], u1[1]), silu_mul(g1[2], u1[2]), silu_mul(g1[3], u1[3]));
                *(u32x2*)rowp = w; }
    }
};
struct EpiResBf16 {
    static constexpr bool PERM = true, AFTER_DRAIN = false;
    const float* res; bf16_t* out; int ldc; float alpha, scale;
    __device__ __forceinline__ void operator()(const f32x4 (&acc)[2][2][4][2], const Unit& u, int wr, int wc, int fr, int fq) const {
        const int row0 = u.pm * BM + wr * 64 + fr, col0 = u.pn * BM + wc * 32 + 8 * fq;
#pragma unroll
        for (int ai = 0; ai < 2; ++ai)
#pragma unroll
            for (int m = 0; m < 4; ++m) { const size_t off = (size_t)(row0 + ai * HALF + m * 16) * ldc + col0;
                f32x4 rv[2][2];
#pragma unroll
                for (int bj = 0; bj < 2; ++bj)
#pragma unroll
                    for (int n = 0; n < 2; ++n) rv[bj][n] = *(const f32x4*)(res + off + bj * HALF + n * 4);
#pragma unroll
                for (int bj = 0; bj < 2; ++bj) { const f32x4 v0 = rv[bj][0] * alpha + acc[ai][bj][m][0] * scale, v1 = rv[bj][1] * alpha + acc[ai][bj][m][1] * scale;
                    u32x4 w; w.x = cvt_pk_bf16(v0[0], v0[1]); w.y = cvt_pk_bf16(v0[2], v0[3]); w.z = cvt_pk_bf16(v1[0], v1[1]); w.w = cvt_pk_bf16(v1[2], v1[3]);
                    *(u32x4*)(out + off + bj * HALF) = w; }
                asm volatile("" ::: "memory"); }
    }
};
struct EpiResF32 {
    static constexpr bool PERM = false, AFTER_DRAIN = false;
    const float* res; float* out; int ldc; float alpha, scale;
    __device__ __forceinline__ void operator()(const f32x4 (&acc)[2][2][4][2], const Unit& u, int wr, int wc, int fr, int fq) const {
        const int row0 = u.pm * BM + wr * 64 + fr, col0 = u.pn * BM + wc * 32 + 4 * fq;
#pragma unroll
        for (int ai = 0; ai < 2; ++ai)
#pragma unroll
            for (int m = 0; m < 4; ++m) { const size_t off = (size_t)(row0 + ai * HALF + m * 16) * ldc + col0;
                f32x4 rv[2][2];
#pragma unroll
                for (int bj = 0; bj < 2; ++bj)
#pragma unroll
                    for (int n = 0; n < 2; ++n) rv[bj][n] = *(const f32x4*)(res + off + bj * HALF + n * 16);
#pragma unroll
                for (int bj = 0; bj < 2; ++bj)
#pragma unroll
                    for (int n = 0; n < 2; ++n) *(f32x4*)(out + off + bj * HALF + n * 16) = rv[bj][n] * alpha + acc[ai][bj][m][n] * scale;
                asm volatile("" ::: "memory"); }
    }
};

__device__ __forceinline__ void mfma8(f32x4& c, const v8i a, const v8i b, const int scl) { asm volatile("v_mfma_scale_f32_16x16x128_f8f6f4 %0, %1, %2, %0, %3, %3 op_sel_hi:[0,0,0]" : "+v"(c) : "v"(a), "v"(b), "v"(scl)); }
template <class Epi, class Sched, bool ALIGN_EPI = false, bool SP2 = false, int OPK = 0>
__device__ __forceinline__ void gemm_phase(PG8_LAS unsigned char* lds, const Gemm g, const Sched& S, const Epi& E) {
    const int tid = threadIdx.x, wid = __builtin_amdgcn_readfirstlane(tid >> 6), lane = tid & 63, wr = wid >> 2, wc = wid & 3, fr = lane & 15, fq = lane >> 4;
    const int K = g.K, nt = K / BK;
    unsigned voffA[2], voffB[2];
#pragma unroll
    for (int i = 0; i < 2; ++i) { int R, C; stage_rc(tid * 16 + i * 8192, R, C); const int Rb = Epi::PERM ? ((R & ~31) + perm32(R & 31)) : R;
        voffA[i] = (unsigned)(R * K + C) * 2u; voffB[i] = (unsigned)(Rb * K + C) * 2u; }
    const size_t kstep = (size_t)(BK * 2);
    const size_t hstep = (size_t)HALF * K * 2;
    const size_t tstep = 2 * hstep;
    const unsigned ldsw = (unsigned)wid * 1024u;
    const int aoff = lds_byte(wr * 64 + fr, fq * 8), boff = lds_byte(wc * 32 + fr, fq * 8);
#define PG8_SA(b, h) (((b) * 2 + (h)) * HTB)
#define PG8_SB(b, h) ((4 + (b) * 2 + (h)) * HTB)
#define PG8_STAGE(bufoff, gbase, voff) do { _Pragma("unroll") for (int _i = 0; _i < 2; ++_i) \
        __builtin_amdgcn_global_load_lds((const unsigned*)((const char*)(gbase) + (voff)[_i]), (PG8_LAS unsigned*)(lds + (bufoff) + ldsw + _i * 8192), 16, 0, 0); } while (0)
#define PG8_LDA(dst, b, h) do { if constexpr (OPK == 1) { _Pragma("unroll") for (int m = 0; m < 4; ++m) { dst##8[m][0] = *(const PG8_LAS v4i*)(lds + PG8_SA(b, h) + aoff + m * 2048); dst##8[m][1] = *(const PG8_LAS v4i*)(lds + PG8_SA(b, h) + aoff + m * 2048 + 1024); } } \
    else { _Pragma("unroll") for (int m = 0; m < 4; ++m) _Pragma("unroll") for (int k = 0; k < 2; ++k) dst[m][k] = *(const PG8_LAS bf16x8*)(lds + PG8_SA(b, h) + aoff + m * 2048 + k * 1024); } } while (0)
#define PG8_LDB(dst, b, h) do { if constexpr (OPK == 1) { _Pragma("unroll") for (int n = 0; n < 2; ++n) { dst##8[n][0] = *(const PG8_LAS v4i*)(lds + PG8_SB(b, h) + boff + n * 2048); dst##8[n][1] = *(const PG8_LAS v4i*)(lds + PG8_SB(b, h) + boff + n * 2048 + 1024); } } \
    else { _Pragma("unroll") for (int n = 0; n < 2; ++n) _Pragma("unroll") for (int k = 0; k < 2; ++k) dst[n][k] = *(const PG8_LAS bf16x8*)(lds + PG8_SB(b, h) + boff + n * 2048 + k * 1024); } } while (0)
#define PG8_MMA(ai, bj, At, Bt) do { __builtin_amdgcn_s_setprio(1); if constexpr (OPK == 1) { _Pragma("unroll") for (int m = 0; m < 4; ++m) _Pragma("unroll") for (int n = 0; n < 2; ++n) \
        mfma8(acc[ai][bj][m][n], __builtin_shufflevector(Bt##8[n][0], Bt##8[n][1], 0, 1, 2, 3, 4, 5, 6, 7), __builtin_shufflevector(At##8[m][0], At##8[m][1], 0, 1, 2, 3, 4, 5, 6, 7), scl8); } \
    else if constexpr (OPK == 2) { _Pragma("unroll") for (int m = 0; m < 4; ++m) _Pragma("unroll") for (int n = 0; n < 2; ++n) _Pragma("unroll") for (int k = 0; k < 2; ++k) \
        acc[ai][bj][m][n] = __builtin_bit_cast(f32x4, __builtin_amdgcn_mfma_i32_16x16x64_i8(__builtin_bit_cast(v4i, Bt[n][k]), __builtin_bit_cast(v4i, At[m][k]), __builtin_bit_cast(v4i, acc[ai][bj][m][n]), 0, 0, 0)); } \
    else { _Pragma("unroll") for (int m = 0; m < 4; ++m) _Pragma("unroll") for (int n = 0; n < 2; ++n) _Pragma("unroll") for (int k = 0; k < 2; ++k) \
        acc[ai][bj][m][n] = __builtin_amdgcn_mfma_f32_16x16x32_bf16(Bt[n][k], At[m][k], acc[ai][bj][m][n], 0, 0, 0); } __builtin_amdgcn_s_setprio(0); } while (0)
#define PG8_WAIT_V(n) asm volatile("s_waitcnt vmcnt(" #n ")" ::: "memory")
#define PG8_WAIT_L(n) asm volatile("s_waitcnt lgkmcnt(" #n ")" ::: "memory")
#define PG8_BAR __builtin_amdgcn_s_barrier()
#define PG8_SCHED __builtin_amdgcn_sched_barrier(0)
    Unit cur, nxt; int ui = 0;
    if (!S.next(0, cur)) return;
    f32x4 acc[2][2][4][2];
#pragma unroll
    for (int a = 0; a < 2; ++a)
#pragma unroll
        for (int b = 0; b < 2; ++b)
#pragma unroll
            for (int m = 0; m < 4; ++m)
#pragma unroll
                for (int n = 0; n < 2; ++n) acc[a][b][m][n] = (f32x4){0.f, 0.f, 0.f, 0.f};
    bf16x8 At[4][2], B0[2][2], B1[2][2];
    v4i At8[4][2], B08[2][2], B18[2][2];
    int scl8 = 0x7F7F7F7F; asm volatile("" : "+v"(scl8));
    const char* cA = (const char*)g.A + (size_t)cur.pm * tstep; const char* cB = (const char*)g.Bt + (size_t)cur.be * g.bstride + (size_t)cur.pn * tstep;
    S.a_ready(cur);
    if constexpr (SP2) {
        PG8_STAGE(PG8_SB(0, 0), cB, voffB); PG8_STAGE(PG8_SB(0, 1), cB + hstep, voffB); PG8_STAGE(PG8_SA(0, 0), cA, voffA); PG8_STAGE(PG8_SA(0, 1), cA + hstep, voffA);
        if (wr == 1) PG8_BAR;
        PG8_WAIT_V(2); PG8_BAR;
        PG8_STAGE(PG8_SB(1, 0), cB + kstep, voffB); PG8_STAGE(PG8_SA(1, 0), cA + kstep, voffA); PG8_STAGE(PG8_SB(1, 1), cB + hstep + kstep, voffB);
        PG8_WAIT_V(6); PG8_BAR;
    } else {
        PG8_STAGE(PG8_SB(0, 0), cB, voffB); PG8_STAGE(PG8_SA(0, 0), cA, voffA); PG8_STAGE(PG8_SB(0, 1), cB + hstep, voffB); PG8_STAGE(PG8_SA(0, 1), cA + hstep, voffA);
        if (wr == 1) PG8_BAR;
        PG8_WAIT_V(4); PG8_BAR;
        PG8_STAGE(PG8_SB(1, 0), cB + kstep, voffB); PG8_STAGE(PG8_SA(1, 0), cA + kstep, voffA); PG8_STAGE(PG8_SB(1, 1), cB + hstep + kstep, voffB);
        PG8_WAIT_V(6); PG8_BAR;
    }
    for (;;) {
        const bool has_next = S.next(ui + 1, nxt);
        const char* nA = has_next ? (const char*)g.A + (size_t)nxt.pm * tstep : cA; const char* nB = has_next ? (const char*)g.Bt + (size_t)nxt.be * g.bstride + (size_t)nxt.pn * tstep : cB;
#pragma unroll 1
        for (int t = 0; t < nt; t += 2) {
            const bool last = (t == nt - 2);
            const char* a1 = cA + (size_t)(t + 1) * kstep;
            const char* a2 = last ? nA : cA + (size_t)(t + 2) * kstep; const char* b2 = last ? nB : cB + (size_t)(t + 2) * kstep;
            const char* a3 = a2 + kstep; const char* b3 = b2 + kstep;
            if (last && has_next) S.a_ready(nxt);
            if constexpr (SP2) {
            PG8_LDB(B0, 0, 0); PG8_LDB(B1, 0, 1); PG8_SCHED; PG8_LDA(At, 0, 0); PG8_STAGE(PG8_SA(1, 1), a1 + hstep, voffA);
            PG8_WAIT_V(8); PG8_WAIT_L(0); PG8_BAR; PG8_MMA(0, 0, At, B0); PG8_MMA(0, 1, At, B1); PG8_BAR; PG8_SCHED;
            PG8_LDA(At, 0, 1); PG8_STAGE(PG8_SB(0, 0), b2, voffB); PG8_STAGE(PG8_SB(0, 1), b2 + hstep, voffB); PG8_STAGE(PG8_SA(0, 0), a2, voffA);
            PG8_WAIT_V(8); PG8_WAIT_L(0); PG8_BAR; PG8_MMA(1, 0, At, B0); PG8_MMA(1, 1, At, B1); PG8_BAR; PG8_SCHED;
            PG8_LDB(B0, 1, 0); PG8_LDB(B1, 1, 1); PG8_SCHED; PG8_LDA(At, 1, 0); PG8_STAGE(PG8_SA(0, 1), a2 + hstep, voffA);
            PG8_WAIT_V(8); PG8_WAIT_L(0); PG8_BAR; PG8_MMA(0, 0, At, B0); PG8_MMA(0, 1, At, B1); PG8_BAR; PG8_SCHED;
            PG8_LDA(At, 1, 1); PG8_STAGE(PG8_SB(1, 0), b3, voffB); PG8_STAGE(PG8_SB(1, 1), b3 + hstep, voffB); PG8_STAGE(PG8_SA(1, 0), a3, voffA);
            PG8_WAIT_V(8); PG8_WAIT_L(0); PG8_BAR; PG8_MMA(1, 0, At, B0); PG8_MMA(1, 1, At, B1); PG8_BAR; PG8_SCHED;
            } else {
            PG8_LDB(B0, 0, 0); PG8_SCHED; PG8_LDA(At, 0, 0); PG8_STAGE(PG8_SA(1, 1), a1 + hstep, voffA);
            PG8_WAIT_L(8); PG8_BAR; PG8_WAIT_L(0); PG8_MMA(0, 0, At, B0); PG8_BAR; PG8_SCHED;
            PG8_LDB(B1, 0, 1); PG8_STAGE(PG8_SB(0, 0), b2, voffB);
            PG8_BAR; PG8_WAIT_L(0); PG8_MMA(0, 1, At, B1); PG8_BAR;
            PG8_LDA(At, 0, 1); PG8_STAGE(PG8_SA(0, 0), a2, voffA);
            PG8_BAR; PG8_WAIT_L(0); PG8_MMA(1, 0, At, B0); PG8_BAR; PG8_SCHED;
            PG8_STAGE(PG8_SB(0, 1), b2 + hstep, voffB);
            PG8_WAIT_V(6); PG8_BAR; PG8_MMA(1, 1, At, B1); PG8_BAR;
            PG8_LDB(B0, 1, 0); PG8_SCHED; PG8_LDA(At, 1, 0); PG8_STAGE(PG8_SA(0, 1), a2 + hstep, voffA);
            PG8_WAIT_L(8); PG8_BAR; PG8_WAIT_L(0); PG8_MMA(0, 0, At, B0); PG8_BAR; PG8_SCHED;
            PG8_LDB(B1, 1, 1); PG8_STAGE(PG8_SB(1, 0), b3, voffB);
            PG8_BAR; PG8_WAIT_L(0); PG8_MMA(0, 1, At, B1); PG8_BAR;
            PG8_LDA(At, 1, 1); PG8_STAGE(PG8_SA(1, 0), a3, voffA);
            PG8_BAR; PG8_WAIT_L(0); PG8_MMA(1, 0, At, B0); PG8_BAR; PG8_SCHED;
            PG8_STAGE(PG8_SB(1, 1), b3 + hstep, voffB);
            PG8_WAIT_V(6); PG8_BAR; PG8_MMA(1, 1, At, B1); PG8_BAR;
            }
        }
        if constexpr (OPK == 1) asm volatile("s_nop 15\n\ts_nop 15" ::: "memory");
        if constexpr (OPK == 2) {
#pragma unroll
            for (int a = 0; a < 2; ++a)
#pragma unroll
                for (int b = 0; b < 2; ++b)
#pragma unroll
                    for (int m = 0; m < 4; ++m)
#pragma unroll
                        for (int n = 0; n < 2; ++n) { const v4i iv = __builtin_bit_cast(v4i, acc[a][b][m][n]); acc[a][b][m][n] = (f32x4){(float)iv[0], (float)iv[1], (float)iv[2], (float)iv[3]}; }
        }
        if constexpr (ALIGN_EPI) { if (wr == 0) PG8_BAR; }
        if constexpr (!Epi::AFTER_DRAIN) { E(acc, cur, wr, wc, fr, fq); S.done(cur); }
        if (!has_next) break;
#pragma unroll
        for (int a = 0; a < 2; ++a)
#pragma unroll
            for (int b = 0; b < 2; ++b)
#pragma unroll
                for (int m = 0; m < 4; ++m)
#pragma unroll
                    for (int n = 0; n < 2; ++n) acc[a][b][m][n] = (f32x4){0.f, 0.f, 0.f, 0.f};
        cur = nxt; cA = nA; cB = nB; ++ui;
        if constexpr (ALIGN_EPI) { if (wr == 1) PG8_BAR; }
    }
    PG8_WAIT_V(0);
    if constexpr (!ALIGN_EPI) { if (wr == 0) PG8_BAR; }
    PG8_BAR;
    if constexpr (Epi::AFTER_DRAIN) { E.fused(acc, cur, wr, wc, fr, fq, lds, wid, lane); S.done(cur); }
#undef PG8_SA
#undef PG8_SB
#undef PG8_STAGE
#undef PG8_LDA
#undef PG8_LDB
#undef PG8_MMA
#undef PG8_WAIT_V
#undef PG8_WAIT_L
#undef PG8_BAR
#undef PG8_SCHED
}
}

constexpr int BATCH = 2, SEQ = 16384, DM = 1024, NTOK = BATCH * SEQ;
constexpr int CHK = 64, NCHUNK = SEQ / CHK;
constexpr int INC = 1792, KOFF = 512, VOFF = 640, XBOFF = 768, GBOFF = 1280;
constexpr int LRUW = 512, DFF = 2816, DFE = 3584, NEXP = 8;
constexpr int MAXTILES = 264, PASS_TILES = 264, NPASS = 1;
constexpr float ALPHA = 1.41421356237309515f, LN_EPS = 1e-5f, RMS_EPS = 1e-6f, LOG2E = 1.4426950408889634f, QSCALE = 0.125f * LOG2E;
constexpr int NWAVES = 8, NTHREADS = 512;

constexpr size_t MiB = 1u << 20;
constexpr size_t WS_CTL = 0, CTL_ZERO_BYTES = 64 * 1024;
constexpr size_t WS_LUT = 1 * MiB;
constexpr size_t WS_GATEW = 1 * MiB + 64 * 1024;
constexpr size_t WS_HIST = 1 * MiB + 512 * 1024;
constexpr size_t WS_META = 1 * MiB + 576 * 1024;
constexpr size_t WS_TOKE = 2 * MiB, WS_TOKW = 2 * MiB + 256 * 1024, WS_TOKPOS = 2 * MiB + 512 * 1024;
constexpr size_t WS_LRUP = 3 * MiB, WS_LRUE = 4 * MiB, WS_HIN = 5 * MiB;
constexpr size_t WS_WEGU = 8 * MiB, WS_WED = 64 * MiB;
constexpr size_t WS_WIN = 92 * MiB, WS_WOUT = 99 * MiB, WS_WGU = 103 * MiB, WS_WD = 114 * MiB;
constexpr size_t WS_A = 120 * MiB;
constexpr size_t WS_TB = 152 * MiB;
constexpr size_t WS_ZH = 216 * MiB;
constexpr size_t WS_HL = 328 * MiB, WS_PA = 360 * MiB;
constexpr size_t WS_XR = 400 * MiB;
constexpr size_t WS_XS = 120 * MiB;
constexpr size_t WS_Y2 = 120 * MiB;
constexpr size_t WS_HM = 252 * MiB;
constexpr size_t WS_END = 483 * MiB;
constexpr float SA_X = 127.0f / 6.0f, SW_IN = 127.0f * 32.0f / 6.0f, SW_GU = 127.0f * 32.0f / 6.0f;
constexpr float WSC_OUT = 128.0f;
constexpr float WSC_D = 256.0f;
static_assert(WS_WED + (size_t)NEXP * DM * DFE <= WS_WIN && WS_WD + (size_t)DM * DFF * 2 <= WS_A && WS_A + (size_t)NTOK * DM <= WS_TB && WS_TB + (size_t)NTOK * DM * 2 <= WS_ZH && WS_ZH + (size_t)NTOK * DFF * 2 <= WS_END, "ws map");
static_assert(WS_ZH + (size_t)NTOK * INC * 2 <= WS_HL && WS_HL + (size_t)NTOK * LRUW * 2 <= WS_PA && WS_PA + (size_t)NTOK * LRUW * 2 <= WS_ZH + (size_t)NTOK * DFF * 2, "ws map (LRU)");
static_assert(WS_PA + (size_t)NTOK * LRUW * 2 <= WS_XR && WS_XR + (size_t)NTOK * DM * 2 <= WS_END, "ws map (residual)");
static_assert(NPASS == 1 && WS_XS == WS_Y2 && WS_Y2 + (size_t)MAXTILES * 256 * DM * 2 <= WS_HM && WS_HM + (size_t)PASS_TILES * 256 * DFE <= WS_END, "ws map (MoE)");
constexpr int CW_BAR = 0;

constexpr int RING_BYTES = 131072;
constexpr int LDS_LUT = RING_BYTES;
constexpr int LDS_CTAB = LDS_LUT + 8192;
constexpr int CT_CB = 4 * 512, CT_BR = 5 * 512, CT_BI = 6 * 512, CT_SP = 7 * 512;
constexpr int LDS_MISC = LDS_CTAB + 16384;
constexpr int LDS_POS = LDS_MISC + 256;
constexpr int LDS_BYTES = 159744;
static_assert(LDS_POS + 1024 <= LDS_BYTES, "LDS map");

#define GAS __attribute__((address_space(1)))
#define LAS __attribute__((address_space(3)))
typedef unsigned short bf16;
typedef unsigned v4u __attribute__((ext_vector_type(4)));
typedef unsigned v2u __attribute__((ext_vector_type(2)));
typedef float f32x4 __attribute__((ext_vector_type(4)));
typedef float f32x16 __attribute__((ext_vector_type(16)));
typedef short bf16x8 __attribute__((ext_vector_type(8)));
typedef short s16x4 __attribute__((ext_vector_type(4)));
#define LDS_WAIT() asm volatile("s_waitcnt lgkmcnt(0)" ::: "memory")
#define VM_WAIT() asm volatile("s_waitcnt vmcnt(0)" ::: "memory")
__device__ __forceinline__ unsigned pk2(float lo, float hi) { return pg8::cvt_pk_bf16(lo, hi); }
__device__ __forceinline__ float bf2f(unsigned short h) { return __uint_as_float((unsigned)h << 16); }
__device__ __forceinline__ float bflo(unsigned w) { return __uint_as_float(w << 16); }
__device__ __forceinline__ float bfhi(unsigned w) { return __uint_as_float(w & 0xffff0000u); }
__device__ __forceinline__ float wave_sum(float v) {
#pragma unroll
    for (int o = 1; o < 64; o <<= 1) v += __shfl_xor(v, o);
    return v;
}
__device__ __forceinline__ float fast_sigmoid(float x) { return __builtin_amdgcn_rcpf(1.0f + __builtin_amdgcn_exp2f(x * -LOG2E)); }
__device__ __forceinline__ float gelu_tanh(float x) {
    const float t = 1.5957691216057308f * (x + 0.044715f * x * x * x);
    return x * fast_sigmoid(t);
}

#define XB_TMO      128
#define XB_XCNT(j)  (256  + 64 * (j))
#define XB_XSUB(j)  (1280 + 64 * (j))
#define XB_XGEN(j)  (2304 + 64 * (j))
#define XB_TOP      3328
#define XB_TOPGEN   3392
#define XCD_BAR_WORDS 3456
#define XB_SPIN_CAP (1u << 18)

__device__ __forceinline__ unsigned xb_ld(unsigned* p)              { return __hip_atomic_load(p, __ATOMIC_RELAXED, __HIP_MEMORY_SCOPE_AGENT); }
__device__ __forceinline__ unsigned xb_add(unsigned* p, unsigned v) { return __hip_atomic_fetch_add(p, v, __ATOMIC_RELAXED, __HIP_MEMORY_SCOPE_AGENT); }
__device__ __forceinline__ unsigned xb_xcc_id() { return (unsigned)__builtin_amdgcn_s_getreg((3 << 11) | 20) & 0xFu; }
#define XB_SPIN(cond, bar) do { unsigned _sp = 0; while (cond) { __builtin_amdgcn_s_sleep(1); \
    if ((++_sp & 255u) == 0u) { if (xb_ld(&(bar)[XB_TMO])) break; if (_sp > XB_SPIN_CAP) { atomicAdd(&(bar)[XB_TMO], 1u); break; } } } } while (0)

struct XcdBarrier {
    unsigned* bar; unsigned x;
    volatile LAS unsigned* st;
};

__device__ __forceinline__ XcdBarrier xcd_barrier_post(unsigned* bar, volatile LAS unsigned* st) {
    XcdBarrier b; b.bar = bar; b.x = xb_xcc_id(); b.st = st;
    if (threadIdx.x == 0) (void)xb_add(&bar[XB_XCNT(b.x)], 1u);
    return b;
}
__device__ __forceinline__ void xcd_barrier_complete(unsigned* bar, unsigned x, unsigned& nloc, unsigned& nx) {
    const unsigned G = gridDim.x * gridDim.y * gridDim.z;
    unsigned sum, cnt, mine, sp = 0u;
    for (;;) {
        sum = 0u; cnt = 0u; mine = 0u;
#pragma unroll
        for (unsigned j = 0; j < 16; ++j) { const unsigned c = xb_ld(&bar[XB_XCNT(j)]); sum += c; cnt += (c > 0u) ? 1u : 0u; mine = (j == x) ? c : mine; }
        if (sum == G) break;
        __builtin_amdgcn_s_sleep(1);
        if ((++sp & 255u) == 0u) { if (xb_ld(&bar[XB_TMO])) break; if (sp > XB_SPIN_CAP) { atomicAdd(&bar[XB_TMO], 1u); break; } }
    }
    nloc = mine > 0u ? mine : 1u; nx = cnt > 0u ? cnt : 1u;
}

__device__ __forceinline__ void xcd_barrier(const XcdBarrier& b) {
    asm volatile("s_waitcnt vmcnt(0)" ::: "memory");
    __syncthreads();
    if (threadIdx.x == 0) {
        unsigned* bar = b.bar;
        __builtin_amdgcn_s_waitcnt(0);
        unsigned nloc = b.st[0], nx = b.st[1];
        if (nloc == 0u) { xcd_barrier_complete(bar, b.x, nloc, nx); b.st[0] = nloc; b.st[1] = nx; }
        const unsigned old = xb_add(&bar[XB_XSUB(b.x)], 1u);
        const unsigned gen = old / nloc;
        if (old + 1u == (gen + 1u) * nloc) {
            __builtin_amdgcn_fence(__ATOMIC_RELEASE, "agent");
            asm volatile("s_waitcnt vmcnt(0)" ::: "memory");
            const unsigned og = xb_add(&bar[XB_TOP], 1u);
            const unsigned tg = og / nx;
            if (og + 1u == (tg + 1u) * nx) xb_add(&bar[XB_TOPGEN], 1u);
            else XB_SPIN(xb_ld(&bar[XB_TOPGEN]) == tg, bar);
            __builtin_amdgcn_fence(__ATOMIC_ACQUIRE, "agent");
            xb_add(&bar[XB_XGEN(b.x)], 1u);
            asm volatile("s_waitcnt vmcnt(0)" ::: "memory");
        } else {
            XB_SPIN(xb_ld(&bar[XB_XGEN(b.x)]) == gen, bar);
            __builtin_amdgcn_fence(__ATOMIC_ACQUIRE, "agent");
            asm volatile("s_waitcnt vmcnt(0)" ::: "memory");
        }
    }
    __syncthreads();
}

struct Args { const float* in[25]; float* out; unsigned char* ws; int ph_lo, ph_hi; };
struct Frame {
    LAS unsigned char* lds;
    int tid, lane, wave, G, blk;
};

__device__ __forceinline__ void p0_transpose_item(const float* W, int K, int N, bf16* WT, int mode, const float* ksA, const float* ksB, float nscale, int nscale_cols, LAS float* scr, int item, int lane) {
    const int nblk = N / 32, kb = item / nblk, nb = item % nblk, k0 = 64 * kb, n0 = 32 * nb;
    const float* ks = ksA ? (k0 < 512 ? ksA + k0 : ksB + (k0 - 512)) : nullptr;
#pragma unroll
    for (int i = 0; i < 32; ++i) { const int kk = 2 * i + (lane >> 5); float v = W[(size_t)(k0 + kk) * N + n0 + (lane & 31)]; if (ks) v *= ks[kk]; scr[kk * 33 + (lane & 31)] = v; }
    LDS_WAIT(); asm volatile("" ::: "memory");
    const int drow0 = (mode == 0) ? n0 : ((n0 >> 7) * 256 + (n0 & 127) + (mode == 2 ? 128 : 0));
    const float sc = (n0 < nscale_cols) ? nscale : 1.0f;
    const int c = lane & 7;
#pragma unroll
    for (int j = 0; j < 4; ++j) { const int n = (lane >> 3) + 8 * j; const LAS float* s = scr + (8 * c) * 33 + n;
        v4u o; o.x = pk2(s[0 * 33] * sc, s[1 * 33] * sc); o.y = pk2(s[2 * 33] * sc, s[3 * 33] * sc); o.z = pk2(s[4 * 33] * sc, s[5 * 33] * sc); o.w = pk2(s[6 * 33] * sc, s[7 * 33] * sc);
        *(v4u*)(WT + (size_t)(drow0 + n) * K + k0 + 8 * c) = o; }
    LDS_WAIT(); asm volatile("" ::: "memory");
}
template <int KIND  >
__device__ __forceinline__ void p0_transpose_item_f8(const float* W, int K, int N, unsigned char* WT, int mode, float scale, LAS float* scr, int item, int lane, const float* ksA = nullptr, const float* ksB = nullptr, float nscale = 1.0f, int nscale_cols = 0) {
    const int nblk = N / 32, kb = item / nblk, nb = item % nblk, k0 = 64 * kb, n0 = 32 * nb;
    const float* ks = ksA ? (k0 < 512 ? ksA + k0 : ksB + (k0 - 512)) : nullptr;
    if (n0 < nscale_cols) scale *= nscale;
#pragma unroll
    for (int i = 0; i < 32; ++i) { const int kk = 2 * i + (lane >> 5); float v = W[(size_t)(k0 + kk) * N + n0 + (lane & 31)] * scale; if (ks) v *= ks[kk]; scr[kk * 33 + (lane & 31)] = v; }
    LDS_WAIT(); asm volatile("" ::: "memory");
    const int drow0 = (mode == 0) ? n0 : ((n0 >> 7) * 256 + (n0 & 127) + (mode == 2 ? 128 : 0));
    const int c = lane & 3;
#pragma unroll
    for (int j = 0; j < 2; ++j) { const int n = (lane >> 2) + 16 * j; const LAS float* s = scr + (16 * c) * 33 + n;
        v4u o;
        if (KIND == 1) { o.x = pg8::pk4_fp8(s[0 * 33], s[1 * 33], s[2 * 33], s[3 * 33]); o.y = pg8::pk4_fp8(s[4 * 33], s[5 * 33], s[6 * 33], s[7 * 33]);
            o.z = pg8::pk4_fp8(s[8 * 33], s[9 * 33], s[10 * 33], s[11 * 33]); o.w = pg8::pk4_fp8(s[12 * 33], s[13 * 33], s[14 * 33], s[15 * 33]); }
        else { o.x = pg8::pk4_i8(s[0 * 33], s[1 * 33], s[2 * 33], s[3 * 33], 1.0f); o.y = pg8::pk4_i8(s[4 * 33], s[5 * 33], s[6 * 33], s[7 * 33], 1.0f);
            o.z = pg8::pk4_i8(s[8 * 33], s[9 * 33], s[10 * 33], s[11 * 33], 1.0f); o.w = pg8::pk4_i8(s[12 * 33], s[13 * 33], s[14 * 33], s[15 * 33], 1.0f); }
        *(v4u*)(WT + (size_t)(drow0 + n) * K + k0 + 16 * c) = o; }
    LDS_WAIT(); asm volatile("" ::: "memory");
}
__device__ __forceinline__ int t5_bucket(int rel) {
    const int n = rel < 0 ? -rel : rel;
    int v;
    if (n < 8) v = n;
    else { v = 8 + (n >= 12) + (n >= 16) + (n >= 23) + (n >= 32) + (n >= 46) + (n >= 64) + (n >= 91); }
    return (rel > 0 ? 16 : 0) + v;
}
__device__ __forceinline__ void p0_prologue(const Frame& F, const Args& A) {
    unsigned char* ws = A.ws;
    LAS float* scr = (LAS float*)(F.lds + F.wave * 8448);
    const int gw = F.blk * NWAVES + F.wave, NGW = F.G * NWAVES;
    bf16* WIN = (bf16*)(ws + WS_WIN); bf16* WOUT = (bf16*)(ws + WS_WOUT); bf16* WGU = (bf16*)(ws + WS_WGU); bf16* WD = (bf16*)(ws + WS_WD);
    unsigned char* WEGU = ws + WS_WEGU; unsigned char* WED = ws + WS_WED;
    constexpr int T_IN = (DM / 128) * (INC / 128), T_OUT = (DM / 128) * (DM / 128), T_GU = (DM / 128) * (DFF / 128), T_D = (DFF / 128) * (DM / 128);
    constexpr int T_EGU = (DM / 128) * (DFE / 128), T_ED = (DFE / 128) * (DM / 128);
    constexpr int NITEMS = 2 * T_IN + 2 * T_OUT + 2 * T_GU + T_D + NEXP * (2 * T_EGU + T_ED);
    struct Item { const float* src; unsigned char* dst; const float* ks; int K, N, k0, n0, mode, kind; float scale; };
    auto decode = [&](int it, Item& d) {
        int r = it; d.ks = nullptr;
        if (r < 2 * T_IN) { const int l = r / T_IN; r -= l * T_IN; d.src = A.in[2] + (size_t)l * DM * INC; d.K = DM; d.N = INC; d.dst = (unsigned char*)WIN + (size_t)l * INC * DM; d.mode = 0; d.kind = 2; d.scale = SW_IN; }
        else if ((r -= 2 * T_IN) < 2 * T_OUT) { const int l = r / T_OUT; r -= l * T_OUT; d.src = A.in[13] + (size_t)l * DM * DM; d.K = DM; d.N = DM; d.dst = (unsigned char*)WOUT + (size_t)l * DM * DM; d.mode = 0; d.kind = 1; d.scale = WSC_OUT; d.ks = A.in[11] + l * 512; }
        else if ((r -= 2 * T_OUT) < T_GU) { d.src = A.in[16]; d.K = DM; d.N = DFF; d.dst = (unsigned char*)WGU; d.mode = 1; d.kind = 2; d.scale = SW_GU; }
        else if ((r -= T_GU) < T_GU) { d.src = A.in[17]; d.K = DM; d.N = DFF; d.dst = (unsigned char*)WGU; d.mode = 2; d.kind = 2; d.scale = SW_GU; }
        else if ((r -= T_GU) < T_D) { d.src = A.in[18]; d.K = DFF; d.N = DM; d.dst = (unsigned char*)WD; d.mode = 0; d.kind = 1; d.scale = WSC_D; }
        else { r -= T_D; constexpr int PER_E = 2 * T_EGU + T_ED; const int e = r / PER_E; r -= e * PER_E;
            if (r < T_EGU) { d.src = A.in[20] + (size_t)e * DM * DFE; d.K = DM; d.N = DFE; d.dst = WEGU + (size_t)e * 2 * DFE * DM; d.mode = 1; d.kind = 2; d.scale = SW_GU; }
            else if ((r -= T_EGU) < T_EGU) { d.src = A.in[21] + (size_t)e * DM * DFE; d.K = DM; d.N = DFE; d.dst = WEGU + (size_t)e * 2 * DFE * DM; d.mode = 2; d.kind = 2; d.scale = SW_GU; }
            else { r -= T_EGU; d.src = A.in[22] + (size_t)e * DFE * DM; d.K = DFE; d.N = DM; d.dst = WED + (size_t)e * DM * DFE; d.mode = 0; d.kind = 1; d.scale = WSC_D; } }
        const int nblk = d.N / 128; d.k0 = 128 * (r / nblk); d.n0 = 128 * (r % nblk);
        if (d.ks) d.ks = (d.k0 < 512) ? d.ks + d.k0 : (A.in[12] + (d.ks - A.in[11]) + (d.k0 - 512));
    };
    (void)scr; (void)gw; (void)NGW;
    LAS float* tile = (LAS float*)F.lds;
    const int lrow = F.tid >> 5, lcol = (F.tid & 31) * 4;
    f32x4 v[8], nv[8]; Item cur, nxt;
    int it = F.blk;
    if (it < NITEMS) { decode(it, cur);
#pragma unroll
        for (int i = 0; i < 8; ++i) v[i] = *(const f32x4*)(cur.src + (size_t)(cur.k0 + lrow + 16 * i) * cur.N + cur.n0 + lcol); }
    for (; it < NITEMS; it += F.G) {
        const bool more = it + F.G < NITEMS;
        if (more) { decode(it + F.G, nxt);
#pragma unroll
            for (int i = 0; i < 8; ++i) nv[i] = *(const f32x4*)(nxt.src + (size_t)(nxt.k0 + lrow + 16 * i) * nxt.N + nxt.n0 + lcol); }
        asm volatile("" ::: "memory");
#pragma unroll
        for (int i = 0; i < 8; ++i) { float sc = cur.scale; if (cur.ks) sc *= cur.ks[lrow + 16 * i]; *(LAS f32x4*)(tile + (lrow + 16 * i) * 132 + lcol) = v[i] * sc; }
        __syncthreads();
        {   const int drow0 = (cur.mode == 0) ? cur.n0 : ((cur.n0 >> 7) * 256 + (cur.mode == 2 ? 128 : 0));
#pragma unroll
            for (int j = 0; j < 2; ++j) { const int o = F.tid + 512 * j, n = o & 127, c = o >> 7;
                const LAS float* s = tile + (16 * c) * 132 + n;
                v4u w;
                if (cur.kind == 1) { w.x = pg8::pk4_fp8(s[0 * 132], s[1 * 132], s[2 * 132], s[3 * 132]); w.y = pg8::pk4_fp8(s[4 * 132], s[5 * 132], s[6 * 132], s[7 * 132]);
                    w.z = pg8::pk4_fp8(s[8 * 132], s[9 * 132], s[10 * 132], s[11 * 132]); w.w = pg8::pk4_fp8(s[12 * 132], s[13 * 132], s[14 * 132], s[15 * 132]); }
                else { w.x = pg8::pk4_i8(s[0 * 132], s[1 * 132], s[2 * 132], s[3 * 132], 1.0f); w.y = pg8::pk4_i8(s[4 * 132], s[5 * 132], s[6 * 132], s[7 * 132], 1.0f);
                    w.z = pg8::pk4_i8(s[8 * 132], s[9 * 132], s[10 * 132], s[11 * 132], 1.0f); w.w = pg8::pk4_i8(s[12 * 132], s[13 * 132], s[14 * 132], s[15 * 132], 1.0f); }
                *(v4u*)(cur.dst + (size_t)(drow0 + n) * cur.K + cur.k0 + 16 * c) = w; }
        }
        __syncthreads();
        if (more) { cur = nxt;
#pragma unroll
            for (int i = 0; i < 8; ++i) v[i] = nv[i]; }
    }
    { const f32x4* x4 = (const f32x4*)A.in[0]; v4u* o = (v4u*)(ws + WS_A);
      const size_t n16 = (size_t)NTOK * DM / 16, stride = (size_t)F.G * NTHREADS;
      for (size_t i0 = (size_t)F.blk * NTHREADS + F.tid; i0 < n16; i0 += 4 * stride) {
          f32x4 a[4][4];
#pragma unroll
          for (int u = 0; u < 4; ++u) { const size_t i = i0 + u * stride; if (i < n16) {
#pragma unroll
              for (int q = 0; q < 4; ++q) a[u][q] = x4[4 * i + q]; } }
#pragma unroll
          for (int u = 0; u < 4; ++u) { const size_t i = i0 + u * stride; if (i < n16) { v4u w;
              w.x = pg8::pk4_i8(a[u][0].x, a[u][0].y, a[u][0].z, a[u][0].w, SA_X); w.y = pg8::pk4_i8(a[u][1].x, a[u][1].y, a[u][1].z, a[u][1].w, SA_X);
              w.z = pg8::pk4_i8(a[u][2].x, a[u][2].y, a[u][2].z, a[u][2].w, SA_X); w.w = pg8::pk4_i8(a[u][3].x, a[u][3].y, a[u][3].z, a[u][3].w, SA_X); o[i] = w; } } } }
    { bf16* GW = (bf16*)(ws + WS_GATEW);
      for (int i = F.blk * NTHREADS + F.tid; i < 2 * 2 * 8 * 64 * 64; i += F.G * NTHREADS) {
          const int d = i & 63, e = (i >> 6) & 63, n = (i >> 12) & 7, g = (i >> 15) & 1, l = i >> 16;
          const float v = (g ? A.in[8] : A.in[6])[(((size_t)l * 8 + n) * 64 + d) * 64 + e];
          GW[i] = (bf16)(pk2(v, v) & 0xffffu); } }
    if (F.blk == 0 && F.tid < 256) { float* LUT = (float*)(ws + WS_LUT); const int rel = F.tid - 191; const int bk = t5_bucket(rel);
#pragma unroll
        for (int h = 0; h < 8; ++h) LUT[h * 256 + F.tid] = A.in[1][bk * 8 + h] * LOG2E; }
}

template <int D> __device__ __forceinline__ float dpp_shr(float v, float idv) { return __builtin_bit_cast(float, __builtin_amdgcn_update_dpp(__builtin_bit_cast(int, idv), __builtin_bit_cast(int, v), 0x110 + D, 0xF, 0xF, false)); }
__device__ __forceinline__ float dpp_ror1(float v) { return __builtin_bit_cast(float, __builtin_amdgcn_update_dpp(0, __builtin_bit_cast(int, v), 0x121, 0xF, 0xF, false)); }
template <int D> __device__ __forceinline__ void scan_step(float& P, float& H) { const float P1 = dpp_shr<D>(P, 1.0f), H1 = dpp_shr<D>(H, 0.0f); H = P * H1 + H; P = P * P1; }
__device__ __forceinline__ void lru_tables(const Frame& F, const Args& A, int l) {
    LAS float* ct = (LAS float*)(F.lds + LDS_CTAB);
    const int ch = F.tid;
#pragma unroll
    for (int w = 0; w < 4; ++w) ct[w * 512 + ch] = A.in[4][(l * 4 + w) * LRUW + ch];
    ct[CT_CB + ch] = A.in[5][l * LRUW + ch]; ct[CT_BR + ch] = A.in[7][l * LRUW + ch]; ct[CT_BI + ch] = A.in[9][l * LRUW + ch];
    ct[CT_SP + ch] = 8.0f * log1pf(__expf(-A.in[10][l * LRUW + ch]));
}
struct LruNb { bf16x8 wr[2], wi[2]; v2u gb[4]; f32x4 hin; };
template <bool FINAL, int PART  >
__device__ __forceinline__ void lru_load_nb(LruNb& L, int nb, const bf16* Z, size_t row0, int n, int fr, int fq, const bf16* gwr, const bf16* gwi, const float* HinRow) {
    const int ch0 = 64 * n + 16 * nb + 4 * fq;
    if (PART & 1) {
#pragma unroll
        for (int ks = 0; ks < 2; ++ks) { L.wr[ks] = *(const bf16x8*)(gwr + (16 * nb + fr) * 64 + 32 * ks + 8 * fq); L.wi[ks] = *(const bf16x8*)(gwi + (16 * nb + fr) * 64 + 32 * ks + 8 * fq); }
    }
    if (FINAL && (PART & 2)) {
#pragma unroll
        for (int m = 0; m < 4; ++m) L.gb[m] = *(const v2u*)(Z + (row0 + 16 * m + fr) * INC + GBOFF + ch0);
        L.hin = *(const f32x4*)(HinRow + ch0);
    }
}
template <bool FINAL>
__device__ __forceinline__ void lru_tile(const bf16* Z, int b, int c, int n, int lane, const bf16* gwr, const bf16* gwi, const LAS float* ct,
                                         float* outP, float* outE, const float* Hin, LAS float* yl, bf16* HLg, bf16* PAg) {
    const int fr = lane & 15, fq = lane >> 4;
    const size_t seq0 = (size_t)b * SEQ, row0 = seq0 + (size_t)CHK * c;
    const float* HinRow = Hin + ((size_t)b * NCHUNK + c) * LRUW;
    LruNb cur, nxt;
    lru_load_nb<FINAL, 1>(cur, 0, Z, row0, n, fr, fq, gwr, gwi, HinRow);
    v4u xv[2][4][4];
    bf16x8 xa[4][2];
#define LRU_LOADXV(ks) do { _Pragma("unroll") for (int m = 0; m < 4; ++m) _Pragma("unroll") for (int w = 0; w < 4; ++w) { const int tt = CHK * c + 16 * m + fr + w - 3; \
        xv[ks][m][w] = *(const v4u*)(Z + (seq0 + (tt < 0 ? 0 : tt)) * INC + XBOFF + 64 * n + 32 * (ks) + 8 * fq); } } while (0)
#define LRU_CONV(ks) do { const int ch = 64 * n + 32 * (ks) + 8 * fq; float cw[4][8], cb[8]; \
        _Pragma("unroll") for (int w = 0; w < 4; ++w) { const f32x4 a = *(const LAS f32x4*)(ct + w * 512 + ch), bq = *(const LAS f32x4*)(ct + w * 512 + ch + 4); \
            cw[w][0] = a.x; cw[w][1] = a.y; cw[w][2] = a.z; cw[w][3] = a.w; cw[w][4] = bq.x; cw[w][5] = bq.y; cw[w][6] = bq.z; cw[w][7] = bq.w; } \
        { const f32x4 a = *(const LAS f32x4*)(ct + CT_CB + ch), bq = *(const LAS f32x4*)(ct + CT_CB + ch + 4); cb[0] = a.x; cb[1] = a.y; cb[2] = a.z; cb[3] = a.w; cb[4] = bq.x; cb[5] = bq.y; cb[6] = bq.z; cb[7] = bq.w; } \
        _Pragma("unroll") for (int m = 0; m < 4; ++m) { float a8[8]; \
            _Pragma("unroll") for (int j = 0; j < 8; ++j) a8[j] = cb[j]; \
            _Pragma("unroll") for (int w = 0; w < 4; ++w) { v4u v = xv[ks][m][w]; \
                if (c == 0 && m == 0 && w < 3) { if (fr + w - 3 < 0) v = (v4u){0u, 0u, 0u, 0u}; }     \
                a8[0] += cw[w][0] * bflo(v.x); a8[1] += cw[w][1] * bfhi(v.x); a8[2] += cw[w][2] * bflo(v.y); a8[3] += cw[w][3] * bfhi(v.y); \
                a8[4] += cw[w][4] * bflo(v.z); a8[5] += cw[w][5] * bfhi(v.z); a8[6] += cw[w][6] * bflo(v.w); a8[7] += cw[w][7] * bfhi(v.w); } \
            v4u p; p.x = pk2(a8[0], a8[1]); p.y = pk2(a8[2], a8[3]); p.z = pk2(a8[4], a8[5]); p.w = pk2(a8[6], a8[7]); \
            xa[m][ks] = __builtin_bit_cast(bf16x8, p); } } while (0)
    if (FINAL) {
        LRU_LOADXV(0); asm volatile("" ::: "memory"); LRU_CONV(0); asm volatile("" ::: "memory");
        LRU_LOADXV(1); asm volatile("" ::: "memory"); LRU_CONV(1);
    } else {
        LRU_LOADXV(0); LRU_LOADXV(1); asm volatile("" ::: "memory"); LRU_CONV(0); LRU_CONV(1);
    }
#undef LRU_LOADXV
#undef LRU_CONV
    lru_load_nb<FINAL, 2>(cur, 0, Z, row0, n, fr, fq, gwr, gwi, HinRow);
#pragma unroll 1
    for (int nb = 0; nb < 4; ++nb) {
        const int ch0 = 64 * n + 16 * nb + 4 * fq;
        if (nb < 3) lru_load_nb<FINAL, 1>(nxt, nb + 1, Z, row0, n, fr, fq, gwr, gwi, HinRow);
        if (nb > 0) lru_load_nb<FINAL, 2>(cur, nb, Z, row0, n, fr, fq, gwr, gwi, HinRow);
        asm volatile("" ::: "memory");
        bf16x8 idf[2];
#pragma unroll
        for (int ks = 0; ks < 2; ++ks)
#pragma unroll
            for (int j = 0; j < 8; ++j) idf[ks][j] = (32 * ks + 8 * fq + j == 16 * nb + fr) ? (short)0x3F80 : (short)0;
        const f32x4 brv = *(const LAS f32x4*)(ct + CT_BR + ch0), biv = *(const LAS f32x4*)(ct + CT_BI + ch0), spv = *(const LAS f32x4*)(ct + CT_SP + ch0);
        f32x4 dr[4], di[4], dx[4];
#pragma unroll
        for (int m = 0; m < 4; ++m) { dr[m] = (f32x4){0.f, 0.f, 0.f, 0.f}; di[m] = dr[m]; dx[m] = dr[m];
#pragma unroll
            for (int ks = 0; ks < 2; ++ks) {
                dr[m] = __builtin_amdgcn_mfma_f32_16x16x32_bf16(cur.wr[ks], xa[m][ks], dr[m], 0, 0, 0);
                di[m] = __builtin_amdgcn_mfma_f32_16x16x32_bf16(cur.wi[ks], xa[m][ks], di[m], 0, 0, 0);
                dx[m] = __builtin_amdgcn_mfma_f32_16x16x32_bf16(idf[ks], xa[m][ks], dx[m], 0, 0, 0); } }
        float cP[4], cH[4];
#pragma unroll
        for (int r = 0; r < 4; ++r) { cP[r] = 1.0f; cH[r] = FINAL ? cur.hin[r] : 0.0f; }
#pragma unroll
        for (int m = 0; m < 4; ++m) {
            float P[4], H[4];
#pragma unroll
            for (int r = 0; r < 4; ++r) {
                const float rg = fast_sigmoid(dr[m][r] + brv[r]), ig = fast_sigmoid(di[m][r] + biv[r]);
                const float la = -rg * spv[r];
                const float a = __builtin_amdgcn_exp2f(la * LOG2E);
                const float u = __builtin_amdgcn_sqrtf(fmaxf(1.0f - a * a, 0.f)) * (ig * dx[m][r]);
                P[r] = (fr == 0) ? a * cP[r] : a; H[r] = (fr == 0) ? a * cH[r] + u : u;
            }
#pragma unroll
            for (int r = 0; r < 4; ++r) { scan_step<1>(P[r], H[r]); scan_step<2>(P[r], H[r]); scan_step<4>(P[r], H[r]); scan_step<8>(P[r], H[r]); }
            if (!FINAL) {
                const size_t o = (row0 + 16 * m + fr) * LRUW + ch0;
                v2u wh, wp; wh.x = pk2(H[0], H[1]); wh.y = pk2(H[2], H[3]); wp.x = pk2(P[0], P[1]); wp.y = pk2(P[2], P[3]);
                *(v2u*)(HLg + o) = wh; *(v2u*)(PAg + o) = wp;
            }
            if (FINAL) {
                const v2u g = cur.gb[m];
                f32x4 y; y[0] = gelu_tanh(bflo(g.x)) * H[0]; y[1] = gelu_tanh(bfhi(g.x)) * H[1]; y[2] = gelu_tanh(bflo(g.y)) * H[2]; y[3] = gelu_tanh(bfhi(g.y)) * H[3];
                *(LAS f32x4*)(yl + (16 * m + fr) * LRUW + ch0) = y;
            }
#pragma unroll
            for (int r = 0; r < 4; ++r) { cP[r] = dpp_ror1(P[r]); cH[r] = dpp_ror1(H[r]); }
        }
        if (!FINAL) { if (fr == 0) { const size_t o = ((size_t)b * NCHUNK + c) * LRUW + ch0;
            *(f32x4*)(outP + o) = (f32x4){cP[0], cP[1], cP[2], cP[3]}; *(f32x4*)(outE + o) = (f32x4){cH[0], cH[1], cH[2], cH[3]}; } }
        cur.wr[0] = nxt.wr[0]; cur.wr[1] = nxt.wr[1]; cur.wi[0] = nxt.wi[0]; cur.wi[1] = nxt.wi[1];
    }
}

__device__ __forceinline__ void p_lru_summary(const Frame& F, const Args& A, int l, int nrep) {
    unsigned char* ws = A.ws;
    const bf16* Z = (const bf16*)(ws + WS_ZH);
    const bf16* GW = (const bf16*)(ws + WS_GATEW) + (size_t)l * 2 * 8 * 4096;
    lru_tables(F, A, l); __syncthreads();
    for (int it = F.blk; it < BATCH * NCHUNK * nrep; it += F.G) {
        const int b = (it >> 8) & 1, c = it & 255, n = F.wave;
        lru_tile<false>(Z, b, c, n, F.lane, GW + n * 4096, GW + 8 * 4096 + n * 4096, (const LAS float*)(F.lds + LDS_CTAB), (float*)(ws + WS_LRUP), (float*)(ws + WS_LRUE), (const float*)(ws + WS_HIN), nullptr, (bf16*)(ws + WS_HL), (bf16*)(ws + WS_PA));
    }
}
__device__ __forceinline__ void p_lru_carry(const Frame& F, const Args& A) {
    unsigned char* ws = A.ws;
    const float* Pg = (const float*)(ws + WS_LRUP); const float* Eg = (const float*)(ws + WS_LRUE); float* Hg = (float*)(ws + WS_HIN);
    const int gw = F.blk * NWAVES + F.wave, NGW = F.G * NWAVES;
    for (int p = gw; p < BATCH * LRUW; p += NGW) {
        const int b = p >> 9, ch = p & 511;
        float pk[4], ek[4];
#pragma unroll
        for (int k = 0; k < 4; ++k) { const size_t o = ((size_t)b * NCHUNK + 4 * F.lane + k) * LRUW + ch; pk[k] = Pg[o]; ek[k] = Eg[o]; }
        float P = pk[0], H = ek[0];
#pragma unroll
        for (int k = 1; k < 4; ++k) { H = pk[k] * H + ek[k]; P = pk[k] * P; }
#pragma unroll
        for (int d = 1; d < 64; d <<= 1) { const float P1 = __shfl_up(P, d), H1 = __shfl_up(H, d); if (F.lane >= d) { H = P * H1 + H; P = P * P1; } }
        float h = __shfl_up(H, 1); if (F.lane == 0) h = 0.f;
#pragma unroll
        for (int k = 0; k < 4; ++k) { Hg[((size_t)b * NCHUNK + 4 * F.lane + k) * LRUW + ch] = h; h = pk[k] * h + ek[k]; }
    }
}

__device__ __forceinline__ int crow(int r, int hi) { return (r & 3) + 8 * (r >> 2) + 4 * hi; }
__device__ __forceinline__ s16x4 vtr(const LAS unsigned char* p) { return __builtin_bit_cast(s16x4, __builtin_amdgcn_ds_read_tr16_b64_v4i16((LAS s16x4*)p)); }
__device__ __forceinline__ void p_mixer(const Frame& F, const Args& A, int l, int nrep) {
    unsigned char* ws = A.ws;
    const bf16* Z = (const bf16*)(ws + WS_ZH);
    unsigned char* Y8 = ws + WS_A;
    const bf16* GW = (const bf16*)(ws + WS_GATEW) + (size_t)l * 2 * 8 * 4096;
    LAS unsigned char* Kl = F.lds;
    LAS unsigned char* Vl = F.lds + 49152;
    LAS bf16* ya = (LAS bf16*)F.lds;
    LAS float* lut = (LAS float*)(F.lds + LDS_LUT);
    const int lane = F.lane, wave = F.wave, r32 = lane & 31, hi = lane >> 5;
    { const float* LUTg = (const float*)(ws + WS_LUT); for (int i = F.tid; i < 2048; i += NTHREADS) lut[i] = LUTg[i]; }
    const float sinkv = A.in[3][l * 8 + wave] * LOG2E;
    const int kvh = wave >> 2;
    for (int it = F.blk; it < BATCH * NCHUNK * nrep; it += F.G) {
        const int b = (it >> 8) & 1, c = it & 255;
        const size_t row0 = (size_t)b * SEQ + (size_t)CHK * c;
        const int T0 = (c >= 2) ? 0 : 2 - c;
        __syncthreads();
        v4u kq[2][3], vq[2][3];
#pragma unroll
        for (int h2 = 0; h2 < 2; ++h2)
#pragma unroll
            for (int T = 0; T < 3; ++T) {
                kq[h2][T] = (v4u){0u, 0u, 0u, 0u}; vq[h2][T] = kq[h2][T];
                if (T >= T0) { const size_t cr = row0 + (size_t)CHK * T - 2 * CHK;
                    kq[h2][T] = *(const v4u*)(Z + (cr + lane) * INC + KOFF + 64 * h2 + 8 * wave);
                    vq[h2][T] = *(const v4u*)(Z + (cr + 16 * (wave & 3) + (lane >> 2)) * INC + VOFF + 64 * h2 + 32 * (wave >> 2) + 8 * (lane & 3)); }
            }
        bf16x8 qall[2][4];
#pragma unroll
        for (int qb = 0; qb < 2; ++qb)
#pragma unroll
            for (int d0 = 0; d0 < 4; ++d0) qall[qb][d0] = *(const bf16x8*)(Z + (row0 + 32 * qb + r32) * INC + 64 * wave + 16 * d0 + 8 * hi);
        {   const float* hinr = (const float*)(ws + WS_HIN) + ((size_t)b * NCHUNK + c) * LRUW + 8 * lane;
            const f32x4 hi0 = *(const f32x4*)hinr, hi1 = *(const f32x4*)(hinr + 4);
            const bf16* HLg = (const bf16*)(ws + WS_HL); const bf16* PAg = (const bf16*)(ws + WS_PA);
            v4u vh[8], vp[8], vg[8];
#pragma unroll
            for (int i = 0; i < 8; ++i) { const size_t r = row0 + 8 * wave + i;
                vh[i] = *(const v4u*)(HLg + r * LRUW + 8 * lane); vp[i] = *(const v4u*)(PAg + r * LRUW + 8 * lane); vg[i] = *(const v4u*)(Z + r * INC + GBOFF + 8 * lane); }
            asm volatile("" ::: "memory");
#pragma unroll
            for (int i = 0; i < 8; ++i) { const size_t r = row0 + 8 * wave + i;
                float y[8];
                y[0] = gelu_tanh(bflo(vg[i].x)) * (bflo(vh[i].x) + bflo(vp[i].x) * hi0.x); y[1] = gelu_tanh(bfhi(vg[i].x)) * (bfhi(vh[i].x) + bfhi(vp[i].x) * hi0.y);
                y[2] = gelu_tanh(bflo(vg[i].y)) * (bflo(vh[i].y) + bflo(vp[i].y) * hi0.z); y[3] = gelu_tanh(bfhi(vg[i].y)) * (bfhi(vh[i].y) + bfhi(vp[i].y) * hi0.w);
                y[4] = gelu_tanh(bflo(vg[i].z)) * (bflo(vh[i].z) + bflo(vp[i].z) * hi1.x); y[5] = gelu_tanh(bfhi(vg[i].z)) * (bfhi(vh[i].z) + bfhi(vp[i].z) * hi1.y);
                y[6] = gelu_tanh(bflo(vg[i].w)) * (bflo(vh[i].w) + bflo(vp[i].w) * hi1.z); y[7] = gelu_tanh(bfhi(vg[i].w)) * (bfhi(vh[i].w) + bfhi(vp[i].w) * hi1.w);
                const float ss = wave_sum((y[0] * y[0] + y[1] * y[1]) + (y[2] * y[2] + y[3] * y[3]) + (y[4] * y[4] + y[5] * y[5]) + (y[6] * y[6] + y[7] * y[7]));
                const float rstd = 1.0f / sqrtf(ss * (1.0f / 512.0f) + RMS_EPS);
                v2u w; w.x = pg8::pk4_fp8(y[0] * rstd, y[1] * rstd, y[2] * rstd, y[3] * rstd); w.y = pg8::pk4_fp8(y[4] * rstd, y[5] * rstd, y[6] * rstd, y[7] * rstd);
                *(v2u*)(Y8 + r * DM + 512 + 8 * lane) = w; }
        }
#pragma unroll
        for (int h2 = 0; h2 < 2; ++h2)
#pragma unroll
            for (int T = 0; T < 3; ++T) {
                *(LAS v4u*)(Kl + (h2 * 3 + T) * 8192 + wave * 1024 + lane * 16) = kq[h2][T];
                *(LAS v4u*)(Vl + (h2 * 3 + T) * 8192 + wave * 1024 + lane * 16) = vq[h2][T];
            }
        __syncthreads();
        unsigned opk[2][2][8];
#pragma unroll
        for (int qb = 0; qb < 2; ++qb) {
            const int qi = 32 * qb + r32;
            bf16x8 qr[4];
#pragma unroll
            for (int d0 = 0; d0 < 4; ++d0) qr[d0] = qall[qb][d0];
            f32x16 s[3][2];
            const LAS float* lutq = lut + wave * 256 + 63 - qi;
#pragma unroll
            for (int T = 0; T < 3; ++T) {
#pragma unroll
                for (int hf = 0; hf < 2; ++hf)
#pragma unroll
                    for (int r = 0; r < 16; ++r) s[T][hf][r] = lutq[64 * T + 32 * hf + crow(r, hi)];
                const LAS unsigned char* kb = Kl + (kvh * 3 + T) * 8192 + hi * 1024 + r32 * 16;
#pragma unroll
                for (int d0 = 0; d0 < 4; ++d0) {
                    const bf16x8 b0 = *(const LAS bf16x8*)(kb + d0 * 2048), b1 = *(const LAS bf16x8*)(kb + d0 * 2048 + 512);
                    s[T][0] = __builtin_amdgcn_mfma_f32_32x32x16_bf16(b0, qr[d0], s[T][0], 0, 0, 0);
                    s[T][1] = __builtin_amdgcn_mfma_f32_32x32x16_bf16(b1, qr[d0], s[T][1], 0, 0, 0);
                }
                if (T < T0) {
#pragma unroll
                    for (int hf = 0; hf < 2; ++hf)
#pragma unroll
                        for (int r = 0; r < 16; ++r) s[T][hf][r] = -1e30f;
                }
            }
            float mx = sinkv;
#pragma unroll
            for (int T = 0; T < 3; ++T)
#pragma unroll
                for (int hf = 0; hf < 2; ++hf)
#pragma unroll
                    for (int r = 0; r < 16; ++r) mx = fmaxf(mx, s[T][hf][r]);
            mx = fmaxf(mx, __shfl_xor(mx, 32));
            float lsum = 0.f;
#pragma unroll
            for (int T = 0; T < 3; ++T)
#pragma unroll
                for (int hf = 0; hf < 2; ++hf)
#pragma unroll
                    for (int r = 0; r < 16; ++r) { const float p = __builtin_amdgcn_exp2f(s[T][hf][r] - mx); s[T][hf][r] = p; lsum += p; }
            lsum += __shfl_xor(lsum, 32);
            lsum += __builtin_amdgcn_exp2f(sinkv - mx);
            const float inv = 1.0f / lsum;
            f32x16 o[2]; o[0] = (f32x16){0.f, 0.f, 0.f, 0.f, 0.f, 0.f, 0.f, 0.f, 0.f, 0.f, 0.f, 0.f, 0.f, 0.f, 0.f, 0.f}; o[1] = o[0];
#pragma unroll
            for (int T = 0; T < 3; ++T) {
                v4u pw[4];
#pragma unroll
                for (int k = 0; k < 4; ++k) { const int hf = k >> 1, r0 = (k & 1) * 8;
                    pw[k].x = pk2(s[T][hf][r0 + 0], s[T][hf][r0 + 1]); pw[k].y = pk2(s[T][hf][r0 + 2], s[T][hf][r0 + 3]);
                    pw[k].z = pk2(s[T][hf][r0 + 4], s[T][hf][r0 + 5]); pw[k].w = pk2(s[T][hf][r0 + 6], s[T][hf][r0 + 7]); }
                const LAS unsigned char* vb = Vl + (kvh * 3 + T) * 8192 + ((lane >> 4) & 1) * 32 + (lane & 3) * 8 + (4 * hi + ((lane & 15) >> 2)) * 64;
#pragma unroll
                for (int d0 = 0; d0 < 2; ++d0)
#pragma unroll
                    for (int ks = 0; ks < 4; ++ks) {
                        const s16x4 lo = vtr(vb + d0 * 4096 + ks * 1024), hv = vtr(vb + d0 * 4096 + ks * 1024 + 512);
                        const bf16x8 vf = (bf16x8){lo[0], lo[1], lo[2], lo[3], hv[0], hv[1], hv[2], hv[3]};
                        o[d0] = __builtin_amdgcn_mfma_f32_32x32x16_bf16(vf, __builtin_bit_cast(bf16x8, pw[ks]), o[d0], 0, 0, 0);
                    }
            }
#pragma unroll
            for (int d0 = 0; d0 < 2; ++d0)
#pragma unroll
                for (int r = 0; r < 16; r += 2) opk[qb][d0][r >> 1] = pk2(o[d0][r] * inv, o[d0][r + 1] * inv);
        }
        __syncthreads();
#pragma unroll
        for (int qb = 0; qb < 2; ++qb)
#pragma unroll
            for (int d0 = 0; d0 < 2; ++d0)
#pragma unroll
                for (int g = 0; g < 4; ++g) { v2u w; w.x = opk[qb][d0][2 * g]; w.y = opk[qb][d0][2 * g + 1];
                    *(LAS v2u*)(ya + (32 * qb + r32) * 512 + 64 * wave + 32 * d0 + 8 * g + 4 * hi) = w; }
        __syncthreads();
#pragma unroll
        for (int i = 0; i < 8; ++i) { const int tok = 8 * wave + i;
            const v4u w0 = *(const LAS v4u*)(ya + tok * 512 + 8 * lane);
            const float x0 = bflo(w0.x), x1 = bfhi(w0.x), x2 = bflo(w0.y), x3 = bfhi(w0.y), x4 = bflo(w0.z), x5 = bfhi(w0.z), x6 = bflo(w0.w), x7 = bfhi(w0.w);
            const float ss = wave_sum((x0 * x0 + x1 * x1) + (x2 * x2 + x3 * x3) + (x4 * x4 + x5 * x5) + (x6 * x6 + x7 * x7));
            const float rstd = 1.0f / sqrtf(ss * (1.0f / 512.0f) + RMS_EPS);
            v2u w; w.x = pg8::pk4_fp8(x0 * rstd, x1 * rstd, x2 * rstd, x3 * rstd); w.y = pg8::pk4_fp8(x4 * rstd, x5 * rstd, x6 * rstd, x7 * rstd);
            *(v2u*)(Y8 + (row0 + tok) * DM + 8 * lane) = w; }
    }
}

struct LnRow { f32x4 x[2][2]; v4u xb[2]; v4u a[2], b[2]; };
template <int MODE, bool RES16>
__device__ __forceinline__ void ln_load_row(LnRow& L, const float* xres, const bf16* TB, const bf16* Y2, int m, int p0, int p1, int lane) {
#pragma unroll
    for (int j = 0; j < 2; ++j) {
        if (RES16) L.xb[j] = *(const v4u*)((const bf16*)xres + (size_t)m * DM + 8 * lane + 512 * j);
        else {
#pragma unroll
            for (int h = 0; h < 2; ++h) L.x[j][h] = *(const f32x4*)(xres + (size_t)m * DM + 8 * lane + 512 * j + 4 * h); }
        if (MODE != 2) L.a[j] = *(const v4u*)(TB + (size_t)m * DM + 8 * lane + 512 * j);
        else { L.a[j] = *(const v4u*)(Y2 + (size_t)p0 * DM + 8 * lane + 512 * j); L.b[j] = *(const v4u*)(Y2 + (size_t)p1 * DM + 8 * lane + 512 * j); }
    }
}
template <int MODE, bool RES16 = false, bool OUT16 = false>
__device__ __forceinline__ void p_layernorm(const Frame& F, const Args& A, const float* gam, const float* bet, const float* xres, bf16* xout = nullptr) {
    unsigned char* ws = A.ws;
    float* X = A.out;
    unsigned char* XB = ws + WS_A;
    const bf16* TB = (const bf16*)(ws + WS_TB);
    const bf16* Y2 = (const bf16*)(ws + WS_Y2);
    LAS unsigned* misc = (LAS unsigned*)(F.lds + LDS_MISC);
    const int lane = F.lane;
    LAS float* rwl = (LAS float*)F.lds;
    if (MODE == 1) { if (F.tid < 8) misc[F.tid] = 0u;
        for (int k = F.tid; k < DM; k += NTHREADS) { const f32x4 a = *(const f32x4*)(A.in[19] + k * 8), c = *(const f32x4*)(A.in[19] + k * 8 + 4);
            const int q = 8 * (k >> 9) + (k & 7), lk = (k & 511) >> 3; *(LAS f32x4*)(rwl + (q * 64 + lk) * 8) = a; *(LAS f32x4*)(rwl + (q * 64 + lk) * 8 + 4) = c; }
        __syncthreads(); }
    f32x4 gv[2][2], bv[2][2];
#pragma unroll
    for (int j = 0; j < 2; ++j)
#pragma unroll
        for (int h = 0; h < 2; ++h) { gv[j][h] = *(const f32x4*)(gam + 8 * lane + 512 * j + 4 * h); bv[j][h] = *(const f32x4*)(bet + 8 * lane + 512 * j + 4 * h); }
    const int rpw = NTOK / F.G, nt = rpw / NWAVES;
    const int m0 = F.blk * rpw + F.wave;
    int P0 = 0, P1 = 0; float W0 = 0.f, W1 = 0.f;
    if (MODE == 2) { if (lane < nt) { const int m = m0 + NWAVES * lane; P0 = ((const int*)(ws + WS_TOKPOS))[2 * m]; P1 = ((const int*)(ws + WS_TOKPOS))[2 * m + 1];
        W0 = ((const float*)(ws + WS_TOKW))[2 * m]; W1 = ((const float*)(ws + WS_TOKW))[2 * m + 1]; } }
    constexpr bool DEEP = (MODE != 1);
    LnRow cur[2], nxt[2], nx2[2];
#pragma unroll
    for (int r = 0; r < 2; ++r) ln_load_row<MODE, RES16>(cur[r], xres, TB, Y2, m0 + NWAVES * r, __shfl(P0, r), __shfl(P1, r), lane);
    if (DEEP) {
#pragma unroll
        for (int r = 0; r < 2; ++r) ln_load_row<MODE, RES16>(nxt[r], xres, TB, Y2, m0 + NWAVES * (2 + r), __shfl(P0, 2 + r), __shfl(P1, 2 + r), lane);
    }
    for (int t = 0; t < nt; t += 2) {
        if (DEEP) {
            if (t + 4 < nt) {
#pragma unroll
                for (int r = 0; r < 2; ++r) ln_load_row<MODE, RES16>(nx2[r], xres, TB, Y2, m0 + NWAVES * (t + 4 + r), __shfl(P0, t + 4 + r), __shfl(P1, t + 4 + r), lane);
            }
        } else if (t + 2 < nt) {
#pragma unroll
            for (int r = 0; r < 2; ++r) ln_load_row<MODE, RES16>(nxt[r], xres, TB, Y2, m0 + NWAVES * (t + 2 + r), __shfl(P0, t + 2 + r), __shfl(P1, t + 2 + r), lane);
        }
        asm volatile("" ::: "memory");
#pragma unroll
        for (int r = 0; r < 2; ++r) {
            const int m = m0 + NWAVES * (t + r);
            const LnRow& L = cur[r];
            float v[16];
            if (MODE != 2) {
#pragma unroll
                for (int j = 0; j < 2; ++j) { const v4u a = L.a[j]; f32x4 x0 = L.x[j][0], x1 = L.x[j][1];
                    if (RES16) { const v4u xw = L.xb[j]; x0 = (f32x4){bflo(xw.x), bfhi(xw.x), bflo(xw.y), bfhi(xw.y)}; x1 = (f32x4){bflo(xw.z), bfhi(xw.z), bflo(xw.w), bfhi(xw.w)}; }
                    v[8 * j + 0] = ALPHA * x0.x + bflo(a.x); v[8 * j + 1] = ALPHA * x0.y + bfhi(a.x); v[8 * j + 2] = ALPHA * x0.z + bflo(a.y); v[8 * j + 3] = ALPHA * x0.w + bfhi(a.y);
                    v[8 * j + 4] = ALPHA * x1.x + bflo(a.z); v[8 * j + 5] = ALPHA * x1.y + bfhi(a.z); v[8 * j + 6] = ALPHA * x1.z + bflo(a.w); v[8 * j + 7] = ALPHA * x1.w + bfhi(a.w); }
            } else {
                const float w0 = __shfl(W0, t + r), w1 = __shfl(W1, t + r);
#pragma unroll
                for (int j = 0; j < 2; ++j) { const v4u a = L.a[j], c = L.b[j]; const f32x4 x0 = L.x[j][0], x1 = L.x[j][1];
                    v[8 * j + 0] = ALPHA * x0.x + w0 * bflo(a.x) + w1 * bflo(c.x); v[8 * j + 1] = ALPHA * x0.y + w0 * bfhi(a.x) + w1 * bfhi(c.x);
                    v[8 * j + 2] = ALPHA * x0.z + w0 * bflo(a.y) + w1 * bflo(c.y); v[8 * j + 3] = ALPHA * x0.w + w0 * bfhi(a.y) + w1 * bfhi(c.y);
                    v[8 * j + 4] = ALPHA * x1.x + w0 * bflo(a.z) + w1 * bflo(c.z); v[8 * j + 5] = ALPHA * x1.y + w0 * bfhi(a.z) + w1 * bfhi(c.z);
                    v[8 * j + 6] = ALPHA * x1.z + w0 * bflo(a.w) + w1 * bflo(c.w); v[8 * j + 7] = ALPHA * x1.w + w0 * bfhi(a.w) + w1 * bfhi(c.w); }
            }
            float s = 0.f;
#pragma unroll
            for (int q = 0; q < 16; ++q) s += v[q];
            const float mean = wave_sum(s) * (1.f / DM); float s2 = 0.f;
#pragma unroll
            for (int q = 0; q < 16; ++q) { v[q] -= mean; s2 += v[q] * v[q]; }
            const float rstd = __builtin_amdgcn_rsqf(wave_sum(s2) * (1.f / DM) + LN_EPS);
#pragma unroll
            for (int j = 0; j < 2; ++j) {
#pragma unroll
                for (int h = 0; h < 2; ++h) { f32x4 o;
#pragma unroll
                    for (int e = 0; e < 4; ++e) { o[e] = v[8 * j + 4 * h + e] * rstd * gv[j][h][e] + bv[j][h][e]; v[8 * j + 4 * h + e] = o[e]; }
                    if (!OUT16) *(f32x4*)(X + (size_t)m * DM + 8 * lane + 512 * j + 4 * h) = o; }
                if (OUT16) { v4u w; w.x = pk2(v[8 * j], v[8 * j + 1]); w.y = pk2(v[8 * j + 2], v[8 * j + 3]); w.z = pk2(v[8 * j + 4], v[8 * j + 5]); w.w = pk2(v[8 * j + 6], v[8 * j + 7]);
                    *(v4u*)(xout + (size_t)m * DM + 8 * lane + 512 * j) = w; }
            }
            if (MODE == 3) {
#pragma unroll
                for (int j = 0; j < 2; ++j) { v2u w;
                    w.x = pg8::pk4_i8(v[8 * j], v[8 * j + 1], v[8 * j + 2], v[8 * j + 3], SA_X); w.y = pg8::pk4_i8(v[8 * j + 4], v[8 * j + 5], v[8 * j + 6], v[8 * j + 7], SA_X);
                    *(v2u*)(XB + (size_t)m * DM + 8 * lane + 512 * j) = w; }
            }
            if (MODE == 1) {
                float lg[8];
#pragma unroll
                for (int e = 0; e < 8; ++e) lg[e] = 0.f;
#pragma unroll
                for (int q = 0; q < 16; ++q) { const f32x4 a = *(const LAS f32x4*)(rwl + (q * 64 + lane) * 8), c = *(const LAS f32x4*)(rwl + (q * 64 + lane) * 8 + 4); const float xq = v[q];
                    lg[0] += xq * a.x; lg[1] += xq * a.y; lg[2] += xq * a.z; lg[3] += xq * a.w; lg[4] += xq * c.x; lg[5] += xq * c.y; lg[6] += xq * c.z; lg[7] += xq * c.w; }
#pragma unroll
                for (int e = 0; e < 8; ++e) lg[e] = wave_sum(lg[e]);
                int e0 = 0; float v0 = lg[0];
#pragma unroll
                for (int e = 1; e < 8; ++e) if (lg[e] > v0) { v0 = lg[e]; e0 = e; }
                int e1 = -1; float v1 = -3.0e38f;
#pragma unroll
                for (int e = 0; e < 8; ++e) if (e != e0 && lg[e] > v1) { v1 = lg[e]; e1 = e; }
                const float g0 = 1.0f / (1.0f + __expf(v1 - v0)), g1 = 1.0f - g0;
                if (lane == 0) { int* te = (int*)(ws + WS_TOKE) + 2 * m; float* tw = (float*)(ws + WS_TOKW) + 2 * m; te[0] = e0; te[1] = e1; tw[0] = g0; tw[1] = g1;
                    atomicAdd((unsigned*)(misc + e0), 1u); atomicAdd((unsigned*)(misc + e1), 1u); }
            }
        }
        if (t + 2 < nt) { cur[0] = nxt[0]; cur[1] = nxt[1]; if (DEEP) { nxt[0] = nx2[0]; nxt[1] = nx2[1]; } }
    }
    if (MODE == 1) { __syncthreads(); if (F.tid < 8) ((unsigned*)(ws + WS_HIST))[F.blk * 8 + F.tid] = misc[F.tid]; }
}

__device__ __forceinline__ void p_route(const Frame& F, const Args& A) {
    unsigned char* ws = A.ws;
    LAS unsigned* misc = (LAS unsigned*)(F.lds + LDS_MISC);
    LAS int* posl = (LAS int*)(F.lds + LDS_POS);
    const unsigned* hist = (const unsigned*)(ws + WS_HIST);
    const int lane = F.lane, rpw = NTOK / F.G;
    {
        const int e = F.wave; unsigned tot = 0u, bef = 0u;
        for (int v = lane; v < F.G; v += 64) { const unsigned h = hist[v * 8 + e]; tot += h; if (v < F.blk) bef += h; }
#pragma unroll
        for (int o = 1; o < 64; o <<= 1) { tot += __shfl_xor(tot, o); bef += __shfl_xor(bef, o); }
        if (lane == 0) { misc[16 + e] = tot; misc[24 + e] = bef; }
    }
    __syncthreads();
    int seg[9]; seg[0] = 0;
#pragma unroll
    for (int e = 0; e < 8; ++e) seg[e + 1] = seg[e] + (int)((misc[16 + e] + 255u) >> 8);
    if (F.blk == 0 && F.tid == 0) { int* meta = (int*)(ws + WS_META);
#pragma unroll
        for (int e = 0; e < 9; ++e) meta[e] = seg[e];
        meta[9] = seg[8]; }
    if (F.wave == 0) {
        const int* te = (const int*)(ws + WS_TOKE); int* tp = (int*)(ws + WS_TOKPOS); int* rt = nullptr; (void)rt;
        unsigned run[8];
#pragma unroll
        for (int e = 0; e < 8; ++e) run[e] = (unsigned)seg[e] * 256u + misc[24 + e];
        for (int h = 0; h < rpw; h += 64) {
            const int m = F.blk * rpw + h + lane;
#pragma unroll
            for (int k = 0; k < 2; ++k) {
                const int ek = te[2 * m + k]; int pos = 0;
#pragma unroll
                for (int e = 0; e < 8; ++e) { const unsigned long long mask = __ballot(ek == e);
                    if (ek == e) pos = (int)(run[e] + (unsigned)__popcll(mask & ((1ull << lane) - 1ull)));
                    run[e] += (unsigned)__popcll(mask); }
                tp[2 * m + k] = pos; posl[2 * (h + lane) + k] = pos;
            }
        }
    }
    __syncthreads();
    {
        const float* X = A.out; unsigned char* XS = ws + WS_XS;
        f32x4 cur[2][4], nxt[2][4];
#pragma unroll
        for (int r = 0; r < 2; ++r) { const f32x4* xr = (const f32x4*)(X + (size_t)(F.blk * rpw + F.wave + NWAVES * r) * DM) + 4 * lane;
#pragma unroll
            for (int q = 0; q < 4; ++q) cur[r][q] = xr[q]; }
        for (int i = F.wave; i < rpw; i += 2 * NWAVES) {
            const bool more = (i + 2 * NWAVES < rpw);
            if (more) {
#pragma unroll
                for (int r = 0; r < 2; ++r) { const f32x4* xr = (const f32x4*)(X + (size_t)(F.blk * rpw + i + NWAVES * (2 + r)) * DM) + 4 * lane;
#pragma unroll
                    for (int q = 0; q < 4; ++q) nxt[r][q] = xr[q]; }
            }
            asm volatile("" ::: "memory");
#pragma unroll
            for (int r = 0; r < 2; ++r) { const int ii = i + NWAVES * r; const int p0 = posl[2 * ii], p1 = posl[2 * ii + 1];
                v4u w; w.x = pg8::pk4_i8(cur[r][0].x, cur[r][0].y, cur[r][0].z, cur[r][0].w, SA_X); w.y = pg8::pk4_i8(cur[r][1].x, cur[r][1].y, cur[r][1].z, cur[r][1].w, SA_X);
                w.z = pg8::pk4_i8(cur[r][2].x, cur[r][2].y, cur[r][2].z, cur[r][2].w, SA_X); w.w = pg8::pk4_i8(cur[r][3].x, cur[r][3].y, cur[r][3].z, cur[r][3].w, SA_X);
                *((v4u*)(XS + (size_t)p0 * DM) + lane) = w; *((v4u*)(XS + (size_t)p1 * DM) + lane) = w; }
            if (more) {
#pragma unroll
                for (int r = 0; r < 2; ++r)
#pragma unroll
                    for (int q = 0; q < 4; ++q) cur[r][q] = nxt[r][q]; }
        }
    }
    if (F.blk < 8) {
        int r0 = 0, r1 = 0;
#pragma unroll
        for (int e = 0; e < 8; ++e) if (e == F.blk) { r0 = seg[e] * 256 + (int)misc[16 + e]; r1 = seg[e + 1] * 256; }
        v4u* XS4 = (v4u*)(ws + WS_XS);
        for (size_t i = (size_t)r0 * 64 + F.tid; i < (size_t)r1 * 64; i += NTHREADS) XS4[i] = (v4u){0u, 0u, 0u, 0u};
    }
}

#ifndef MK_ONE_LAUNCH
#define MK_ONE_LAUNCH 1
#endif
constexpr int PH_MOE = 17, PH_FINAL = PH_MOE + 2 * NPASS, NPHASES = PH_FINAL + 1;

#ifndef PH_MASK
#define PH_MASK 0xFFFFFFFFu
#endif
#ifndef DUP_MASK
#define DUP_MASK 0u
#endif
#define NREP(k) ((((unsigned)DUP_MASK >> (k)) & 1u) ? 2 : 1)
#define IN(k) (((PH_MASK >> (k)) & 1u) && lo <= (k) && (k) < hi)
#define SEAM(k) do { if (MK_ONE_LAUNCH && lo <= (k) && (k) + 1 < hi) xcd_barrier(bar); } while (0)
template <int l>
__device__ __forceinline__ void layer_phases(const Frame& F, const Args& args, const XcdBarrier& bar, const int lo, const int hi) {
    unsigned char* ws = args.ws;
        const int pb = 1 + 9 * l;
        const float* xres = (l == 0) ? args.in[0] : args.out;
        if (IN(pb + 0)) {
            pg8::Gemm g{(const bf16*)(ws + WS_A), (const bf16*)(ws + WS_WIN + (size_t)l * INC * DM), NTOK, INC, DM / 2, 0};
            pg8::StaticOrder S; S.init(NTOK, INC, F.G, F.blk, NREP(pb + 0));
            pg8::EpiBf16 E{(bf16*)(ws + WS_ZH), INC, 1.0f / (SA_X * SW_IN), QSCALE / (SA_X * SW_IN), 2};
            pg8::gemm_phase<pg8::EpiBf16, pg8::StaticOrder, true, true, 2>(F.lds, g, S, E);
            SEAM(pb + 0);
        }
        if (IN(pb + 1)) { p_lru_summary(F, args, l, NREP(pb + 1)); SEAM(pb + 1); }
        if (IN(pb + 2)) for (int rep_ = 0; rep_ < NREP(pb + 2); ++rep_) { p_lru_carry(F, args); SEAM(pb + 2); }
        if (IN(pb + 3)) { p_mixer(F, args, l, NREP(pb + 3)); SEAM(pb + 3); }
        if (IN(pb + 4)) {
            pg8::Gemm g{(const bf16*)(ws + WS_A), (const bf16*)(ws + WS_WOUT + (size_t)l * DM * DM), NTOK, DM, DM / 2, 0};
            pg8::StaticOrder S; S.init(NTOK, DM, F.G, F.blk, NREP(pb + 4));
            pg8::EpiBf16 E{(bf16*)(ws + WS_TB), DM, 1.0f / WSC_OUT, 1.0f / WSC_OUT, 0};
            pg8::gemm_phase<pg8::EpiBf16, pg8::StaticOrder, true, true, 1>(F.lds, g, S, E);
            SEAM(pb + 4);
        }
        if (l == 0) {
            if (IN(6)) for (int rep_ = 0; rep_ < NREP(6); ++rep_) { p_layernorm<3, false, true>(F, args, args.in[14], args.in[15], args.in[0], (bf16*)(ws + WS_XR)); SEAM(6); }
            if (IN(7)) {
                pg8::Gemm g{(const bf16*)(ws + WS_A), (const bf16*)(ws + WS_WGU), NTOK, 2 * DFF, DM / 2, 0};
                pg8::StaticOrder S; S.init(NTOK, 2 * DFF, F.G, F.blk, NREP(7));
                pg8::EpiSwiGLU8 E{ws + WS_ZH, DFF, 1.0f / (SA_X * SW_GU)};
                pg8::gemm_phase<pg8::EpiSwiGLU8, pg8::StaticOrder, true, true, 2>(F.lds, g, S, E);
                SEAM(7);
            }
            if (IN(8)) {
                pg8::Gemm g{(const bf16*)(ws + WS_ZH), (const bf16*)(ws + WS_WD), NTOK, DM, DFF / 2, 0};
                pg8::StaticOrder S; S.init(NTOK, DM, F.G, F.blk, NREP(8));
                pg8::EpiBf16 E{(bf16*)(ws + WS_TB), DM, 1.0f / WSC_D, 1.0f / WSC_D, 0};
                pg8::gemm_phase<pg8::EpiBf16, pg8::StaticOrder, true, true, 1>(F.lds, g, S, E);
                SEAM(8);
            }
            if (IN(9)) for (int rep_ = 0; rep_ < NREP(9); ++rep_) { p_layernorm<3, true, true>(F, args, args.in[23], args.in[24], (const float*)(ws + WS_XR), (bf16*)(ws + WS_XR)); SEAM(9); }
        } else {
            if (IN(15)) for (int rep_ = 0; rep_ < NREP(15); ++rep_) { p_layernorm<1, true, false>(F, args, args.in[14] + DM, args.in[15] + DM, (const float*)(ws + WS_XR)); SEAM(15); }
            if (IN(16)) for (int rep_ = 0; rep_ < NREP(16); ++rep_) { p_route(F, args); SEAM(16); }
            for (int p = 0; p < NPASS; ++p) {
                int s1 = 0, s2 = 0, s3 = 0, s4 = 0, s5 = 0, s6 = 0, s7 = 0, nt = 0;
                if (IN(PH_MOE + 2 * p) || IN(PH_MOE + 1 + 2 * p)) { const int* meta = (const int*)(ws + WS_META);
                    s1 = __builtin_amdgcn_readfirstlane(meta[1]); s2 = __builtin_amdgcn_readfirstlane(meta[2]); s3 = __builtin_amdgcn_readfirstlane(meta[3]); s4 = __builtin_amdgcn_readfirstlane(meta[4]);
                    s5 = __builtin_amdgcn_readfirstlane(meta[5]); s6 = __builtin_amdgcn_readfirstlane(meta[6]); s7 = __builtin_amdgcn_readfirstlane(meta[7]); nt = __builtin_amdgcn_readfirstlane(meta[9]); }
                int nm = nt - PASS_TILES * p; nm = nm > PASS_TILES ? PASS_TILES : nm;
                if (IN(PH_MOE + 2 * p)) {
                    if (nm > 0) {
                        pg8::Gemm g{(const bf16*)(ws + WS_XS + (size_t)p * PASS_TILES * 256 * DM), (const bf16*)(ws + WS_WEGU), nm * 256, 2 * DFE, DM / 2, (size_t)2 * DFE * DM};
                        pg8::MoeOrder S; S.so.init(nm * 256, 2 * DFE, F.G, F.blk, NREP(PH_MOE + 2 * p)); S.tile0 = p * PASS_TILES; S.s1 = s1; S.s2 = s2; S.s3 = s3; S.s4 = s4; S.s5 = s5; S.s6 = s6; S.s7 = s7;
                        pg8::EpiSwiGLU8 E{ws + WS_HM, DFE, 1.0f / (SA_X * SW_GU)};
                        pg8::gemm_phase<pg8::EpiSwiGLU8, pg8::MoeOrder, true, true, 2>(F.lds, g, S, E);
                    }
                    SEAM(PH_MOE + 2 * p);
                }
                if (IN(PH_MOE + 1 + 2 * p)) {
                    if (nm > 0) {
                        pg8::Gemm g{(const bf16*)(ws + WS_HM), (const bf16*)(ws + WS_WED), nm * 256, DM, DFE / 2, (size_t)DM * DFE};
                        pg8::MoeOrder S; S.so.init(nm * 256, DM, F.G, F.blk, NREP(PH_MOE + 1 + 2 * p)); S.tile0 = p * PASS_TILES; S.s1 = s1; S.s2 = s2; S.s3 = s3; S.s4 = s4; S.s5 = s5; S.s6 = s6; S.s7 = s7;
                        pg8::EpiBf16 E{(bf16*)(ws + WS_Y2) + (size_t)p * PASS_TILES * 256 * DM, DM, 1.0f / WSC_D, 1.0f / WSC_D, 0};
                        pg8::gemm_phase<pg8::EpiBf16, pg8::MoeOrder, true, true, 1>(F.lds, g, S, E);
                    }
                    SEAM(PH_MOE + 1 + 2 * p);
                }
            }
            if (IN(PH_FINAL)) for (int rep_ = 0; rep_ < NREP(PH_FINAL); ++rep_) { p_layernorm<2>(F, args, args.in[23] + DM, args.in[24] + DM, args.out); }
        }
}
__global__ void __launch_bounds__(NTHREADS, 2) fwd_kernel(Args args) {
    extern __shared__ __attribute__((aligned(16))) unsigned char lds_raw[];
    Frame F;
    F.lds = (LAS unsigned char*)lds_raw;
    F.tid = threadIdx.x; F.lane = F.tid & 63; F.wave = __builtin_amdgcn_readfirstlane(F.tid >> 6);
    F.G = gridDim.x; F.blk = blockIdx.x;
    unsigned char* ws = args.ws;
    volatile LAS unsigned* MISC = (volatile LAS unsigned*)(F.lds + LDS_MISC);
    if (F.tid < 64) MISC[F.tid] = 0u;
    __syncthreads();
    XcdBarrier bar; bar.bar = (unsigned*)(ws + WS_CTL) + CW_BAR; bar.x = 0; bar.st = nullptr;
    if (MK_ONE_LAUNCH) bar = xcd_barrier_post((unsigned*)(ws + WS_CTL) + CW_BAR, MISC + 8);
    const int lo = args.ph_lo, hi = args.ph_hi;

    if (IN(0)) for (int rep_ = 0; rep_ < NREP(0); ++rep_) { p0_prologue(F, args); SEAM(0); }

    layer_phases<0>(F, args, bar, lo, hi);
    layer_phases<1>(F, args, bar, lo, hi);
}

extern "C" void kernel_launch(void* const* d_in, const int* in_sizes, int n_in, void* d_out, int out_size, void* d_ws, size_t ws_size, hipStream_t stream) {
    static int grid = 0;
    if (grid == 0) {
        if (n_in != 25 || in_sizes[0] != NTOK * DM || out_size != NTOK * DM || ws_size < WS_END) {
            fprintf(stderr, "kernel_launch: unexpected problem: n_in %d in0 %d out %d ws %zu (need %zu)\n", n_in, n_in > 0 ? in_sizes[0] : -1, out_size, ws_size, (size_t)WS_END); grid = -1; return; }
        int dev = 0, cus = 0, per_cu = 0;
        if (hipGetDevice(&dev) != hipSuccess || hipDeviceGetAttribute(&cus, hipDeviceAttributeMultiprocessorCount, dev) != hipSuccess) { fprintf(stderr, "kernel_launch: device query failed\n"); grid = -1; return; }
        if (hipFuncSetAttribute((const void*)fwd_kernel, hipFuncAttributeMaxDynamicSharedMemorySize, LDS_BYTES) != hipSuccess) { fprintf(stderr, "kernel_launch: hipFuncSetAttribute failed\n"); grid = -1; return; }
        if (hipOccupancyMaxActiveBlocksPerMultiprocessor(&per_cu, (const void*)fwd_kernel, NTHREADS, LDS_BYTES) != hipSuccess || per_cu < 1)
            fprintf(stderr, "kernel_launch: note: occupancy query reports %d workgroups per CU\n", per_cu);
        (void)hipGetLastError();
        grid = cus;
        if (grid != 256) fprintf(stderr, "kernel_launch: note: %d CUs (built for 256)\n", grid);
        if (NTOK % grid != 0 || grid > 256) grid = 256;
    }
    if (grid < 0) return;
    (void)hipMemsetAsync((char*)d_ws + WS_CTL, 0, CTL_ZERO_BYTES, stream);
    Args a{};
    for (int i = 0; i < 25; ++i) a.in[i] = (const float*)d_in[i];
    a.out = (float*)d_out; a.ws = (unsigned char*)d_ws;
#if MK_ONE_LAUNCH
    a.ph_lo = 0; a.ph_hi = NPHASES;
    hipLaunchKernelGGL(fwd_kernel, dim3(grid), dim3(NTHREADS), LDS_BYTES, stream, a);
#else
    for (int k = 0; k < NPHASES; ++k) { a.ph_lo = k; a.ph_hi = k + 1; hipLaunchKernelGGL(fwd_kernel, dim3(grid), dim3(NTHREADS), LDS_BYTES, stream, a); }
#endif
    const hipError_t le = hipPeekAtLastError();
    if (le != hipSuccess) fprintf(stderr, "kernel_launch: launch failed: %s\n", hipGetErrorName(le));
}
```
